# Optimizing an MI355X kernel written in HIP

```python
import jax, jax.numpy as jnp
from jax import lax
import numpy as np

D_MODEL = 1024
BATCH = 1
SEQ = 16384
DEPTH = 2
DEC_BATCH = 8
DEC_SEQ = 8192
PAST_LEN = 128

D_LRU = D_MODEL
N_LRU_HEADS = 8
LRU_BLOCK = D_LRU // N_LRU_HEADS
CONV_WIDTH = 4
CONV_LEFT = CONV_WIDTH // 2
LRU_C = 8.0
N_DIRS = 2
D_FOURIER = D_MODEL
N_FOURIER_GROUPS = 4
FOURIER_GROUP = D_FOURIER // N_FOURIER_GROUPS
N_BRANCHES = 2
D_IN = 2 * D_LRU + 2 * D_FOURIER + N_BRANCHES * D_MODEL
EPS = 1e-6

kernel_name = "hawk_fnet_parallel_adaln_encoder"


def rms_norm(x, g):
    xf = x.astype(jnp.float32)
    y = xf * lax.rsqrt(jnp.mean(xf * xf, axis=-1, keepdims=True) + EPS)
    return (y * g.astype(jnp.float32)).astype(x.dtype)


def centred_dwconv(x, w, b):
    S = x.shape[1]
    xp = jnp.pad(x, ((0, 0), (CONV_LEFT, CONV_WIDTH - 1 - CONV_LEFT), (0, 0)))
    y = xp[:, 0:S] * w[0] + b
    for k in range(1, CONV_WIDTH):
        y = y + xp[:, k:k + S] * w[k]
    return y


def _lin_combine(left, right):
    a1, b1 = left
    a2, b2 = right
    return a1 * a2, a2 * b1 + b2


def rg_lru(x, w_gates, b_gates, lam, reverse):
    Bn, S, _ = x.shape
    xf = x.astype(jnp.float32)
    xh = xf.reshape(Bn, S, N_LRU_HEADS, LRU_BLOCK)
    g = jnp.einsum('bshi,ghij->gbshj', xh, w_gates.astype(jnp.float32)).reshape(2, Bn, S, D_LRU)
    g = g + b_gates.astype(jnp.float32)[:, None, None, :]
    r = jax.nn.sigmoid(g[0])
    i = jax.nn.sigmoid(g[1])
    log_a = -LRU_C * r * jax.nn.softplus(-lam.astype(jnp.float32))
    a = jnp.exp(log_a)
    mult = jnp.sqrt(-jnp.expm1(2.0 * log_a))
    start = (S - 1) if reverse else 0
    is_start = (jnp.arange(S) == start)[None, :, None]
    mult = jnp.where(is_start, 1.0, mult)
    _, h = lax.associative_scan(_lin_combine, (a, mult * i * xf), reverse=reverse, axis=1)
    return h


def fourier_mix(x):
    Bn, S, _ = x.shape
    xg = x.astype(jnp.float32).reshape(Bn, S, N_FOURIER_GROUPS, FOURIER_GROUP)
    y = jnp.fft.fftn(xg, axes=(1, 3), norm="ortho").real
    return y.reshape(Bn, S, D_FOURIER)


def layer(x, c, norm_g, w_ada, b_ada, w_in, conv_w, conv_b, w_rg, b_rg, lam, w_a_out, w_b_out, w_o):
    mod = jax.nn.silu(c) @ w_ada + b_ada
    shift, scale, gate = jnp.split(mod, 3, axis=-1)
    h = rms_norm(x, norm_g) * (1.0 + scale[:, None, :]) + shift[:, None, :]
    proj = h @ w_in
    xa, ga, xb, gb, merge = jnp.split(
        proj, [D_LRU, 2 * D_LRU, 2 * D_LRU + D_FOURIER, 2 * D_LRU + 2 * D_FOURIER], axis=-1)
    xa = centred_dwconv(xa, conv_w, conv_b)
    ya = rg_lru(xa, w_rg[0], b_rg[0], lam[0], False) + rg_lru(xa, w_rg[1], b_rg[1], lam[1], True)
    ya = (ya.astype(x.dtype) * jax.nn.silu(ga)) @ w_a_out
    yb = (fourier_mix(xb).astype(x.dtype) * jax.nn.silu(gb)) @ w_b_out
    sa, sb = jnp.split(jax.nn.sigmoid(merge), 2, axis=-1)
    out = (sa * ya + sb * yb) @ w_o
    return x + gate[:, None, :] * out


def trunk(x, c, norm_g, w_ada, b_ada, w_in, conv_w, conv_b, w_rg, b_rg, lam, w_a_out, w_b_out, w_o, final_g):
    for l in range(DEPTH):
        x = layer(x, c, norm_g[l], w_ada[l], b_ada[l], w_in[l], conv_w[l], conv_b[l],
                  w_rg[l], b_rg[l], lam[l], w_a_out[l], w_b_out[l], w_o[l])
    return rms_norm(x, final_g)


def setup_inputs(seed: int = 0) -> dict:
    key = jax.random.key(seed)
    ks = jax.random.split(key, 20)
    f32 = jnp.float32
    x_prompt = jax.random.normal(ks[0], (BATCH, SEQ, D_MODEL), f32)
    x_sample = jax.random.normal(ks[1], (DEC_BATCH, DEC_SEQ, D_MODEL), f32)
    c_prompt = jax.random.normal(ks[2], (BATCH, D_MODEL), f32)
    c_sample = jax.random.normal(ks[3], (DEC_BATCH, D_MODEL), f32)
    norm_g = 1.0 + 0.05 * jax.random.normal(ks[4], (DEPTH, D_MODEL), f32)
    w_ada = jax.random.normal(ks[5], (DEPTH, D_MODEL, 3 * D_MODEL), f32) * (0.5 * D_MODEL ** -0.5)
    b_ada = 0.02 * jax.random.normal(ks[6], (DEPTH, 3 * D_MODEL), f32)
    w_in = jax.random.normal(ks[7], (DEPTH, D_MODEL, D_IN), f32) * D_MODEL ** -0.5
    conv_w = jax.random.normal(ks[8], (DEPTH, CONV_WIDTH, D_LRU), f32) * CONV_WIDTH ** -0.5
    conv_b = 0.02 * jax.random.normal(ks[9], (DEPTH, D_LRU), f32)
    w_rg = jax.random.normal(ks[10], (DEPTH, N_DIRS, 2, N_LRU_HEADS, LRU_BLOCK, LRU_BLOCK), f32) * LRU_BLOCK ** -0.5
    b_rg = 0.02 * jax.random.normal(ks[11], (DEPTH, N_DIRS, 2, D_LRU), f32)
    u = jax.random.uniform(ks[12], (DEPTH, N_DIRS, D_LRU), f32, minval=0.9, maxval=0.999)
    a0 = u ** (1.0 / LRU_C)
    lam = jnp.log(a0) - jnp.log1p(-a0)
    w_a_out = jax.random.normal(ks[13], (DEPTH, D_LRU, D_MODEL), f32) * D_LRU ** -0.5
    w_b_out = jax.random.normal(ks[14], (DEPTH, D_FOURIER, D_MODEL), f32) * D_FOURIER ** -0.5
    w_o = jax.random.normal(ks[15], (DEPTH, D_MODEL, D_MODEL), f32) * D_MODEL ** -0.5
    final_g = 1.0 + 0.05 * jax.random.normal(ks[16], (D_MODEL,), f32)
    return {"x_prompt": x_prompt, "x_sample": x_sample, "c_prompt": c_prompt, "c_sample": c_sample,
            "norm_g": norm_g, "w_ada": w_ada, "b_ada": b_ada, "w_in": w_in,
            "conv_w": conv_w, "conv_b": conv_b, "w_rg": w_rg, "b_rg": b_rg, "lam": lam,
            "w_a_out": w_a_out, "w_b_out": w_b_out, "w_o": w_o, "final_g": final_g}


def reference(x_prompt, x_sample, c_prompt, c_sample, norm_g, w_ada, b_ada, w_in, conv_w, conv_b,
              w_rg, b_rg, lam, w_a_out, w_b_out, w_o, final_g):
    y_prompt = trunk(x_prompt, c_prompt, norm_g, w_ada, b_ada, w_in, conv_w, conv_b, w_rg, b_rg, lam,
                     w_a_out, w_b_out, w_o, final_g)
    y_sample = trunk(x_sample, c_sample, norm_g, w_ada, b_ada, w_in, conv_w, conv_b, w_rg, b_rg, lam,
                     w_a_out, w_b_out, w_o, final_g)
    return (y_prompt, y_sample)
```

```cpp
#include <hip/hip_runtime.h>
#include <hip/hip_cooperative_groups.h>
#include <cstdio>
namespace cg = cooperative_groups;

typedef unsigned short u16;
typedef __attribute__((ext_vector_type(8))) short bf16x8;
typedef __attribute__((ext_vector_type(4))) float f32x4;

#define DEVFN __device__ __forceinline__

constexpr int D = 1024;
constexpr int T_TOT = 81920;
constexpr long UNIT = (long)T_TOT * D;
constexpr int D_IN = 6144;

constexpr long OFF_W = 6 * UNIT;
constexpr long W_CAT = 0;
constexpr long W_A = 7168L * 1024;
constexpr long W_B = W_A + 1048576;
constexpr long W_O = W_B + 1048576;
constexpr long W_RG = W_O + 1048576;
constexpr long LW = W_RG + 524288;
constexpr long OFF_TAB = OFF_W + 2 * LW;
constexpr long T_D1A = 0;
constexpr long T_D1B = 65536;
constexpr long T_D2 = T_D1B + 16384;
constexpr long T_DC = T_D2 + 32768;
constexpr long TAB_ELEMS = T_DC + 131072;
constexpr long OFF_TW_BYTES = (OFF_TAB + TAB_ELEMS) * 2;
constexpr long OFF_MOD_BYTES = OFF_TW_BYTES + 131072;
constexpr long OFF_BAR_BYTES = OFF_MOD_BYTES + 221184;
constexpr long WS_NEED = OFF_BAR_BYTES + 16384;

constexpr int TILE = 128 * 64;
constexpr int SMEM_BYTES = 65536;

struct Params {
  const float* x_prompt; const float* x_sample; const float* c_prompt; const float* c_sample;
  const float* norm_g; const float* w_ada; const float* b_ada; const float* w_in;
  const float* conv_w; const float* conv_b; const float* w_rg; const float* b_rg; const float* lam;
  const float* w_a_out; const float* w_b_out; const float* w_o; const float* final_g;
  float* out; unsigned char* ws;
};

typedef __attribute__((ext_vector_type(2))) float f32x2_t;
typedef __attribute__((ext_vector_type(2))) __bf16 bf16x2_t;
DEVFN u16 f2bf(float f) {
  __bf16 h = (__bf16)f;
  return *(u16*)&h;
}
DEVFN float bf2f(u16 h) { return __uint_as_float(((unsigned)h) << 16); }
DEVFN unsigned pack2(float a, float b) {
  f32x2_t v = {a, b};
  bf16x2_t r = __builtin_convertvector(v, bf16x2_t);
  return *(unsigned*)&r;
}
DEVFN float lo2f(unsigned v) { return __uint_as_float(v << 16); }
DEVFN float hi2f(unsigned v) { return __uint_as_float(v & 0xffff0000u); }
DEVFN float sigm(float x) { return __builtin_amdgcn_rcpf(1.f + __expf(-x)); }
DEVFN float silu(float x) { return x * __builtin_amdgcn_rcpf(1.f + __expf(-x)); }
DEVFN float one_minus_exp(float x) {
  float pl = -x * (1.f + x * (0.5f + x * (1.f / 6.f + x * (1.f / 24.f + x * (1.f / 120.f + x * (1.f / 720.f))))));
  float dr = 1.f - __expf(x);
  return x > -0.3f ? pl : dr;
}

DEVFN int otid() { int t = threadIdx.x; asm volatile("" : "+v"(t)); return t; }
DEVFN int seq_of(int g) { int seg = g >> 13; return seg < 2 ? 0 : seg - 1; }
DEVFN int seq_start(int s) { return s == 0 ? 0 : 16384 + (s - 1) * 8192; }
DEVFN int seq_len(int s) { return s == 0 ? 16384 : 8192; }

DEVFN u16* U(const Params& p, int i) { return (u16*)(p.ws) + (long)i * UNIT; }
DEVFN u16* WL(const Params& p, int l) { return (u16*)(p.ws) + OFF_W + (long)l * LW; }
DEVFN u16* TAB(const Params& p) { return (u16*)(p.ws) + OFF_TAB; }
DEVFN float2* TW(const Params& p) { return (float2*)(p.ws + OFF_TW_BYTES); }
DEVFN float* MOD(const Params& p) { return (float*)(p.ws + OFF_MOD_BYTES); }
DEVFN const float* xrow(const Params& p, int g) {
  return g < 16384 ? p.x_prompt + (long)g * D : p.x_sample + (long)(g - 16384) * D;
}

struct LdPlain {
  static constexpr bool kDma = true; static constexpr bool kTr = false;
  const u16* base; unsigned off0; unsigned cst; int t_;
  DEVFN void init(int tid_, const u16* b, unsigned row0, unsigned stride) {
    unsigned tid = tid_; t_ = tid_;
    base = b;
    off0 = (row0 + (tid >> 3)) * stride + (((tid & 7) ^ ((tid >> 3) & 7)) << 3);
    cst = 32 * stride;
  }
  DEVFN void issue(u16* tile, int c, int kt) const {
    __builtin_amdgcn_global_load_lds((const unsigned*)(base + (off0 + c * cst + kt * 64)),
                                     (unsigned*)(tile + (t_ + c * 256) * 8), 16, 0, 0);
  }
  DEVFN uint4 load(int, int) const { return make_uint4(0, 0, 0, 0); }
  DEVFN void store(u16*, int, uint4) const {}
};
struct LdRows4 {
  static constexpr bool kDma = true; static constexpr bool kTr = false;
  const u16* base; unsigned off[4]; int t_;
  DEVFN void issue(u16* tile, int c, int kt) const {
    __builtin_amdgcn_global_load_lds((const unsigned*)(base + (off[c] + kt * 64)),
                                     (unsigned*)(tile + (t_ + c * 256) * 8), 16, 0, 0);
  }
  DEVFN uint4 load(int, int) const { return make_uint4(0, 0, 0, 0); }
  DEVFN void store(u16*, int, uint4) const {}
};
struct LdF32 {
  static constexpr bool kDma = false; static constexpr bool kTr = false;
  const float* base; unsigned off0; unsigned cst; int t_;
  DEVFN void init(int tid_, const float* b, unsigned row0, unsigned stride, unsigned col0) {
    unsigned tid = tid_; t_ = tid_;
    base = b;
    off0 = (row0 + (tid >> 3)) * stride + col0 + (tid & 7) * 8;
    cst = 32 * stride;
  }
  DEVFN void issue(u16*, int, int) const {}
  DEVFN uint4 load(int c, int kt) const {
    const float4* q = (const float4*)(base + (off0 + c * cst + kt * 64));
    float4 a = q[0], b = q[1];
    uint4 r; r.x = pack2(a.x, a.y); r.y = pack2(a.z, a.w); r.z = pack2(b.x, b.y); r.w = pack2(b.z, b.w);
    return r;
  }
  DEVFN void store(u16* tile, int c, uint4 v) const {
    int idx = t_ + c * 256;
    int row = idx >> 3, kc = idx & 7;
    *(uint4*)(tile + row * 64 + ((kc ^ (row & 7)) << 3)) = v;
  }
};
DEVFN int trf(int r) { return ((r & 3) << 2) | ((r >> 2) & 3); }
template <class TokFn>
struct LdTrans {
  static constexpr bool kDma = false; static constexpr bool kTr = false;
  TokFn tok; int t_;
  DEVFN void issue(u16*, int, int) const {}
  DEVFN uint4 load(int c, int kt) const {
    int idx = t_ + c * 256;
    int kk = idx & 63, cc = idx >> 6;
    const u16* b; unsigned o = tok(kt * 64 + kk, b);
    return *(const uint4*)(b + (o + cc * 8));
  }
  DEVFN void store(u16* tile, int c, uint4 v) const {
    int idx = t_ + c * 256;
    int kk = idx & 63, cc = idx >> 6;
    u16* q = tile + (cc * 8) * 64 + (kk & 7);
    int kc = kk >> 3;
    q[0 * 64 + ((kc ^ 0) << 3)] = (u16)(v.x & 0xffff); q[1 * 64 + ((kc ^ 1) << 3)] = (u16)(v.x >> 16);
    q[2 * 64 + ((kc ^ 2) << 3)] = (u16)(v.y & 0xffff); q[3 * 64 + ((kc ^ 3) << 3)] = (u16)(v.y >> 16);
    q[4 * 64 + ((kc ^ 4) << 3)] = (u16)(v.z & 0xffff); q[5 * 64 + ((kc ^ 5) << 3)] = (u16)(v.z >> 16);
    q[6 * 64 + ((kc ^ 6) << 3)] = (u16)(v.w & 0xffff); q[7 * 64 + ((kc ^ 7) << 3)] = (u16)(v.w >> 16);
  }
};

typedef __attribute__((ext_vector_type(4))) short s16x4;
DEVFN s16x4 lds_tr_read(const u16* q) {
  return __builtin_amdgcn_ds_read_tr16_b64_v4i16((s16x4 __attribute__((address_space(3)))*)(q));
}

DEVFN void zero_acc(f32x4 (&acc)[4][4]) {
#pragma unroll
  for (int i = 0; i < 4; ++i)
#pragma unroll
    for (int j = 0; j < 4; ++j) acc[i][j] = f32x4{0.f, 0.f, 0.f, 0.f};
}

template <class LA, class LB>
DEVFN void gemm_core(int tid, f32x4 (&acc)[4][4], int nk, const LA& la, const LB& lb, u16* smem) {
  const int lane = tid & 63, w = tid >> 6, wm = w >> 1, wn = w & 1;
  const int lr = lane & 15, quad = lane >> 4;
  uint4 ra[4], rb[4];
  if (LA::kDma) {
#pragma unroll
    for (int c = 0; c < 4; ++c) la.issue(smem, c, 0);
  } else {
#pragma unroll
    for (int c = 0; c < 4; ++c) ra[c] = la.load(c, 0);
  }
  if (LB::kDma) {
#pragma unroll
    for (int c = 0; c < 4; ++c) lb.issue(smem + TILE, c, 0);
  } else {
#pragma unroll
    for (int c = 0; c < 4; ++c) rb[c] = lb.load(c, 0);
  }
  if (!LA::kDma) {
#pragma unroll
    for (int c = 0; c < 4; ++c) la.store(smem, c, ra[c]);
  }
  if (!LB::kDma) {
#pragma unroll
    for (int c = 0; c < 4; ++c) lb.store(smem + TILE, c, rb[c]);
  }
  asm volatile("s_waitcnt vmcnt(0)" ::: "memory");
  __syncthreads();
  const int aoff = (wm * 64 + lr) * 64, boff = (wn * 64 + lr) * 64;
  const int sw0 = ((quad) ^ (lr & 7)) << 3, sw1 = ((4 + quad) ^ (lr & 7)) << 3;
  int troff[4][2];
  if (LB::kTr) {
    const int q = lr >> 2, pp = lr & 3;
#pragma unroll
    for (int j = 0; j < 4; ++j)
#pragma unroll
      for (int h = 0; h < 2; ++h) {
        int r = quad * 8 + h * 4 + q;
        int ch = (wn * 8 + j * 2 + (pp >> 1)) ^ trf(r);
        troff[j][h] = r * 128 + ch * 8 + (pp & 1) * 4;
      }
  }
  for (int kt = 0; kt < nk; ++kt) {
    const u16* sA = smem + (kt & 1) * 2 * TILE;
    const u16* sB = sA + TILE;
    u16* nA = smem + ((kt + 1) & 1) * 2 * TILE;
    const bool more = (kt + 1) < nk;
    if (more) {
      if (LA::kDma) {
#pragma unroll
        for (int c = 0; c < 4; ++c) la.issue(nA, c, kt + 1);
      } else {
#pragma unroll
        for (int c = 0; c < 4; ++c) ra[c] = la.load(c, kt + 1);
      }
      if (LB::kDma) {
#pragma unroll
        for (int c = 0; c < 4; ++c) lb.issue(nA + TILE, c, kt + 1);
      } else {
#pragma unroll
        for (int c = 0; c < 4; ++c) rb[c] = lb.load(c, kt + 1);
      }
    }
#pragma unroll
    for (int ks = 0; ks < 2; ++ks) {
      const int sw = ks == 0 ? sw0 : sw1;
      bf16x8 af[4], bfr[4];
#pragma unroll
      for (int i = 0; i < 4; ++i) af[i] = *(const bf16x8*)(sA + aoff + i * 1024 + sw);
      if (LB::kTr) {
#pragma unroll
        for (int j = 0; j < 4; ++j) {
          s16x4 lo = lds_tr_read(sB + troff[j][0] + ks * 4096);
          s16x4 hi = lds_tr_read(sB + troff[j][1] + ks * 4096);
          bfr[j] = __builtin_shufflevector(lo, hi, 0, 1, 2, 3, 4, 5, 6, 7);
        }
      } else {
#pragma unroll
        for (int j = 0; j < 4; ++j) bfr[j] = *(const bf16x8*)(sB + boff + j * 1024 + sw);
      }
#pragma unroll
      for (int i = 0; i < 4; ++i)
#pragma unroll
        for (int j = 0; j < 4; ++j)
          acc[i][j] = __builtin_amdgcn_mfma_f32_16x16x32_bf16(bfr[j], af[i], acc[i][j], 0, 0, 0);
    }
    if (more) {
      if (!LA::kDma) {
#pragma unroll
        for (int c = 0; c < 4; ++c) la.store(nA, c, ra[c]);
      }
      if (!LB::kDma) {
#pragma unroll
        for (int c = 0; c < 4; ++c) lb.store(nA + TILE, c, rb[c]);
      }
    }
    asm volatile("s_waitcnt vmcnt(0)" ::: "memory");
    __syncthreads();
  }
}

DEVFN bool tile_xcd(int it, int ngrp, int ntn, int& mt, int& nt) {
  const int G = gridDim.x, b = blockIdx.x;
  if (G == 512) {
    if (it >= 10 * ngrp) return false;
    int xcd = b & 7, loc = b >> 3;
    mt = xcd * 80 + (it / ngrp) * 8 + (loc >> 3);
    nt = (it % ngrp) * 8 + (loc & 7);
    return true;
  }
  int tile = b + it * G;
  if (tile >= 640 * ntn) return false;
  mt = tile / ntn; nt = tile % ntn;
  return true;
}

DEVFN void transpose_tile(const float* src, long ld, u16* dst, long ldd, float* sT) {
  const int tid = otid();
#pragma unroll
  for (int pss = 0; pss < 4; ++pss) {
    int kk = (tid >> 4) + pss * 16, n4 = (tid & 15) * 4;
    float4 v = *(const float4*)(src + (long)kk * ld + n4);
    sT[kk * 65 + n4 + 0] = v.x; sT[kk * 65 + n4 + 1] = v.y; sT[kk * 65 + n4 + 2] = v.z; sT[kk * 65 + n4 + 3] = v.w;
  }
  __syncthreads();
  {
    int n = tid >> 2, k0 = (tid & 3) * 16;
    unsigned o[8];
#pragma unroll
    for (int e = 0; e < 8; ++e) o[e] = pack2(sT[(k0 + 2 * e) * 65 + n], sT[(k0 + 2 * e + 1) * 65 + n]);
    uint4* q = (uint4*)(dst + (long)n * ldd + k0);
    q[0] = make_uint4(o[0], o[1], o[2], o[3]);
    q[1] = make_uint4(o[4], o[5], o[6], o[7]);
  }
  __syncthreads();
}

DEVFN void phase_prologue(const Params& p, unsigned char* smem_raw) {
  const int tid = otid();
  constexpr int NJ_TR = 4352, NJ_MOD = 96, NJ_TAB = 256;
  for (int job = blockIdx.x; job < NJ_TR + NJ_MOD + NJ_TAB; job += gridDim.x) {
    if (job < NJ_TR) {
      float* sT = (float*)smem_raw;
      int l = job / 2176, r = job % 2176;
      u16* wl = WL(p, l);
      if (r < 1280) {
        int kt = r / 80, ntile = r % 80;
        int orow = ntile * 64;
        int scol;
        if (orow < 2048) scol = orow; else { orow += 2048; scol = orow - 1024; }
        transpose_tile(p.w_in + (long)l * D * D_IN + (long)(kt * 64) * D_IN + scol, D_IN,
                       wl + W_CAT + (long)orow * D + kt * 64, D, sT);
      } else if (r < 2048) {
        int r2 = r - 1280, which = r2 >> 8, t = r2 & 255, kt = t >> 4, ntile = t & 15;
        const float* src = (which == 0 ? p.w_a_out : which == 1 ? p.w_b_out : p.w_o) + (long)l * 1048576;
        long doff = which == 0 ? W_A : which == 1 ? W_B : W_O;
        transpose_tile(src + (long)(kt * 64) * D + ntile * 64, D, wl + doff + (long)(ntile * 64) * D + kt * 64, D, sT);
      } else {
        int r3 = r - 2048, mat = r3 >> 2, t = r3 & 3, kt = t >> 1, ntile = t & 1;
        const float* src = p.w_rg + ((long)l * 32 + mat) * 16384;
        transpose_tile(src + (long)(kt * 64) * 128 + ntile * 64, 128,
                       wl + W_RG + (long)mat * 16384 + (long)(ntile * 64) * 128 + kt * 64, 128, sT);
      }
    } else if (job < NJ_TR + NJ_MOD) {
      int jm = job - NJ_TR, l = jm / 48, cgp = jm % 48;
      float* sc = (float*)smem_raw;
      float* red = sc + 9 * 1024;
      for (int i = tid; i < 9 * 1024; i += 256) {
        int s = i >> 10, k = i & 1023;
        float cv = s == 0 ? p.c_prompt[k] : p.c_sample[(s - 1) * 1024 + k];
        sc[i] = silu(cv);
      }
      __syncthreads();
      int col = cgp * 64 + (tid & 63), kq = tid >> 6;
      float a0 = 0, a1 = 0, a2 = 0, a3 = 0, a4 = 0, a5 = 0, a6 = 0, a7 = 0, a8 = 0;
      const float* wp = p.w_ada + (long)l * D * 3072 + col;
#pragma unroll 4
      for (int k = kq * 256; k < kq * 256 + 256; ++k) {
        float wv = wp[(long)k * 3072];
        a0 += sc[0 * 1024 + k] * wv; a1 += sc[1 * 1024 + k] * wv; a2 += sc[2 * 1024 + k] * wv;
        a3 += sc[3 * 1024 + k] * wv; a4 += sc[4 * 1024 + k] * wv; a5 += sc[5 * 1024 + k] * wv;
        a6 += sc[6 * 1024 + k] * wv; a7 += sc[7 * 1024 + k] * wv; a8 += sc[8 * 1024 + k] * wv;
      }
      float* rq = red + kq * 9 * 64 + (tid & 63);
      rq[0 * 64] = a0; rq[1 * 64] = a1; rq[2 * 64] = a2; rq[3 * 64] = a3; rq[4 * 64] = a4;
      rq[5 * 64] = a5; rq[6 * 64] = a6; rq[7 * 64] = a7; rq[8 * 64] = a8;
      __syncthreads();
      for (int i = tid; i < 9 * 64; i += 256) {
        int s = i >> 6, cc = i & 63;
        float v = red[0 * 576 + i] + red[1 * 576 + i] + red[2 * 576 + i] + red[3 * 576 + i];
        int cf = cgp * 64 + cc;
        MOD(p)[((long)l * 9 + s) * 3072 + cf] = v + p.b_ada[l * 3072 + cf];
      }
      __syncthreads();
    } else {
      int jt = job - NJ_TR - NJ_MOD;
      u16* tab = TAB(p);
#pragma unroll
      for (int e4 = 0; e4 < 4; ++e4) {
        int e = jt * 1024 + e4 * 256 + tid;
        if (e < 65536) {
          int m = e >> 8, k = e & 255;
          int k1 = (m >> 5) * 16 + (m & 15), ro = (m >> 4) & 1, ri = k >> 7, s1 = k & 127;
          float x = 2.f * (float)((k1 * s1) & 127) / 128.f;
          float cs = cospif(x), sn = sinpif(x);
          float v = (ro == ri) ? cs : (ro == 0 ? sn : -sn);
          tab[T_D1A + e] = f2bf(v);
        } else if (e < 65536 + 16384) {
          int e2 = e - 65536;
          int m = e2 >> 7, k = e2 & 127;
          int k1 = (m >> 5) * 16 + (m & 15), ro = (m >> 4) & 1, ri = k >> 6, s1 = k & 63;
          float x = 2.f * (float)((k1 * s1) & 63) / 64.f;
          float cs = cospif(x), sn = sinpif(x);
          float v = (ro == ri) ? cs : (ro == 0 ? sn : -sn);
          tab[T_D1B + e2] = f2bf(v);
        } else if (e < 65536 + 16384 + 32768) {
          int e2 = e - 65536 - 16384;
          int k2 = e2 >> 8, k = e2 & 255, ri = k >> 7, s2 = k & 127;
          float x = 2.f * (float)((k2 * s2) & 127) / 128.f;
          float v = ri == 0 ? cospif(x) : sinpif(x);
          tab[T_D2 + e2] = f2bf(v);
        } else if (e < 65536 + 16384 + 32768 + 131072) {
          int e2 = e - 65536 - 16384 - 32768;
          int row = e2 >> 8, c = e2 & 255, ri = row >> 8, m = row & 255;
          float x = 2.f * (float)((m * c) & 255) / 256.f;
          float v = ri == 0 ? cospif(x) : -sinpif(x);
          tab[T_DC + e2] = f2bf(v);
        } else {
          int e2 = e - (65536 + 16384 + 32768 + 131072);
          if (e2 < 16384) {
            float x = 2.f * (float)e2 / 16384.f;
            TW(p)[e2] = make_float2(cospif(x), sinpif(x));
          }
        }
      }
    }
  }
}

DEVFN void phase_fold(const Params& p, u16* smem) {
  for (int tile = blockIdx.x; tile < 256; tile += gridDim.x) {
    const int tid = otid(), lane = tid & 63, w = tid >> 6, wm = w >> 1, wn = w & 1, lr = lane & 15, quad = lane >> 4;
    int l = tile >> 7, g = (tile >> 5) & 3, mt = (tile >> 3) & 3, nt = tile & 7;
    LdPlain la; la.init(tid, TAB(p) + T_DC, mt * 128, 256);
    LdF32 lb; lb.init(tid, p.w_in + (long)l * D * D_IN, nt * 128, D_IN, 2048 + g * 256);
    f32x4 acc[4][4]; zero_acc(acc);
    gemm_core(tid, acc, 4, la, lb, smem);
    int ri = mt >> 1;
    u16* wc = WL(p, l) + W_CAT;
#pragma unroll
    for (int i = 0; i < 4; ++i) {
      int mrow = (mt & 1) * 128 + wm * 64 + i * 16 + lr;
      unsigned orow = 2048 + ri * 1024 + g * 256 + mrow;
#pragma unroll
      for (int j = 0; j < 4; ++j) {
        int n = nt * 128 + wn * 64 + j * 16 + quad * 4;
        uint2 o; o.x = pack2(acc[i][j][0], acc[i][j][1]); o.y = pack2(acc[i][j][2], acc[i][j][3]);
        *(uint2*)(wc + orow * D + n) = o;
      }
    }
  }
}

DEVFN void phase_h(const Params& p, int l) {
  const int lane = threadIdx.x & 63;
  const int wid = blockIdx.x * 4 + (threadIdx.x >> 6), nw = gridDim.x * 4;
  const float* ng = p.norm_g + l * D;
  const float* modl = MOD(p) + (long)l * 9 * 3072;
  u16* H = U(p, 0);
  for (int g = wid; g < T_TOT; g += nw) {
    const float* xb = (l == 0) ? (g < 16384 ? p.x_prompt : p.x_sample) : p.out;
    const unsigned xo = (unsigned)((l == 0 && g >= 16384) ? g - 16384 : g) * D;
    const float* xr = xb + xo;
    const float* md = modl + seq_of(g) * 3072;
    float4 v[4];
    float ss = 0.f;
#pragma unroll
    for (int i = 0; i < 4; ++i) {
      v[i] = *(const float4*)(xr + i * 256 + lane * 4);
      ss += v[i].x * v[i].x + v[i].y * v[i].y + v[i].z * v[i].z + v[i].w * v[i].w;
    }
#pragma unroll
    for (int o = 32; o >= 1; o >>= 1) ss += __shfl_xor(ss, o, 64);
    float rstd = rsqrtf(ss * (1.f / 1024.f) + 1e-6f);
#pragma unroll
    for (int i = 0; i < 4; ++i) {
      int c = i * 256 + lane * 4;
      float4 g4 = *(const float4*)(ng + c);
      float4 sh = *(const float4*)(md + c);
      float4 sc = *(const float4*)(md + 1024 + c);
      float h0 = v[i].x * rstd * g4.x * (1.f + sc.x) + sh.x;
      float h1 = v[i].y * rstd * g4.y * (1.f + sc.y) + sh.y;
      float h2 = v[i].z * rstd * g4.z * (1.f + sc.z) + sh.z;
      float h3 = v[i].w * rstd * g4.w * (1.f + sc.w) + sh.w;
      uint2 o; o.x = pack2(h0, h1); o.y = pack2(h2, h3);
      *(uint2*)(H + ((unsigned)g * D + c)) = o;
    }
  }
}

DEVFN void phase_final(const Params& p) {
  const int lane = threadIdx.x & 63;
  const int wid = blockIdx.x * 4 + (threadIdx.x >> 6), nw = gridDim.x * 4;
  for (int g = wid; g < T_TOT; g += nw) {
    float* xr = p.out + (unsigned)g * D;
    float4 v[4];
    float ss = 0.f;
#pragma unroll
    for (int i = 0; i < 4; ++i) {
      v[i] = *(const float4*)(xr + i * 256 + lane * 4);
      ss += v[i].x * v[i].x + v[i].y * v[i].y + v[i].z * v[i].z + v[i].w * v[i].w;
    }
#pragma unroll
    for (int o = 32; o >= 1; o >>= 1) ss += __shfl_xor(ss, o, 64);
    float rstd = rsqrtf(ss * (1.f / 1024.f) + 1e-6f);
#pragma unroll
    for (int i = 0; i < 4; ++i) {
      int c = i * 256 + lane * 4;
      float4 g4 = *(const float4*)(p.final_g + c);
      float4 o;
      o.x = v[i].x * rstd * g4.x; o.y = v[i].y * rstd * g4.y; o.z = v[i].z * rstd * g4.z; o.w = v[i].w * rstd * g4.w;
      *(float4*)(xr + c) = o;
    }
  }
}

DEVFN void phase_gemm1(const Params& p, int l, u16* smem) {
  const u16* H = U(p, 0);
  const u16* W = WL(p, l) + W_CAT;
  for (int it = 0;; ++it) {
    int mt, nt;
    if (!tile_xcd(it, 5, 40, mt, nt)) break;
    const int tid = otid(), lane = tid & 63, w = tid >> 6, wm = w >> 1, wn = w & 1, lr = lane & 15, quad = lane >> 4;
    LdPlain la; la.init(tid, H, mt * 128, D);
    LdPlain lb; lb.init(tid, W, nt * 128, D);
    f32x4 acc[4][4]; zero_acc(acc);
    gemm_core(tid, acc, 16, la, lb, smem);
    int unit = nt >> 3, col0 = (nt & 7) * 128;
    u16* outp = U(p, 1 + unit);
    bool act = (unit == 1) || (unit == 4);
#pragma unroll
    for (int i = 0; i < 4; ++i) {
      unsigned g = mt * 128 + wm * 64 + i * 16 + lr;
#pragma unroll
      for (int j = 0; j < 4; ++j) {
        unsigned c = col0 + wn * 64 + j * 16 + quad * 4;
        float v0 = acc[i][j][0], v1 = acc[i][j][1], v2 = acc[i][j][2], v3 = acc[i][j][3];
        if (act) { v0 = silu(v0); v1 = silu(v1); v2 = silu(v2); v3 = silu(v3); }
        uint2 o; o.x = pack2(v0, v1); o.y = pack2(v2, v3);
        *(uint2*)(outp + g * D + c) = o;
      }
    }
  }
}

struct TokF1 {
  const u16* zr; const u16* zi; int n1; unsigned off;
  DEVFN unsigned operator()(int k, const u16*& b) const {
    int ri = k >= n1 ? 1 : 0;
    int s1 = k - ri * n1;
    b = ri ? zi : zr;
    return off + (unsigned)(s1 * 128) * D;
  }
};
DEVFN void f1_twiddle(int tid, const Params& p, const f32x4 (&acc)[4][4], int hf, int s2, int smask, int twmul,
                      uint2 (&o1)[2][4], uint2 (&o2)[2][4]) {
  const int lane = tid & 63, w = tid >> 6, wm = w >> 1, lr = lane & 15;
  const float2* tw = TW(p);
#pragma unroll
  for (int b = 0; b < 2; ++b) {
    int k1 = (hf * 4 + wm * 2 + b) * 16 + lr;
    float2 t = tw[((k1 * s2) & smask) * twmul];
#pragma unroll
    for (int j = 0; j < 4; ++j) {
      f32x4 orr = acc[2 * b][j], oii = acc[2 * b + 1][j];
      o1[b][j].x = pack2(orr[0] * t.x + oii[0] * t.y, orr[1] * t.x + oii[1] * t.y);
      o1[b][j].y = pack2(orr[2] * t.x + oii[2] * t.y, orr[3] * t.x + oii[3] * t.y);
      o2[b][j].x = pack2(oii[0] * t.x - orr[0] * t.y, oii[1] * t.x - orr[1] * t.y);
      o2[b][j].y = pack2(oii[2] * t.x - orr[2] * t.y, oii[3] * t.x - orr[3] * t.y);
    }
  }
}
DEVFN void f1_write(int tid, int hf, unsigned off, const uint2 (&o1)[2][4], const uint2 (&o2)[2][4], u16* zr, u16* zi) {
  const int lane = tid & 63, w = tid >> 6, wm = w >> 1, wn = w & 1, lr = lane & 15, quad = lane >> 4;
#pragma unroll
  for (int b = 0; b < 2; ++b) {
    unsigned k1 = (hf * 4 + wm * 2 + b) * 16 + lr;
    unsigned rowoff = off + (k1 * 128) * D + wn * 64 + quad * 4;
#pragma unroll
    for (int j = 0; j < 4; ++j) {
      *(uint2*)(zr + (rowoff + j * 16)) = o1[b][j];
      *(uint2*)(zi + (rowoff + j * 16)) = o2[b][j];
    }
  }
}
DEVFN void phase_fft1(const Params& p, u16* smem) {
  u16* zr = U(p, 3);
  u16* zi = U(p, 4);
  for (int tile = blockIdx.x; tile < 9216; tile += gridDim.x) {
    const int tid = otid();
    int seq, s2, ct, n1;
    if (tile < 1024) { seq = 0; s2 = tile >> 3; ct = tile & 7; n1 = 128; }
    else { int t2 = tile - 1024; seq = 1 + (t2 >> 10); s2 = (t2 >> 3) & 127; ct = t2 & 7; n1 = 64; }
    const unsigned off = (unsigned)(seq_start(seq) + s2) * D + ct * 128;
    LdTrans<TokF1> lb; lb.t_ = tid; lb.tok.zr = zr; lb.tok.zi = zi; lb.tok.n1 = n1; lb.tok.off = off;
    const int K = 2 * n1, nk = K >> 6;
    const u16* tab = TAB(p) + (seq == 0 ? T_D1A : T_D1B);
    const int smask = seq == 0 ? 16383 : 8191, twmul = seq == 0 ? 1 : 2;
    uint2 a1[2][4], a2[2][4];
    {
      f32x4 acc[4][4]; zero_acc(acc);
      LdPlain la; la.init(tid, tab, 0, K); gemm_core(tid, acc, nk, la, lb, smem);
      f1_twiddle(tid, p, acc, 0, s2, smask, twmul, a1, a2);
    }
    if (seq == 0) {
      uint2 b1[2][4], b2[2][4];
      {
        f32x4 acc[4][4]; zero_acc(acc);
        LdPlain la; la.init(tid, tab, 128, K); gemm_core(tid, acc, nk, la, lb, smem);
        f1_twiddle(tid, p, acc, 1, s2, smask, twmul, b1, b2);
      }
      f1_write(tid, 1, off, b1, b2, zr, zi);
    }
    f1_write(tid, 0, off, a1, a2, zr, zi);
  }
}

struct TokF2 {
  const u16* zr; const u16* zi; unsigned off;
  DEVFN unsigned operator()(int k, const u16*& b) const {
    int ri = k >> 7, s2 = k & 127;
    b = ri ? zi : zr;
    return off + (unsigned)s2 * D;
  }
};
DEVFN void phase_fft2(const Params& p, u16* smem) {
  u16* zr = U(p, 3);
  const u16* gbp = U(p, 5);
  for (int tile = blockIdx.x; tile < 5120; tile += gridDim.x) {
    const int tid = otid(), lane = tid & 63, w = tid >> 6, wm = w >> 1, wn = w & 1, lr = lane & 15, quad = lane >> 4;
    int seq, k1, ct, n1;
    if (tile < 1024) { seq = 0; k1 = tile >> 3; ct = tile & 7; n1 = 128; }
    else { int t2 = tile - 1024; seq = 1 + (t2 >> 9); k1 = (t2 >> 3) & 63; ct = t2 & 7; n1 = 64; }
    const int sst = seq_start(seq);
    const unsigned off = (unsigned)(sst + k1 * 128) * D + ct * 128;
    LdTrans<TokF2> lb; lb.t_ = tid; lb.tok.zr = zr; lb.tok.zi = U(p, 4); lb.tok.off = off;
    LdPlain la; la.init(tid, TAB(p) + T_D2, 0, 256);
    f32x4 acc[4][4]; zero_acc(acc);
    gemm_core(tid, acc, 4, la, lb, smem);
    const float nrm = seq == 0 ? (1.f / 2048.f) : 6.9053396600248786e-4f;
#pragma unroll
    for (int i = 0; i < 4; ++i) {
      unsigned k2 = wm * 64 + i * 16 + lr;
      unsigned goff = (unsigned)(sst + k1 + n1 * k2) * D + ct * 128;
#pragma unroll
      for (int j = 0; j < 4; ++j) {
        unsigned cl = wn * 64 + j * 16 + quad * 4;
        uint2 gv = *(const uint2*)(gbp + (goff + cl));
        uint2 o;
        o.x = pack2(acc[i][j][0] * nrm * lo2f(gv.x), acc[i][j][1] * nrm * hi2f(gv.x));
        o.y = pack2(acc[i][j][2] * nrm * lo2f(gv.y), acc[i][j][3] * nrm * hi2f(gv.y));
        *(uint2*)(zr + (off + k2 * D + cl)) = o;
      }
    }
  }
}

constexpr int SA_LD = 128;
template <int PASS>
DEVFN void phase_scan(const Params& p, int l, int dirsel, unsigned char* smem_raw) {
  float* sAf = (float*)smem_raw;
  u16* sXa = (u16*)smem_raw;
  float* sCw = (float*)(smem_raw + 17152);
  u16* sBh = (u16*)(smem_raw + 32768);
  u16* sXc = (u16*)(smem_raw + 32768 + 16384);
  const int tid = otid(), lane = tid & 63, w = tid >> 6, lr = lane & 15, quad = lane >> 4;
  const int head = blockIdx.x & 7;
  const int dir = PASS == 1 ? ((blockIdx.x >> 3) & 1) : dirsel;
  const int tstart = PASS == 1 ? (blockIdx.x >> 4) : (blockIdx.x >> 3);
  const int tstep = PASS == 1 ? (gridDim.x >> 4) : (gridDim.x >> 3);
  const u16* xa = U(p, 1);
  u16* ga = U(p, 2);
  u16* hf = U(p, 5);
  float2* agg = (float2*)U(p, 4);
  float* carry = (float*)(agg + 1280L * 2 * 1024);
  bf16x8 bw[4][4];
  {
    const u16* wrg = WL(p, l) + W_RG;
#pragma unroll
    for (int jt = 0; jt < 4; ++jt) {
      int q = jt >> 1, col = w * 32 + (jt & 1) * 16 + lr;
      const u16* bp = wrg + (unsigned)((((dir * 2 + q) * 8 + head) * 128 + col) * 128 + quad * 8);
#pragma unroll
      for (int ks = 0; ks < 4; ++ks) bw[jt][ks] = *(const bf16x8*)(bp + ks * 32);
    }
  }
  float spl[2], brr[2], bii[2];
#pragma unroll
  for (int jc = 0; jc < 2; ++jc) {
    int cgl = head * 128 + w * 32 + jc * 16 + lr;
    float lm = p.lam[(l * 2 + dir) * D + cgl];
    spl[jc] = -8.f * 1.4426950408889634f * log1pf(expf(-lm));
    brr[jc] = -1.4426950408889634f * p.b_rg[((l * 2 + dir) * 2 + 0) * D + cgl];
    bii[jc] = -1.4426950408889634f * p.b_rg[((l * 2 + dir) * 2 + 1) * D + cgl];
  }
  __syncthreads();
  for (int tt = tstart; tt < 1280; tt += tstep) {
    const int g0 = tt * 64;
    const int seq = seq_of(g0), sst = seq_start(seq), send = sst + seq_len(seq);
    for (int idx = tid; idx < 67 * 16; idx += 256) {
      int row = idx >> 4, cc = idx & 15;
      int g = g0 - 2 + row;
      uint4 v = make_uint4(0, 0, 0, 0);
      if (g >= sst && g < send) v = *(const uint4*)(xa + ((unsigned)g * D + head * 128 + cc * 8));
      *(uint4*)(sXa + row * 128 + cc * 8) = v;
    }
    for (int i = tid; i < 640; i += 256) {
      int k = i >> 7, c = i & 127;
      sCw[i] = k < 4 ? p.conv_w[(l * 4 + k) * D + head * 128 + c] : p.conv_b[l * D + head * 128 + c];
    }
    __syncthreads();
#pragma unroll 1
    for (int hh = 0; hh < 2; ++hh) {
      int tl = tid >> 2, cb = (tid & 3) * 32 + hh * 16;
      float o[16];
#pragma unroll
      for (int e = 0; e < 16; ++e) o[e] = sCw[512 + cb + e];
#pragma unroll
      for (int k = 0; k < 4; ++k) {
        uint4 v0 = *(const uint4*)(sXa + (tl + k) * 128 + cb);
        uint4 v1 = *(const uint4*)(sXa + (tl + k) * 128 + cb + 8);
        const float* wk = sCw + k * 128 + cb;
        o[0] += wk[0] * lo2f(v0.x); o[1] += wk[1] * hi2f(v0.x);
        o[2] += wk[2] * lo2f(v0.y); o[3] += wk[3] * hi2f(v0.y);
        o[4] += wk[4] * lo2f(v0.z); o[5] += wk[5] * hi2f(v0.z);
        o[6] += wk[6] * lo2f(v0.w); o[7] += wk[7] * hi2f(v0.w);
        o[8] += wk[8] * lo2f(v1.x); o[9] += wk[9] * hi2f(v1.x);
        o[10] += wk[10] * lo2f(v1.y); o[11] += wk[11] * hi2f(v1.y);
        o[12] += wk[12] * lo2f(v1.z); o[13] += wk[13] * hi2f(v1.z);
        o[14] += wk[14] * lo2f(v1.w); o[15] += wk[15] * hi2f(v1.w);
      }
      uint4 q0, q1;
      q0.x = pack2(o[0], o[1]); q0.y = pack2(o[2], o[3]); q0.z = pack2(o[4], o[5]); q0.w = pack2(o[6], o[7]);
      q1.x = pack2(o[8], o[9]); q1.y = pack2(o[10], o[11]); q1.z = pack2(o[12], o[13]); q1.w = pack2(o[14], o[15]);
      *(uint4*)(sXc + tl * 128 + ((((cb >> 3) + 0) ^ (tl & 7)) << 3)) = q0;
      *(uint4*)(sXc + tl * 128 + ((((cb >> 3) + 1) ^ (tl & 7)) << 3)) = q1;
    }
    __syncthreads();
    const int gstart = dir == 0 ? sst : send - 1;
#pragma unroll 1
    for (int hv = 0; hv < 2; ++hv) {
      f32x4 acc[2][4];
#pragma unroll
      for (int it = 0; it < 2; ++it)
#pragma unroll
        for (int jt = 0; jt < 4; ++jt) acc[it][jt] = f32x4{0.f, 0.f, 0.f, 0.f};
#pragma unroll
      for (int ks = 0; ks < 4; ++ks) {
#pragma unroll
        for (int it = 0; it < 2; ++it) {
          bf16x8 af = *(const bf16x8*)(sXc + ((hv * 2 + it) * 16 + lr) * 128 + (((ks * 4 + quad) ^ (lr & 7)) << 3));
#pragma unroll
          for (int jt = 0; jt < 4; ++jt)
            acc[it][jt] = __builtin_amdgcn_mfma_f32_16x16x32_bf16(af, bw[jt][ks], acc[it][jt], 0, 0, 0);
        }
      }
#pragma unroll
      for (int it = 0; it < 2; ++it)
#pragma unroll
        for (int jc = 0; jc < 2; ++jc) {
#pragma unroll
          for (int r = 0; r < 4; ++r) {
            int tl = (hv * 2 + it) * 16 + quad * 4 + r, c = w * 32 + jc * 16 + lr;
            float er = 1.f + __builtin_amdgcn_exp2f(fminf(fmaf(acc[it][jc][r], -1.4426950408889634f, brr[jc]), 60.f));
            float ei = 1.f + __builtin_amdgcn_exp2f(fminf(fmaf(acc[it][2 + jc][r], -1.4426950408889634f, bii[jc]), 60.f));
            float q = __builtin_amdgcn_rcpf(er * ei);
            float rr = q * ei, ii = q * er;
            float a = __builtin_amdgcn_exp2f(rr * spl[jc]);
            float mult = __builtin_amdgcn_sqrtf((1.f - a) * (1.f + a));
            if (g0 + tl == gstart) mult = 1.f;
            float xv = bf2f(sXc[tl * 128 + (((c >> 3) ^ (tl & 7)) << 3) + (c & 7)]);
            sAf[tl * SA_LD + c] = a;
            sBh[tl * 128 + c] = f2bf(mult * ii * xv);
          }
        }
    }
    __syncthreads();
    if (tid < 128) {
      const int c = tid;
      const unsigned aidx = (unsigned)(tt * 2 + dir) * 1024 + head * 128 + c;
      const float* ap = sAf + c;
      u16* bp = sBh + c;
      if (PASS == 1) {
        float h = 0.f, P = 1.f;
        if (dir == 0) {
#pragma unroll 16
          for (int st = 0; st < 64; ++st) { float a = ap[st * SA_LD]; h = a * h + bf2f(bp[st * 128]); P *= a; }
        } else {
#pragma unroll 16
          for (int st = 63; st >= 0; --st) { float a = ap[st * SA_LD]; h = a * h + bf2f(bp[st * 128]); P *= a; }
        }
        agg[aidx] = make_float2(P, h);
      } else {
        float h = carry[aidx];
        if (dir == 0) {
#pragma unroll 16
          for (int st = 0; st < 64; ++st) { h = ap[st * SA_LD] * h + bf2f(bp[st * 128]); bp[st * 128] = f2bf(h); }
        } else {
#pragma unroll 16
          for (int st = 63; st >= 0; --st) { h = ap[st * SA_LD] * h + bf2f(bp[st * 128]); bp[st * 128] = f2bf(h); }
        }
      }
    }
    if (PASS == 3) {
      __syncthreads();
#pragma unroll
      for (int cch = 0; cch < 4; ++cch) {
        int chunk = tid + cch * 256;
        int t = chunk >> 4, cc = (chunk & 15) * 8;
        unsigned off = (unsigned)(g0 + t) * D + head * 128 + cc;
        uint4 hv = *(const uint4*)(sBh + t * 128 + cc);
        if (dir == 0) {
          *(uint4*)(hf + off) = hv;
        } else {
          uint4 fv = *(const uint4*)(hf + off);
          uint4 gv = *(const uint4*)(ga + off);
          uint4 o;
          o.x = pack2((lo2f(fv.x) + lo2f(hv.x)) * lo2f(gv.x), (hi2f(fv.x) + hi2f(hv.x)) * hi2f(gv.x));
          o.y = pack2((lo2f(fv.y) + lo2f(hv.y)) * lo2f(gv.y), (hi2f(fv.y) + hi2f(hv.y)) * hi2f(gv.y));
          o.z = pack2((lo2f(fv.z) + lo2f(hv.z)) * lo2f(gv.z), (hi2f(fv.z) + hi2f(hv.z)) * hi2f(gv.z));
          o.w = pack2((lo2f(fv.w) + lo2f(hv.w)) * lo2f(gv.w), (hi2f(fv.w) + hi2f(hv.w)) * hi2f(gv.w));
          *(uint4*)(ga + off) = o;
        }
      }
    }
    __syncthreads();
  }
}

DEVFN void phase_carry(const Params& p) {
  const float2* __restrict__ agg = (const float2*)U(p, 4);
  float* __restrict__ carry = (float*)(agg + 1280L * 2 * 1024);
  const int lane = threadIdx.x & 63, w = threadIdx.x >> 6;
  for (int u = blockIdx.x + gridDim.x * w; u < 288; u += gridDim.x * 4) {
    int id = u * 64 + lane;
    int seq = id >> 11, dir = (id >> 10) & 1, c = id & 1023;
    int nt = seq_len(seq) >> 6, tile0 = seq_start(seq) >> 6;
    float h = 0.f;
#pragma unroll 8
    for (int k = 0; k < nt; ++k) {
      int tt = tile0 + (dir ? nt - 1 - k : k);
      unsigned ix = (unsigned)(tt * 2 + dir) * 1024 + c;
      float2 v = agg[ix];
      carry[ix] = h;
      h = v.x * h + v.y;
    }
  }
}

DEVFN void phase_merge(const Params& p, int l, u16* smem) {
  const u16* wl = WL(p, l);
  u16* mo = U(p, 1);
  u16* tb = U(p, 5);
  for (int it = 0;; ++it) {
    int mt, nt;
    if (!tile_xcd(it, 1, 8, mt, nt)) break;
    const int g0 = mt * 128;
#pragma unroll 1
    for (int br = 0; br < 2; ++br) {
      {
        const int tid = otid(), lane = tid & 63, w = tid >> 6, wm = w >> 1, wn = w & 1, lr = lane & 15, quad = lane >> 4;
        f32x4 acc[4][4]; zero_acc(acc);
        LdRows4 la; la.t_ = tid;
        if (br == 0) {
          la.base = U(p, 2);
#pragma unroll
          for (int c = 0; c < 4; ++c) la.off[c] = (unsigned)(g0 + (tid >> 3) + c * 32) * D + (((tid & 7) ^ ((tid >> 3) & 7)) << 3);
        } else {
          const int seq = seq_of(g0), sst = seq_start(seq);
          const int lg = seq == 0 ? 7 : 6;
          la.base = U(p, 3);
#pragma unroll
          for (int c = 0; c < 4; ++c) {
            int t = g0 - sst + (tid >> 3) + c * 32;
            int urow = ((t & ((1 << lg) - 1)) << 7) + (t >> lg);
            la.off[c] = (unsigned)(sst + urow) * D + (((tid & 7) ^ ((tid >> 3) & 7)) << 3);
          }
        }
        LdPlain lb; lb.init(tid, wl + (br == 0 ? W_A : W_B), nt * 128, D);
        gemm_core(tid, acc, 16, la, lb, smem);
#pragma unroll
        for (int i = 0; i < 4; ++i) {
          unsigned g = g0 + wm * 64 + i * 16 + lr;
#pragma unroll
          for (int j = 0; j < 4; ++j) {
            unsigned c = nt * 128 + wn * 64 + j * 16 + quad * 4;
            uint2 o; o.x = pack2(acc[i][j][0], acc[i][j][1]); o.y = pack2(acc[i][j][2], acc[i][j][3]);
            *(uint2*)(tb + (g * D + c)) = o;
          }
        }
      }
      {
        const int tid = otid(), lane = tid & 63, w = tid >> 6, wm = w >> 1, wn = w & 1, lr = lane & 15, quad = lane >> 4;
        f32x4 acc[4][4]; zero_acc(acc);
        LdPlain la; la.init(tid, U(p, 0), g0, D);
        LdPlain lb; lb.init(tid, wl + W_CAT, 5120 + br * 1024 + nt * 128, D);
        gemm_core(tid, acc, 16, la, lb, smem);
#pragma unroll
        for (int i = 0; i < 4; ++i) {
          unsigned g = g0 + wm * 64 + i * 16 + lr;
#pragma unroll
          for (int j = 0; j < 4; ++j) {
            unsigned c = nt * 128 + wn * 64 + j * 16 + quad * 4;
            uint2 tv = *(const uint2*)(tb + (g * D + c));
            float v0 = sigm(acc[i][j][0]) * lo2f(tv.x);
            float v1 = sigm(acc[i][j][1]) * hi2f(tv.x);
            float v2 = sigm(acc[i][j][2]) * lo2f(tv.y);
            float v3 = sigm(acc[i][j][3]) * hi2f(tv.y);
            uint2* op = (uint2*)(mo + (g * D + c));
            if (br == 1) {
              uint2 pv = *op;
              v0 += lo2f(pv.x); v1 += hi2f(pv.x); v2 += lo2f(pv.y); v3 += hi2f(pv.y);
            }
            uint2 o; o.x = pack2(v0, v1); o.y = pack2(v2, v3);
            *op = o;
          }
        }
      }
    }
  }
}

DEVFN void phase_out(const Params& p, int l, u16* smem) {
  const u16* wo = WL(p, l) + W_O;
  for (int it = 0;; ++it) {
    int mt, nt;
    if (!tile_xcd(it, 1, 8, mt, nt)) break;
    const int tid = otid(), lane = tid & 63, w = tid >> 6, wm = w >> 1, wn = w & 1, lr = lane & 15, quad = lane >> 4;
    const int g0 = mt * 128;
    LdPlain la; la.init(tid, U(p, 1), g0, D);
    LdPlain lb; lb.init(tid, wo, nt * 128, D);
    f32x4 acc[4][4]; zero_acc(acc);
    gemm_core(tid, acc, 16, la, lb, smem);
    const float* gate = MOD(p) + ((long)l * 9 + seq_of(g0)) * 3072 + 2048;
#pragma unroll
    for (int i = 0; i < 4; ++i) {
      unsigned g = g0 + wm * 64 + i * 16 + lr;
      const float* xb = (l == 0) ? (g0 < 16384 ? p.x_prompt : p.x_sample) : p.out;
      const float* xr = xb + (unsigned)((l == 0 && g0 >= 16384) ? g - 16384 : g) * D;
      float* orow = p.out + g * D;
#pragma unroll
      for (int j = 0; j < 4; ++j) {
        unsigned c = nt * 128 + wn * 64 + j * 16 + quad * 4;
        float4 xv = *(const float4*)(xr + c);
        float4 gt = *(const float4*)(gate + c);
        float4 o;
        o.x = xv.x + gt.x * acc[i][j][0]; o.y = xv.y + gt.y * acc[i][j][1];
        o.z = xv.z + gt.z * acc[i][j][2]; o.w = xv.w + gt.w * acc[i][j][3];
        *(float4*)(orow + c) = o;
      }
    }
  }
}

#define XB_TMO      128
#define XB_XCNT(j)  (256  + 64 * (j))
#define XB_XSUB(j)  (1280 + 64 * (j))
#define XB_XGEN(j)  (2304 + 64 * (j))
#define XB_TOP      3328
#define XB_TOPGEN   3392
#define XCD_BAR_WORDS 3456
#define XB_SPIN_CAP (1u << 18)
#define LAS __attribute__((address_space(3)))

__device__ __forceinline__ unsigned xb_ld(unsigned* p)              { return __hip_atomic_load(p, __ATOMIC_RELAXED, __HIP_MEMORY_SCOPE_AGENT); }
__device__ __forceinline__ unsigned xb_add(unsigned* p, unsigned v) { return __hip_atomic_fetch_add(p, v, __ATOMIC_RELAXED, __HIP_MEMORY_SCOPE_AGENT); }
__device__ __forceinline__ unsigned xb_xcc_id() { return (unsigned)__builtin_amdgcn_s_getreg((3 << 11) | 20) & 0xFu; }
#define XB_SPIN(cond, bar) do { unsigned _sp = 0; while (cond) { __builtin_amdgcn_s_sleep(1); \
    if ((++_sp & 255u) == 0u) { if (xb_ld(&(bar)[XB_TMO])) break; if (_sp > XB_SPIN_CAP) { atomicAdd(&(bar)[XB_TMO], 1u); break; } } } } while (0)

struct XcdBarrier {
    unsigned* bar; unsigned x;
    volatile LAS unsigned* st;
};

__device__ __forceinline__ XcdBarrier xcd_barrier_post(unsigned* bar, volatile LAS unsigned* st) {
    XcdBarrier b; b.bar = bar; b.x = xb_xcc_id(); b.st = st;
    if (threadIdx.x == 0) (void)xb_add(&bar[XB_XCNT(b.x)], 1u);
    return b;
}
__device__ __forceinline__ void xcd_barrier_complete(unsigned* bar, unsigned x, unsigned& nloc, unsigned& nx) {
    const unsigned G = gridDim.x * gridDim.y * gridDim.z;
    unsigned sum, cnt, mine, sp = 0u;
    for (;;) {
        sum = 0u; cnt = 0u; mine = 0u;
#pragma unroll
        for (unsigned j = 0; j < 16; ++j) { const unsigned c = xb_ld(&bar[XB_XCNT(j)]); sum += c; cnt += (c > 0u) ? 1u : 0u; mine = (j == x) ? c : mine; }
        if (sum == G) break;
        __builtin_amdgcn_s_sleep(1);
        if ((++sp & 255u) == 0u) { if (xb_ld(&bar[XB_TMO])) break; if (sp > XB_SPIN_CAP) { atomicAdd(&bar[XB_TMO], 1u); break; } }
    }
    nloc = mine > 0u ? mine : 1u; nx = cnt > 0u ? cnt : 1u;
}

__device__ __forceinline__ void xcd_barrier(const XcdBarrier& b) {
    asm volatile("s_waitcnt vmcnt(0)" ::: "memory");
    __syncthreads();
    if (threadIdx.x == 0) {
        unsigned* bar = b.bar;
        __builtin_amdgcn_s_waitcnt(0);
        unsigned nloc = b.st[0], nx = b.st[1];
        if (nloc == 0u) { xcd_barrier_complete(bar, b.x, nloc, nx); b.st[0] = nloc; b.st[1] = nx; }
        const unsigned old = xb_add(&bar[XB_XSUB(b.x)], 1u);
        const unsigned gen = old / nloc;
        if (old + 1u == (gen + 1u) * nloc) {
            __builtin_amdgcn_fence(__ATOMIC_RELEASE, "agent");
            asm volatile("s_waitcnt vmcnt(0)" ::: "memory");
            const unsigned og = xb_add(&bar[XB_TOP], 1u);
            const unsigned tg = og / nx;
            if (og + 1u == (tg + 1u) * nx) xb_add(&bar[XB_TOPGEN], 1u);
            else XB_SPIN(xb_ld(&bar[XB_TOPGEN]) == tg, bar);
            __builtin_amdgcn_fence(__ATOMIC_ACQUIRE, "agent");
            xb_add(&bar[XB_XGEN(b.x)], 1u);
            asm volatile("s_waitcnt vmcnt(0)" ::: "memory");
        } else {
            XB_SPIN(xb_ld(&bar[XB_XGEN(b.x)]) == gen, bar);
            __builtin_amdgcn_fence(__ATOMIC_ACQUIRE, "agent");
            asm volatile("s_waitcnt vmcnt(0)" ::: "memory");
        }
    }
    __syncthreads();
}


__global__ void __launch_bounds__(256, 2) hawk_fnet_megakernel(Params p) {
  extern __shared__ __attribute__((aligned(16))) unsigned char smem_raw[];
  cg::grid_group grid = cg::this_grid();
  u16* smem = (u16*)smem_raw;

  __shared__ unsigned xb_st[4];
  unsigned* bar = (unsigned*)(p.ws + OFF_BAR_BYTES);
  if (blockIdx.x == 0) {
    for (int i = threadIdx.x; i < XCD_BAR_WORDS; i += 256) __hip_atomic_store(&bar[i], 0u, __ATOMIC_RELAXED, __HIP_MEMORY_SCOPE_AGENT);
  }
  if (threadIdx.x < 4) xb_st[threadIdx.x] = 0u;
  phase_prologue(p, smem_raw);
  grid.sync();
  XcdBarrier xb = xcd_barrier_post(bar, (volatile LAS unsigned*)xb_st);
  phase_fold(p, smem);
  phase_h(p, 0);
  xcd_barrier(xb);
  for (int l = 0; l < 2; ++l) {
    phase_gemm1(p, l, smem);
    xcd_barrier(xb);
    phase_fft1(p, smem);
    xcd_barrier(xb);
    phase_fft2(p, smem);
    xcd_barrier(xb);
    phase_scan<1>(p, l, 0, smem_raw);
    xcd_barrier(xb);
    phase_carry(p);
    xcd_barrier(xb);
    phase_scan<3>(p, l, 0, smem_raw);
    xcd_barrier(xb);
    phase_scan<3>(p, l, 1, smem_raw);
    xcd_barrier(xb);
    phase_merge(p, l, smem);
    xcd_barrier(xb);
    phase_out(p, l, smem);
    xcd_barrier(xb);
    if (l == 0) { phase_h(p, 1); xcd_barrier(xb); }
  }
  phase_final(p);
}

extern "C" void kernel_launch(void* const* d_in, const int* in_sizes, int n_in,
                              void* d_out, int out_size, void* d_ws, size_t ws_size,
                              hipStream_t stream) {
  (void)in_sizes; (void)n_in; (void)out_size;
  if (ws_size < (size_t)WS_NEED) {
    fprintf(stderr, "workspace too small: %zu < %ld\n", ws_size, (long)WS_NEED);
    return;
  }
  static int grid_blocks = 0;
  if (!grid_blocks) {
    hipFuncSetAttribute((const void*)hawk_fnet_megakernel, hipFuncAttributeMaxDynamicSharedMemorySize, SMEM_BYTES);
    int dev = 0, cus = 0, per_cu = 0;
    hipGetDevice(&dev);
    hipDeviceGetAttribute(&cus, hipDeviceAttributeMultiprocessorCount, dev);
    hipOccupancyMaxActiveBlocksPerMultiprocessor(&per_cu, hawk_fnet_megakernel, 256, SMEM_BYTES);
    if (per_cu > 2) per_cu = 2;
    if (per_cu < 1) per_cu = 1;
    grid_blocks = (cus * per_cu) & ~15;
  }
  Params p{};
  p.x_prompt = (const float*)d_in[0]; p.x_sample = (const float*)d_in[1];
  p.c_prompt = (const float*)d_in[2]; p.c_sample = (const float*)d_in[3];
  p.norm_g = (const float*)d_in[4]; p.w_ada = (const float*)d_in[5]; p.b_ada = (const float*)d_in[6];
  p.w_in = (const float*)d_in[7]; p.conv_w = (const float*)d_in[8]; p.conv_b = (const float*)d_in[9];
  p.w_rg = (const float*)d_in[10]; p.b_rg = (const float*)d_in[11]; p.lam = (const float*)d_in[12];
  p.w_a_out = (const float*)d_in[13]; p.w_b_out = (const float*)d_in[14]; p.w_o = (const float*)d_in[15];
  p.final_g = (const float*)d_in[16];
  p.out = (float*)d_out; p.ws = (unsigned char*)d_ws;
  void* args[] = {&p};
  hipError_t e = hipLaunchCooperativeKernel((void*)hawk_fnet_megakernel, dim3(grid_blocks), dim3(256), args, SMEM_BYTES, stream);
  if (e != hipSuccess) fprintf(stderr, "cooperative launch failed: %s (grid %d)\n", hipGetErrorString(e), grid_blocks);
}
```

```cpp
#include <hip/hip_runtime.h>
#include <hip/hip_cooperative_groups.h>
#include <cstdio>
namespace cg = cooperative_groups;

typedef unsigned short u16;
typedef __attribute__((ext_vector_type(8))) short bf16x8;
typedef __attribute__((ext_vector_type(4))) float f32x4;

#define DEVFN __device__ __forceinline__

constexpr int D = 1024;
constexpr int T_TOT = 81920;
constexpr long UNIT = (long)T_TOT * D;
constexpr int D_IN = 6144;

constexpr long OFF_W = 6 * UNIT;
constexpr long W_CAT = 0;
constexpr long W_A = 7168L * 1024;
constexpr long W_B = W_A + 1048576;
constexpr long W_O = W_B + 1048576;
constexpr long W_RG = W_O + 1048576;
constexpr long LW = W_RG + 524288;
constexpr long OFF_TAB = OFF_W + 2 * LW;
constexpr long T_D1A = 0;
constexpr long T_D1B = 65536;
constexpr long T_D2 = T_D1B + 16384;
constexpr long T_DC = T_D2 + 32768;
constexpr long TAB_ELEMS = T_DC + 131072;
constexpr long OFF_TW_BYTES = (OFF_TAB + TAB_ELEMS) * 2;
constexpr long OFF_MOD_BYTES = OFF_TW_BYTES + 131072;
constexpr long OFF_BAR_BYTES = OFF_MOD_BYTES + 221184;
constexpr long WS_NEED = OFF_BAR_BYTES + 16384;

constexpr int TILE = 128 * 64;
constexpr int SMEM_BYTES = 65536;

struct Params {
  const float* x_prompt; const float* x_sample; const float* c_prompt; const float* c_sample;
  const float* norm_g; const float* w_ada; const float* b_ada; const float* w_in;
  const float* conv_w; const float* conv_b; const float* w_rg; const float* b_rg; const float* lam;
  const float* w_a_out; const float* w_b_out; const float* w_o; const float* final_g;
  float* out; unsigned char* ws;
};

typedef __attribute__((ext_vector_type(2))) float f32x2_t;
typedef __attribute__((ext_vector_type(2))) __bf16 bf16x2_t;
DEVFN u16 f2bf(float f) {
  __bf16 h = (__bf16)f;
  return *(u16*)&h;
}
DEVFN float bf2f(u16 h) { return __uint_as_float(((unsigned)h) << 16); }
DEVFN unsigned pack2(float a, float b) {
  f32x2_t v = {a, b};
  bf16x2_t r = __builtin_convertvector(v, bf16x2_t);
  return *(unsigned*)&r;
}
DEVFN float lo2f(unsigned v) { return __uint_as_float(v << 16); }
DEVFN float hi2f(unsigned v) { return __uint_as_float(v & 0xffff0000u); }
DEVFN float sigm(float x) { return __builtin_amdgcn_rcpf(1.f + __expf(-x)); }
DEVFN float silu(float x) { return x * __builtin_amdgcn_rcpf(1.f + __expf(-x)); }
DEVFN float one_minus_exp(float x) {
  float pl = -x * (1.f + x * (0.5f + x * (1.f / 6.f + x * (1.f / 24.f + x * (1.f / 120.f + x * (1.f / 720.f))))));
  float dr = 1.f - __expf(x);
  return x > -0.3f ? pl : dr;
}

DEVFN int otid() { int t = threadIdx.x; asm volatile("" : "+v"(t)); return t; }
DEVFN int seq_of(int g) { int seg = g >> 13; return seg < 2 ? 0 : seg - 1; }
DEVFN int seq_start(int s) { return s == 0 ? 0 : 16384 + (s - 1) * 8192; }
DEVFN int seq_len(int s) { return s == 0 ? 16384 : 8192; }

DEVFN u16* U(const Params& p, int i) { return (u16*)(p.ws) + (long)i * UNIT; }
DEVFN u16* WL(const Params& p, int l) { return (u16*)(p.ws) + OFF_W + (long)l * LW; }
DEVFN u16* TAB(const Params& p) { return (u16*)(p.ws) + OFF_TAB; }
DEVFN float2* TW(const Params& p) { return (float2*)(p.ws + OFF_TW_BYTES); }
DEVFN float* MOD(const Params& p) { return (float*)(p.ws + OFF_MOD_BYTES); }
DEVFN const float* xrow(const Params& p, int g) {
  return g < 16384 ? p.x_prompt + (long)g * D : p.x_sample + (long)(g - 16384) * D;
}

struct LdPlain {
  static constexpr bool kDma = true; static constexpr bool kTr = false;
  const u16* base; unsigned off0; unsigned cst; int t_;
  DEVFN void init(int tid_, const u16* b, unsigned row0, unsigned stride) {
    unsigned tid = tid_; t_ = tid_;
    base = b;
    off0 = (row0 + (tid >> 3)) * stride + (((tid & 7) ^ ((tid >> 3) & 7)) << 3);
    cst = 32 * stride;
  }
  DEVFN void issue(u16* tile, int c, int kt) const {
    __builtin_amdgcn_global_load_lds((const unsigned*)(base + (off0 + c * cst + kt * 64)),
                                     (unsigned*)(tile + (t_ + c * 256) * 8), 16, 0, 0);
  }
  DEVFN uint4 load(int, int) const { return make_uint4(0, 0, 0, 0); }
  DEVFN void store(u16*, int, uint4) const {}
};
struct LdRows4 {
  static constexpr bool kDma = true; static constexpr bool kTr = false;
  const u16* base; unsigned off[4]; int t_;
  DEVFN void issue(u16* tile, int c, int kt) const {
    __builtin_amdgcn_global_load_lds((const unsigned*)(base + (off[c] + kt * 64)),
                                     (unsigned*)(tile + (t_ + c * 256) * 8), 16, 0, 0);
  }
  DEVFN uint4 load(int, int) const { return make_uint4(0, 0, 0, 0); }
  DEVFN void store(u16*, int, uint4) const {}
};
struct LdF32 {
  static constexpr bool kDma = false; static constexpr bool kTr = false;
  const float* base; unsigned off0; unsigned cst; int t_;
  DEVFN void init(int tid_, const float* b, unsigned row0, unsigned stride, unsigned col0) {
    unsigned tid = tid_; t_ = tid_;
    base = b;
    off0 = (row0 + (tid >> 3)) * stride + col0 + (tid & 7) * 8;
    cst = 32 * stride;
  }
  DEVFN void issue(u16*, int, int) const {}
  DEVFN uint4 load(int c, int kt) const {
    const float4* q = (const float4*)(base + (off0 + c * cst + kt * 64));
    float4 a = q[0], b = q[1];
    uint4 r; r.x = pack2(a.x, a.y); r.y = pack2(a.z, a.w); r.z = pack2(b.x, b.y); r.w = pack2(b.z, b.w);
    return r;
  }
  DEVFN void store(u16* tile, int c, uint4 v) const {
    int idx = t_ + c * 256;
    int row = idx >> 3, kc = idx & 7;
    *(uint4*)(tile + row * 64 + ((kc ^ (row & 7)) << 3)) = v;
  }
};
DEVFN int trf(int r) { return ((r & 3) << 2) | ((r >> 2) & 3); }
template <class TokFn>
struct LdTrans {
  static constexpr bool kDma = false; static constexpr bool kTr = false;
  TokFn tok; int t_;
  DEVFN void issue(u16*, int, int) const {}
  DEVFN uint4 load(int c, int kt) const {
    int idx = t_ + c * 256;
    int kk = idx & 63, cc = idx >> 6;
    const u16* b; unsigned o = tok(kt * 64 + kk, b);
    return *(const uint4*)(b + (o + cc * 8));
  }
  DEVFN void store(u16* tile, int c, uint4 v) const {
    int idx = t_ + c * 256;
    int kk = idx & 63, cc = idx >> 6;
    u16* q = tile + (cc * 8) * 64 + (kk & 7);
    int kc = kk >> 3;
    q[0 * 64 + ((kc ^ 0) << 3)] = (u16)(v.x & 0xffff); q[1 * 64 + ((kc ^ 1) << 3)] = (u16)(v.x >> 16);
    q[2 * 64 + ((kc ^ 2) << 3)] = (u16)(v.y & 0xffff); q[3 * 64 + ((kc ^ 3) << 3)] = (u16)(v.y >> 16);
    q[4 * 64 + ((kc ^ 4) << 3)] = (u16)(v.z & 0xffff); q[5 * 64 + ((kc ^ 5) << 3)] = (u16)(v.z >> 16);
    q[6 * 64 + ((kc ^ 6) << 3)] = (u16)(v.w & 0xffff); q[7 * 64 + ((kc ^ 7) << 3)] = (u16)(v.w >> 16);
  }
};

typedef __attribute__((ext_vector_type(4))) short s16x4;
DEVFN s16x4 lds_tr_read(const u16* q) {
  return __builtin_amdgcn_ds_read_tr16_b64_v4i16((s16x4 __attribute__((address_space(3)))*)(q));
}

DEVFN void zero_acc(f32x4 (&acc)[4][4]) {
#pragma unroll
  for (int i = 0; i < 4; ++i)
#pragma unroll
    for (int j = 0; j < 4; ++j) acc[i][j] = f32x4{0.f, 0.f, 0.f, 0.f};
}

template <class LA, class LB>
DEVFN void gemm_core(int tid, f32x4 (&acc)[4][4], int nk, const LA& la, const LB& lb, u16* smem) {
  const int lane = tid & 63, w = tid >> 6, wm = w >> 1, wn = w & 1;
  const int lr = lane & 15, quad = lane >> 4;
  uint4 ra[4], rb[4];
  if (LA::kDma) {
#pragma unroll
    for (int c = 0; c < 4; ++c) la.issue(smem, c, 0);
  } else {
#pragma unroll
    for (int c = 0; c < 4; ++c) ra[c] = la.load(c, 0);
  }
  if (LB::kDma) {
#pragma unroll
    for (int c = 0; c < 4; ++c) lb.issue(smem + TILE, c, 0);
  } else {
#pragma unroll
    for (int c = 0; c < 4; ++c) rb[c] = lb.load(c, 0);
  }
  if (!LA::kDma) {
#pragma unroll
    for (int c = 0; c < 4; ++c) la.store(smem, c, ra[c]);
  }
  if (!LB::kDma) {
#pragma unroll
    for (int c = 0; c < 4; ++c) lb.store(smem + TILE, c, rb[c]);
  }
  asm volatile("s_waitcnt vmcnt(0)" ::: "memory");
  __syncthreads();
  const int aoff = (wm * 64 + lr) * 64, boff = (wn * 64 + lr) * 64;
  const int sw0 = ((quad) ^ (lr & 7)) << 3, sw1 = ((4 + quad) ^ (lr & 7)) << 3;
  int troff[4][2];
  if (LB::kTr) {
    const int q = lr >> 2, pp = lr & 3;
#pragma unroll
    for (int j = 0; j < 4; ++j)
#pragma unroll
      for (int h = 0; h < 2; ++h) {
        int r = quad * 8 + h * 4 + q;
        int ch = (wn * 8 + j * 2 + (pp >> 1)) ^ trf(r);
        troff[j][h] = r * 128 + ch * 8 + (pp & 1) * 4;
      }
  }
  for (int kt = 0; kt < nk; ++kt) {
    const u16* sA = smem + (kt & 1) * 2 * TILE;
    const u16* sB = sA + TILE;
    u16* nA = smem + ((kt + 1) & 1) * 2 * TILE;
    const bool more = (kt + 1) < nk;
    if (more) {
      if (LA::kDma) {
#pragma unroll
        for (int c = 0; c < 4; ++c) la.issue(nA, c, kt + 1);
      } else {
#pragma unroll
        for (int c = 0; c < 4; ++c) ra[c] = la.load(c, kt + 1);
      }
      if (LB::kDma) {
#pragma unroll
        for (int c = 0; c < 4; ++c) lb.issue(nA + TILE, c, kt + 1);
      } else {
#pragma unroll
        for (int c = 0; c < 4; ++c) rb[c] = lb.load(c, kt + 1);
      }
    }
#pragma unroll
    for (int ks = 0; ks < 2; ++ks) {
      const int sw = ks == 0 ? sw0 : sw1;
      bf16x8 af[4], bfr[4];
#pragma unroll
      for (int i = 0; i < 4; ++i) af[i] = *(const bf16x8*)(sA + aoff + i * 1024 + sw);
      if (LB::kTr) {
#pragma unroll
        for (int j = 0; j < 4; ++j) {
          s16x4 lo = lds_tr_read(sB + troff[j][0] + ks * 4096);
          s16x4 hi = lds_tr_read(sB + troff[j][1] + ks * 4096);
          bfr[j] = __builtin_shufflevector(lo, hi, 0, 1, 2, 3, 4, 5, 6, 7);
        }
      } else {
#pragma unroll
        for (int j = 0; j < 4; ++j) bfr[j] = *(const bf16x8*)(sB + boff + j * 1024 + sw);
      }
      __builtin_amdgcn_s_setprio(1);
#pragma unroll
      for (int i = 0; i < 4; ++i)
#pragma unroll
        for (int j = 0; j < 4; ++j)
          acc[i][j] = __builtin_amdgcn_mfma_f32_16x16x32_bf16(bfr[j], af[i], acc[i][j], 0, 0, 0);
      __builtin_amdgcn_s_setprio(0);
    }
    if (more) {
      if (!LA::kDma) {
#pragma unroll
        for (int c = 0; c < 4; ++c) la.store(nA, c, ra[c]);
      }
      if (!LB::kDma) {
#pragma unroll
        for (int c = 0; c < 4; ++c) lb.store(nA + TILE, c, rb[c]);
      }
    }
    asm volatile("s_waitcnt vmcnt(0)" ::: "memory");
    __syncthreads();
  }
}

DEVFN bool tile_xcd(int it, int ngrp, int ntn, int& mt, int& nt) {
  const int G = gridDim.x, b = blockIdx.x;
  if (G == 512) {
    if (it >= 10 * ngrp) return false;
    int xcd = b & 7, loc = b >> 3;
    mt = xcd * 80 + (it / ngrp) * 8 + (loc >> 3);
    nt = (it % ngrp) * 8 + (loc & 7);
    return true;
  }
  int tile = b + it * G;
  if (tile >= 640 * ntn) return false;
  mt = tile / ntn; nt = tile % ntn;
  return true;
}

DEVFN void transpose_tile(const float* src, long ld, u16* dst, long ldd, float* sT) {
  const int tid = otid();
#pragma unroll
  for (int pss = 0; pss < 4; ++pss) {
    int kk = (tid >> 4) + pss * 16, n4 = (tid & 15) * 4;
    float4 v = *(const float4*)(src + (long)kk * ld + n4);
    sT[kk * 65 + n4 + 0] = v.x; sT[kk * 65 + n4 + 1] = v.y; sT[kk * 65 + n4 + 2] = v.z; sT[kk * 65 + n4 + 3] = v.w;
  }
  __syncthreads();
  {
    int n = tid >> 2, k0 = (tid & 3) * 16;
    unsigned o[8];
#pragma unroll
    for (int e = 0; e < 8; ++e) o[e] = pack2(sT[(k0 + 2 * e) * 65 + n], sT[(k0 + 2 * e + 1) * 65 + n]);
    uint4* q = (uint4*)(dst + (long)n * ldd + k0);
    q[0] = make_uint4(o[0], o[1], o[2], o[3]);
    q[1] = make_uint4(o[4], o[5], o[6], o[7]);
  }
  __syncthreads();
}

DEVFN void phase_prologue(const Params& p, unsigned char* smem_raw) {
  const int tid = otid();
  constexpr int NJ_TR = 4352, NJ_MOD = 96, NJ_TAB = 256;
  for (int job = blockIdx.x; job < NJ_TR + NJ_MOD + NJ_TAB; job += gridDim.x) {
    if (job < NJ_TR) {
      float* sT = (float*)smem_raw;
      int l = job / 2176, r = job % 2176;
      u16* wl = WL(p, l);
      if (r < 1280) {
        int kt = r / 80, ntile = r % 80;
        int orow = ntile * 64;
        int scol;
        if (orow < 2048) scol = orow; else { orow += 2048; scol = orow - 1024; }
        transpose_tile(p.w_in + (long)l * D * D_IN + (long)(kt * 64) * D_IN + scol, D_IN,
                       wl + W_CAT + (long)orow * D + kt * 64, D, sT);
      } else if (r < 2048) {
        int r2 = r - 1280, which = r2 >> 8, t = r2 & 255, kt = t >> 4, ntile = t & 15;
        const float* src = (which == 0 ? p.w_a_out : which == 1 ? p.w_b_out : p.w_o) + (long)l * 1048576;
        long doff = which == 0 ? W_A : which == 1 ? W_B : W_O;
        transpose_tile(src + (long)(kt * 64) * D + ntile * 64, D, wl + doff + (long)(ntile * 64) * D + kt * 64, D, sT);
      } else {
        int r3 = r - 2048, mat = r3 >> 2, t = r3 & 3, kt = t >> 1, ntile = t & 1;
        const float* src = p.w_rg + ((long)l * 32 + mat) * 16384;
        transpose_tile(src + (long)(kt * 64) * 128 + ntile * 64, 128,
                       wl + W_RG + (long)mat * 16384 + (long)(ntile * 64) * 128 + kt * 64, 128, sT);
      }
    } else if (job < NJ_TR + NJ_MOD) {
      int jm = job - NJ_TR, l = jm / 48, cgp = jm % 48;
      float* sc = (float*)smem_raw;
      float* red = sc + 9 * 1024;
      for (int i = tid; i < 9 * 1024; i += 256) {
        int s = i >> 10, k = i & 1023;
        float cv = s == 0 ? p.c_prompt[k] : p.c_sample[(s - 1) * 1024 + k];
        sc[i] = silu(cv);
      }
      __syncthreads();
      int col = cgp * 64 + (tid & 63), kq = tid >> 6;
      float a0 = 0, a1 = 0, a2 = 0, a3 = 0, a4 = 0, a5 = 0, a6 = 0, a7 = 0, a8 = 0;
      const float* wp = p.w_ada + (long)l * D * 3072 + col;
#pragma unroll 4
      for (int k = kq * 256; k < kq * 256 + 256; ++k) {
        float wv = wp[(long)k * 3072];
        a0 += sc[0 * 1024 + k] * wv; a1 += sc[1 * 1024 + k] * wv; a2 += sc[2 * 1024 + k] * wv;
        a3 += sc[3 * 1024 + k] * wv; a4 += sc[4 * 1024 + k] * wv; a5 += sc[5 * 1024 + k] * wv;
        a6 += sc[6 * 1024 + k] * wv; a7 += sc[7 * 1024 + k] * wv; a8 += sc[8 * 1024 + k] * wv;
      }
      float* rq = red + kq * 9 * 64 + (tid & 63);
      rq[0 * 64] = a0; rq[1 * 64] = a1; rq[2 * 64] = a2; rq[3 * 64] = a3; rq[4 * 64] = a4;
      rq[5 * 64] = a5; rq[6 * 64] = a6; rq[7 * 64] = a7; rq[8 * 64] = a8;
      __syncthreads();
      for (int i = tid; i < 9 * 64; i += 256) {
        int s = i >> 6, cc = i & 63;
        float v = red[0 * 576 + i] + red[1 * 576 + i] + red[2 * 576 + i] + red[3 * 576 + i];
        int cf = cgp * 64 + cc;
        MOD(p)[((long)l * 9 + s) * 3072 + cf] = v + p.b_ada[l * 3072 + cf];
      }
      __syncthreads();
    } else {
      int jt = job - NJ_TR - NJ_MOD;
      u16* tab = TAB(p);
#pragma unroll
      for (int e4 = 0; e4 < 4; ++e4) {
        int e = jt * 1024 + e4 * 256 + tid;
        if (e < 65536) {
          int m = e >> 8, k = e & 255;
          int k1 = (m >> 5) * 16 + (m & 15), ro = (m >> 4) & 1, ri = k >> 7, s1 = k & 127;
          float x = 2.f * (float)((k1 * s1) & 127) / 128.f;
          float cs = cospif(x), sn = sinpif(x);
          float v = (ro == ri) ? cs : (ro == 0 ? sn : -sn);
          tab[T_D1A + e] = f2bf(v);
        } else if (e < 65536 + 16384) {
          int e2 = e - 65536;
          int m = e2 >> 7, k = e2 & 127;
          int k1 = (m >> 5) * 16 + (m & 15), ro = (m >> 4) & 1, ri = k >> 6, s1 = k & 63;
          float x = 2.f * (float)((k1 * s1) & 63) / 64.f;
          float cs = cospif(x), sn = sinpif(x);
          float v = (ro == ri) ? cs : (ro == 0 ? sn : -sn);
          tab[T_D1B + e2] = f2bf(v);
        } else if (e < 65536 + 16384 + 32768) {
          int e2 = e - 65536 - 16384;
          int k2 = e2 >> 8, k = e2 & 255, ri = k >> 7, s2 = k & 127;
          float x = 2.f * (float)((k2 * s2) & 127) / 128.f;
          float v = ri == 0 ? cospif(x) : sinpif(x);
          tab[T_D2 + e2] = f2bf(v);
        } else if (e < 65536 + 16384 + 32768 + 131072) {
          int e2 = e - 65536 - 16384 - 32768;
          int row = e2 >> 8, c = e2 & 255, ri = row >> 8, m = row & 255;
          float x = 2.f * (float)((m * c) & 255) / 256.f;
          float v = ri == 0 ? cospif(x) : -sinpif(x);
          tab[T_DC + e2] = f2bf(v);
        } else {
          int e2 = e - (65536 + 16384 + 32768 + 131072);
          if (e2 < 16384) {
            float x = 2.f * (float)e2 / 16384.f;
            TW(p)[e2] = make_float2(cospif(x), sinpif(x));
          }
        }
      }
    }
  }
}

DEVFN void phase_fold(const Params& p, u16* smem) {
  for (int tile = blockIdx.x; tile < 256; tile += gridDim.x) {
    const int tid = otid(), lane = tid & 63, w = tid >> 6, wm = w >> 1, wn = w & 1, lr = lane & 15, quad = lane >> 4;
    int l = tile >> 7, g = (tile >> 5) & 3, mt = (tile >> 3) & 3, nt = tile & 7;
    LdPlain la; la.init(tid, TAB(p) + T_DC, mt * 128, 256);
    LdF32 lb; lb.init(tid, p.w_in + (long)l * D * D_IN, nt * 128, D_IN, 2048 + g * 256);
    f32x4 acc[4][4]; zero_acc(acc);
    gemm_core(tid, acc, 4, la, lb, smem);
    int ri = mt >> 1;
    u16* wc = WL(p, l) + W_CAT;
#pragma unroll
    for (int i = 0; i < 4; ++i) {
      int mrow = (mt & 1) * 128 + wm * 64 + i * 16 + lr;
      unsigned orow = 2048 + ri * 1024 + g * 256 + mrow;
#pragma unroll
      for (int j = 0; j < 4; ++j) {
        int n = nt * 128 + wn * 64 + j * 16 + quad * 4;
        uint2 o; o.x = pack2(acc[i][j][0], acc[i][j][1]); o.y = pack2(acc[i][j][2], acc[i][j][3]);
        *(uint2*)(wc + orow * D + n) = o;
      }
    }
  }
}

DEVFN void phase_h(const Params& p, int l) {
  const int lane = threadIdx.x & 63;
  const int wid = blockIdx.x * 4 + (threadIdx.x >> 6), nw = gridDim.x * 4;
  const float* ng = p.norm_g + l * D;
  const float* modl = MOD(p) + (long)l * 9 * 3072;
  u16* H = U(p, 0);
  for (int g = wid; g < T_TOT; g += nw) {
    const float* xb = (l == 0) ? (g < 16384 ? p.x_prompt : p.x_sample) : p.out;
    const unsigned xo = (unsigned)((l == 0 && g >= 16384) ? g - 16384 : g) * D;
    const float* xr = xb + xo;
    const float* md = modl + seq_of(g) * 3072;
    float4 v[4];
    float ss = 0.f;
#pragma unroll
    for (int i = 0; i < 4; ++i) {
      v[i] = *(const float4*)(xr + i * 256 + lane * 4);
      ss += v[i].x * v[i].x + v[i].y * v[i].y + v[i].z * v[i].z + v[i].w * v[i].w;
    }
#pragma unroll
    for (int o = 32; o >= 1; o >>= 1) ss += __shfl_xor(ss, o, 64);
    float rstd = rsqrtf(ss * (1.f / 1024.f) + 1e-6f);
#pragma unroll
    for (int i = 0; i < 4; ++i) {
      int c = i * 256 + lane * 4;
      float4 g4 = *(const float4*)(ng + c);
      float4 sh = *(const float4*)(md + c);
      float4 sc = *(const float4*)(md + 1024 + c);
      float h0 = v[i].x * rstd * g4.x * (1.f + sc.x) + sh.x;
      float h1 = v[i].y * rstd * g4.y * (1.f + sc.y) + sh.y;
      float h2 = v[i].z * rstd * g4.z * (1.f + sc.z) + sh.z;
      float h3 = v[i].w * rstd * g4.w * (1.f + sc.w) + sh.w;
      uint2 o; o.x = pack2(h0, h1); o.y = pack2(h2, h3);
      *(uint2*)(H + ((unsigned)g * D + c)) = o;
    }
  }
}

DEVFN void phase_final(const Params& p) {
  const int lane = threadIdx.x & 63;
  const int wid = blockIdx.x * 4 + (threadIdx.x >> 6), nw = gridDim.x * 4;
  for (int g = wid; g < T_TOT; g += nw) {
    float* xr = p.out + (unsigned)g * D;
    float4 v[4];
    float ss = 0.f;
#pragma unroll
    for (int i = 0; i < 4; ++i) {
      v[i] = *(const float4*)(xr + i * 256 + lane * 4);
      ss += v[i].x * v[i].x + v[i].y * v[i].y + v[i].z * v[i].z + v[i].w * v[i].w;
    }
#pragma unroll
    for (int o = 32; o >= 1; o >>= 1) ss += __shfl_xor(ss, o, 64);
    float rstd = rsqrtf(ss * (1.f / 1024.f) + 1e-6f);
#pragma unroll
    for (int i = 0; i < 4; ++i) {
      int c = i * 256 + lane * 4;
      float4 g4 = *(const float4*)(p.final_g + c);
      float4 o;
      o.x = v[i].x * rstd * g4.x; o.y = v[i].y * rstd * g4.y; o.z = v[i].z * rstd * g4.z; o.w = v[i].w * rstd * g4.w;
      *(float4*)(xr + c) = o;
    }
  }
}

DEVFN void phase_gemm1(const Params& p, int l, u16* smem) {
  const u16* H = U(p, 0);
  const u16* W = WL(p, l) + W_CAT;
  for (int it = 0;; ++it) {
    int mt, nt;
    if (!tile_xcd(it, 5, 40, mt, nt)) break;
    const int tid = otid(), lane = tid & 63, w = tid >> 6, wm = w >> 1, wn = w & 1, lr = lane & 15, quad = lane >> 4;
    LdPlain la; la.init(tid, H, mt * 128, D);
    LdPlain lb; lb.init(tid, W, nt * 128, D);
    f32x4 acc[4][4]; zero_acc(acc);
    gemm_core(tid, acc, 16, la, lb, smem);
    int unit = nt >> 3, col0 = (nt & 7) * 128;
    u16* outp = U(p, 1 + unit);
    bool act = (unit == 1) || (unit == 4);
#pragma unroll
    for (int i = 0; i < 4; ++i) {
      unsigned g = mt * 128 + wm * 64 + i * 16 + lr;
#pragma unroll
      for (int j = 0; j < 4; ++j) {
        unsigned c = col0 + wn * 64 + j * 16 + quad * 4;
        float v0 = acc[i][j][0], v1 = acc[i][j][1], v2 = acc[i][j][2], v3 = acc[i][j][3];
        if (act) { v0 = silu(v0); v1 = silu(v1); v2 = silu(v2); v3 = silu(v3); }
        uint2 o; o.x = pack2(v0, v1); o.y = pack2(v2, v3);
        *(uint2*)(outp + g * D + c) = o;
      }
    }
  }
}

struct TokF1 {
  const u16* zr; const u16* zi; int n1; unsigned off;
  DEVFN unsigned operator()(int k, const u16*& b) const {
    int ri = k >= n1 ? 1 : 0;
    int s1 = k - ri * n1;
    b = ri ? zi : zr;
    return off + (unsigned)(s1 * 128) * D;
  }
};
DEVFN void f1_twiddle(int tid, const Params& p, const f32x4 (&acc)[4][4], int hf, int s2, int smask, int twmul,
                      uint2 (&o1)[2][4], uint2 (&o2)[2][4]) {
  const int lane = tid & 63, w = tid >> 6, wm = w >> 1, lr = lane & 15;
  const float2* tw = TW(p);
#pragma unroll
  for (int b = 0; b < 2; ++b) {
    int k1 = (hf * 4 + wm * 2 + b) * 16 + lr;
    float2 t = tw[((k1 * s2) & smask) * twmul];
#pragma unroll
    for (int j = 0; j < 4; ++j) {
      f32x4 orr = acc[2 * b][j], oii = acc[2 * b + 1][j];
      o1[b][j].x = pack2(orr[0] * t.x + oii[0] * t.y, orr[1] * t.x + oii[1] * t.y);
      o1[b][j].y = pack2(orr[2] * t.x + oii[2] * t.y, orr[3] * t.x + oii[3] * t.y);
      o2[b][j].x = pack2(oii[0] * t.x - orr[0] * t.y, oii[1] * t.x - orr[1] * t.y);
      o2[b][j].y = pack2(oii[2] * t.x - orr[2] * t.y, oii[3] * t.x - orr[3] * t.y);
    }
  }
}
DEVFN void f1_write(int tid, int hf, unsigned off, const uint2 (&o1)[2][4], const uint2 (&o2)[2][4], u16* zr, u16* zi) {
  const int lane = tid & 63, w = tid >> 6, wm = w >> 1, wn = w & 1, lr = lane & 15, quad = lane >> 4;
#pragma unroll
  for (int b = 0; b < 2; ++b) {
    unsigned k1 = (hf * 4 + wm * 2 + b) * 16 + lr;
    unsigned rowoff = off + (k1 * 128) * D + wn * 64 + quad * 4;
#pragma unroll
    for (int j = 0; j < 4; ++j) {
      *(uint2*)(zr + (rowoff + j * 16)) = o1[b][j];
      *(uint2*)(zi + (rowoff + j * 16)) = o2[b][j];
    }
  }
}
DEVFN void phase_fft1(const Params& p, u16* smem) {
  u16* zr = U(p, 3);
  u16* zi = U(p, 4);
  for (int tile = blockIdx.x; tile < 9216; tile += gridDim.x) {
    const int tid = otid();
    int seq, s2, ct, n1;
    if (tile < 1024) { seq = 0; s2 = tile >> 3; ct = tile & 7; n1 = 128; }
    else { int t2 = tile - 1024; seq = 1 + (t2 >> 10); s2 = (t2 >> 3) & 127; ct = t2 & 7; n1 = 64; }
    const unsigned off = (unsigned)(seq_start(seq) + s2) * D + ct * 128;
    LdTrans<TokF1> lb; lb.t_ = tid; lb.tok.zr = zr; lb.tok.zi = zi; lb.tok.n1 = n1; lb.tok.off = off;
    const int K = 2 * n1, nk = K >> 6;
    const u16* tab = TAB(p) + (seq == 0 ? T_D1A : T_D1B);
    const int smask = seq == 0 ? 16383 : 8191, twmul = seq == 0 ? 1 : 2;
    uint2 a1[2][4], a2[2][4];
    {
      f32x4 acc[4][4]; zero_acc(acc);
      LdPlain la; la.init(tid, tab, 0, K); gemm_core(tid, acc, nk, la, lb, smem);
      f1_twiddle(tid, p, acc, 0, s2, smask, twmul, a1, a2);
    }
    if (seq == 0) {
      uint2 b1[2][4], b2[2][4];
      {
        f32x4 acc[4][4]; zero_acc(acc);
        LdPlain la; la.init(tid, tab, 128, K); gemm_core(tid, acc, nk, la, lb, smem);
        f1_twiddle(tid, p, acc, 1, s2, smask, twmul, b1, b2);
      }
      f1_write(tid, 1, off, b1, b2, zr, zi);
    }
    f1_write(tid, 0, off, a1, a2, zr, zi);
  }
}

struct TokF2 {
  const u16* zr; const u16* zi; unsigned off;
  DEVFN unsigned operator()(int k, const u16*& b) const {
    int ri = k >> 7, s2 = k & 127;
    b = ri ? zi : zr;
    return off + (unsigned)s2 * D;
  }
};
DEVFN void phase_fft2(const Params& p, u16* smem) {
  u16* zr = U(p, 3);
  const u16* gbp = U(p, 5);
  for (int tile = blockIdx.x; tile < 5120; tile += gridDim.x) {
    const int tid = otid(), lane = tid & 63, w = tid >> 6, wm = w >> 1, wn = w & 1, lr = lane & 15, quad = lane >> 4;
    int seq, k1, ct, n1;
    if (tile < 1024) { seq = 0; k1 = tile >> 3; ct = tile & 7; n1 = 128; }
    else { int t2 = tile - 1024; seq = 1 + (t2 >> 9); k1 = (t2 >> 3) & 63; ct = t2 & 7; n1 = 64; }
    const int sst = seq_start(seq);
    const unsigned off = (unsigned)(sst + k1 * 128) * D + ct * 128;
    LdTrans<TokF2> lb; lb.t_ = tid; lb.tok.zr = zr; lb.tok.zi = U(p, 4); lb.tok.off = off;
    LdPlain la; la.init(tid, TAB(p) + T_D2, 0, 256);
    f32x4 acc[4][4]; zero_acc(acc);
    gemm_core(tid, acc, 4, la, lb, smem);
    const float nrm = seq == 0 ? (1.f / 2048.f) : 6.9053396600248786e-4f;
#pragma unroll
    for (int i = 0; i < 4; ++i) {
      unsigned k2 = wm * 64 + i * 16 + lr;
      unsigned goff = (unsigned)(sst + k1 + n1 * k2) * D + ct * 128;
#pragma unroll
      for (int j = 0; j < 4; ++j) {
        unsigned cl = wn * 64 + j * 16 + quad * 4;
        uint2 gv = *(const uint2*)(gbp + (goff + cl));
        uint2 o;
        o.x = pack2(acc[i][j][0] * nrm * lo2f(gv.x), acc[i][j][1] * nrm * hi2f(gv.x));
        o.y = pack2(acc[i][j][2] * nrm * lo2f(gv.y), acc[i][j][3] * nrm * hi2f(gv.y));
        *(uint2*)(zr + (off + k2 * D + cl)) = o;
      }
    }
  }
}

constexpr int SA_LD = 128;
template <int PASS>
DEVFN void phase_scan(const Params& p, int l, int dirsel, unsigned char* smem_raw) {
  float* sAf = (float*)smem_raw;
  u16* sXa = (u16*)smem_raw;
  float* sCw = (float*)(smem_raw + 17152);
  u16* sBh = (u16*)(smem_raw + 32768);
  u16* sXc = (u16*)(smem_raw + 32768 + 16384);
  const int tid = otid(), lane = tid & 63, w = tid >> 6, lr = lane & 15, quad = lane >> 4;
  const int head = blockIdx.x & 7;
  const int dir = PASS == 1 ? ((blockIdx.x >> 3) & 1) : dirsel;
  const int tstart = PASS == 1 ? (blockIdx.x >> 4) : (blockIdx.x >> 3);
  const int tstep = PASS == 1 ? (gridDim.x >> 4) : (gridDim.x >> 3);
  const u16* xa = U(p, 1);
  u16* ga = U(p, 2);
  u16* hf = U(p, 5);
  float2* agg = (float2*)U(p, 4);
  float* carry = (float*)(agg + 1280L * 2 * 1024);
  bf16x8 bw[4][4];
  {
    const u16* wrg = WL(p, l) + W_RG;
#pragma unroll
    for (int jt = 0; jt < 4; ++jt) {
      int q = jt >> 1, col = w * 32 + (jt & 1) * 16 + lr;
      const u16* bp = wrg + (unsigned)((((dir * 2 + q) * 8 + head) * 128 + col) * 128 + quad * 8);
#pragma unroll
      for (int ks = 0; ks < 4; ++ks) bw[jt][ks] = *(const bf16x8*)(bp + ks * 32);
    }
  }
  float spl[2], brr[2], bii[2];
#pragma unroll
  for (int jc = 0; jc < 2; ++jc) {
    int cgl = head * 128 + w * 32 + jc * 16 + lr;
    float lm = p.lam[(l * 2 + dir) * D + cgl];
    spl[jc] = -8.f * 1.4426950408889634f * log1pf(expf(-lm));
    brr[jc] = -1.4426950408889634f * p.b_rg[((l * 2 + dir) * 2 + 0) * D + cgl];
    bii[jc] = -1.4426950408889634f * p.b_rg[((l * 2 + dir) * 2 + 1) * D + cgl];
  }
  __syncthreads();
  for (int tt = tstart; tt < 1280; tt += tstep) {
    const int g0 = tt * 64;
    const int seq = seq_of(g0), sst = seq_start(seq), send = sst + seq_len(seq);
    for (int idx = tid; idx < 67 * 16; idx += 256) {
      int row = idx >> 4, cc = idx & 15;
      int g = g0 - 2 + row;
      uint4 v = make_uint4(0, 0, 0, 0);
      if (g >= sst && g < send) v = *(const uint4*)(xa + ((unsigned)g * D + head * 128 + cc * 8));
      *(uint4*)(sXa + row * 128 + cc * 8) = v;
    }
    for (int i = tid; i < 640; i += 256) {
      int k = i >> 7, c = i & 127;
      sCw[i] = k < 4 ? p.conv_w[(l * 4 + k) * D + head * 128 + c] : p.conv_b[l * D + head * 128 + c];
    }
    __syncthreads();
#pragma unroll 1
    for (int hh = 0; hh < 2; ++hh) {
      int tl = tid >> 2, cb = (tid & 3) * 32 + hh * 16;
      float o[16];
#pragma unroll
      for (int e = 0; e < 16; ++e) o[e] = sCw[512 + cb + e];
#pragma unroll
      for (int k = 0; k < 4; ++k) {
        uint4 v0 = *(const uint4*)(sXa + (tl + k) * 128 + cb);
        uint4 v1 = *(const uint4*)(sXa + (tl + k) * 128 + cb + 8);
        const float* wk = sCw + k * 128 + cb;
        o[0] += wk[0] * lo2f(v0.x); o[1] += wk[1] * hi2f(v0.x);
        o[2] += wk[2] * lo2f(v0.y); o[3] += wk[3] * hi2f(v0.y);
        o[4] += wk[4] * lo2f(v0.z); o[5] += wk[5] * hi2f(v0.z);
        o[6] += wk[6] * lo2f(v0.w); o[7] += wk[7] * hi2f(v0.w);
        o[8] += wk[8] * lo2f(v1.x); o[9] += wk[9] * hi2f(v1.x);
        o[10] += wk[10] * lo2f(v1.y); o[11] += wk[11] * hi2f(v1.y);
        o[12] += wk[12] * lo2f(v1.z); o[13] += wk[13] * hi2f(v1.z);
        o[14] += wk[14] * lo2f(v1.w); o[15] += wk[15] * hi2f(v1.w);
      }
      uint4 q0, q1;
      q0.x = pack2(o[0], o[1]); q0.y = pack2(o[2], o[3]); q0.z = pack2(o[4], o[5]); q0.w = pack2(o[6], o[7]);
      q1.x = pack2(o[8], o[9]); q1.y = pack2(o[10], o[11]); q1.z = pack2(o[12], o[13]); q1.w = pack2(o[14], o[15]);
      *(uint4*)(sXc + tl * 128 + ((((cb >> 3) + 0) ^ (tl & 7)) << 3)) = q0;
      *(uint4*)(sXc + tl * 128 + ((((cb >> 3) + 1) ^ (tl & 7)) << 3)) = q1;
    }
    __syncthreads();
    const int gstart = dir == 0 ? sst : send - 1;
#pragma unroll 1
    for (int hv = 0; hv < 2; ++hv) {
      f32x4 acc[2][4];
#pragma unroll
      for (int it = 0; it < 2; ++it)
#pragma unroll
        for (int jt = 0; jt < 4; ++jt) acc[it][jt] = f32x4{0.f, 0.f, 0.f, 0.f};
#pragma unroll
      for (int ks = 0; ks < 4; ++ks) {
#pragma unroll
        for (int it = 0; it < 2; ++it) {
          bf16x8 af = *(const bf16x8*)(sXc + ((hv * 2 + it) * 16 + lr) * 128 + (((ks * 4 + quad) ^ (lr & 7)) << 3));
#pragma unroll
          for (int jt = 0; jt < 4; ++jt)
            acc[it][jt] = __builtin_amdgcn_mfma_f32_16x16x32_bf16(af, bw[jt][ks], acc[it][jt], 0, 0, 0);
        }
      }
#pragma unroll
      for (int it = 0; it < 2; ++it)
#pragma unroll
        for (int jc = 0; jc < 2; ++jc) {
#pragma unroll
          for (int r = 0; r < 4; ++r) {
            int tl = (hv * 2 + it) * 16 + quad * 4 + r, c = w * 32 + jc * 16 + lr;
            float er = 1.f + __builtin_amdgcn_exp2f(fminf(fmaf(acc[it][jc][r], -1.4426950408889634f, brr[jc]), 60.f));
            float ei = 1.f + __builtin_amdgcn_exp2f(fminf(fmaf(acc[it][2 + jc][r], -1.4426950408889634f, bii[jc]), 60.f));
            float q = __builtin_amdgcn_rcpf(er * ei);
            float rr = q * ei, ii = q * er;
            float a = __builtin_amdgcn_exp2f(rr * spl[jc]);
            float mult = __builtin_amdgcn_sqrtf((1.f - a) * (1.f + a));
            if (g0 + tl == gstart) mult = 1.f;
            float xv = bf2f(sXc[tl * 128 + (((c >> 3) ^ (tl & 7)) << 3) + (c & 7)]);
            sAf[tl * SA_LD + c] = a;
            sBh[tl * 128 + c] = f2bf(mult * ii * xv);
          }
        }
    }
    __syncthreads();
    if (tid < 128) {
      const int c = tid;
      const unsigned aidx = (unsigned)(tt * 2 + dir) * 1024 + head * 128 + c;
      const float* ap = sAf + c;
      u16* bp = sBh + c;
      if (PASS == 1) {
        float h = 0.f, P = 1.f;
        if (dir == 0) {
#pragma unroll 16
          for (int st = 0; st < 64; ++st) { float a = ap[st * SA_LD]; h = a * h + bf2f(bp[st * 128]); P *= a; }
        } else {
#pragma unroll 16
          for (int st = 63; st >= 0; --st) { float a = ap[st * SA_LD]; h = a * h + bf2f(bp[st * 128]); P *= a; }
        }
        agg[aidx] = make_float2(P, h);
      } else {
        float h = carry[aidx];
        if (dir == 0) {
#pragma unroll 16
          for (int st = 0; st < 64; ++st) { h = ap[st * SA_LD] * h + bf2f(bp[st * 128]); bp[st * 128] = f2bf(h); }
        } else {
#pragma unroll 16
          for (int st = 63; st >= 0; --st) { h = ap[st * SA_LD] * h + bf2f(bp[st * 128]); bp[st * 128] = f2bf(h); }
        }
      }
    }
    if (PASS == 3) {
      __syncthreads();
#pragma unroll
      for (int cch = 0; cch < 4; ++cch) {
        int chunk = tid + cch * 256;
        int t = chunk >> 4, cc = (chunk & 15) * 8;
        unsigned off = (unsigned)(g0 + t) * D + head * 128 + cc;
        uint4 hv = *(const uint4*)(sBh + t * 128 + cc);
        if (dir == 0) {
          *(uint4*)(hf + off) = hv;
        } else {
          uint4 fv = *(const uint4*)(hf + off);
          uint4 gv = *(const uint4*)(ga + off);
          uint4 o;
          o.x = pack2((lo2f(fv.x) + lo2f(hv.x)) * lo2f(gv.x), (hi2f(fv.x) + hi2f(hv.x)) * hi2f(gv.x));
          o.y = pack2((lo2f(fv.y) + lo2f(hv.y)) * lo2f(gv.y), (hi2f(fv.y) + hi2f(hv.y)) * hi2f(gv.y));
          o.z = pack2((lo2f(fv.z) + lo2f(hv.z)) * lo2f(gv.z), (hi2f(fv.z) + hi2f(hv.z)) * hi2f(gv.z));
          o.w = pack2((lo2f(fv.w) + lo2f(hv.w)) * lo2f(gv.w), (hi2f(fv.w) + hi2f(hv.w)) * hi2f(gv.w));
          *(uint4*)(ga + off) = o;
        }
      }
    }
    __syncthreads();
  }
}

DEVFN void phase_carry(const Params& p) {
  const float2* __restrict__ agg = (const float2*)U(p, 4);
  float* __restrict__ carry = (float*)(agg + 1280L * 2 * 1024);
  const int lane = threadIdx.x & 63, w = threadIdx.x >> 6;
  for (int u = blockIdx.x + gridDim.x * w; u < 288; u += gridDim.x * 4) {
    int id = u * 64 + lane;
    int seq = id >> 11, dir = (id >> 10) & 1, c = id & 1023;
    int nt = seq_len(seq) >> 6, tile0 = seq_start(seq) >> 6;
    float h = 0.f;
#pragma unroll 8
    for (int k = 0; k < nt; ++k) {
      int tt = tile0 + (dir ? nt - 1 - k : k);
      unsigned ix = (unsigned)(tt * 2 + dir) * 1024 + c;
      float2 v = agg[ix];
      carry[ix] = h;
      h = v.x * h + v.y;
    }
  }
}

DEVFN void phase_merge(const Params& p, int l, u16* smem) {
  const u16* wl = WL(p, l);
  u16* mo = U(p, 1);
  u16* tb = U(p, 5);
  for (int it = 0;; ++it) {
    int mt, nt;
    if (!tile_xcd(it, 1, 8, mt, nt)) break;
    const int g0 = mt * 128;
#pragma unroll 1
    for (int br = 0; br < 2; ++br) {
      {
        const int tid = otid(), lane = tid & 63, w = tid >> 6, wm = w >> 1, wn = w & 1, lr = lane & 15, quad = lane >> 4;
        f32x4 acc[4][4]; zero_acc(acc);
        LdRows4 la; la.t_ = tid;
        if (br == 0) {
          la.base = U(p, 2);
#pragma unroll
          for (int c = 0; c < 4; ++c) la.off[c] = (unsigned)(g0 + (tid >> 3) + c * 32) * D + (((tid & 7) ^ ((tid >> 3) & 7)) << 3);
        } else {
          const int seq = seq_of(g0), sst = seq_start(seq);
          const int lg = seq == 0 ? 7 : 6;
          la.base = U(p, 3);
#pragma unroll
          for (int c = 0; c < 4; ++c) {
            int t = g0 - sst + (tid >> 3) + c * 32;
            int urow = ((t & ((1 << lg) - 1)) << 7) + (t >> lg);
            la.off[c] = (unsigned)(sst + urow) * D + (((tid & 7) ^ ((tid >> 3) & 7)) << 3);
          }
        }
        LdPlain lb; lb.init(tid, wl + (br == 0 ? W_A : W_B), nt * 128, D);
        gemm_core(tid, acc, 16, la, lb, smem);
#pragma unroll
        for (int i = 0; i < 4; ++i) {
          unsigned g = g0 + wm * 64 + i * 16 + lr;
#pragma unroll
          for (int j = 0; j < 4; ++j) {
            unsigned c = nt * 128 + wn * 64 + j * 16 + quad * 4;
            uint2 o; o.x = pack2(acc[i][j][0], acc[i][j][1]); o.y = pack2(acc[i][j][2], acc[i][j][3]);
            *(uint2*)(tb + (g * D + c)) = o;
          }
        }
      }
      {
        const int tid = otid(), lane = tid & 63, w = tid >> 6, wm = w >> 1, wn = w & 1, lr = lane & 15, quad = lane >> 4;
        f32x4 acc[4][4]; zero_acc(acc);
        LdPlain la; la.init(tid, U(p, 0), g0, D);
        LdPlain lb; lb.init(tid, wl + W_CAT, 5120 + br * 1024 + nt * 128, D);
        gemm_core(tid, acc, 16, la, lb, smem);
#pragma unroll
        for (int i = 0; i < 4; ++i) {
          unsigned g = g0 + wm * 64 + i * 16 + lr;
#pragma unroll
          for (int j = 0; j < 4; ++j) {
            unsigned c = nt * 128 + wn * 64 + j * 16 + quad * 4;
            uint2 tv = *(const uint2*)(tb + (g * D + c));
            float v0 = sigm(acc[i][j][0]) * lo2f(tv.x);
            float v1 = sigm(acc[i][j][1]) * hi2f(tv.x);
            float v2 = sigm(acc[i][j][2]) * lo2f(tv.y);
            float v3 = sigm(acc[i][j][3]) * hi2f(tv.y);
            uint2* op = (uint2*)(mo + (g * D + c));
            if (br == 1) {
              uint2 pv = *op;
              v0 += lo2f(pv.x); v1 += hi2f(pv.x); v2 += lo2f(pv.y); v3 += hi2f(pv.y);
            }
            uint2 o; o.x = pack2(v0, v1); o.y = pack2(v2, v3);
            *op = o;
          }
        }
      }
    }
  }
}

DEVFN void phase_out(const Params& p, int l, u16* smem) {
  const u16* wo = WL(p, l) + W_O;
  for (int it = 0;; ++it) {
    int mt, nt;
    if (!tile_xcd(it, 1, 8, mt, nt)) break;
    const int tid = otid(), lane = tid & 63, w = tid >> 6, wm = w >> 1, wn = w & 1, lr = lane & 15, quad = lane >> 4;
    const int g0 = mt * 128;
    LdPlain la; la.init(tid, U(p, 1), g0, D);
    LdPlain lb; lb.init(tid, wo, nt * 128, D);
    f32x4 acc[4][4]; zero_acc(acc);
    gemm_core(tid, acc, 16, la, lb, smem);
    const float* gate = MOD(p) + ((long)l * 9 + seq_of(g0)) * 3072 + 2048;
#pragma unroll
    for (int i = 0; i < 4; ++i) {
      unsigned g = g0 + wm * 64 + i * 16 + lr;
      const float* xb = (l == 0) ? (g0 < 16384 ? p.x_prompt : p.x_sample) : p.out;
      const float* xr = xb + (unsigned)((l == 0 && g0 >= 16384) ? g - 16384 : g) * D;
      float* orow = p.out + g * D;
#pragma unroll
      for (int j = 0; j < 4; ++j) {
        unsigned c = nt * 128 + wn * 64 + j * 16 + quad * 4;
        float4 xv = *(const float4*)(xr + c);
        float4 gt = *(const float4*)(gate + c);
        float4 o;
        o.x = xv.x + gt.x * acc[i][j][0]; o.y = xv.y + gt.y * acc[i][j][1];
        o.z = xv.z + gt.z * acc[i][j][2]; o.w = xv.w + gt.w * acc[i][j][3];
        *(float4*)(orow + c) = o;
      }
    }
  }
}

#define XB_TMO      128
#define XB_XCNT(j)  (256  + 64 * (j))
#define XB_XSUB(j)  (1280 + 64 * (j))
#define XB_XGEN(j)  (2304 + 64 * (j))
#define XB_TOP      3328
#define XB_TOPGEN   3392
#define XCD_BAR_WORDS 3456
#define XB_SPIN_CAP (1u << 18)
#define LAS __attribute__((address_space(3)))

__device__ __forceinline__ unsigned xb_ld(unsigned* p)              { return __hip_atomic_load(p, __ATOMIC_RELAXED, __HIP_MEMORY_SCOPE_AGENT); }
__device__ __forceinline__ unsigned xb_add(unsigned* p, unsigned v) { return __hip_atomic_fetch_add(p, v, __ATOMIC_RELAXED, __HIP_MEMORY_SCOPE_AGENT); }
__device__ __forceinline__ unsigned xb_xcc_id() { return (unsigned)__builtin_amdgcn_s_getreg((3 << 11) | 20) & 0xFu; }
#define XB_SPIN(cond, bar) do { unsigned _sp = 0; while (cond) { __builtin_amdgcn_s_sleep(1); \
    if ((++_sp & 255u) == 0u) { if (xb_ld(&(bar)[XB_TMO])) break; if (_sp > XB_SPIN_CAP) { atomicAdd(&(bar)[XB_TMO], 1u); break; } } } } while (0)

struct XcdBarrier {
    unsigned* bar; unsigned x;
    volatile LAS unsigned* st;
};

__device__ __forceinline__ XcdBarrier xcd_barrier_post(unsigned* bar, volatile LAS unsigned* st) {
    XcdBarrier b; b.bar = bar; b.x = xb_xcc_id(); b.st = st;
    if (threadIdx.x == 0) (void)xb_add(&bar[XB_XCNT(b.x)], 1u);
    return b;
}
__device__ __forceinline__ void xcd_barrier_complete(unsigned* bar, unsigned x, unsigned& nloc, unsigned& nx) {
    const unsigned G = gridDim.x * gridDim.y * gridDim.z;
    unsigned sum, cnt, mine, sp = 0u;
    for (;;) {
        sum = 0u; cnt = 0u; mine = 0u;
#pragma unroll
        for (unsigned j = 0; j < 16; ++j) { const unsigned c = xb_ld(&bar[XB_XCNT(j)]); sum += c; cnt += (c > 0u) ? 1u : 0u; mine = (j == x) ? c : mine; }
        if (sum == G) break;
        __builtin_amdgcn_s_sleep(1);
        if ((++sp & 255u) == 0u) { if (xb_ld(&bar[XB_TMO])) break; if (sp > XB_SPIN_CAP) { atomicAdd(&bar[XB_TMO], 1u); break; } }
    }
    nloc = mine > 0u ? mine : 1u; nx = cnt > 0u ? cnt : 1u;
}

__device__ __forceinline__ void xcd_barrier(const XcdBarrier& b) {
    asm volatile("s_waitcnt vmcnt(0)" ::: "memory");
    __syncthreads();
    if (threadIdx.x == 0) {
        unsigned* bar = b.bar;
        __builtin_amdgcn_s_waitcnt(0);
        unsigned nloc = b.st[0], nx = b.st[1];
        if (nloc == 0u) { xcd_barrier_complete(bar, b.x, nloc, nx); b.st[0] = nloc; b.st[1] = nx; }
        const unsigned old = xb_add(&bar[XB_XSUB(b.x)], 1u);
        const unsigned gen = old / nloc;
        if (old + 1u == (gen + 1u) * nloc) {
            __builtin_amdgcn_fence(__ATOMIC_RELEASE, "agent");
            asm volatile("s_waitcnt vmcnt(0)" ::: "memory");
            const unsigned og = xb_add(&bar[XB_TOP], 1u);
            const unsigned tg = og / nx;
            if (og + 1u == (tg + 1u) * nx) xb_add(&bar[XB_TOPGEN], 1u);
            else XB_SPIN(xb_ld(&bar[XB_TOPGEN]) == tg, bar);
            __builtin_amdgcn_fence(__ATOMIC_ACQUIRE, "agent");
            xb_add(&bar[XB_XGEN(b.x)], 1u);
            asm volatile("s_waitcnt vmcnt(0)" ::: "memory");
        } else {
            XB_SPIN(xb_ld(&bar[XB_XGEN(b.x)]) == gen, bar);
            __builtin_amdgcn_fence(__ATOMIC_ACQUIRE, "agent");
            asm volatile("s_waitcnt vmcnt(0)" ::: "memory");
        }
    }
    __syncthreads();
}


__global__ void __launch_bounds__(256, 2) hawk_fnet_megakernel(Params p) {
  extern __shared__ __attribute__((aligned(16))) unsigned char smem_raw[];
  cg::grid_group grid = cg::this_grid();
  u16* smem = (u16*)smem_raw;

  __shared__ unsigned xb_st[4];
  unsigned* bar = (unsigned*)(p.ws + OFF_BAR_BYTES);
  if (blockIdx.x == 0) {
    for (int i = threadIdx.x; i < XCD_BAR_WORDS; i += 256) __hip_atomic_store(&bar[i], 0u, __ATOMIC_RELAXED, __HIP_MEMORY_SCOPE_AGENT);
  }
  if (threadIdx.x < 4) xb_st[threadIdx.x] = 0u;
  phase_prologue(p, smem_raw);
  grid.sync();
  XcdBarrier xb = xcd_barrier_post(bar, (volatile LAS unsigned*)xb_st);
  phase_fold(p, smem);
  phase_h(p, 0);
  xcd_barrier(xb);
  for (int l = 0; l < 2; ++l) {
    phase_gemm1(p, l, smem);
    xcd_barrier(xb);
    phase_fft1(p, smem);
    xcd_barrier(xb);
    phase_fft2(p, smem);
    xcd_barrier(xb);
    phase_scan<1>(p, l, 0, smem_raw);
    xcd_barrier(xb);
    phase_carry(p);
    xcd_barrier(xb);
    phase_scan<3>(p, l, 0, smem_raw);
    xcd_barrier(xb);
    phase_scan<3>(p, l, 1, smem_raw);
    xcd_barrier(xb);
    phase_merge(p, l, smem);
    xcd_barrier(xb);
    phase_out(p, l, smem);
    xcd_barrier(xb);
    if (l == 0) { phase_h(p, 1); xcd_barrier(xb); }
  }
  phase_final(p);
}

extern "C" void kernel_launch(void* const* d_in, const int* in_sizes, int n_in,
                              void* d_out, int out_size, void* d_ws, size_t ws_size,
                              hipStream_t stream) {
  (void)in_sizes; (void)n_in; (void)out_size;
  if (ws_size < (size_t)WS_NEED) {
    fprintf(stderr, "workspace too small: %zu < %ld\n", ws_size, (long)WS_NEED);
    return;
  }
  static int grid_blocks = 0;
  if (!grid_blocks) {
    hipFuncSetAttribute((const void*)hawk_fnet_megakernel, hipFuncAttributeMaxDynamicSharedMemorySize, SMEM_BYTES);
    int dev = 0, cus = 0, per_cu = 0;
    hipGetDevice(&dev);
    hipDeviceGetAttribute(&cus, hipDeviceAttributeMultiprocessorCount, dev);
    hipOccupancyMaxActiveBlocksPerMultiprocessor(&per_cu, hawk_fnet_megakernel, 256, SMEM_BYTES);
    if (per_cu > 2) per_cu = 2;
    if (per_cu < 1) per_cu = 1;
    grid_blocks = (cus * per_cu) & ~15;
  }
  Params p{};
  p.x_prompt = (const float*)d_in[0]; p.x_sample = (const float*)d_in[1];
  p.c_prompt = (const float*)d_in[2]; p.c_sample = (const float*)d_in[3];
  p.norm_g = (const float*)d_in[4]; p.w_ada = (const float*)d_in[5]; p.b_ada = (const float*)d_in[6];
  p.w_in = (const float*)d_in[7]; p.conv_w = (const float*)d_in[8]; p.conv_b = (const float*)d_in[9];
  p.w_rg = (const float*)d_in[10]; p.b_rg = (const float*)d_in[11]; p.lam = (const float*)d_in[12];
  p.w_a_out = (const float*)d_in[13]; p.w_b_out = (const float*)d_in[14]; p.w_o = (const float*)d_in[15];
  p.final_g = (const float*)d_in[16];
  p.out = (float*)d_out; p.ws = (unsigned char*)d_ws;
  void* args[] = {&p};
  hipError_t e = hipLaunchCooperativeKernel((void*)hawk_fnet_megakernel, dim3(grid_blocks), dim3(256), args, SMEM_BYTES, stream);
  if (e != hipSuccess) fprintf(stderr, "cooperative launch failed: %s (grid %d)\n", hipGetErrorString(e), grid_blocks);
}
```

```cpp
#include <hip/hip_runtime.h>
#include <hip/hip_cooperative_groups.h>
#include <cstdio>
namespace cg = cooperative_groups;

typedef unsigned short u16;
typedef __attribute__((ext_vector_type(8))) short bf16x8;
typedef __attribute__((ext_vector_type(4))) float f32x4;

#define DEVFN __device__ __forceinline__

constexpr int D = 1024;
constexpr int T_TOT = 81920;
constexpr long UNIT = (long)T_TOT * D;
constexpr int D_IN = 6144;

constexpr long OFF_W = 6 * UNIT;
constexpr long W_CAT = 0;
constexpr long W_A = 7168L * 1024;
constexpr long W_B = W_A + 1048576;
constexpr long W_O = W_B + 1048576;
constexpr long W_RG = W_O + 1048576;
constexpr long LW = W_RG + 524288;
constexpr long OFF_TAB = OFF_W + 2 * LW;
constexpr long T_D1A = 0;
constexpr long T_D1B = 65536;
constexpr long T_D2 = T_D1B + 16384;
constexpr long T_DC = T_D2 + 32768;
constexpr long TAB_ELEMS = T_DC + 131072;
constexpr long OFF_TW_BYTES = (OFF_TAB + TAB_ELEMS) * 2;
constexpr long OFF_MOD_BYTES = OFF_TW_BYTES + 131072;
constexpr long OFF_BAR_BYTES = OFF_MOD_BYTES + 221184;
constexpr long WS_NEED = OFF_BAR_BYTES + 16384;

constexpr int TILE = 128 * 64;
constexpr int SMEM_BYTES = 73728;

struct Params {
  const float* x_prompt; const float* x_sample; const float* c_prompt; const float* c_sample;
  const float* norm_g; const float* w_ada; const float* b_ada; const float* w_in;
  const float* conv_w; const float* conv_b; const float* w_rg; const float* b_rg; const float* lam;
  const float* w_a_out; const float* w_b_out; const float* w_o; const float* final_g;
  float* out; unsigned char* ws;
};

typedef __attribute__((ext_vector_type(2))) float f32x2_t;
typedef __attribute__((ext_vector_type(2))) __bf16 bf16x2_t;
DEVFN u16 f2bf(float f) {
  __bf16 h = (__bf16)f;
  return *(u16*)&h;
}
DEVFN float bf2f(u16 h) { return __uint_as_float(((unsigned)h) << 16); }
DEVFN unsigned pack2(float a, float b) {
  f32x2_t v = {a, b};
  bf16x2_t r = __builtin_convertvector(v, bf16x2_t);
  return *(unsigned*)&r;
}
DEVFN float lo2f(unsigned v) { return __uint_as_float(v << 16); }
DEVFN float hi2f(unsigned v) { return __uint_as_float(v & 0xffff0000u); }
DEVFN float sigm(float x) { return __builtin_amdgcn_rcpf(1.f + __expf(-x)); }
DEVFN float silu(float x) { return x * __builtin_amdgcn_rcpf(1.f + __expf(-x)); }
DEVFN float one_minus_exp(float x) {
  float pl = -x * (1.f + x * (0.5f + x * (1.f / 6.f + x * (1.f / 24.f + x * (1.f / 120.f + x * (1.f / 720.f))))));
  float dr = 1.f - __expf(x);
  return x > -0.3f ? pl : dr;
}

DEVFN int otid() { int t = threadIdx.x; asm volatile("" : "+v"(t)); return t; }
DEVFN int seq_of(int g) { int seg = g >> 13; return seg < 2 ? 0 : seg - 1; }
DEVFN int seq_start(int s) { return s == 0 ? 0 : 16384 + (s - 1) * 8192; }
DEVFN int seq_len(int s) { return s == 0 ? 16384 : 8192; }

DEVFN u16* U(const Params& p, int i) { return (u16*)(p.ws) + (long)i * UNIT; }
DEVFN u16* WL(const Params& p, int l) { return (u16*)(p.ws) + OFF_W + (long)l * LW; }
DEVFN u16* TAB(const Params& p) { return (u16*)(p.ws) + OFF_TAB; }
DEVFN float2* TW(const Params& p) { return (float2*)(p.ws + OFF_TW_BYTES); }
DEVFN float* MOD(const Params& p) { return (float*)(p.ws + OFF_MOD_BYTES); }
DEVFN const float* xrow(const Params& p, int g) {
  return g < 16384 ? p.x_prompt + (long)g * D : p.x_sample + (long)(g - 16384) * D;
}

struct LdPlain {
  static constexpr bool kDma = true; static constexpr bool kTr = false;
  const u16* base; unsigned off0; unsigned cst; int t_; unsigned row0_, stride_;
  DEVFN unsigned rowoff(int r) const { return (row0_ + r) * stride_; }
  DEVFN void init(int tid_, const u16* b, unsigned row0, unsigned stride) {
    unsigned tid = tid_; t_ = tid_; row0_ = row0; stride_ = stride;
    base = b;
    off0 = (row0 + (tid >> 3)) * stride + (((tid & 7) ^ ((tid >> 3) & 7)) << 3);
    cst = 32 * stride;
  }
  DEVFN void issue(u16* tile, int c, int kt) const {
    __builtin_amdgcn_global_load_lds((const unsigned*)(base + (off0 + c * cst + kt * 64)),
                                     (unsigned*)(tile + (t_ + c * 256) * 8), 16, 0, 0);
  }
  DEVFN uint4 load(int, int) const { return make_uint4(0, 0, 0, 0); }
  DEVFN void store(u16*, int, uint4) const {}
};
struct LdRows4 {
  static constexpr bool kDma = true; static constexpr bool kTr = false;
  const u16* base; unsigned off[4]; int t_;
  DEVFN void issue(u16* tile, int c, int kt) const {
    __builtin_amdgcn_global_load_lds((const unsigned*)(base + (off[c] + kt * 64)),
                                     (unsigned*)(tile + (t_ + c * 256) * 8), 16, 0, 0);
  }
  DEVFN uint4 load(int, int) const { return make_uint4(0, 0, 0, 0); }
  DEVFN void store(u16*, int, uint4) const {}
};
struct LdF32 {
  static constexpr bool kDma = false; static constexpr bool kTr = false;
  const float* base; unsigned off0; unsigned cst; int t_;
  DEVFN void init(int tid_, const float* b, unsigned row0, unsigned stride, unsigned col0) {
    unsigned tid = tid_; t_ = tid_;
    base = b;
    off0 = (row0 + (tid >> 3)) * stride + col0 + (tid & 7) * 8;
    cst = 32 * stride;
  }
  DEVFN void issue(u16*, int, int) const {}
  DEVFN uint4 load(int c, int kt) const {
    const float4* q = (const float4*)(base + (off0 + c * cst + kt * 64));
    float4 a = q[0], b = q[1];
    uint4 r; r.x = pack2(a.x, a.y); r.y = pack2(a.z, a.w); r.z = pack2(b.x, b.y); r.w = pack2(b.z, b.w);
    return r;
  }
  DEVFN void store(u16* tile, int c, uint4 v) const {
    int idx = t_ + c * 256;
    int row = idx >> 3, kc = idx & 7;
    *(uint4*)(tile + row * 64 + ((kc ^ (row & 7)) << 3)) = v;
  }
};
DEVFN int trf(int r) { return ((r & 3) << 2) | ((r >> 2) & 3); }
template <class TokFn>
struct LdTrans {
  static constexpr bool kDma = false; static constexpr bool kTr = false;
  TokFn tok; int t_;
  DEVFN void issue(u16*, int, int) const {}
  DEVFN uint4 load(int c, int kt) const {
    int idx = t_ + c * 256;
    int kk = idx & 63, cc = idx >> 6;
    const u16* b; unsigned o = tok(kt * 64 + kk, b);
    return *(const uint4*)(b + (o + cc * 8));
  }
  DEVFN void store(u16* tile, int c, uint4 v) const {
    int idx = t_ + c * 256;
    int kk = idx & 63, cc = idx >> 6;
    u16* q = tile + (cc * 8) * 64 + (kk & 7);
    int kc = kk >> 3;
    q[0 * 64 + ((kc ^ 0) << 3)] = (u16)(v.x & 0xffff); q[1 * 64 + ((kc ^ 1) << 3)] = (u16)(v.x >> 16);
    q[2 * 64 + ((kc ^ 2) << 3)] = (u16)(v.y & 0xffff); q[3 * 64 + ((kc ^ 3) << 3)] = (u16)(v.y >> 16);
    q[4 * 64 + ((kc ^ 4) << 3)] = (u16)(v.z & 0xffff); q[5 * 64 + ((kc ^ 5) << 3)] = (u16)(v.z >> 16);
    q[6 * 64 + ((kc ^ 6) << 3)] = (u16)(v.w & 0xffff); q[7 * 64 + ((kc ^ 7) << 3)] = (u16)(v.w >> 16);
  }
};

typedef __attribute__((ext_vector_type(4))) short s16x4;
DEVFN s16x4 lds_tr_read(const u16* q) {
  return __builtin_amdgcn_ds_read_tr16_b64_v4i16((s16x4 __attribute__((address_space(3)))*)(q));
}

DEVFN void zero_acc(f32x4 (&acc)[4][4]) {
#pragma unroll
  for (int i = 0; i < 4; ++i)
#pragma unroll
    for (int j = 0; j < 4; ++j) acc[i][j] = f32x4{0.f, 0.f, 0.f, 0.f};
}

template <class LA, class LB>
DEVFN void gemm_core(int tid, f32x4 (&acc)[4][4], int nk, const LA& la, const LB& lb, u16* smem) {
  const int lane = tid & 63, w = tid >> 6, wm = w >> 1, wn = w & 1;
  const int lr = lane & 15, quad = lane >> 4;
  uint4 ra[4], rb[4];
  if (LA::kDma) {
#pragma unroll
    for (int c = 0; c < 4; ++c) la.issue(smem, c, 0);
  } else {
#pragma unroll
    for (int c = 0; c < 4; ++c) ra[c] = la.load(c, 0);
  }
  if (LB::kDma) {
#pragma unroll
    for (int c = 0; c < 4; ++c) lb.issue(smem + TILE, c, 0);
  } else {
#pragma unroll
    for (int c = 0; c < 4; ++c) rb[c] = lb.load(c, 0);
  }
  if (!LA::kDma) {
#pragma unroll
    for (int c = 0; c < 4; ++c) la.store(smem, c, ra[c]);
  }
  if (!LB::kDma) {
#pragma unroll
    for (int c = 0; c < 4; ++c) lb.store(smem + TILE, c, rb[c]);
  }
  asm volatile("s_waitcnt vmcnt(0)" ::: "memory");
  __syncthreads();
  const int aoff = (wm * 64 + lr) * 64, boff = (wn * 64 + lr) * 64;
  const int sw0 = ((quad) ^ (lr & 7)) << 3, sw1 = ((4 + quad) ^ (lr & 7)) << 3;
  int troff[4][2];
  if (LB::kTr) {
    const int q = lr >> 2, pp = lr & 3;
#pragma unroll
    for (int j = 0; j < 4; ++j)
#pragma unroll
      for (int h = 0; h < 2; ++h) {
        int r = quad * 8 + h * 4 + q;
        int ch = (wn * 8 + j * 2 + (pp >> 1)) ^ trf(r);
        troff[j][h] = r * 128 + ch * 8 + (pp & 1) * 4;
      }
  }
  for (int kt = 0; kt < nk; ++kt) {
    const u16* sA = smem + (kt & 1) * 2 * TILE;
    const u16* sB = sA + TILE;
    u16* nA = smem + ((kt + 1) & 1) * 2 * TILE;
    const bool more = (kt + 1) < nk;
    if (more) {
      if (LA::kDma) {
#pragma unroll
        for (int c = 0; c < 4; ++c) la.issue(nA, c, kt + 1);
      } else {
#pragma unroll
        for (int c = 0; c < 4; ++c) ra[c] = la.load(c, kt + 1);
      }
      if (LB::kDma) {
#pragma unroll
        for (int c = 0; c < 4; ++c) lb.issue(nA + TILE, c, kt + 1);
      } else {
#pragma unroll
        for (int c = 0; c < 4; ++c) rb[c] = lb.load(c, kt + 1);
      }
    }
#pragma unroll
    for (int ks = 0; ks < 2; ++ks) {
      const int sw = ks == 0 ? sw0 : sw1;
      bf16x8 af[4], bfr[4];
#pragma unroll
      for (int i = 0; i < 4; ++i) af[i] = *(const bf16x8*)(sA + aoff + i * 1024 + sw);
      if (LB::kTr) {
#pragma unroll
        for (int j = 0; j < 4; ++j) {
          s16x4 lo = lds_tr_read(sB + troff[j][0] + ks * 4096);
          s16x4 hi = lds_tr_read(sB + troff[j][1] + ks * 4096);
          bfr[j] = __builtin_shufflevector(lo, hi, 0, 1, 2, 3, 4, 5, 6, 7);
        }
      } else {
#pragma unroll
        for (int j = 0; j < 4; ++j) bfr[j] = *(const bf16x8*)(sB + boff + j * 1024 + sw);
      }
      __builtin_amdgcn_s_setprio(1);
#pragma unroll
      for (int i = 0; i < 4; ++i)
#pragma unroll
        for (int j = 0; j < 4; ++j)
          acc[i][j] = __builtin_amdgcn_mfma_f32_16x16x32_bf16(bfr[j], af[i], acc[i][j], 0, 0, 0);
      __builtin_amdgcn_s_setprio(0);
    }
    if (more) {
      if (!LA::kDma) {
#pragma unroll
        for (int c = 0; c < 4; ++c) la.store(nA, c, ra[c]);
      }
      if (!LB::kDma) {
#pragma unroll
        for (int c = 0; c < 4; ++c) lb.store(nA + TILE, c, rb[c]);
      }
    }
    asm volatile("s_waitcnt vmcnt(0)" ::: "memory");
    __syncthreads();
  }
}

struct LdPerm {
  const u16* base; int g0, sst, lg;
  DEVFN unsigned rowoff(int r) const {
    int t = g0 - sst + r;
    int urow = ((t & ((1 << lg) - 1)) << 7) + (t >> lg);
    return (unsigned)(sst + urow) * D;
  }
};
#define GLDS16(gp, lp) __builtin_amdgcn_global_load_lds((const unsigned*)(gp), (unsigned*)(lp), 16, 0, 0)
DEVFN void zero_acc8(f32x4 (&acc)[8][4]) {
#pragma unroll
  for (int i = 0; i < 8; ++i)
#pragma unroll
    for (int j = 0; j < 4; ++j) acc[i][j] = f32x4{0.f, 0.f, 0.f, 0.f};
}
template <class LA, class LB>
DEVFN void gemm_core_b(int tid, f32x4 (&acc)[8][4], int nk, const LA& la, const LB& lb, u16* smem) {
  const int lane = tid & 63, w = tid >> 6, wm = w >> 1, wn = w & 1;
  const int lr = lane & 15, quad = lane >> 4;
  const int r0 = tid >> 2;
  const unsigned sw = (unsigned)(((tid & 3) ^ ((0 - (tid >> 4)) & 3)) << 3);
  const unsigned oa0 = la.rowoff(r0) + sw, oa1 = la.rowoff(r0 + 64) + sw, oa2 = la.rowoff(r0 + 128) + sw, oa3 = la.rowoff(r0 + 192) + sw;
  const unsigned ob0 = lb.rowoff(r0) + sw, ob1 = lb.rowoff(r0 + 64) + sw;
  const u16* ga = la.base; const u16* gb = lb.base;
  u16* l0 = smem + tid * 8;
#define ISSUE_STAGE(st, kt) do { u16* _s = l0 + (st) * 12288; unsigned _k = (unsigned)(kt) * 32u; \
    GLDS16(ga + (oa0 + _k), _s); GLDS16(ga + (oa1 + _k), _s + 2048); GLDS16(ga + (oa2 + _k), _s + 4096); GLDS16(ga + (oa3 + _k), _s + 6144); \
    GLDS16(gb + (ob0 + _k), _s + 8192); GLDS16(gb + (ob1 + _k), _s + 10240); } while (0)
  asm volatile("s_waitcnt vmcnt(0)" ::: "memory");
  ISSUE_STAGE(0, 0);
  ISSUE_STAGE(1, 1);
  const int fsw = (quad ^ ((0 - (lr >> 2)) & 3)) << 3;
  const int aoff = (wm * 128 + lr) * 32 + fsw, boff = 8192 + (wn * 64 + lr) * 32 + fsw;
  int cur = 0, nxt = 2;
  for (int kt = 0; kt < nk; ++kt) {
    if (kt + 1 < nk) asm volatile("s_waitcnt vmcnt(6)" ::: "memory");
    else asm volatile("s_waitcnt vmcnt(0)" ::: "memory");
    __builtin_amdgcn_s_barrier();
    asm volatile("" ::: "memory");
    if (kt + 2 < nk) ISSUE_STAGE(nxt, kt + 2);
    const u16* sb = smem + cur * 12288;
    bf16x8 af[8], bfr[4];
#pragma unroll
    for (int j = 0; j < 4; ++j) bfr[j] = *(const bf16x8*)(sb + boff + j * 512);
#pragma unroll
    for (int i = 0; i < 8; ++i) af[i] = *(const bf16x8*)(sb + aoff + i * 512);
    __builtin_amdgcn_s_setprio(1);
#pragma unroll
    for (int i = 0; i < 8; ++i)
#pragma unroll
      for (int j = 0; j < 4; ++j)
        acc[i][j] = __builtin_amdgcn_mfma_f32_16x16x32_bf16(bfr[j], af[i], acc[i][j], 0, 0, 0);
    __builtin_amdgcn_s_setprio(0);
    cur = cur == 2 ? 0 : cur + 1;
    nxt = nxt == 2 ? 0 : nxt + 1;
  }
  asm volatile("s_waitcnt lgkmcnt(0)" ::: "memory");
  __builtin_amdgcn_s_barrier();
  asm volatile("" ::: "memory");
#undef ISSUE_STAGE
}

DEVFN bool tile_xcd(int it, int ngrp, int ntn, int& mt, int& nt) {
  const int G = gridDim.x, b = blockIdx.x;
  if (G == 512) {
    if (it >= 5 * ngrp) return false;
    int xcd = b & 7, loc = b >> 3;
    mt = xcd * 40 + (it / ngrp) * 8 + (loc >> 3);
    nt = (it % ngrp) * 8 + (loc & 7);
    return true;
  }
  int tile = b + it * G;
  if (tile >= 320 * ntn) return false;
  mt = tile / ntn; nt = tile % ntn;
  return true;
}

DEVFN void transpose_tile(const float* src, long ld, u16* dst, long ldd, float* sT) {
  const int tid = otid();
#pragma unroll
  for (int pss = 0; pss < 4; ++pss) {
    int kk = (tid >> 4) + pss * 16, n4 = (tid & 15) * 4;
    float4 v = *(const float4*)(src + (long)kk * ld + n4);
    sT[kk * 65 + n4 + 0] = v.x; sT[kk * 65 + n4 + 1] = v.y; sT[kk * 65 + n4 + 2] = v.z; sT[kk * 65 + n4 + 3] = v.w;
  }
  __syncthreads();
  {
    int n = tid >> 2, k0 = (tid & 3) * 16;
    unsigned o[8];
#pragma unroll
    for (int e = 0; e < 8; ++e) o[e] = pack2(sT[(k0 + 2 * e) * 65 + n], sT[(k0 + 2 * e + 1) * 65 + n]);
    uint4* q = (uint4*)(dst + (long)n * ldd + k0);
    q[0] = make_uint4(o[0], o[1], o[2], o[3]);
    q[1] = make_uint4(o[4], o[5], o[6], o[7]);
  }
  __syncthreads();
}

DEVFN void phase_prologue(const Params& p, unsigned char* smem_raw) {
  const int tid = otid();
  constexpr int NJ_TR = 4352, NJ_MOD = 96, NJ_TAB = 256;
  for (int job = blockIdx.x; job < NJ_TR + NJ_MOD + NJ_TAB; job += gridDim.x) {
    if (job < NJ_TR) {
      float* sT = (float*)smem_raw;
      int l = job / 2176, r = job % 2176;
      u16* wl = WL(p, l);
      if (r < 1280) {
        int kt = r / 80, ntile = r % 80;
        int orow = ntile * 64;
        int scol;
        if (orow < 2048) scol = orow; else { orow += 2048; scol = orow - 1024; }
        transpose_tile(p.w_in + (long)l * D * D_IN + (long)(kt * 64) * D_IN + scol, D_IN,
                       wl + W_CAT + (long)orow * D + kt * 64, D, sT);
      } else if (r < 2048) {
        int r2 = r - 1280, which = r2 >> 8, t = r2 & 255, kt = t >> 4, ntile = t & 15;
        const float* src = (which == 0 ? p.w_a_out : which == 1 ? p.w_b_out : p.w_o) + (long)l * 1048576;
        long doff = which == 0 ? W_A : which == 1 ? W_B : W_O;
        transpose_tile(src + (long)(kt * 64) * D + ntile * 64, D, wl + doff + (long)(ntile * 64) * D + kt * 64, D, sT);
      } else {
        int r3 = r - 2048, mat = r3 >> 2, t = r3 & 3, kt = t >> 1, ntile = t & 1;
        const float* src = p.w_rg + ((long)l * 32 + mat) * 16384;
        transpose_tile(src + (long)(kt * 64) * 128 + ntile * 64, 128,
                       wl + W_RG + (long)mat * 16384 + (long)(ntile * 64) * 128 + kt * 64, 128, sT);
      }
    } else if (job < NJ_TR + NJ_MOD) {
      int jm = job - NJ_TR, l = jm / 48, cgp = jm % 48;
      float* sc = (float*)smem_raw;
      float* red = sc + 9 * 1024;
      for (int i = tid; i < 9 * 1024; i += 256) {
        int s = i >> 10, k = i & 1023;
        float cv = s == 0 ? p.c_prompt[k] : p.c_sample[(s - 1) * 1024 + k];
        sc[i] = silu(cv);
      }
      __syncthreads();
      int col = cgp * 64 + (tid & 63), kq = tid >> 6;
      float a0 = 0, a1 = 0, a2 = 0, a3 = 0, a4 = 0, a5 = 0, a6 = 0, a7 = 0, a8 = 0;
      const float* wp = p.w_ada + (long)l * D * 3072 + col;
#pragma unroll 4
      for (int k = kq * 256; k < kq * 256 + 256; ++k) {
        float wv = wp[(long)k * 3072];
        a0 += sc[0 * 1024 + k] * wv; a1 += sc[1 * 1024 + k] * wv; a2 += sc[2 * 1024 + k] * wv;
        a3 += sc[3 * 1024 + k] * wv; a4 += sc[4 * 1024 + k] * wv; a5 += sc[5 * 1024 + k] * wv;
        a6 += sc[6 * 1024 + k] * wv; a7 += sc[7 * 1024 + k] * wv; a8 += sc[8 * 1024 + k] * wv;
      }
      float* rq = red + kq * 9 * 64 + (tid & 63);
      rq[0 * 64] = a0; rq[1 * 64] = a1; rq[2 * 64] = a2; rq[3 * 64] = a3; rq[4 * 64] = a4;
      rq[5 * 64] = a5; rq[6 * 64] = a6; rq[7 * 64] = a7; rq[8 * 64] = a8;
      __syncthreads();
      for (int i = tid; i < 9 * 64; i += 256) {
        int s = i >> 6, cc = i & 63;
        float v = red[0 * 576 + i] + red[1 * 576 + i] + red[2 * 576 + i] + red[3 * 576 + i];
        int cf = cgp * 64 + cc;
        MOD(p)[((long)l * 9 + s) * 3072 + cf] = v + p.b_ada[l * 3072 + cf];
      }
      __syncthreads();
    } else {
      int jt = job - NJ_TR - NJ_MOD;
      u16* tab = TAB(p);
#pragma unroll
      for (int e4 = 0; e4 < 4; ++e4) {
        int e = jt * 1024 + e4 * 256 + tid;
        if (e < 65536) {
          int m = e >> 8, k = e & 255;
          int k1 = (m >> 5) * 16 + (m & 15), ro = (m >> 4) & 1, ri = k >> 7, s1 = k & 127;
          float x = 2.f * (float)((k1 * s1) & 127) / 128.f;
          float cs = cospif(x), sn = sinpif(x);
          float v = (ro == ri) ? cs : (ro == 0 ? sn : -sn);
          tab[T_D1A + e] = f2bf(v);
        } else if (e < 65536 + 16384) {
          int e2 = e - 65536;
          int m = e2 >> 7, k = e2 & 127;
          int k1 = (m >> 5) * 16 + (m & 15), ro = (m >> 4) & 1, ri = k >> 6, s1 = k & 63;
          float x = 2.f * (float)((k1 * s1) & 63) / 64.f;
          float cs = cospif(x), sn = sinpif(x);
          float v = (ro == ri) ? cs : (ro == 0 ? sn : -sn);
          tab[T_D1B + e2] = f2bf(v);
        } else if (e < 65536 + 16384 + 32768) {
          int e2 = e - 65536 - 16384;
          int k2 = e2 >> 8, k = e2 & 255, ri = k >> 7, s2 = k & 127;
          float x = 2.f * (float)((k2 * s2) & 127) / 128.f;
          float v = ri == 0 ? cospif(x) : sinpif(x);
          tab[T_D2 + e2] = f2bf(v);
        } else if (e < 65536 + 16384 + 32768 + 131072) {
          int e2 = e - 65536 - 16384 - 32768;
          int row = e2 >> 8, c = e2 & 255, ri = row >> 8, m = row & 255;
          float x = 2.f * (float)((m * c) & 255) / 256.f;
          float v = ri == 0 ? cospif(x) : -sinpif(x);
          tab[T_DC + e2] = f2bf(v);
        } else {
          int e2 = e - (65536 + 16384 + 32768 + 131072);
          if (e2 < 16384) {
            float x = 2.f * (float)e2 / 16384.f;
            TW(p)[e2] = make_float2(cospif(x), sinpif(x));
          }
        }
      }
    }
  }
}

DEVFN void phase_fold(const Params& p, u16* smem) {
  for (int tile = blockIdx.x; tile < 256; tile += gridDim.x) {
    const int tid = otid(), lane = tid & 63, w = tid >> 6, wm = w >> 1, wn = w & 1, lr = lane & 15, quad = lane >> 4;
    int l = tile >> 7, g = (tile >> 5) & 3, mt = (tile >> 3) & 3, nt = tile & 7;
    LdPlain la; la.init(tid, TAB(p) + T_DC, mt * 128, 256);
    LdF32 lb; lb.init(tid, p.w_in + (long)l * D * D_IN, nt * 128, D_IN, 2048 + g * 256);
    f32x4 acc[4][4]; zero_acc(acc);
    gemm_core(tid, acc, 4, la, lb, smem);
    int ri = mt >> 1;
    u16* wc = WL(p, l) + W_CAT;
#pragma unroll
    for (int i = 0; i < 4; ++i) {
      int mrow = (mt & 1) * 128 + wm * 64 + i * 16 + lr;
      unsigned orow = 2048 + ri * 1024 + g * 256 + mrow;
#pragma unroll
      for (int j = 0; j < 4; ++j) {
        int n = nt * 128 + wn * 64 + j * 16 + quad * 4;
        uint2 o; o.x = pack2(acc[i][j][0], acc[i][j][1]); o.y = pack2(acc[i][j][2], acc[i][j][3]);
        *(uint2*)(wc + orow * D + n) = o;
      }
    }
  }
}

DEVFN void phase_h(const Params& p, int l) {
  const int lane = threadIdx.x & 63;
  const int wid = blockIdx.x * 4 + (threadIdx.x >> 6), nw = gridDim.x * 4;
  const float* ng = p.norm_g + l * D;
  const float* modl = MOD(p) + (long)l * 9 * 3072;
  u16* H = U(p, 0);
  for (int g = wid; g < T_TOT; g += nw) {
    const float* xb = (l == 0) ? (g < 16384 ? p.x_prompt : p.x_sample) : p.out;
    const unsigned xo = (unsigned)((l == 0 && g >= 16384) ? g - 16384 : g) * D;
    const float* xr = xb + xo;
    const float* md = modl + seq_of(g) * 3072;
    float4 v[4];
    float ss = 0.f;
#pragma unroll
    for (int i = 0; i < 4; ++i) {
      v[i] = *(const float4*)(xr + i * 256 + lane * 4);
      ss += v[i].x * v[i].x + v[i].y * v[i].y + v[i].z * v[i].z + v[i].w * v[i].w;
    }
#pragma unroll
    for (int o = 32; o >= 1; o >>= 1) ss += __shfl_xor(ss, o, 64);
    float rstd = rsqrtf(ss * (1.f / 1024.f) + 1e-6f);
#pragma unroll
    for (int i = 0; i < 4; ++i) {
      int c = i * 256 + lane * 4;
      float4 g4 = *(const float4*)(ng + c);
      float4 sh = *(const float4*)(md + c);
      float4 sc = *(const float4*)(md + 1024 + c);
      float h0 = v[i].x * rstd * g4.x * (1.f + sc.x) + sh.x;
      float h1 = v[i].y * rstd * g4.y * (1.f + sc.y) + sh.y;
      float h2 = v[i].z * rstd * g4.z * (1.f + sc.z) + sh.z;
      float h3 = v[i].w * rstd * g4.w * (1.f + sc.w) + sh.w;
      uint2 o; o.x = pack2(h0, h1); o.y = pack2(h2, h3);
      *(uint2*)(H + ((unsigned)g * D + c)) = o;
    }
  }
}

DEVFN void phase_final(const Params& p) {
  const int lane = threadIdx.x & 63;
  const int wid = blockIdx.x * 4 + (threadIdx.x >> 6), nw = gridDim.x * 4;
  for (int g = wid; g < T_TOT; g += nw) {
    float* xr = p.out + (unsigned)g * D;
    float4 v[4];
    float ss = 0.f;
#pragma unroll
    for (int i = 0; i < 4; ++i) {
      v[i] = *(const float4*)(xr + i * 256 + lane * 4);
      ss += v[i].x * v[i].x + v[i].y * v[i].y + v[i].z * v[i].z + v[i].w * v[i].w;
    }
#pragma unroll
    for (int o = 32; o >= 1; o >>= 1) ss += __shfl_xor(ss, o, 64);
    float rstd = rsqrtf(ss * (1.f / 1024.f) + 1e-6f);
#pragma unroll
    for (int i = 0; i < 4; ++i) {
      int c = i * 256 + lane * 4;
      float4 g4 = *(const float4*)(p.final_g + c);
      float4 o;
      o.x = v[i].x * rstd * g4.x; o.y = v[i].y * rstd * g4.y; o.z = v[i].z * rstd * g4.z; o.w = v[i].w * rstd * g4.w;
      *(float4*)(xr + c) = o;
    }
  }
}

DEVFN void phase_gemm1(const Params& p, int l, u16* smem) {
  const u16* H = U(p, 0);
  const u16* W = WL(p, l) + W_CAT;
  for (int it = 0;; ++it) {
    int mt, nt;
    if (!tile_xcd(it, 5, 40, mt, nt)) break;
    const int tid = otid(), lane = tid & 63, w = tid >> 6, wm = w >> 1, wn = w & 1, lr = lane & 15, quad = lane >> 4;
    LdPlain la; la.init(tid, H, mt * 256, D);
    LdPlain lb; lb.init(tid, W, nt * 128, D);
    f32x4 acc[8][4]; zero_acc8(acc);
    gemm_core_b(tid, acc, 32, la, lb, smem);
    int unit = nt >> 3, col0 = (nt & 7) * 128;
    u16* outp = U(p, 1 + unit);
    bool act = (unit == 1) || (unit == 4);
#pragma unroll
    for (int i = 0; i < 8; ++i) {
      unsigned g = mt * 256 + wm * 128 + i * 16 + lr;
#pragma unroll
      for (int j = 0; j < 4; ++j) {
        unsigned c = col0 + wn * 64 + j * 16 + quad * 4;
        float v0 = acc[i][j][0], v1 = acc[i][j][1], v2 = acc[i][j][2], v3 = acc[i][j][3];
        if (act) { v0 = silu(v0); v1 = silu(v1); v2 = silu(v2); v3 = silu(v3); }
        uint2 o; o.x = pack2(v0, v1); o.y = pack2(v2, v3);
        *(uint2*)(outp + g * D + c) = o;
      }
    }
  }
}

struct TokF1 {
  const u16* zr; const u16* zi; int n1; unsigned off;
  DEVFN unsigned operator()(int k, const u16*& b) const {
    int ri = k >= n1 ? 1 : 0;
    int s1 = k - ri * n1;
    b = ri ? zi : zr;
    return off + (unsigned)(s1 * 128) * D;
  }
};
DEVFN void f1_twiddle(int tid, const Params& p, const f32x4 (&acc)[4][4], int hf, int s2, int smask, int twmul,
                      uint2 (&o1)[2][4], uint2 (&o2)[2][4]) {
  const int lane = tid & 63, w = tid >> 6, wm = w >> 1, lr = lane & 15;
  const float2* tw = TW(p);
#pragma unroll
  for (int b = 0; b < 2; ++b) {
    int k1 = (hf * 4 + wm * 2 + b) * 16 + lr;
    float2 t = tw[((k1 * s2) & smask) * twmul];
#pragma unroll
    for (int j = 0; j < 4; ++j) {
      f32x4 orr = acc[2 * b][j], oii = acc[2 * b + 1][j];
      o1[b][j].x = pack2(orr[0] * t.x + oii[0] * t.y, orr[1] * t.x + oii[1] * t.y);
      o1[b][j].y = pack2(orr[2] * t.x + oii[2] * t.y, orr[3] * t.x + oii[3] * t.y);
      o2[b][j].x = pack2(oii[0] * t.x - orr[0] * t.y, oii[1] * t.x - orr[1] * t.y);
      o2[b][j].y = pack2(oii[2] * t.x - orr[2] * t.y, oii[3] * t.x - orr[3] * t.y);
    }
  }
}
DEVFN void f1_write(int tid, int hf, unsigned off, const uint2 (&o1)[2][4], const uint2 (&o2)[2][4], u16* zr, u16* zi) {
  const int lane = tid & 63, w = tid >> 6, wm = w >> 1, wn = w & 1, lr = lane & 15, quad = lane >> 4;
#pragma unroll
  for (int b = 0; b < 2; ++b) {
    unsigned k1 = (hf * 4 + wm * 2 + b) * 16 + lr;
    unsigned rowoff = off + (k1 * 128) * D + wn * 64 + quad * 4;
#pragma unroll
    for (int j = 0; j < 4; ++j) {
      *(uint2*)(zr + (rowoff + j * 16)) = o1[b][j];
      *(uint2*)(zi + (rowoff + j * 16)) = o2[b][j];
    }
  }
}
DEVFN void phase_fft1(const Params& p, u16* smem) {
  u16* zr = U(p, 3);
  u16* zi = U(p, 4);
  for (int tile = blockIdx.x; tile < 9216; tile += gridDim.x) {
    const int tid = otid();
    int seq, s2, ct, n1;
    if (tile < 1024) { seq = 0; s2 = tile >> 3; ct = tile & 7; n1 = 128; }
    else { int t2 = tile - 1024; seq = 1 + (t2 >> 10); s2 = (t2 >> 3) & 127; ct = t2 & 7; n1 = 64; }
    const unsigned off = (unsigned)(seq_start(seq) + s2) * D + ct * 128;
    LdTrans<TokF1> lb; lb.t_ = tid; lb.tok.zr = zr; lb.tok.zi = zi; lb.tok.n1 = n1; lb.tok.off = off;
    const int K = 2 * n1, nk = K >> 6;
    const u16* tab = TAB(p) + (seq == 0 ? T_D1A : T_D1B);
    const int smask = seq == 0 ? 16383 : 8191, twmul = seq == 0 ? 1 : 2;
    uint2 a1[2][4], a2[2][4];
    {
      f32x4 acc[4][4]; zero_acc(acc);
      LdPlain la; la.init(tid, tab, 0, K); gemm_core(tid, acc, nk, la, lb, smem);
      f1_twiddle(tid, p, acc, 0, s2, smask, twmul, a1, a2);
    }
    if (seq == 0) {
      uint2 b1[2][4], b2[2][4];
      {
        f32x4 acc[4][4]; zero_acc(acc);
        LdPlain la; la.init(tid, tab, 128, K); gemm_core(tid, acc, nk, la, lb, smem);
        f1_twiddle(tid, p, acc, 1, s2, smask, twmul, b1, b2);
      }
      f1_write(tid, 1, off, b1, b2, zr, zi);
    }
    f1_write(tid, 0, off, a1, a2, zr, zi);
  }
}

struct TokF2 {
  const u16* zr; const u16* zi; unsigned off;
  DEVFN unsigned operator()(int k, const u16*& b) const {
    int ri = k >> 7, s2 = k & 127;
    b = ri ? zi : zr;
    return off + (unsigned)s2 * D;
  }
};
DEVFN void phase_fft2(const Params& p, u16* smem) {
  u16* zr = U(p, 3);
  const u16* gbp = U(p, 5);
  for (int tile = blockIdx.x; tile < 5120; tile += gridDim.x) {
    const int tid = otid(), lane = tid & 63, w = tid >> 6, wm = w >> 1, wn = w & 1, lr = lane & 15, quad = lane >> 4;
    int seq, k1, ct, n1;
    if (tile < 1024) { seq = 0; k1 = tile >> 3; ct = tile & 7; n1 = 128; }
    else { int t2 = tile - 1024; seq = 1 + (t2 >> 9); k1 = (t2 >> 3) & 63; ct = t2 & 7; n1 = 64; }
    const int sst = seq_start(seq);
    const unsigned off = (unsigned)(sst + k1 * 128) * D + ct * 128;
    LdTrans<TokF2> lb; lb.t_ = tid; lb.tok.zr = zr; lb.tok.zi = U(p, 4); lb.tok.off = off;
    LdPlain la; la.init(tid, TAB(p) + T_D2, 0, 256);
    f32x4 acc[4][4]; zero_acc(acc);
    gemm_core(tid, acc, 4, la, lb, smem);
    const float nrm = seq == 0 ? (1.f / 2048.f) : 6.9053396600248786e-4f;
#pragma unroll
    for (int i = 0; i < 4; ++i) {
      unsigned k2 = wm * 64 + i * 16 + lr;
      unsigned goff = (unsigned)(sst + k1 + n1 * k2) * D + ct * 128;
#pragma unroll
      for (int j = 0; j < 4; ++j) {
        unsigned cl = wn * 64 + j * 16 + quad * 4;
        uint2 gv = *(const uint2*)(gbp + (goff + cl));
        uint2 o;
        o.x = pack2(acc[i][j][0] * nrm * lo2f(gv.x), acc[i][j][1] * nrm * hi2f(gv.x));
        o.y = pack2(acc[i][j][2] * nrm * lo2f(gv.y), acc[i][j][3] * nrm * hi2f(gv.y));
        *(uint2*)(zr + (off + k2 * D + cl)) = o;
      }
    }
  }
}

constexpr int SA_LD = 128;
template <int PASS>
DEVFN void phase_scan(const Params& p, int l, int dirsel, unsigned char* smem_raw) {
  float* sAf = (float*)smem_raw;
  u16* sBh = (u16*)(smem_raw + 32768);
  u16* sXc = (u16*)(smem_raw + 32768 + 16384);
  const int tid = otid(), lane = tid & 63, w = tid >> 6, lr = lane & 15, quad = lane >> 4;
  const int head = blockIdx.x & 7;
  const int dir = PASS == 1 ? ((blockIdx.x >> 3) & 1) : dirsel;
  const int tstart = PASS == 1 ? (blockIdx.x >> 4) : (blockIdx.x >> 3);
  const int tstep = PASS == 1 ? (gridDim.x >> 4) : (gridDim.x >> 3);
  const u16* xa = U(p, 1);
  u16* ga = U(p, 2);
  u16* hf = U(p, 5);
  float2* agg = (float2*)U(p, 4);
  float* carry = (float*)(agg + 1280L * 2 * 1024);
  bf16x8 bw[4][4];
  {
    const u16* wrg = WL(p, l) + W_RG;
#pragma unroll
    for (int jt = 0; jt < 4; ++jt) {
      int q = jt >> 1, col = w * 32 + (jt & 1) * 16 + lr;
      const u16* bp = wrg + (unsigned)((((dir * 2 + q) * 8 + head) * 128 + col) * 128 + quad * 8);
#pragma unroll
      for (int ks = 0; ks < 4; ++ks) bw[jt][ks] = *(const bf16x8*)(bp + ks * 32);
    }
  }
  float spl[2], brr[2], bii[2];
#pragma unroll
  for (int jc = 0; jc < 2; ++jc) {
    int cgl = head * 128 + w * 32 + jc * 16 + lr;
    float lm = p.lam[(l * 2 + dir) * D + cgl];
    spl[jc] = -8.f * 1.4426950408889634f * log1pf(expf(-lm));
    brr[jc] = -1.4426950408889634f * p.b_rg[((l * 2 + dir) * 2 + 0) * D + cgl];
    bii[jc] = -1.4426950408889634f * p.b_rg[((l * 2 + dir) * 2 + 1) * D + cgl];
  }
  const int c8 = tid & 15, tg = tid >> 4;
  float* sCw = (float*)(smem_raw + 65536);
  for (int i = tid; i < 640; i += 256) {
    int k = i >> 7, c = i & 127;
    sCw[i] = k < 4 ? p.conv_w[(l * 4 + k) * D + head * 128 + c] : p.conv_b[l * D + head * 128 + c];
  }
  __syncthreads();
  uint4 xr[7];
#define LOAD_XROWS(TT) do { const int _g0 = (TT) * 64; const int _sq = seq_of(_g0), _ss = seq_start(_sq), _se = _ss + seq_len(_sq); \
    _Pragma("unroll") for (int r = 0; r < 7; ++r) { int _g = _g0 + tg * 4 - 2 + r; xr[r] = make_uint4(0, 0, 0, 0); \
      if (_g >= _ss && _g < _se) xr[r] = *(const uint4*)(xa + ((unsigned)_g * D + head * 128 + c8 * 8)); } } while (0)
  if (tstart < 1280) LOAD_XROWS(tstart);
  for (int tt = tstart; tt < 1280; tt += tstep) {
    const int g0 = tt * 64;
    const int seq = seq_of(g0), sst = seq_start(seq), send = sst + seq_len(seq);
#pragma unroll
    for (int j = 0; j < 4; ++j) {
      float o[8];
      {
        float4 b0 = *(const float4*)(sCw + 512 + c8 * 8), b1 = *(const float4*)(sCw + 512 + c8 * 8 + 4);
        o[0] = b0.x; o[1] = b0.y; o[2] = b0.z; o[3] = b0.w; o[4] = b1.x; o[5] = b1.y; o[6] = b1.z; o[7] = b1.w;
      }
#pragma unroll
      for (int k = 0; k < 4; ++k) {
        uint4 v = xr[j + k];
        float4 w0 = *(const float4*)(sCw + k * 128 + c8 * 8), w1 = *(const float4*)(sCw + k * 128 + c8 * 8 + 4);
        o[0] += w0.x * lo2f(v.x); o[1] += w0.y * hi2f(v.x);
        o[2] += w0.z * lo2f(v.y); o[3] += w0.w * hi2f(v.y);
        o[4] += w1.x * lo2f(v.z); o[5] += w1.y * hi2f(v.z);
        o[6] += w1.z * lo2f(v.w); o[7] += w1.w * hi2f(v.w);
      }
      uint4 q0;
      q0.x = pack2(o[0], o[1]); q0.y = pack2(o[2], o[3]); q0.z = pack2(o[4], o[5]); q0.w = pack2(o[6], o[7]);
      const int tl = tg * 4 + j;
      *(uint4*)(sXc + tl * 128 + ((c8 ^ (tl & 7)) << 3)) = q0;
    }
    __syncthreads();
    if (tt + tstep < 1280) LOAD_XROWS(tt + tstep);
    const int gstart = dir == 0 ? sst : send - 1;
#pragma unroll 1
    for (int hv = 0; hv < 2; ++hv) {
      f32x4 acc[2][4];
#pragma unroll
      for (int it = 0; it < 2; ++it)
#pragma unroll
        for (int jt = 0; jt < 4; ++jt) acc[it][jt] = f32x4{0.f, 0.f, 0.f, 0.f};
#pragma unroll
      for (int ks = 0; ks < 4; ++ks) {
#pragma unroll
        for (int it = 0; it < 2; ++it) {
          bf16x8 af = *(const bf16x8*)(sXc + ((hv * 2 + it) * 16 + lr) * 128 + (((ks * 4 + quad) ^ (lr & 7)) << 3));
#pragma unroll
          for (int jt = 0; jt < 4; ++jt)
            acc[it][jt] = __builtin_amdgcn_mfma_f32_16x16x32_bf16(af, bw[jt][ks], acc[it][jt], 0, 0, 0);
        }
      }
#pragma unroll
      for (int it = 0; it < 2; ++it)
#pragma unroll
        for (int jc = 0; jc < 2; ++jc) {
#pragma unroll
          for (int r = 0; r < 4; ++r) {
            int tl = (hv * 2 + it) * 16 + quad * 4 + r, c = w * 32 + jc * 16 + lr;
            float er = 1.f + __builtin_amdgcn_exp2f(fminf(fmaf(acc[it][jc][r], -1.4426950408889634f, brr[jc]), 60.f));
            float ei = 1.f + __builtin_amdgcn_exp2f(fminf(fmaf(acc[it][2 + jc][r], -1.4426950408889634f, bii[jc]), 60.f));
            float q = __builtin_amdgcn_rcpf(er * ei);
            float rr = q * ei, ii = q * er;
            float a = __builtin_amdgcn_exp2f(rr * spl[jc]);
            float mult = __builtin_amdgcn_sqrtf((1.f - a) * (1.f + a));
            if (g0 + tl == gstart) mult = 1.f;
            float xv = bf2f(sXc[tl * 128 + (((c >> 3) ^ (tl & 7)) << 3) + (c & 7)]);
            sAf[tl * SA_LD + c] = a;
            sBh[tl * 128 + c] = f2bf(mult * ii * xv);
          }
        }
    }
    __syncthreads();
    if (tid < 128) {
      const int c = tid;
      const unsigned aidx = (unsigned)(tt * 2 + dir) * 1024 + head * 128 + c;
      const float* ap = sAf + c;
      u16* bp = sBh + c;
      if (PASS == 1) {
        float h = 0.f, P = 1.f;
        if (dir == 0) {
#pragma unroll 16
          for (int st = 0; st < 64; ++st) { float a = ap[st * SA_LD]; h = a * h + bf2f(bp[st * 128]); P *= a; }
        } else {
#pragma unroll 16
          for (int st = 63; st >= 0; --st) { float a = ap[st * SA_LD]; h = a * h + bf2f(bp[st * 128]); P *= a; }
        }
        agg[aidx] = make_float2(P, h);
      } else {
        float h = carry[aidx];
        if (dir == 0) {
#pragma unroll 16
          for (int st = 0; st < 64; ++st) { h = ap[st * SA_LD] * h + bf2f(bp[st * 128]); bp[st * 128] = f2bf(h); }
        } else {
#pragma unroll 16
          for (int st = 63; st >= 0; --st) { h = ap[st * SA_LD] * h + bf2f(bp[st * 128]); bp[st * 128] = f2bf(h); }
        }
      }
    }
    if (PASS == 3) {
      __syncthreads();
#pragma unroll
      for (int cch = 0; cch < 4; ++cch) {
        int chunk = tid + cch * 256;
        int t = chunk >> 4, cc = (chunk & 15) * 8;
        unsigned off = (unsigned)(g0 + t) * D + head * 128 + cc;
        uint4 hv = *(const uint4*)(sBh + t * 128 + cc);
        if (dir == 0) {
          *(uint4*)(hf + off) = hv;
        } else {
          uint4 fv = *(const uint4*)(hf + off);
          uint4 gv = *(const uint4*)(ga + off);
          uint4 o;
          o.x = pack2((lo2f(fv.x) + lo2f(hv.x)) * lo2f(gv.x), (hi2f(fv.x) + hi2f(hv.x)) * hi2f(gv.x));
          o.y = pack2((lo2f(fv.y) + lo2f(hv.y)) * lo2f(gv.y), (hi2f(fv.y) + hi2f(hv.y)) * hi2f(gv.y));
          o.z = pack2((lo2f(fv.z) + lo2f(hv.z)) * lo2f(gv.z), (hi2f(fv.z) + hi2f(hv.z)) * hi2f(gv.z));
          o.w = pack2((lo2f(fv.w) + lo2f(hv.w)) * lo2f(gv.w), (hi2f(fv.w) + hi2f(hv.w)) * hi2f(gv.w));
          *(uint4*)(ga + off) = o;
        }
      }
    }
    __syncthreads();
  }
#undef LOAD_XROWS
}

DEVFN void phase_carry(const Params& p) {
  const float2* __restrict__ agg = (const float2*)U(p, 4);
  float* __restrict__ carry = (float*)(agg + 1280L * 2 * 1024);
  const int lane = threadIdx.x & 63, w = threadIdx.x >> 6;
  for (int u = blockIdx.x + gridDim.x * w; u < 288; u += gridDim.x * 4) {
    int id = u * 64 + lane;
    int seq = id >> 11, dir = (id >> 10) & 1, c = id & 1023;
    int nt = seq_len(seq) >> 6, tile0 = seq_start(seq) >> 6;
    float h = 0.f;
#pragma unroll 8
    for (int k = 0; k < nt; ++k) {
      int tt = tile0 + (dir ? nt - 1 - k : k);
      unsigned ix = (unsigned)(tt * 2 + dir) * 1024 + c;
      float2 v = agg[ix];
      carry[ix] = h;
      h = v.x * h + v.y;
    }
  }
}

DEVFN void phase_merge(const Params& p, int l, u16* smem) {
  const u16* wl = WL(p, l);
  u16* mo = U(p, 1);
  u16* tb = U(p, 5);
  for (int it = 0;; ++it) {
    int mt, nt;
    if (!tile_xcd(it, 1, 8, mt, nt)) break;
    const int g0 = mt * 256;
#pragma unroll 1
    for (int br = 0; br < 2; ++br) {
      {
        const int tid = otid(), lane = tid & 63, w = tid >> 6, wm = w >> 1, wn = w & 1, lr = lane & 15, quad = lane >> 4;
        f32x4 acc[8][4]; zero_acc8(acc);
        LdPlain lb; lb.init(tid, wl + (br == 0 ? W_A : W_B), nt * 128, D);
        if (br == 0) {
          LdPlain la; la.init(tid, U(p, 2), g0, D);
          gemm_core_b(tid, acc, 32, la, lb, smem);
        } else {
          const int seq = seq_of(g0);
          LdPerm la; la.base = U(p, 3); la.g0 = g0; la.sst = seq_start(seq); la.lg = seq == 0 ? 7 : 6;
          gemm_core_b(tid, acc, 32, la, lb, smem);
        }
#pragma unroll
        for (int i = 0; i < 8; ++i) {
          unsigned g = g0 + wm * 128 + i * 16 + lr;
#pragma unroll
          for (int j = 0; j < 4; ++j) {
            unsigned c = nt * 128 + wn * 64 + j * 16 + quad * 4;
            uint2 o; o.x = pack2(acc[i][j][0], acc[i][j][1]); o.y = pack2(acc[i][j][2], acc[i][j][3]);
            *(uint2*)(tb + (g * D + c)) = o;
          }
        }
      }
      {
        const int tid = otid(), lane = tid & 63, w = tid >> 6, wm = w >> 1, wn = w & 1, lr = lane & 15, quad = lane >> 4;
        f32x4 acc[8][4]; zero_acc8(acc);
        LdPlain la; la.init(tid, U(p, 0), g0, D);
        LdPlain lb; lb.init(tid, wl + W_CAT, 5120 + br * 1024 + nt * 128, D);
        gemm_core_b(tid, acc, 32, la, lb, smem);
#pragma unroll
        for (int i = 0; i < 8; ++i) {
          unsigned g = g0 + wm * 128 + i * 16 + lr;
#pragma unroll
          for (int j = 0; j < 4; ++j) {
            unsigned c = nt * 128 + wn * 64 + j * 16 + quad * 4;
            uint2 tv = *(const uint2*)(tb + (g * D + c));
            float v0 = sigm(acc[i][j][0]) * lo2f(tv.x);
            float v1 = sigm(acc[i][j][1]) * hi2f(tv.x);
            float v2 = sigm(acc[i][j][2]) * lo2f(tv.y);
            float v3 = sigm(acc[i][j][3]) * hi2f(tv.y);
            uint2* op = (uint2*)(mo + (g * D + c));
            if (br == 1) {
              uint2 pv = *op;
              v0 += lo2f(pv.x); v1 += hi2f(pv.x); v2 += lo2f(pv.y); v3 += hi2f(pv.y);
            }
            uint2 o; o.x = pack2(v0, v1); o.y = pack2(v2, v3);
            *op = o;
          }
        }
      }
    }
  }
}

DEVFN void phase_out(const Params& p, int l, u16* smem) {
  const u16* wo = WL(p, l) + W_O;
  for (int it = 0;; ++it) {
    int mt, nt;
    if (!tile_xcd(it, 1, 8, mt, nt)) break;
    const int tid = otid(), lane = tid & 63, w = tid >> 6, wm = w >> 1, wn = w & 1, lr = lane & 15, quad = lane >> 4;
    const int g0 = mt * 256;
    LdPlain la; la.init(tid, U(p, 1), g0, D);
    LdPlain lb; lb.init(tid, wo, nt * 128, D);
    f32x4 acc[8][4]; zero_acc8(acc);
    gemm_core_b(tid, acc, 32, la, lb, smem);
    const float* gate = MOD(p) + ((long)l * 9 + seq_of(g0)) * 3072 + 2048;
#pragma unroll
    for (int i = 0; i < 8; ++i) {
      unsigned g = g0 + wm * 128 + i * 16 + lr;
      const float* xb = (l == 0) ? (g0 < 16384 ? p.x_prompt : p.x_sample) : p.out;
      const float* xr = xb + (unsigned)((l == 0 && g0 >= 16384) ? g - 16384 : g) * D;
      float* orow = p.out + g * D;
#pragma unroll
      for (int j = 0; j < 4; ++j) {
        unsigned c = nt * 128 + wn * 64 + j * 16 + quad * 4;
        float4 xv = *(const float4*)(xr + c);
        float4 gt = *(const float4*)(gate + c);
        float4 o;
        o.x = xv.x + gt.x * acc[i][j][0]; o.y = xv.y + gt.y * acc[i][j][1];
        o.z = xv.z + gt.z * acc[i][j][2]; o.w = xv.w + gt.w * acc[i][j][3];
        *(float4*)(orow + c) = o;
      }
    }
  }
}

#define XB_TMO      128
#define XB_XCNT(j)  (256  + 64 * (j))
#define XB_XSUB(j)  (1280 + 64 * (j))
#define XB_XGEN(j)  (2304 + 64 * (j))
#define XB_TOP      3328
#define XB_TOPGEN   3392
#define XCD_BAR_WORDS 3456
#define XB_SPIN_CAP (1u << 18)
#define LAS __attribute__((address_space(3)))

__device__ __forceinline__ unsigned xb_ld(unsigned* p)              { return __hip_atomic_load(p, __ATOMIC_RELAXED, __HIP_MEMORY_SCOPE_AGENT); }
__device__ __forceinline__ unsigned xb_add(unsigned* p, unsigned v) { return __hip_atomic_fetch_add(p, v, __ATOMIC_RELAXED, __HIP_MEMORY_SCOPE_AGENT); }
__device__ __forceinline__ unsigned xb_xcc_id() { return (unsigned)__builtin_amdgcn_s_getreg((3 << 11) | 20) & 0xFu; }
#define XB_SPIN(cond, bar) do { unsigned _sp = 0; while (cond) { __builtin_amdgcn_s_sleep(1); \
    if ((++_sp & 255u) == 0u) { if (xb_ld(&(bar)[XB_TMO])) break; if (_sp > XB_SPIN_CAP) { atomicAdd(&(bar)[XB_TMO], 1u); break; } } } } while (0)

struct XcdBarrier {
    unsigned* bar; unsigned x;
    volatile LAS unsigned* st;
};

__device__ __forceinline__ XcdBarrier xcd_barrier_post(unsigned* bar, volatile LAS unsigned* st) {
    XcdBarrier b; b.bar = bar; b.x = xb_xcc_id(); b.st = st;
    if (threadIdx.x == 0) (void)xb_add(&bar[XB_XCNT(b.x)], 1u);
    return b;
}
__device__ __forceinline__ void xcd_barrier_complete(unsigned* bar, unsigned x, unsigned& nloc, unsigned& nx) {
    const unsigned G = gridDim.x * gridDim.y * gridDim.z;
    unsigned sum, cnt, mine, sp = 0u;
    for (;;) {
        sum = 0u; cnt = 0u; mine = 0u;
#pragma unroll
        for (unsigned j = 0; j < 16; ++j) { const unsigned c = xb_ld(&bar[XB_XCNT(j)]); sum += c; cnt += (c > 0u) ? 1u : 0u; mine = (j == x) ? c : mine; }
        if (sum == G) break;
        __builtin_amdgcn_s_sleep(1);
        if ((++sp & 255u) == 0u) { if (xb_ld(&bar[XB_TMO])) break; if (sp > XB_SPIN_CAP) { atomicAdd(&bar[XB_TMO], 1u); break; } }
    }
    nloc = mine > 0u ? mine : 1u; nx = cnt > 0u ? cnt : 1u;
}

__device__ __forceinline__ void xcd_barrier(const XcdBarrier& b) {
    asm volatile("s_waitcnt vmcnt(0)" ::: "memory");
    __syncthreads();
    if (threadIdx.x == 0) {
        unsigned* bar = b.bar;
        __builtin_amdgcn_s_waitcnt(0);
        unsigned nloc = b.st[0], nx = b.st[1];
        if (nloc == 0u) { xcd_barrier_complete(bar, b.x, nloc, nx); b.st[0] = nloc; b.st[1] = nx; }
        const unsigned old = xb_add(&bar[XB_XSUB(b.x)], 1u);
        const unsigned gen = old / nloc;
        if (old + 1u == (gen + 1u) * nloc) {
            __builtin_amdgcn_fence(__ATOMIC_RELEASE, "agent");
            asm volatile("s_waitcnt vmcnt(0)" ::: "memory");
            const unsigned og = xb_add(&bar[XB_TOP], 1u);
            const unsigned tg = og / nx;
            if (og + 1u == (tg + 1u) * nx) xb_add(&bar[XB_TOPGEN], 1u);
            else XB_SPIN(xb_ld(&bar[XB_TOPGEN]) == tg, bar);
            __builtin_amdgcn_fence(__ATOMIC_ACQUIRE, "agent");
            xb_add(&bar[XB_XGEN(b.x)], 1u);
            asm volatile("s_waitcnt vmcnt(0)" ::: "memory");
        } else {
            XB_SPIN(xb_ld(&bar[XB_XGEN(b.x)]) == gen, bar);
            __builtin_amdgcn_fence(__ATOMIC_ACQUIRE, "agent");
            asm volatile("s_waitcnt vmcnt(0)" ::: "memory");
        }
    }
    __syncthreads();
}


__global__ void __launch_bounds__(256, 2) hawk_fnet_megakernel(Params p) {
  extern __shared__ __attribute__((aligned(16))) unsigned char smem_raw[];
  cg::grid_group grid = cg::this_grid();
  u16* smem = (u16*)smem_raw;

  __shared__ unsigned xb_st[4];
  unsigned* bar = (unsigned*)(p.ws + OFF_BAR_BYTES);
  if (blockIdx.x == 0) {
    for (int i = threadIdx.x; i < XCD_BAR_WORDS; i += 256) __hip_atomic_store(&bar[i], 0u, __ATOMIC_RELAXED, __HIP_MEMORY_SCOPE_AGENT);
  }
  if (threadIdx.x < 4) xb_st[threadIdx.x] = 0u;
  phase_prologue(p, smem_raw);
  grid.sync();
  XcdBarrier xb = xcd_barrier_post(bar, (volatile LAS unsigned*)xb_st);
  phase_fold(p, smem);
  phase_h(p, 0);
  xcd_barrier(xb);
  for (int l = 0; l < 2; ++l) {
    phase_gemm1(p, l, smem);
    xcd_barrier(xb);
    phase_fft1(p, smem);
    xcd_barrier(xb);
    phase_fft2(p, smem);
    xcd_barrier(xb);
    phase_scan<1>(p, l, 0, smem_raw);
    xcd_barrier(xb);
    phase_carry(p);
    xcd_barrier(xb);
    phase_scan<3>(p, l, 0, smem_raw);
    xcd_barrier(xb);
    phase_scan<3>(p, l, 1, smem_raw);
    xcd_barrier(xb);
    phase_merge(p, l, smem);
    xcd_barrier(xb);
    phase_out(p, l, smem);
    xcd_barrier(xb);
    if (l == 0) { phase_h(p, 1); xcd_barrier(xb); }
  }
  phase_final(p);
}

extern "C" void kernel_launch(void* const* d_in, const int* in_sizes, int n_in,
                              void* d_out, int out_size, void* d_ws, size_t ws_size,
                              hipStream_t stream) {
  (void)in_sizes; (void)n_in; (void)out_size;
  if (ws_size < (size_t)WS_NEED) {
    fprintf(stderr, "workspace too small: %zu < %ld\n", ws_size, (long)WS_NEED);
    return;
  }
  static int grid_blocks = 0;
  if (!grid_blocks) {
    hipFuncSetAttribute((const void*)hawk_fnet_megakernel, hipFuncAttributeMaxDynamicSharedMemorySize, SMEM_BYTES);
    int dev = 0, cus = 0, per_cu = 0;
    hipGetDevice(&dev);
    hipDeviceGetAttribute(&cus, hipDeviceAttributeMultiprocessorCount, dev);
    hipOccupancyMaxActiveBlocksPerMultiprocessor(&per_cu, hawk_fnet_megakernel, 256, SMEM_BYTES);
    if (per_cu > 2) per_cu = 2;
    if (per_cu < 1) per_cu = 1;
    grid_blocks = (cus * per_cu) & ~15;
  }
  Params p{};
  p.x_prompt = (const float*)d_in[0]; p.x_sample = (const float*)d_in[1];
  p.c_prompt = (const float*)d_in[2]; p.c_sample = (const float*)d_in[3];
  p.norm_g = (const float*)d_in[4]; p.w_ada = (const float*)d_in[5]; p.b_ada = (const float*)d_in[6];
  p.w_in = (const float*)d_in[7]; p.conv_w = (const float*)d_in[8]; p.conv_b = (const float*)d_in[9];
  p.w_rg = (const float*)d_in[10]; p.b_rg = (const float*)d_in[11]; p.lam = (const float*)d_in[12];
  p.w_a_out = (const float*)d_in[13]; p.w_b_out = (const float*)d_in[14]; p.w_o = (const float*)d_in[15];
  p.final_g = (const float*)d_in[16];
  p.out = (float*)d_out; p.ws = (unsigned char*)d_ws;
  void* args[] = {&p};
  hipError_t e = hipLaunchCooperativeKernel((void*)hawk_fnet_megakernel, dim3(grid_blocks), dim3(256), args, SMEM_BYTES, stream);
  if (e != hipSuccess) fprintf(stderr, "cooperative launch failed: %s (grid %d)\n", hipGetErrorString(e), grid_blocks);
}
```

```cpp
#include <hip/hip_runtime.h>
#include <hip/hip_cooperative_groups.h>
#include <cstdio>
namespace cg = cooperative_groups;

typedef unsigned short u16;
typedef __attribute__((ext_vector_type(8))) short bf16x8;
typedef __attribute__((ext_vector_type(4))) float f32x4;

#define DEVFN __device__ __forceinline__

constexpr int D = 1024;
constexpr int T_TOT = 81920;
constexpr long UNIT = (long)T_TOT * D;
constexpr int D_IN = 6144;

constexpr long OFF_W = 6 * UNIT;
constexpr long W_CAT = 0;
constexpr long W_A = 7168L * 1024;
constexpr long W_B = W_A + 1048576;
constexpr long W_O = W_B + 1048576;
constexpr long W_RG = W_O + 1048576;
constexpr long LW = W_RG + 524288;
constexpr long OFF_TAB = OFF_W + 2 * LW;
constexpr long T_D1A = 0;
constexpr long T_D1B = 65536;
constexpr long T_D2 = T_D1B + 16384;
constexpr long T_DC = T_D2 + 32768;
constexpr long TAB_ELEMS = T_DC + 131072;
constexpr long OFF_TW_BYTES = (OFF_TAB + TAB_ELEMS) * 2;
constexpr long OFF_MOD_BYTES = OFF_TW_BYTES + 131072;
constexpr long OFF_BAR_BYTES = OFF_MOD_BYTES + 221184;
constexpr long OFF_LB_BYTES = OFF_BAR_BYTES + 16384;
constexpr long LB_SLOT_BYTES = 20480L * 128 * 8;
constexpr long WS_NEED = OFF_LB_BYTES + LB_SLOT_BYTES + 20480 * 4 + 10240 * 4;
static_assert(WS_NEED <= (1L << 30), "workspace map exceeds the guaranteed 1 GiB");

constexpr int TILE = 128 * 64;
constexpr int SMEM_BYTES = 73728;

struct Params {
  const float* x_prompt; const float* x_sample; const float* c_prompt; const float* c_sample;
  const float* norm_g; const float* w_ada; const float* b_ada; const float* w_in;
  const float* conv_w; const float* conv_b; const float* w_rg; const float* b_rg; const float* lam;
  const float* w_a_out; const float* w_b_out; const float* w_o; const float* final_g;
  float* out; unsigned char* ws;
};

typedef __attribute__((ext_vector_type(2))) float f32x2_t;
typedef __attribute__((ext_vector_type(2))) __bf16 bf16x2_t;
DEVFN u16 f2bf(float f) {
  __bf16 h = (__bf16)f;
  return *(u16*)&h;
}
DEVFN float bf2f(u16 h) { return __uint_as_float(((unsigned)h) << 16); }
DEVFN unsigned pack2(float a, float b) {
  f32x2_t v = {a, b};
  bf16x2_t r = __builtin_convertvector(v, bf16x2_t);
  return *(unsigned*)&r;
}
DEVFN float lo2f(unsigned v) { return __uint_as_float(v << 16); }
DEVFN float hi2f(unsigned v) { return __uint_as_float(v & 0xffff0000u); }
DEVFN float sigm(float x) { return __builtin_amdgcn_rcpf(1.f + __expf(-x)); }
DEVFN float silu(float x) { return x * __builtin_amdgcn_rcpf(1.f + __expf(-x)); }
DEVFN float one_minus_exp(float x) {
  float pl = -x * (1.f + x * (0.5f + x * (1.f / 6.f + x * (1.f / 24.f + x * (1.f / 120.f + x * (1.f / 720.f))))));
  float dr = 1.f - __expf(x);
  return x > -0.3f ? pl : dr;
}

DEVFN int otid() { int t = threadIdx.x; asm volatile("" : "+v"(t)); return t; }
DEVFN int seq_of(int g) { int seg = g >> 13; return seg < 2 ? 0 : seg - 1; }
DEVFN int seq_start(int s) { return s == 0 ? 0 : 16384 + (s - 1) * 8192; }
DEVFN int seq_len(int s) { return s == 0 ? 16384 : 8192; }

DEVFN u16* U(const Params& p, int i) { return (u16*)(p.ws) + (long)i * UNIT; }
DEVFN u16* WL(const Params& p, int l) { return (u16*)(p.ws) + OFF_W + (long)l * LW; }
DEVFN u16* TAB(const Params& p) { return (u16*)(p.ws) + OFF_TAB; }
DEVFN float2* TW(const Params& p) { return (float2*)(p.ws + OFF_TW_BYTES); }
DEVFN float* MOD(const Params& p) { return (float*)(p.ws + OFF_MOD_BYTES); }
DEVFN const float* xrow(const Params& p, int g) {
  return g < 16384 ? p.x_prompt + (long)g * D : p.x_sample + (long)(g - 16384) * D;
}

struct LdPlain {
  static constexpr bool kDma = true; static constexpr bool kTr = false;
  const u16* base; unsigned off0; unsigned cst; int t_; unsigned row0_, stride_;
  DEVFN unsigned rowoff(int r) const { return (row0_ + r) * stride_; }
  DEVFN void init(int tid_, const u16* b, unsigned row0, unsigned stride) {
    unsigned tid = tid_; t_ = tid_; row0_ = row0; stride_ = stride;
    base = b;
    off0 = (row0 + (tid >> 3)) * stride + (((tid & 7) ^ ((tid >> 3) & 7)) << 3);
    cst = 32 * stride;
  }
  DEVFN void issue(u16* tile, int c, int kt) const {
    __builtin_amdgcn_global_load_lds((const unsigned*)(base + (off0 + c * cst + kt * 64)),
                                     (unsigned*)(tile + (t_ + c * 256) * 8), 16, 0, 0);
  }
  DEVFN uint4 load(int, int) const { return make_uint4(0, 0, 0, 0); }
  DEVFN void store(u16*, int, uint4) const {}
};
struct LdRows4 {
  static constexpr bool kDma = true; static constexpr bool kTr = false;
  const u16* base; unsigned off[4]; int t_;
  DEVFN void issue(u16* tile, int c, int kt) const {
    __builtin_amdgcn_global_load_lds((const unsigned*)(base + (off[c] + kt * 64)),
                                     (unsigned*)(tile + (t_ + c * 256) * 8), 16, 0, 0);
  }
  DEVFN uint4 load(int, int) const { return make_uint4(0, 0, 0, 0); }
  DEVFN void store(u16*, int, uint4) const {}
};
struct LdF32 {
  static constexpr bool kDma = false; static constexpr bool kTr = false;
  const float* base; unsigned off0; unsigned cst; int t_;
  DEVFN void init(int tid_, const float* b, unsigned row0, unsigned stride, unsigned col0) {
    unsigned tid = tid_; t_ = tid_;
    base = b;
    off0 = (row0 + (tid >> 3)) * stride + col0 + (tid & 7) * 8;
    cst = 32 * stride;
  }
  DEVFN void issue(u16*, int, int) const {}
  DEVFN uint4 load(int c, int kt) const {
    const float4* q = (const float4*)(base + (off0 + c * cst + kt * 64));
    float4 a = q[0], b = q[1];
    uint4 r; r.x = pack2(a.x, a.y); r.y = pack2(a.z, a.w); r.z = pack2(b.x, b.y); r.w = pack2(b.z, b.w);
    return r;
  }
  DEVFN void store(u16* tile, int c, uint4 v) const {
    int idx = t_ + c * 256;
    int row = idx >> 3, kc = idx & 7;
    *(uint4*)(tile + row * 64 + ((kc ^ (row & 7)) << 3)) = v;
  }
};
DEVFN int trf(int r) { return ((r & 3) << 2) | ((r >> 2) & 3); }
template <class TokFn>
struct LdTrans {
  static constexpr bool kDma = false; static constexpr bool kTr = false;
  TokFn tok; int t_;
  DEVFN void issue(u16*, int, int) const {}
  DEVFN uint4 load(int c, int kt) const {
    int idx = t_ + c * 256;
    int kk = idx & 63, cc = idx >> 6;
    const u16* b; unsigned o = tok(kt * 64 + kk, b);
    return *(const uint4*)(b + (o + cc * 8));
  }
  DEVFN void store(u16* tile, int c, uint4 v) const {
    int idx = t_ + c * 256;
    int kk = idx & 63, cc = idx >> 6;
    u16* q = tile + (cc * 8) * 64 + (kk & 7);
    int kc = kk >> 3;
    q[0 * 64 + ((kc ^ 0) << 3)] = (u16)(v.x & 0xffff); q[1 * 64 + ((kc ^ 1) << 3)] = (u16)(v.x >> 16);
    q[2 * 64 + ((kc ^ 2) << 3)] = (u16)(v.y & 0xffff); q[3 * 64 + ((kc ^ 3) << 3)] = (u16)(v.y >> 16);
    q[4 * 64 + ((kc ^ 4) << 3)] = (u16)(v.z & 0xffff); q[5 * 64 + ((kc ^ 5) << 3)] = (u16)(v.z >> 16);
    q[6 * 64 + ((kc ^ 6) << 3)] = (u16)(v.w & 0xffff); q[7 * 64 + ((kc ^ 7) << 3)] = (u16)(v.w >> 16);
  }
};

typedef __attribute__((ext_vector_type(4))) short s16x4;
DEVFN s16x4 lds_tr_read(const u16* q) {
  return __builtin_amdgcn_ds_read_tr16_b64_v4i16((s16x4 __attribute__((address_space(3)))*)(q));
}

DEVFN void zero_acc(f32x4 (&acc)[4][4]) {
#pragma unroll
  for (int i = 0; i < 4; ++i)
#pragma unroll
    for (int j = 0; j < 4; ++j) acc[i][j] = f32x4{0.f, 0.f, 0.f, 0.f};
}

template <class LA, class LB>
DEVFN void gemm_core(int tid, f32x4 (&acc)[4][4], int nk, const LA& la, const LB& lb, u16* smem) {
  const int lane = tid & 63, w = tid >> 6, wm = w >> 1, wn = w & 1;
  const int lr = lane & 15, quad = lane >> 4;
  uint4 ra[4], rb[4];
  if (LA::kDma) {
#pragma unroll
    for (int c = 0; c < 4; ++c) la.issue(smem, c, 0);
  } else {
#pragma unroll
    for (int c = 0; c < 4; ++c) ra[c] = la.load(c, 0);
  }
  if (LB::kDma) {
#pragma unroll
    for (int c = 0; c < 4; ++c) lb.issue(smem + TILE, c, 0);
  } else {
#pragma unroll
    for (int c = 0; c < 4; ++c) rb[c] = lb.load(c, 0);
  }
  if (!LA::kDma) {
#pragma unroll
    for (int c = 0; c < 4; ++c) la.store(smem, c, ra[c]);
  }
  if (!LB::kDma) {
#pragma unroll
    for (int c = 0; c < 4; ++c) lb.store(smem + TILE, c, rb[c]);
  }
  asm volatile("s_waitcnt vmcnt(0)" ::: "memory");
  __syncthreads();
  const int aoff = (wm * 64 + lr) * 64, boff = (wn * 64 + lr) * 64;
  const int sw0 = ((quad) ^ (lr & 7)) << 3, sw1 = ((4 + quad) ^ (lr & 7)) << 3;
  int troff[4][2];
  if (LB::kTr) {
    const int q = lr >> 2, pp = lr & 3;
#pragma unroll
    for (int j = 0; j < 4; ++j)
#pragma unroll
      for (int h = 0; h < 2; ++h) {
        int r = quad * 8 + h * 4 + q;
        int ch = (wn * 8 + j * 2 + (pp >> 1)) ^ trf(r);
        troff[j][h] = r * 128 + ch * 8 + (pp & 1) * 4;
      }
  }
  for (int kt = 0; kt < nk; ++kt) {
    const u16* sA = smem + (kt & 1) * 2 * TILE;
    const u16* sB = sA + TILE;
    u16* nA = smem + ((kt + 1) & 1) * 2 * TILE;
    const bool more = (kt + 1) < nk;
    if (more) {
      if (LA::kDma) {
#pragma unroll
        for (int c = 0; c < 4; ++c) la.issue(nA, c, kt + 1);
      } else {
#pragma unroll
        for (int c = 0; c < 4; ++c) ra[c] = la.load(c, kt + 1);
      }
      if (LB::kDma) {
#pragma unroll
        for (int c = 0; c < 4; ++c) lb.issue(nA + TILE, c, kt + 1);
      } else {
#pragma unroll
        for (int c = 0; c < 4; ++c) rb[c] = lb.load(c, kt + 1);
      }
    }
#pragma unroll
    for (int ks = 0; ks < 2; ++ks) {
      const int sw = ks == 0 ? sw0 : sw1;
      bf16x8 af[4], bfr[4];
#pragma unroll
      for (int i = 0; i < 4; ++i) af[i] = *(const bf16x8*)(sA + aoff + i * 1024 + sw);
      if (LB::kTr) {
#pragma unroll
        for (int j = 0; j < 4; ++j) {
          s16x4 lo = lds_tr_read(sB + troff[j][0] + ks * 4096);
          s16x4 hi = lds_tr_read(sB + troff[j][1] + ks * 4096);
          bfr[j] = __builtin_shufflevector(lo, hi, 0, 1, 2, 3, 4, 5, 6, 7);
        }
      } else {
#pragma unroll
        for (int j = 0; j < 4; ++j) bfr[j] = *(const bf16x8*)(sB + boff + j * 1024 + sw);
      }
      __builtin_amdgcn_s_setprio(1);
#pragma unroll
      for (int i = 0; i < 4; ++i)
#pragma unroll
        for (int j = 0; j < 4; ++j)
          acc[i][j] = __builtin_amdgcn_mfma_f32_16x16x32_bf16(bfr[j], af[i], acc[i][j], 0, 0, 0);
      __builtin_amdgcn_s_setprio(0);
    }
    if (more) {
      if (!LA::kDma) {
#pragma unroll
        for (int c = 0; c < 4; ++c) la.store(nA, c, ra[c]);
      }
      if (!LB::kDma) {
#pragma unroll
        for (int c = 0; c < 4; ++c) lb.store(nA + TILE, c, rb[c]);
      }
    }
    asm volatile("s_waitcnt vmcnt(0)" ::: "memory");
    __syncthreads();
  }
}

struct LdPerm {
  const u16* base; int g0, sst, lg;
  DEVFN unsigned rowoff(int r) const {
    int t = g0 - sst + r;
    int urow = ((t & ((1 << lg) - 1)) << 7) + (t >> lg);
    return (unsigned)(sst + urow) * D;
  }
};
#define GLDS16(gp, lp) __builtin_amdgcn_global_load_lds((const unsigned*)(gp), (unsigned*)(lp), 16, 0, 0)
DEVFN void zero_acc8(f32x4 (&acc)[8][4]) {
#pragma unroll
  for (int i = 0; i < 8; ++i)
#pragma unroll
    for (int j = 0; j < 4; ++j) acc[i][j] = f32x4{0.f, 0.f, 0.f, 0.f};
}
template <class LA, class LB>
DEVFN void gemm_core_b(int tid, f32x4 (&acc)[8][4], int nk, const LA& la, const LB& lb, u16* smem) {
  const int lane = tid & 63, w = tid >> 6, wm = w >> 1, wn = w & 1;
  const int lr = lane & 15, quad = lane >> 4;
  const int r0 = tid >> 2;
  const unsigned sw = (unsigned)(((tid & 3) ^ ((0 - (tid >> 4)) & 3)) << 3);
  const unsigned oa0 = la.rowoff(r0) + sw, oa1 = la.rowoff(r0 + 64) + sw, oa2 = la.rowoff(r0 + 128) + sw, oa3 = la.rowoff(r0 + 192) + sw;
  const unsigned ob0 = lb.rowoff(r0) + sw, ob1 = lb.rowoff(r0 + 64) + sw;
  const u16* ga = la.base; const u16* gb = lb.base;
  u16* l0 = smem + tid * 8;
#define ISSUE_STAGE(st, kt) do { u16* _s = l0 + (st) * 12288; unsigned _k = (unsigned)(kt) * 32u; \
    GLDS16(ga + (oa0 + _k), _s); GLDS16(ga + (oa1 + _k), _s + 2048); GLDS16(ga + (oa2 + _k), _s + 4096); GLDS16(ga + (oa3 + _k), _s + 6144); \
    GLDS16(gb + (ob0 + _k), _s + 8192); GLDS16(gb + (ob1 + _k), _s + 10240); } while (0)
  asm volatile("s_waitcnt vmcnt(0)" ::: "memory");
  ISSUE_STAGE(0, 0);
  ISSUE_STAGE(1, 1);
  const int fsw = (quad ^ ((0 - (lr >> 2)) & 3)) << 3;
  const int aoff = (wm * 128 + lr) * 32 + fsw, boff = 8192 + (wn * 64 + lr) * 32 + fsw;
  int cur = 0, nxt = 2;
  for (int kt = 0; kt < nk; ++kt) {
    if (kt + 1 < nk) asm volatile("s_waitcnt vmcnt(6)" ::: "memory");
    else asm volatile("s_waitcnt vmcnt(0)" ::: "memory");
    __builtin_amdgcn_s_barrier();
    asm volatile("" ::: "memory");
    if (kt + 2 < nk) ISSUE_STAGE(nxt, kt + 2);
    const u16* sb = smem + cur * 12288;
    bf16x8 af[8], bfr[4];
#pragma unroll
    for (int j = 0; j < 4; ++j) bfr[j] = *(const bf16x8*)(sb + boff + j * 512);
#pragma unroll
    for (int i = 0; i < 8; ++i) af[i] = *(const bf16x8*)(sb + aoff + i * 512);
    __builtin_amdgcn_s_setprio(1);
#pragma unroll
    for (int i = 0; i < 8; ++i)
#pragma unroll
      for (int j = 0; j < 4; ++j)
        acc[i][j] = __builtin_amdgcn_mfma_f32_16x16x32_bf16(bfr[j], af[i], acc[i][j], 0, 0, 0);
    __builtin_amdgcn_s_setprio(0);
    cur = cur == 2 ? 0 : cur + 1;
    nxt = nxt == 2 ? 0 : nxt + 1;
  }
  asm volatile("s_waitcnt lgkmcnt(0)" ::: "memory");
  __builtin_amdgcn_s_barrier();
  asm volatile("" ::: "memory");
#undef ISSUE_STAGE
}

DEVFN bool tile_xcd(int it, int ngrp, int ntn, int& mt, int& nt) {
  const int G = gridDim.x, b = blockIdx.x;
  if (G == 512) {
    if (it >= 5 * ngrp) return false;
    int xcd = b & 7, loc = b >> 3;
    mt = xcd * 40 + (it / ngrp) * 8 + (loc >> 3);
    nt = (it % ngrp) * 8 + (loc & 7);
    return true;
  }
  int tile = b + it * G;
  if (tile >= 320 * ntn) return false;
  mt = tile / ntn; nt = tile % ntn;
  return true;
}

DEVFN void transpose_tile(const float* src, long ld, u16* dst, long ldd, float* sT) {
  const int tid = otid();
#pragma unroll
  for (int pss = 0; pss < 4; ++pss) {
    int kk = (tid >> 4) + pss * 16, n4 = (tid & 15) * 4;
    float4 v = *(const float4*)(src + (long)kk * ld + n4);
    sT[kk * 65 + n4 + 0] = v.x; sT[kk * 65 + n4 + 1] = v.y; sT[kk * 65 + n4 + 2] = v.z; sT[kk * 65 + n4 + 3] = v.w;
  }
  __syncthreads();
  {
    int n = tid >> 2, k0 = (tid & 3) * 16;
    unsigned o[8];
#pragma unroll
    for (int e = 0; e < 8; ++e) o[e] = pack2(sT[(k0 + 2 * e) * 65 + n], sT[(k0 + 2 * e + 1) * 65 + n]);
    uint4* q = (uint4*)(dst + (long)n * ldd + k0);
    q[0] = make_uint4(o[0], o[1], o[2], o[3]);
    q[1] = make_uint4(o[4], o[5], o[6], o[7]);
  }
  __syncthreads();
}

DEVFN void phase_prologue(const Params& p, unsigned char* smem_raw) {
  const int tid = otid();
  constexpr int NJ_TR = 4352, NJ_MOD = 96, NJ_TAB = 256;
  for (int job = blockIdx.x; job < NJ_TR + NJ_MOD + NJ_TAB; job += gridDim.x) {
    if (job < NJ_TR) {
      float* sT = (float*)smem_raw;
      int l = job / 2176, r = job % 2176;
      u16* wl = WL(p, l);
      if (r < 1280) {
        int kt = r / 80, ntile = r % 80;
        int orow = ntile * 64;
        int scol;
        if (orow < 2048) scol = orow; else { orow += 2048; scol = orow - 1024; }
        transpose_tile(p.w_in + (long)l * D * D_IN + (long)(kt * 64) * D_IN + scol, D_IN,
                       wl + W_CAT + (long)orow * D + kt * 64, D, sT);
      } else if (r < 2048) {
        int r2 = r - 1280, which = r2 >> 8, t = r2 & 255, kt = t >> 4, ntile = t & 15;
        const float* src = (which == 0 ? p.w_a_out : which == 1 ? p.w_b_out : p.w_o) + (long)l * 1048576;
        long doff = which == 0 ? W_A : which == 1 ? W_B : W_O;
        transpose_tile(src + (long)(kt * 64) * D + ntile * 64, D, wl + doff + (long)(ntile * 64) * D + kt * 64, D, sT);
      } else {
        int r3 = r - 2048, mat = r3 >> 2, t = r3 & 3, kt = t >> 1, ntile = t & 1;
        const float* src = p.w_rg + ((long)l * 32 + mat) * 16384;
        transpose_tile(src + (long)(kt * 64) * 128 + ntile * 64, 128,
                       wl + W_RG + (long)mat * 16384 + (long)(ntile * 64) * 128 + kt * 64, 128, sT);
      }
    } else if (job < NJ_TR + NJ_MOD) {
      int jm = job - NJ_TR, l = jm / 48, cgp = jm % 48;
      float* sc = (float*)smem_raw;
      float* red = sc + 9 * 1024;
      for (int i = tid; i < 9 * 1024; i += 256) {
        int s = i >> 10, k = i & 1023;
        float cv = s == 0 ? p.c_prompt[k] : p.c_sample[(s - 1) * 1024 + k];
        sc[i] = silu(cv);
      }
      __syncthreads();
      int col = cgp * 64 + (tid & 63), kq = tid >> 6;
      float a0 = 0, a1 = 0, a2 = 0, a3 = 0, a4 = 0, a5 = 0, a6 = 0, a7 = 0, a8 = 0;
      const float* wp = p.w_ada + (long)l * D * 3072 + col;
#pragma unroll 4
      for (int k = kq * 256; k < kq * 256 + 256; ++k) {
        float wv = wp[(long)k * 3072];
        a0 += sc[0 * 1024 + k] * wv; a1 += sc[1 * 1024 + k] * wv; a2 += sc[2 * 1024 + k] * wv;
        a3 += sc[3 * 1024 + k] * wv; a4 += sc[4 * 1024 + k] * wv; a5 += sc[5 * 1024 + k] * wv;
        a6 += sc[6 * 1024 + k] * wv; a7 += sc[7 * 1024 + k] * wv; a8 += sc[8 * 1024 + k] * wv;
      }
      float* rq = red + kq * 9 * 64 + (tid & 63);
      rq[0 * 64] = a0; rq[1 * 64] = a1; rq[2 * 64] = a2; rq[3 * 64] = a3; rq[4 * 64] = a4;
      rq[5 * 64] = a5; rq[6 * 64] = a6; rq[7 * 64] = a7; rq[8 * 64] = a8;
      __syncthreads();
      for (int i = tid; i < 9 * 64; i += 256) {
        int s = i >> 6, cc = i & 63;
        float v = red[0 * 576 + i] + red[1 * 576 + i] + red[2 * 576 + i] + red[3 * 576 + i];
        int cf = cgp * 64 + cc;
        MOD(p)[((long)l * 9 + s) * 3072 + cf] = v + p.b_ada[l * 3072 + cf];
      }
      __syncthreads();
    } else {
      int jt = job - NJ_TR - NJ_MOD;
      u16* tab = TAB(p);
#pragma unroll
      for (int e4 = 0; e4 < 4; ++e4) {
        int e = jt * 1024 + e4 * 256 + tid;
        if (e < 65536) {
          int m = e >> 8, k = e & 255;
          int k1 = (m >> 5) * 16 + (m & 15), ro = (m >> 4) & 1, ri = k >> 7, s1 = k & 127;
          float x = 2.f * (float)((k1 * s1) & 127) / 128.f;
          float cs = cospif(x), sn = sinpif(x);
          float v = (ro == ri) ? cs : (ro == 0 ? sn : -sn);
          tab[T_D1A + e] = f2bf(v);
        } else if (e < 65536 + 16384) {
          int e2 = e - 65536;
          int m = e2 >> 7, k = e2 & 127;
          int k1 = (m >> 5) * 16 + (m & 15), ro = (m >> 4) & 1, ri = k >> 6, s1 = k & 63;
          float x = 2.f * (float)((k1 * s1) & 63) / 64.f;
          float cs = cospif(x), sn = sinpif(x);
          float v = (ro == ri) ? cs : (ro == 0 ? sn : -sn);
          tab[T_D1B + e2] = f2bf(v);
        } else if (e < 65536 + 16384 + 32768) {
          int e2 = e - 65536 - 16384;
          int k2 = e2 >> 8, k = e2 & 255, ri = k >> 7, s2 = k & 127;
          float x = 2.f * (float)((k2 * s2) & 127) / 128.f;
          float v = ri == 0 ? cospif(x) : sinpif(x);
          tab[T_D2 + e2] = f2bf(v);
        } else if (e < 65536 + 16384 + 32768 + 131072) {
          int e2 = e - 65536 - 16384 - 32768;
          int row = e2 >> 8, c = e2 & 255, ri = row >> 8, m = row & 255;
          float x = 2.f * (float)((m * c) & 255) / 256.f;
          float v = ri == 0 ? cospif(x) : -sinpif(x);
          tab[T_DC + e2] = f2bf(v);
        } else {
          int e2 = e - (65536 + 16384 + 32768 + 131072);
          if (e2 < 16384) {
            float x = 2.f * (float)e2 / 16384.f;
            TW(p)[e2] = make_float2(cospif(x), sinpif(x));
          }
        }
      }
    }
  }
}

DEVFN void phase_fold(const Params& p, u16* smem) {
  for (int tile = blockIdx.x; tile < 256; tile += gridDim.x) {
    const int tid = otid(), lane = tid & 63, w = tid >> 6, wm = w >> 1, wn = w & 1, lr = lane & 15, quad = lane >> 4;
    int l = tile >> 7, g = (tile >> 5) & 3, mt = (tile >> 3) & 3, nt = tile & 7;
    LdPlain la; la.init(tid, TAB(p) + T_DC, mt * 128, 256);
    LdF32 lb; lb.init(tid, p.w_in + (long)l * D * D_IN, nt * 128, D_IN, 2048 + g * 256);
    f32x4 acc[4][4]; zero_acc(acc);
    gemm_core(tid, acc, 4, la, lb, smem);
    int ri = mt >> 1;
    u16* wc = WL(p, l) + W_CAT;
#pragma unroll
    for (int i = 0; i < 4; ++i) {
      int mrow = (mt & 1) * 128 + wm * 64 + i * 16 + lr;
      unsigned orow = 2048 + ri * 1024 + g * 256 + mrow;
#pragma unroll
      for (int j = 0; j < 4; ++j) {
        int n = nt * 128 + wn * 64 + j * 16 + quad * 4;
        uint2 o; o.x = pack2(acc[i][j][0], acc[i][j][1]); o.y = pack2(acc[i][j][2], acc[i][j][3]);
        *(uint2*)(wc + orow * D + n) = o;
      }
    }
  }
}

DEVFN void phase_h(const Params& p, int l) {
  const int lane = threadIdx.x & 63;
  const int wid = blockIdx.x * 4 + (threadIdx.x >> 6), nw = gridDim.x * 4;
  const float* ng = p.norm_g + l * D;
  const float* modl = MOD(p) + (long)l * 9 * 3072;
  u16* H = U(p, 0);
  for (int g = wid; g < T_TOT; g += nw) {
    const float* xb = (l == 0) ? (g < 16384 ? p.x_prompt : p.x_sample) : p.out;
    const unsigned xo = (unsigned)((l == 0 && g >= 16384) ? g - 16384 : g) * D;
    const float* xr = xb + xo;
    const float* md = modl + seq_of(g) * 3072;
    float4 v[4];
    float ss = 0.f;
#pragma unroll
    for (int i = 0; i < 4; ++i) {
      v[i] = *(const float4*)(xr + i * 256 + lane * 4);
      ss += v[i].x * v[i].x + v[i].y * v[i].y + v[i].z * v[i].z + v[i].w * v[i].w;
    }
#pragma unroll
    for (int o = 32; o >= 1; o >>= 1) ss += __shfl_xor(ss, o, 64);
    float rstd = rsqrtf(ss * (1.f / 1024.f) + 1e-6f);
#pragma unroll
    for (int i = 0; i < 4; ++i) {
      int c = i * 256 + lane * 4;
      float4 g4 = *(const float4*)(ng + c);
      float4 sh = *(const float4*)(md + c);
      float4 sc = *(const float4*)(md + 1024 + c);
      float h0 = v[i].x * rstd * g4.x * (1.f + sc.x) + sh.x;
      float h1 = v[i].y * rstd * g4.y * (1.f + sc.y) + sh.y;
      float h2 = v[i].z * rstd * g4.z * (1.f + sc.z) + sh.z;
      float h3 = v[i].w * rstd * g4.w * (1.f + sc.w) + sh.w;
      uint2 o; o.x = pack2(h0, h1); o.y = pack2(h2, h3);
      *(uint2*)(H + ((unsigned)g * D + c)) = o;
    }
  }
}

DEVFN void phase_final(const Params& p) {
  const int lane = threadIdx.x & 63;
  const int wid = blockIdx.x * 4 + (threadIdx.x >> 6), nw = gridDim.x * 4;
  for (int g = wid; g < T_TOT; g += nw) {
    float* xr = p.out + (unsigned)g * D;
    float4 v[4];
    float ss = 0.f;
#pragma unroll
    for (int i = 0; i < 4; ++i) {
      v[i] = *(const float4*)(xr + i * 256 + lane * 4);
      ss += v[i].x * v[i].x + v[i].y * v[i].y + v[i].z * v[i].z + v[i].w * v[i].w;
    }
#pragma unroll
    for (int o = 32; o >= 1; o >>= 1) ss += __shfl_xor(ss, o, 64);
    float rstd = rsqrtf(ss * (1.f / 1024.f) + 1e-6f);
#pragma unroll
    for (int i = 0; i < 4; ++i) {
      int c = i * 256 + lane * 4;
      float4 g4 = *(const float4*)(p.final_g + c);
      float4 o;
      o.x = v[i].x * rstd * g4.x; o.y = v[i].y * rstd * g4.y; o.z = v[i].z * rstd * g4.z; o.w = v[i].w * rstd * g4.w;
      *(float4*)(xr + c) = o;
    }
  }
}

DEVFN void phase_gemm1(const Params& p, int l, u16* smem) {
  const u16* H = U(p, 0);
  const u16* W = WL(p, l) + W_CAT;
  for (int it = 0;; ++it) {
    int mt, nt;
    if (!tile_xcd(it, 5, 40, mt, nt)) break;
    const int tid = otid(), lane = tid & 63, w = tid >> 6, wm = w >> 1, wn = w & 1, lr = lane & 15, quad = lane >> 4;
    LdPlain la; la.init(tid, H, mt * 256, D);
    LdPlain lb; lb.init(tid, W, nt * 128, D);
    f32x4 acc[8][4]; zero_acc8(acc);
    gemm_core_b(tid, acc, 32, la, lb, smem);
    int unit = nt >> 3, col0 = (nt & 7) * 128;
    u16* outp = U(p, 1 + unit);
    bool act = (unit == 1) || (unit == 4);
#pragma unroll
    for (int i = 0; i < 8; ++i) {
      unsigned g = mt * 256 + wm * 128 + i * 16 + lr;
#pragma unroll
      for (int j = 0; j < 4; ++j) {
        unsigned c = col0 + wn * 64 + j * 16 + quad * 4;
        float v0 = acc[i][j][0], v1 = acc[i][j][1], v2 = acc[i][j][2], v3 = acc[i][j][3];
        if (act) { v0 = silu(v0); v1 = silu(v1); v2 = silu(v2); v3 = silu(v3); }
        uint2 o; o.x = pack2(v0, v1); o.y = pack2(v2, v3);
        *(uint2*)(outp + g * D + c) = o;
      }
    }
  }
}

struct TokF1 {
  const u16* zr; const u16* zi; int n1; unsigned off;
  DEVFN unsigned operator()(int k, const u16*& b) const {
    int ri = k >= n1 ? 1 : 0;
    int s1 = k - ri * n1;
    b = ri ? zi : zr;
    return off + (unsigned)(s1 * 128) * D;
  }
};
DEVFN void f1_twiddle(int tid, const Params& p, const f32x4 (&acc)[4][4], int hf, int s2, int smask, int twmul,
                      uint2 (&o1)[2][4], uint2 (&o2)[2][4]) {
  const int lane = tid & 63, w = tid >> 6, wm = w >> 1, lr = lane & 15;
  const float2* tw = TW(p);
#pragma unroll
  for (int b = 0; b < 2; ++b) {
    int k1 = (hf * 4 + wm * 2 + b) * 16 + lr;
    float2 t = tw[((k1 * s2) & smask) * twmul];
#pragma unroll
    for (int j = 0; j < 4; ++j) {
      f32x4 orr = acc[2 * b][j], oii = acc[2 * b + 1][j];
      o1[b][j].x = pack2(orr[0] * t.x + oii[0] * t.y, orr[1] * t.x + oii[1] * t.y);
      o1[b][j].y = pack2(orr[2] * t.x + oii[2] * t.y, orr[3] * t.x + oii[3] * t.y);
      o2[b][j].x = pack2(oii[0] * t.x - orr[0] * t.y, oii[1] * t.x - orr[1] * t.y);
      o2[b][j].y = pack2(oii[2] * t.x - orr[2] * t.y, oii[3] * t.x - orr[3] * t.y);
    }
  }
}
DEVFN void f1_write(int tid, int hf, unsigned off, const uint2 (&o1)[2][4], const uint2 (&o2)[2][4], u16* zr, u16* zi) {
  const int lane = tid & 63, w = tid >> 6, wm = w >> 1, wn = w & 1, lr = lane & 15, quad = lane >> 4;
#pragma unroll
  for (int b = 0; b < 2; ++b) {
    unsigned k1 = (hf * 4 + wm * 2 + b) * 16 + lr;
    unsigned rowoff = off + (k1 * 128) * D + wn * 64 + quad * 4;
#pragma unroll
    for (int j = 0; j < 4; ++j) {
      *(uint2*)(zr + (rowoff + j * 16)) = o1[b][j];
      *(uint2*)(zi + (rowoff + j * 16)) = o2[b][j];
    }
  }
}
DEVFN void phase_fft1(const Params& p, u16* smem) {
  u16* zr = U(p, 3);
  u16* zi = U(p, 4);
  for (int tile = blockIdx.x; tile < 9216; tile += gridDim.x) {
    const int tid = otid();
    int seq, s2, ct, n1;
    if (tile < 1024) { seq = 0; s2 = tile >> 3; ct = tile & 7; n1 = 128; }
    else { int t2 = tile - 1024; seq = 1 + (t2 >> 10); s2 = (t2 >> 3) & 127; ct = t2 & 7; n1 = 64; }
    const unsigned off = (unsigned)(seq_start(seq) + s2) * D + ct * 128;
    LdTrans<TokF1> lb; lb.t_ = tid; lb.tok.zr = zr; lb.tok.zi = zi; lb.tok.n1 = n1; lb.tok.off = off;
    const int K = 2 * n1, nk = K >> 6;
    const u16* tab = TAB(p) + (seq == 0 ? T_D1A : T_D1B);
    const int smask = seq == 0 ? 16383 : 8191, twmul = seq == 0 ? 1 : 2;
    uint2 a1[2][4], a2[2][4];
    {
      f32x4 acc[4][4]; zero_acc(acc);
      LdPlain la; la.init(tid, tab, 0, K); gemm_core(tid, acc, nk, la, lb, smem);
      f1_twiddle(tid, p, acc, 0, s2, smask, twmul, a1, a2);
    }
    if (seq == 0) {
      uint2 b1[2][4], b2[2][4];
      {
        f32x4 acc[4][4]; zero_acc(acc);
        LdPlain la; la.init(tid, tab, 128, K); gemm_core(tid, acc, nk, la, lb, smem);
        f1_twiddle(tid, p, acc, 1, s2, smask, twmul, b1, b2);
      }
      f1_write(tid, 1, off, b1, b2, zr, zi);
    }
    f1_write(tid, 0, off, a1, a2, zr, zi);
  }
}

struct TokF2 {
  const u16* zr; const u16* zi; unsigned off;
  DEVFN unsigned operator()(int k, const u16*& b) const {
    int ri = k >> 7, s2 = k & 127;
    b = ri ? zi : zr;
    return off + (unsigned)s2 * D;
  }
};
DEVFN void phase_fft2(const Params& p, u16* smem) {
  u16* zr = U(p, 3);
  const u16* gbp = U(p, 5);
  for (int tile = blockIdx.x; tile < 5120; tile += gridDim.x) {
    const int tid = otid(), lane = tid & 63, w = tid >> 6, wm = w >> 1, wn = w & 1, lr = lane & 15, quad = lane >> 4;
    int seq, k1, ct, n1;
    if (tile < 1024) { seq = 0; k1 = tile >> 3; ct = tile & 7; n1 = 128; }
    else { int t2 = tile - 1024; seq = 1 + (t2 >> 9); k1 = (t2 >> 3) & 63; ct = t2 & 7; n1 = 64; }
    const int sst = seq_start(seq);
    const unsigned off = (unsigned)(sst + k1 * 128) * D + ct * 128;
    LdTrans<TokF2> lb; lb.t_ = tid; lb.tok.zr = zr; lb.tok.zi = U(p, 4); lb.tok.off = off;
    LdPlain la; la.init(tid, TAB(p) + T_D2, 0, 256);
    f32x4 acc[4][4]; zero_acc(acc);
    gemm_core(tid, acc, 4, la, lb, smem);
    const float nrm = seq == 0 ? (1.f / 2048.f) : 6.9053396600248786e-4f;
#pragma unroll
    for (int i = 0; i < 4; ++i) {
      unsigned k2 = wm * 64 + i * 16 + lr;
      unsigned goff = (unsigned)(sst + k1 + n1 * k2) * D + ct * 128;
#pragma unroll
      for (int j = 0; j < 4; ++j) {
        unsigned cl = wn * 64 + j * 16 + quad * 4;
        uint2 gv = *(const uint2*)(gbp + (goff + cl));
        uint2 o;
        o.x = pack2(acc[i][j][0] * nrm * lo2f(gv.x), acc[i][j][1] * nrm * hi2f(gv.x));
        o.y = pack2(acc[i][j][2] * nrm * lo2f(gv.y), acc[i][j][3] * nrm * hi2f(gv.y));
        *(uint2*)(zr + (off + k2 * D + cl)) = o;
      }
    }
  }
}

constexpr int SA_LD = 128;
template <int PASS>
DEVFN void phase_scan(const Params& p, int l, int dirsel, unsigned char* smem_raw) {
  float* sAf = (float*)smem_raw;
  u16* sBh = (u16*)(smem_raw + 32768);
  u16* sXc = (u16*)(smem_raw + 32768 + 16384);
  const int tid = otid(), lane = tid & 63, w = tid >> 6, lr = lane & 15, quad = lane >> 4;
  const int head = blockIdx.x & 7;
  const int dir = PASS == 1 ? ((blockIdx.x >> 3) & 1) : dirsel;
  const int tstart = PASS == 1 ? (blockIdx.x >> 4) : (blockIdx.x >> 3);
  const int tstep = PASS == 1 ? (gridDim.x >> 4) : (gridDim.x >> 3);
  const u16* xa = U(p, 1);
  u16* ga = U(p, 2);
  u16* hf = U(p, 5);
  float2* agg = (float2*)U(p, 4);
  float* carry = (float*)(agg + 1280L * 2 * 1024);
  bf16x8 bw[4][4];
  {
    const u16* wrg = WL(p, l) + W_RG;
#pragma unroll
    for (int jt = 0; jt < 4; ++jt) {
      int q = jt >> 1, col = w * 32 + (jt & 1) * 16 + lr;
      const u16* bp = wrg + (unsigned)((((dir * 2 + q) * 8 + head) * 128 + col) * 128 + quad * 8);
#pragma unroll
      for (int ks = 0; ks < 4; ++ks) bw[jt][ks] = *(const bf16x8*)(bp + ks * 32);
    }
  }
  float spl[2], brr[2], bii[2];
#pragma unroll
  for (int jc = 0; jc < 2; ++jc) {
    int cgl = head * 128 + w * 32 + jc * 16 + lr;
    float lm = p.lam[(l * 2 + dir) * D + cgl];
    spl[jc] = -8.f * 1.4426950408889634f * log1pf(expf(-lm));
    brr[jc] = -1.4426950408889634f * p.b_rg[((l * 2 + dir) * 2 + 0) * D + cgl];
    bii[jc] = -1.4426950408889634f * p.b_rg[((l * 2 + dir) * 2 + 1) * D + cgl];
  }
  const int c8 = tid & 15, tg = tid >> 4;
  float* sCw = (float*)(smem_raw + 65536);
  for (int i = tid; i < 640; i += 256) {
    int k = i >> 7, c = i & 127;
    sCw[i] = k < 4 ? p.conv_w[(l * 4 + k) * D + head * 128 + c] : p.conv_b[l * D + head * 128 + c];
  }
  __syncthreads();
  uint4 xr[7];
#define LOAD_XROWS(TT) do { const int _g0 = (TT) * 64; const int _sq = seq_of(_g0), _ss = seq_start(_sq), _se = _ss + seq_len(_sq); \
    _Pragma("unroll") for (int r = 0; r < 7; ++r) { int _g = _g0 + tg * 4 - 2 + r; xr[r] = make_uint4(0, 0, 0, 0); \
      if (_g >= _ss && _g < _se) xr[r] = *(const uint4*)(xa + ((unsigned)_g * D + head * 128 + c8 * 8)); } } while (0)
  if (tstart < 1280) LOAD_XROWS(tstart);
  for (int tt = tstart; tt < 1280; tt += tstep) {
    const int g0 = tt * 64;
    const int seq = seq_of(g0), sst = seq_start(seq), send = sst + seq_len(seq);
#pragma unroll
    for (int j = 0; j < 4; ++j) {
      float o[8];
      {
        float4 b0 = *(const float4*)(sCw + 512 + c8 * 8), b1 = *(const float4*)(sCw + 512 + c8 * 8 + 4);
        o[0] = b0.x; o[1] = b0.y; o[2] = b0.z; o[3] = b0.w; o[4] = b1.x; o[5] = b1.y; o[6] = b1.z; o[7] = b1.w;
      }
#pragma unroll
      for (int k = 0; k < 4; ++k) {
        uint4 v = xr[j + k];
        float4 w0 = *(const float4*)(sCw + k * 128 + c8 * 8), w1 = *(const float4*)(sCw + k * 128 + c8 * 8 + 4);
        o[0] += w0.x * lo2f(v.x); o[1] += w0.y * hi2f(v.x);
        o[2] += w0.z * lo2f(v.y); o[3] += w0.w * hi2f(v.y);
        o[4] += w1.x * lo2f(v.z); o[5] += w1.y * hi2f(v.z);
        o[6] += w1.z * lo2f(v.w); o[7] += w1.w * hi2f(v.w);
      }
      uint4 q0;
      q0.x = pack2(o[0], o[1]); q0.y = pack2(o[2], o[3]); q0.z = pack2(o[4], o[5]); q0.w = pack2(o[6], o[7]);
      const int tl = tg * 4 + j;
      *(uint4*)(sXc + tl * 128 + ((c8 ^ (tl & 7)) << 3)) = q0;
    }
    __syncthreads();
    if (tt + tstep < 1280) LOAD_XROWS(tt + tstep);
    const int gstart = dir == 0 ? sst : send - 1;
#pragma unroll 1
    for (int hv = 0; hv < 2; ++hv) {
      f32x4 acc[2][4];
#pragma unroll
      for (int it = 0; it < 2; ++it)
#pragma unroll
        for (int jt = 0; jt < 4; ++jt) acc[it][jt] = f32x4{0.f, 0.f, 0.f, 0.f};
#pragma unroll
      for (int ks = 0; ks < 4; ++ks) {
#pragma unroll
        for (int it = 0; it < 2; ++it) {
          bf16x8 af = *(const bf16x8*)(sXc + ((hv * 2 + it) * 16 + lr) * 128 + (((ks * 4 + quad) ^ (lr & 7)) << 3));
#pragma unroll
          for (int jt = 0; jt < 4; ++jt)
            acc[it][jt] = __builtin_amdgcn_mfma_f32_16x16x32_bf16(af, bw[jt][ks], acc[it][jt], 0, 0, 0);
        }
      }
#pragma unroll
      for (int it = 0; it < 2; ++it)
#pragma unroll
        for (int jc = 0; jc < 2; ++jc) {
#pragma unroll
          for (int r = 0; r < 4; ++r) {
            int tl = (hv * 2 + it) * 16 + quad * 4 + r, c = w * 32 + jc * 16 + lr;
            float er = 1.f + __builtin_amdgcn_exp2f(fminf(fmaf(acc[it][jc][r], -1.4426950408889634f, brr[jc]), 60.f));
            float ei = 1.f + __builtin_amdgcn_exp2f(fminf(fmaf(acc[it][2 + jc][r], -1.4426950408889634f, bii[jc]), 60.f));
            float q = __builtin_amdgcn_rcpf(er * ei);
            float rr = q * ei, ii = q * er;
            float a = __builtin_amdgcn_exp2f(rr * spl[jc]);
            float mult = __builtin_amdgcn_sqrtf((1.f - a) * (1.f + a));
            if (g0 + tl == gstart) mult = 1.f;
            float xv = bf2f(sXc[tl * 128 + (((c >> 3) ^ (tl & 7)) << 3) + (c & 7)]);
            sAf[tl * SA_LD + c] = a;
            sBh[tl * 128 + c] = f2bf(mult * ii * xv);
          }
        }
    }
    __syncthreads();
    if (tid < 128) {
      const int c = tid;
      const unsigned aidx = (unsigned)(tt * 2 + dir) * 1024 + head * 128 + c;
      const float* ap = sAf + c;
      u16* bp = sBh + c;
      if (PASS == 1) {
        float h = 0.f, P = 1.f;
        if (dir == 0) {
#pragma unroll 16
          for (int st = 0; st < 64; ++st) { float a = ap[st * SA_LD]; h = a * h + bf2f(bp[st * 128]); P *= a; }
        } else {
#pragma unroll 16
          for (int st = 63; st >= 0; --st) { float a = ap[st * SA_LD]; h = a * h + bf2f(bp[st * 128]); P *= a; }
        }
        agg[aidx] = make_float2(P, h);
      } else {
        float h = carry[aidx];
        if (dir == 0) {
#pragma unroll 16
          for (int st = 0; st < 64; ++st) { h = ap[st * SA_LD] * h + bf2f(bp[st * 128]); bp[st * 128] = f2bf(h); }
        } else {
#pragma unroll 16
          for (int st = 63; st >= 0; --st) { h = ap[st * SA_LD] * h + bf2f(bp[st * 128]); bp[st * 128] = f2bf(h); }
        }
      }
    }
    if (PASS == 3) {
      __syncthreads();
#pragma unroll
      for (int cch = 0; cch < 4; ++cch) {
        int chunk = tid + cch * 256;
        int t = chunk >> 4, cc = (chunk & 15) * 8;
        unsigned off = (unsigned)(g0 + t) * D + head * 128 + cc;
        uint4 hv = *(const uint4*)(sBh + t * 128 + cc);
        if (dir == 0) {
          *(uint4*)(hf + off) = hv;
        } else {
          uint4 fv = *(const uint4*)(hf + off);
          uint4 gv = *(const uint4*)(ga + off);
          uint4 o;
          o.x = pack2((lo2f(fv.x) + lo2f(hv.x)) * lo2f(gv.x), (hi2f(fv.x) + hi2f(hv.x)) * hi2f(gv.x));
          o.y = pack2((lo2f(fv.y) + lo2f(hv.y)) * lo2f(gv.y), (hi2f(fv.y) + hi2f(hv.y)) * hi2f(gv.y));
          o.z = pack2((lo2f(fv.z) + lo2f(hv.z)) * lo2f(gv.z), (hi2f(fv.z) + hi2f(hv.z)) * hi2f(gv.z));
          o.w = pack2((lo2f(fv.w) + lo2f(hv.w)) * lo2f(gv.w), (hi2f(fv.w) + hi2f(hv.w)) * hi2f(gv.w));
          *(uint4*)(ga + off) = o;
        }
      }
    }
    __syncthreads();
  }
#undef LOAD_XROWS
}

DEVFN void lb_st64(unsigned long long* q, unsigned long long v) { __hip_atomic_store(q, v, __ATOMIC_RELAXED, __HIP_MEMORY_SCOPE_AGENT); }
DEVFN unsigned long long lb_ld64(const unsigned long long* q) { return __hip_atomic_load(q, __ATOMIC_RELAXED, __HIP_MEMORY_SCOPE_AGENT); }
DEVFN void lb_st32(unsigned* q, unsigned v) { __hip_atomic_store(q, v, __ATOMIC_RELAXED, __HIP_MEMORY_SCOPE_AGENT); }
DEVFN unsigned lb_ld32(const unsigned* q) { return __hip_atomic_load(q, __ATOMIC_RELAXED, __HIP_MEMORY_SCOPE_AGENT); }
DEVFN unsigned long long lb_pack(float a, float b) { return (unsigned long long)__float_as_uint(a) | ((unsigned long long)__float_as_uint(b) << 32); }
DEVFN int lb_rank(int seq, int pos) { return seq == 0 ? (pos >> 1) * 10 + ((pos & 1) ? 9 : 0) : pos * 10 + seq; }
DEVFN void lb_decode(int r, int dir, int& seq, int& pos, int& tt) {
  int pair = r / 10, j = r - pair * 10;
  if (j == 0) { seq = 0; pos = 2 * pair; } else if (j == 9) { seq = 0; pos = 2 * pair + 1; } else { seq = j; pos = pair; }
  int len = seq == 0 ? 256 : 128;
  tt = (seq_start(seq) >> 6) + (dir ? len - 1 - pos : pos);
}
DEVFN void phase_scan_lb(const Params& p, int l, unsigned char* smem_raw) {
  float* sAf = (float*)smem_raw;
  u16* sBh = (u16*)(smem_raw + 32768);
  u16* sXc = (u16*)(smem_raw + 32768 + 16384);
  unsigned* sflag = (unsigned*)(smem_raw + 65536 + 2560);
  const int tid = otid(), lane = tid & 63, w = tid >> 6, lr = lane & 15, quad = lane >> 4;
  const int hd = blockIdx.x & 15, head = hd >> 1, dir = hd & 1;
  const int rstart = blockIdx.x >> 4, rstep = gridDim.x >> 4;
  const u16* xa = U(p, 1);
  u16* ga = U(p, 2);
  u16* hown = dir == 0 ? U(p, 5) : U(p, 4);
  const u16* hoth = dir == 0 ? U(p, 4) : U(p, 5);
  unsigned long long* slot = (unsigned long long*)(p.ws + OFF_LB_BYTES);
  unsigned* stat = (unsigned*)(p.ws + OFF_LB_BYTES + LB_SLOT_BYTES);
  unsigned* cnt = stat + 20480;
  const unsigned ep = 2u * (unsigned)l;
  bf16x8 bw[4][4];
  {
    const u16* wrg = WL(p, l) + W_RG;
#pragma unroll
    for (int jt = 0; jt < 4; ++jt) {
      int q = jt >> 1, col = w * 32 + (jt & 1) * 16 + lr;
      const u16* bp = wrg + (unsigned)((((dir * 2 + q) * 8 + head) * 128 + col) * 128 + quad * 8);
#pragma unroll
      for (int ks = 0; ks < 4; ++ks) bw[jt][ks] = *(const bf16x8*)(bp + ks * 32);
    }
  }
  float spl[2], brr[2], bii[2];
#pragma unroll
  for (int jc = 0; jc < 2; ++jc) {
    int cgl = head * 128 + w * 32 + jc * 16 + lr;
    float lm = p.lam[(l * 2 + dir) * D + cgl];
    spl[jc] = -8.f * 1.4426950408889634f * log1pf(expf(-lm));
    brr[jc] = -1.4426950408889634f * p.b_rg[((l * 2 + dir) * 2 + 0) * D + cgl];
    bii[jc] = -1.4426950408889634f * p.b_rg[((l * 2 + dir) * 2 + 1) * D + cgl];
  }
  const int c8 = tid & 15, tg = tid >> 4;
  float* sCw = (float*)(smem_raw + 65536);
  for (int i = tid; i < 640; i += 256) {
    int k = i >> 7, c = i & 127;
    sCw[i] = k < 4 ? p.conv_w[(l * 4 + k) * D + head * 128 + c] : p.conv_b[l * D + head * 128 + c];
  }
  __syncthreads();
  uint4 xr[7];
#define LOAD_XROWS(TT) do { const int _g0 = (TT) * 64; const int _sq = seq_of(_g0), _ss = seq_start(_sq), _se = _ss + seq_len(_sq); \
    _Pragma("unroll") for (int r_ = 0; r_ < 7; ++r_) { int _g = _g0 + tg * 4 - 2 + r_; xr[r_] = make_uint4(0, 0, 0, 0); \
      if (_g >= _ss && _g < _se) xr[r_] = *(const uint4*)(xa + ((unsigned)_g * D + head * 128 + c8 * 8)); } } while (0)
  if (rstart < 1280) { int sq_, ps_, t0_; lb_decode(rstart, dir, sq_, ps_, t0_); LOAD_XROWS(t0_); }
  for (int r = rstart; r < 1280; r += rstep) {
    int seq, pos, tt;
    lb_decode(r, dir, seq, pos, tt);
    const int item = r * 16 + hd;
    const int g0 = tt * 64;
    const int sst = seq_start(seq), send = sst + seq_len(seq);
#pragma unroll
    for (int j = 0; j < 4; ++j) {
      float o[8];
      {
        float4 b0 = *(const float4*)(sCw + 512 + c8 * 8), b1 = *(const float4*)(sCw + 512 + c8 * 8 + 4);
        o[0] = b0.x; o[1] = b0.y; o[2] = b0.z; o[3] = b0.w; o[4] = b1.x; o[5] = b1.y; o[6] = b1.z; o[7] = b1.w;
      }
#pragma unroll
      for (int k = 0; k < 4; ++k) {
        uint4 v = xr[j + k];
        float4 w0 = *(const float4*)(sCw + k * 128 + c8 * 8), w1 = *(const float4*)(sCw + k * 128 + c8 * 8 + 4);
        o[0] += w0.x * lo2f(v.x); o[1] += w0.y * hi2f(v.x);
        o[2] += w0.z * lo2f(v.y); o[3] += w0.w * hi2f(v.y);
        o[4] += w1.x * lo2f(v.z); o[5] += w1.y * hi2f(v.z);
        o[6] += w1.z * lo2f(v.w); o[7] += w1.w * hi2f(v.w);
      }
      uint4 q0;
      q0.x = pack2(o[0], o[1]); q0.y = pack2(o[2], o[3]); q0.z = pack2(o[4], o[5]); q0.w = pack2(o[6], o[7]);
      const int tl = tg * 4 + j;
      *(uint4*)(sXc + tl * 128 + ((c8 ^ (tl & 7)) << 3)) = q0;
    }
    __syncthreads();
    if (r + rstep < 1280) { int sq_, ps_, t1_; lb_decode(r + rstep, dir, sq_, ps_, t1_); LOAD_XROWS(t1_); }
    const int gstart = dir == 0 ? sst : send - 1;
#pragma unroll 1
    for (int hv = 0; hv < 2; ++hv) {
      f32x4 acc[2][4];
#pragma unroll
      for (int it = 0; it < 2; ++it)
#pragma unroll
        for (int jt = 0; jt < 4; ++jt) acc[it][jt] = f32x4{0.f, 0.f, 0.f, 0.f};
#pragma unroll
      for (int ks = 0; ks < 4; ++ks) {
#pragma unroll
        for (int it = 0; it < 2; ++it) {
          bf16x8 af = *(const bf16x8*)(sXc + ((hv * 2 + it) * 16 + lr) * 128 + (((ks * 4 + quad) ^ (lr & 7)) << 3));
#pragma unroll
          for (int jt = 0; jt < 4; ++jt)
            acc[it][jt] = __builtin_amdgcn_mfma_f32_16x16x32_bf16(af, bw[jt][ks], acc[it][jt], 0, 0, 0);
        }
      }
#pragma unroll
      for (int it = 0; it < 2; ++it)
#pragma unroll
        for (int jc = 0; jc < 2; ++jc) {
#pragma unroll
          for (int r = 0; r < 4; ++r) {
            int tl = (hv * 2 + it) * 16 + quad * 4 + r, c = w * 32 + jc * 16 + lr;
            float er = 1.f + __builtin_amdgcn_exp2f(fminf(fmaf(acc[it][jc][r], -1.4426950408889634f, brr[jc]), 60.f));
            float ei = 1.f + __builtin_amdgcn_exp2f(fminf(fmaf(acc[it][2 + jc][r], -1.4426950408889634f, bii[jc]), 60.f));
            float q = __builtin_amdgcn_rcpf(er * ei);
            float rr = q * ei, ii = q * er;
            float a = __builtin_amdgcn_exp2f(rr * spl[jc]);
            float mult = __builtin_amdgcn_sqrtf((1.f - a) * (1.f + a));
            if (g0 + tl == gstart) mult = 1.f;
            float xv = bf2f(sXc[tl * 128 + (((c >> 3) ^ (tl & 7)) << 3) + (c & 7)]);
            sAf[tl * SA_LD + c] = a;
            sBh[tl * 128 + c] = f2bf(mult * ii * xv);
          }
        }
    }
    __syncthreads();
    float aggP = 1.f, aggH = 0.f;
    if (tid < 128) {
      const float* ap = sAf + tid;
      const u16* bp = sBh + tid;
      if (dir == 0) {
#pragma unroll 16
        for (int st = 0; st < 64; ++st) { float a = ap[st * SA_LD]; aggH = a * aggH + bf2f(bp[st * 128]); aggP *= a; }
      } else {
#pragma unroll 16
        for (int st = 63; st >= 0; --st) { float a = ap[st * SA_LD]; aggH = a * aggH + bf2f(bp[st * 128]); aggP *= a; }
      }
      lb_st64(slot + (unsigned)item * 128 + tid, lb_pack(pos == 0 ? 0.f : aggP, aggH));
    }
    asm volatile("s_waitcnt vmcnt(0)" ::: "memory");
    __syncthreads();
    if (tid == 0) lb_st32(stat + item, ep + (pos == 0 ? 2u : 1u));
    float carry = 0.f;
    if (pos > 0) {
      if (tid < 128) {
        float Pr = 1.f, Hr = 0.f;
        int pj = pos - 1;
        for (;;) {
          const int j = lb_rank(seq, pj) * 16 + hd;
          unsigned sv, spins = 0;
          while ((sv = lb_ld32(stat + j)) < ep + 1u) { __builtin_amdgcn_s_sleep(1); if (++spins > (1u << 18)) break; }
          unsigned long long v = lb_ld64(slot + (unsigned)j * 128 + tid);
          float Pj = __uint_as_float((unsigned)v), Hj = __uint_as_float((unsigned)(v >> 32));
          Hr += Pr * Hj;
          Pr *= Pj;
          if (sv >= ep + 2u || pj == 0) break;
          --pj;
        }
        carry = Hr;
        lb_st64(slot + (unsigned)item * 128 + tid, lb_pack(0.f, aggP * carry + aggH));
      }
      asm volatile("s_waitcnt vmcnt(0)" ::: "memory");
      __syncthreads();
      if (tid == 0) lb_st32(stat + item, ep + 2u);
    }
    if (tid < 128) {
      const float* ap = sAf + tid;
      u16* bp = sBh + tid;
      float h = carry;
      if (dir == 0) {
#pragma unroll 16
        for (int st = 0; st < 64; ++st) { h = ap[st * SA_LD] * h + bf2f(bp[st * 128]); bp[st * 128] = f2bf(h); }
      } else {
#pragma unroll 16
        for (int st = 63; st >= 0; --st) { h = ap[st * SA_LD] * h + bf2f(bp[st * 128]); bp[st * 128] = f2bf(h); }
      }
    }
    __syncthreads();
#pragma unroll
    for (int cch = 0; cch < 4; ++cch) {
      int chunk = tid + cch * 256;
      int t = chunk >> 4, cc = (chunk & 15) * 8;
      unsigned off = (unsigned)(g0 + t) * D + head * 128 + cc;
      uint4 hv = *(const uint4*)(sBh + t * 128 + cc);
      unsigned long long* q = (unsigned long long*)(hown + off);
      lb_st64(q, (unsigned long long)hv.x | ((unsigned long long)hv.y << 32));
      lb_st64(q + 1, (unsigned long long)hv.z | ((unsigned long long)hv.w << 32));
    }
    asm volatile("s_waitcnt vmcnt(0)" ::: "memory");
    __syncthreads();
    if (tid == 0) sflag[0] = __hip_atomic_fetch_add(cnt + tt * 8 + head, 1u, __ATOMIC_RELAXED, __HIP_MEMORY_SCOPE_AGENT);
    __syncthreads();
    if (sflag[0] == ep + 1u) {
#pragma unroll
      for (int cch = 0; cch < 4; ++cch) {
        int chunk = tid + cch * 256;
        int t = chunk >> 4, cc = (chunk & 15) * 8;
        unsigned off = (unsigned)(g0 + t) * D + head * 128 + cc;
        uint4 hv = *(const uint4*)(sBh + t * 128 + cc);
        const unsigned long long* q = (const unsigned long long*)(hoth + off);
        unsigned long long f0 = lb_ld64(q), f1 = lb_ld64(q + 1);
        uint4 fv = make_uint4((unsigned)f0, (unsigned)(f0 >> 32), (unsigned)f1, (unsigned)(f1 >> 32));
        uint4 gv = *(const uint4*)(ga + off);
        uint4 o;
        o.x = pack2((lo2f(fv.x) + lo2f(hv.x)) * lo2f(gv.x), (hi2f(fv.x) + hi2f(hv.x)) * hi2f(gv.x));
        o.y = pack2((lo2f(fv.y) + lo2f(hv.y)) * lo2f(gv.y), (hi2f(fv.y) + hi2f(hv.y)) * hi2f(gv.y));
        o.z = pack2((lo2f(fv.z) + lo2f(hv.z)) * lo2f(gv.z), (hi2f(fv.z) + hi2f(hv.z)) * hi2f(gv.z));
        o.w = pack2((lo2f(fv.w) + lo2f(hv.w)) * lo2f(gv.w), (hi2f(fv.w) + hi2f(hv.w)) * hi2f(gv.w));
        *(uint4*)(ga + off) = o;
      }
    }
    __syncthreads();
  }
#undef LOAD_XROWS
}

DEVFN void phase_carry(const Params& p) {
  const float2* __restrict__ agg = (const float2*)U(p, 4);
  float* __restrict__ carry = (float*)(agg + 1280L * 2 * 1024);
  const int lane = threadIdx.x & 63, w = threadIdx.x >> 6;
  for (int u = blockIdx.x + gridDim.x * w; u < 288; u += gridDim.x * 4) {
    int id = u * 64 + lane;
    int seq = id >> 11, dir = (id >> 10) & 1, c = id & 1023;
    int nt = seq_len(seq) >> 6, tile0 = seq_start(seq) >> 6;
    float h = 0.f;
#pragma unroll 8
    for (int k = 0; k < nt; ++k) {
      int tt = tile0 + (dir ? nt - 1 - k : k);
      unsigned ix = (unsigned)(tt * 2 + dir) * 1024 + c;
      float2 v = agg[ix];
      carry[ix] = h;
      h = v.x * h + v.y;
    }
  }
}

DEVFN void phase_merge(const Params& p, int l, u16* smem) {
  const u16* wl = WL(p, l);
  u16* mo = U(p, 1);
  u16* tb = U(p, 5);
  for (int it = 0;; ++it) {
    int mt, nt;
    if (!tile_xcd(it, 1, 8, mt, nt)) break;
    const int g0 = mt * 256;
#pragma unroll 1
    for (int br = 0; br < 2; ++br) {
      {
        const int tid = otid(), lane = tid & 63, w = tid >> 6, wm = w >> 1, wn = w & 1, lr = lane & 15, quad = lane >> 4;
        f32x4 acc[8][4]; zero_acc8(acc);
        LdPlain lb; lb.init(tid, wl + (br == 0 ? W_A : W_B), nt * 128, D);
        if (br == 0) {
          LdPlain la; la.init(tid, U(p, 2), g0, D);
          gemm_core_b(tid, acc, 32, la, lb, smem);
        } else {
          const int seq = seq_of(g0);
          LdPerm la; la.base = U(p, 3); la.g0 = g0; la.sst = seq_start(seq); la.lg = seq == 0 ? 7 : 6;
          gemm_core_b(tid, acc, 32, la, lb, smem);
        }
#pragma unroll
        for (int i = 0; i < 8; ++i) {
          unsigned g = g0 + wm * 128 + i * 16 + lr;
#pragma unroll
          for (int j = 0; j < 4; ++j) {
            unsigned c = nt * 128 + wn * 64 + j * 16 + quad * 4;
            uint2 o; o.x = pack2(acc[i][j][0], acc[i][j][1]); o.y = pack2(acc[i][j][2], acc[i][j][3]);
            *(uint2*)(tb + (g * D + c)) = o;
          }
        }
      }
      {
        const int tid = otid(), lane = tid & 63, w = tid >> 6, wm = w >> 1, wn = w & 1, lr = lane & 15, quad = lane >> 4;
        f32x4 acc[8][4]; zero_acc8(acc);
        LdPlain la; la.init(tid, U(p, 0), g0, D);
        LdPlain lb; lb.init(tid, wl + W_CAT, 5120 + br * 1024 + nt * 128, D);
        gemm_core_b(tid, acc, 32, la, lb, smem);
#pragma unroll
        for (int i = 0; i < 8; ++i) {
          unsigned g = g0 + wm * 128 + i * 16 + lr;
#pragma unroll
          for (int j = 0; j < 4; ++j) {
            unsigned c = nt * 128 + wn * 64 + j * 16 + quad * 4;
            uint2 tv = *(const uint2*)(tb + (g * D + c));
            float v0 = sigm(acc[i][j][0]) * lo2f(tv.x);
            float v1 = sigm(acc[i][j][1]) * hi2f(tv.x);
            float v2 = sigm(acc[i][j][2]) * lo2f(tv.y);
            float v3 = sigm(acc[i][j][3]) * hi2f(tv.y);
            uint2* op = (uint2*)(mo + (g * D + c));
            if (br == 1) {
              uint2 pv = *op;
              v0 += lo2f(pv.x); v1 += hi2f(pv.x); v2 += lo2f(pv.y); v3 += hi2f(pv.y);
            }
            uint2 o; o.x = pack2(v0, v1); o.y = pack2(v2, v3);
            *op = o;
          }
        }
      }
    }
  }
}

DEVFN void phase_out(const Params& p, int l, u16* smem) {
  const u16* wo = WL(p, l) + W_O;
  for (int it = 0;; ++it) {
    int mt, nt;
    if (!tile_xcd(it, 1, 8, mt, nt)) break;
    const int tid = otid(), lane = tid & 63, w = tid >> 6, wm = w >> 1, wn = w & 1, lr = lane & 15, quad = lane >> 4;
    const int g0 = mt * 256;
    LdPlain la; la.init(tid, U(p, 1), g0, D);
    LdPlain lb; lb.init(tid, wo, nt * 128, D);
    f32x4 acc[8][4]; zero_acc8(acc);
    gemm_core_b(tid, acc, 32, la, lb, smem);
    const float* gate = MOD(p) + ((long)l * 9 + seq_of(g0)) * 3072 + 2048;
#pragma unroll
    for (int i = 0; i < 8; ++i) {
      unsigned g = g0 + wm * 128 + i * 16 + lr;
      const float* xb = (l == 0) ? (g0 < 16384 ? p.x_prompt : p.x_sample) : p.out;
      const float* xr = xb + (unsigned)((l == 0 && g0 >= 16384) ? g - 16384 : g) * D;
      float* orow = p.out + g * D;
#pragma unroll
      for (int j = 0; j < 4; ++j) {
        unsigned c = nt * 128 + wn * 64 + j * 16 + quad * 4;
        float4 xv = *(const float4*)(xr + c);
        float4 gt = *(const float4*)(gate + c);
        float4 o;
        o.x = xv.x + gt.x * acc[i][j][0]; o.y = xv.y + gt.y * acc[i][j][1];
        o.z = xv.z + gt.z * acc[i][j][2]; o.w = xv.w + gt.w * acc[i][j][3];
        *(float4*)(orow + c) = o;
      }
    }
  }
}

#define XB_TMO      128
#define XB_XCNT(j)  (256  + 64 * (j))
#define XB_XSUB(j)  (1280 + 64 * (j))
#define XB_XGEN(j)  (2304 + 64 * (j))
#define XB_TOP      3328
#define XB_TOPGEN   3392
#define XCD_BAR_WORDS 3456
#define XB_SPIN_CAP (1u << 18)
#define LAS __attribute__((address_space(3)))

__device__ __forceinline__ unsigned xb_ld(unsigned* p)              { return __hip_atomic_load(p, __ATOMIC_RELAXED, __HIP_MEMORY_SCOPE_AGENT); }
__device__ __forceinline__ unsigned xb_add(unsigned* p, unsigned v) { return __hip_atomic_fetch_add(p, v, __ATOMIC_RELAXED, __HIP_MEMORY_SCOPE_AGENT); }
__device__ __forceinline__ unsigned xb_xcc_id() { return (unsigned)__builtin_amdgcn_s_getreg((3 << 11) | 20) & 0xFu; }
#define XB_SPIN(cond, bar) do { unsigned _sp = 0; while (cond) { __builtin_amdgcn_s_sleep(1); \
    if ((++_sp & 255u) == 0u) { if (xb_ld(&(bar)[XB_TMO])) break; if (_sp > XB_SPIN_CAP) { atomicAdd(&(bar)[XB_TMO], 1u); break; } } } } while (0)

struct XcdBarrier {
    unsigned* bar; unsigned x;
    volatile LAS unsigned* st;
};

__device__ __forceinline__ XcdBarrier xcd_barrier_post(unsigned* bar, volatile LAS unsigned* st) {
    XcdBarrier b; b.bar = bar; b.x = xb_xcc_id(); b.st = st;
    if (threadIdx.x == 0) (void)xb_add(&bar[XB_XCNT(b.x)], 1u);
    return b;
}
__device__ __forceinline__ void xcd_barrier_complete(unsigned* bar, unsigned x, unsigned& nloc, unsigned& nx) {
    const unsigned G = gridDim.x * gridDim.y * gridDim.z;
    unsigned sum, cnt, mine, sp = 0u;
    for (;;) {
        sum = 0u; cnt = 0u; mine = 0u;
#pragma unroll
        for (unsigned j = 0; j < 16; ++j) { const unsigned c = xb_ld(&bar[XB_XCNT(j)]); sum += c; cnt += (c > 0u) ? 1u : 0u; mine = (j == x) ? c : mine; }
        if (sum == G) break;
        __builtin_amdgcn_s_sleep(1);
        if ((++sp & 255u) == 0u) { if (xb_ld(&bar[XB_TMO])) break; if (sp > XB_SPIN_CAP) { atomicAdd(&bar[XB_TMO], 1u); break; } }
    }
    nloc = mine > 0u ? mine : 1u; nx = cnt > 0u ? cnt : 1u;
}

__device__ __forceinline__ void xcd_barrier(const XcdBarrier& b) {
    asm volatile("s_waitcnt vmcnt(0)" ::: "memory");
    __syncthreads();
    if (threadIdx.x == 0) {
        unsigned* bar = b.bar;
        __builtin_amdgcn_s_waitcnt(0);
        unsigned nloc = b.st[0], nx = b.st[1];
        if (nloc == 0u) { xcd_barrier_complete(bar, b.x, nloc, nx); b.st[0] = nloc; b.st[1] = nx; }
        const unsigned old = xb_add(&bar[XB_XSUB(b.x)], 1u);
        const unsigned gen = old / nloc;
        if (old + 1u == (gen + 1u) * nloc) {
            __builtin_amdgcn_fence(__ATOMIC_RELEASE, "agent");
            asm volatile("s_waitcnt vmcnt(0)" ::: "memory");
            const unsigned og = xb_add(&bar[XB_TOP], 1u);
            const unsigned tg = og / nx;
            if (og + 1u == (tg + 1u) * nx) xb_add(&bar[XB_TOPGEN], 1u);
            else XB_SPIN(xb_ld(&bar[XB_TOPGEN]) == tg, bar);
            __builtin_amdgcn_fence(__ATOMIC_ACQUIRE, "agent");
            xb_add(&bar[XB_XGEN(b.x)], 1u);
            asm volatile("s_waitcnt vmcnt(0)" ::: "memory");
        } else {
            XB_SPIN(xb_ld(&bar[XB_XGEN(b.x)]) == gen, bar);
            __builtin_amdgcn_fence(__ATOMIC_ACQUIRE, "agent");
            asm volatile("s_waitcnt vmcnt(0)" ::: "memory");
        }
    }
    __syncthreads();
}


__global__ void __launch_bounds__(256, 2) hawk_fnet_megakernel(Params p) {
  extern __shared__ __attribute__((aligned(16))) unsigned char smem_raw[];
  cg::grid_group grid = cg::this_grid();
  u16* smem = (u16*)smem_raw;

  __shared__ unsigned xb_st[4];
  unsigned* bar = (unsigned*)(p.ws + OFF_BAR_BYTES);
  if (blockIdx.x == 0) {
    for (int i = threadIdx.x; i < XCD_BAR_WORDS; i += 256) __hip_atomic_store(&bar[i], 0u, __ATOMIC_RELAXED, __HIP_MEMORY_SCOPE_AGENT);
  }
  if (threadIdx.x < 4) xb_st[threadIdx.x] = 0u;
  {
    unsigned* lbs = (unsigned*)(p.ws + OFF_LB_BYTES + LB_SLOT_BYTES);
    for (int i = blockIdx.x * 256 + threadIdx.x; i < 20480 + 10240; i += gridDim.x * 256)
      __hip_atomic_store(&lbs[i], 0u, __ATOMIC_RELAXED, __HIP_MEMORY_SCOPE_AGENT);
  }
  phase_prologue(p, smem_raw);
  grid.sync();
  XcdBarrier xb = xcd_barrier_post(bar, (volatile LAS unsigned*)xb_st);
  phase_fold(p, smem);
  phase_h(p, 0);
  xcd_barrier(xb);
  for (int l = 0; l < 2; ++l) {
    phase_gemm1(p, l, smem);
    xcd_barrier(xb);
    phase_fft1(p, smem);
    xcd_barrier(xb);
    phase_fft2(p, smem);
    xcd_barrier(xb);
    phase_scan_lb(p, l, smem_raw);
    xcd_barrier(xb);
    phase_merge(p, l, smem);
    xcd_barrier(xb);
    phase_out(p, l, smem);
    xcd_barrier(xb);
    if (l == 0) { phase_h(p, 1); xcd_barrier(xb); }
  }
  phase_final(p);
}

extern "C" void kernel_launch(void* const* d_in, const int* in_sizes, int n_in,
                              void* d_out, int out_size, void* d_ws, size_t ws_size,
                              hipStream_t stream) {
  (void)in_sizes; (void)n_in; (void)out_size;
  if (ws_size < (size_t)WS_NEED) {
    fprintf(stderr, "workspace too small: %zu < %ld\n", ws_size, (long)WS_NEED);
    return;
  }
  static int grid_blocks = 0;
  if (!grid_blocks) {
    hipFuncSetAttribute((const void*)hawk_fnet_megakernel, hipFuncAttributeMaxDynamicSharedMemorySize, SMEM_BYTES);
    int dev = 0, cus = 0, per_cu = 0;
    hipGetDevice(&dev);
    hipDeviceGetAttribute(&cus, hipDeviceAttributeMultiprocessorCount, dev);
    hipOccupancyMaxActiveBlocksPerMultiprocessor(&per_cu, hawk_fnet_megakernel, 256, SMEM_BYTES);
    if (per_cu > 2) per_cu = 2;
    if (per_cu < 1) per_cu = 1;
    grid_blocks = (cus * per_cu) & ~15;
  }
  Params p{};
  p.x_prompt = (const float*)d_in[0]; p.x_sample = (const float*)d_in[1];
  p.c_prompt = (const float*)d_in[2]; p.c_sample = (const float*)d_in[3];
  p.norm_g = (const float*)d_in[4]; p.w_ada = (const float*)d_in[5]; p.b_ada = (const float*)d_in[6];
  p.w_in = (const float*)d_in[7]; p.conv_w = (const float*)d_in[8]; p.conv_b = (const float*)d_in[9];
  p.w_rg = (const float*)d_in[10]; p.b_rg = (const float*)d_in[11]; p.lam = (const float*)d_in[12];
  p.w_a_out = (const float*)d_in[13]; p.w_b_out = (const float*)d_in[14]; p.w_o = (const float*)d_in[15];
  p.final_g = (const float*)d_in[16];
  p.out = (float*)d_out; p.ws = (unsigned char*)d_ws;
  void* args[] = {&p};
  hipError_t e = hipLaunchCooperativeKernel((void*)hawk_fnet_megakernel, dim3(grid_blocks), dim3(256), args, SMEM_BYTES, stream);
  if (e != hipSuccess) fprintf(stderr, "cooperative launch failed: %s (grid %d)\n", hipGetErrorString(e), grid_blocks);
}
```

```cpp
#include <hip/hip_runtime.h>
#include <hip/hip_cooperative_groups.h>
#include <cstdio>
namespace cg = cooperative_groups;

typedef unsigned short u16;
typedef __attribute__((ext_vector_type(8))) short bf16x8;
typedef __attribute__((ext_vector_type(4))) float f32x4;

#define DEVFN __device__ __forceinline__

constexpr int D = 1024;
constexpr int T_TOT = 81920;
constexpr long UNIT = (long)T_TOT * D;
constexpr int D_IN = 6144;

constexpr long OFF_W = 6 * UNIT;
constexpr long W_CAT = 0;
constexpr long W_A = 7168L * 1024;
constexpr long W_B = W_A + 1048576;
constexpr long W_O = W_B + 1048576;
constexpr long W_RG = W_O + 1048576;
constexpr long LW = W_RG + 524288;
constexpr long OFF_TAB = OFF_W + 2 * LW;
constexpr long T_D1A = 0;
constexpr long T_D1B = 65536;
constexpr long T_D2 = T_D1B + 16384;
constexpr long T_DC = T_D2 + 32768;
constexpr long TAB_ELEMS = T_DC + 131072;
constexpr long OFF_TW_BYTES = (OFF_TAB + TAB_ELEMS) * 2;
constexpr long OFF_MOD_BYTES = OFF_TW_BYTES + 131072;
constexpr long OFF_BAR_BYTES = OFF_MOD_BYTES + 221184;
constexpr long OFF_LB_BYTES = OFF_BAR_BYTES + 16384;
constexpr long LB_SLOT_BYTES = 20480L * 128 * 8;
constexpr long WS_NEED = OFF_LB_BYTES + LB_SLOT_BYTES + 20480 * 4 + 10240 * 4;
static_assert(WS_NEED <= (1L << 30), "workspace map exceeds the guaranteed 1 GiB");

constexpr int TILE = 128 * 64;
constexpr int SMEM_BYTES = 73728;

struct Params {
  const float* x_prompt; const float* x_sample; const float* c_prompt; const float* c_sample;
  const float* norm_g; const float* w_ada; const float* b_ada; const float* w_in;
  const float* conv_w; const float* conv_b; const float* w_rg; const float* b_rg; const float* lam;
  const float* w_a_out; const float* w_b_out; const float* w_o; const float* final_g;
  float* out; unsigned char* ws;
};

typedef __attribute__((ext_vector_type(2))) float f32x2_t;
typedef __attribute__((ext_vector_type(2))) __bf16 bf16x2_t;
DEVFN u16 f2bf(float f) {
  __bf16 h = (__bf16)f;
  return *(u16*)&h;
}
DEVFN float bf2f(u16 h) { return __uint_as_float(((unsigned)h) << 16); }
DEVFN unsigned pack2(float a, float b) {
  f32x2_t v = {a, b};
  bf16x2_t r = __builtin_convertvector(v, bf16x2_t);
  return *(unsigned*)&r;
}
DEVFN float lo2f(unsigned v) { return __uint_as_float(v << 16); }
DEVFN float hi2f(unsigned v) { return __uint_as_float(v & 0xffff0000u); }
DEVFN float sigm(float x) { return __builtin_amdgcn_rcpf(1.f + __expf(-x)); }
DEVFN float silu(float x) { return x * __builtin_amdgcn_rcpf(1.f + __expf(-x)); }
DEVFN float one_minus_exp(float x) {
  float pl = -x * (1.f + x * (0.5f + x * (1.f / 6.f + x * (1.f / 24.f + x * (1.f / 120.f + x * (1.f / 720.f))))));
  float dr = 1.f - __expf(x);
  return x > -0.3f ? pl : dr;
}

DEVFN int otid() { int t = threadIdx.x; asm volatile("" : "+v"(t)); return t; }
DEVFN int seq_of(int g) { int seg = g >> 13; return seg < 2 ? 0 : seg - 1; }
DEVFN int seq_start(int s) { return s == 0 ? 0 : 16384 + (s - 1) * 8192; }
DEVFN int seq_len(int s) { return s == 0 ? 16384 : 8192; }

DEVFN u16* U(const Params& p, int i) { return (u16*)(p.ws) + (long)i * UNIT; }
DEVFN u16* WL(const Params& p, int l) { return (u16*)(p.ws) + OFF_W + (long)l * LW; }
DEVFN u16* TAB(const Params& p) { return (u16*)(p.ws) + OFF_TAB; }
DEVFN float2* TW(const Params& p) { return (float2*)(p.ws + OFF_TW_BYTES); }
DEVFN float* MOD(const Params& p) { return (float*)(p.ws + OFF_MOD_BYTES); }
DEVFN const float* xrow(const Params& p, int g) {
  return g < 16384 ? p.x_prompt + (long)g * D : p.x_sample + (long)(g - 16384) * D;
}

struct LdPlain {
  static constexpr bool kDma = true; static constexpr bool kTr = false;
  const u16* base; unsigned off0; unsigned cst; int t_; unsigned row0_, stride_;
  DEVFN unsigned rowoff(int r) const { return (row0_ + r) * stride_; }
  DEVFN void init(int tid_, const u16* b, unsigned row0, unsigned stride) {
    unsigned tid = tid_; t_ = tid_; row0_ = row0; stride_ = stride;
    base = b;
    off0 = (row0 + (tid >> 3)) * stride + (((tid & 7) ^ ((tid >> 3) & 7)) << 3);
    cst = 32 * stride;
  }
  DEVFN void issue(u16* tile, int c, int kt) const {
    __builtin_amdgcn_global_load_lds((const unsigned*)(base + (off0 + c * cst + kt * 64)),
                                     (unsigned*)(tile + (t_ + c * 256) * 8), 16, 0, 0);
  }
  DEVFN uint4 load(int, int) const { return make_uint4(0, 0, 0, 0); }
  DEVFN void store(u16*, int, uint4) const {}
};
struct LdRows4 {
  static constexpr bool kDma = true; static constexpr bool kTr = false;
  const u16* base; unsigned off[4]; int t_;
  DEVFN void issue(u16* tile, int c, int kt) const {
    __builtin_amdgcn_global_load_lds((const unsigned*)(base + (off[c] + kt * 64)),
                                     (unsigned*)(tile + (t_ + c * 256) * 8), 16, 0, 0);
  }
  DEVFN uint4 load(int, int) const { return make_uint4(0, 0, 0, 0); }
  DEVFN void store(u16*, int, uint4) const {}
};
struct LdF32 {
  static constexpr bool kDma = false; static constexpr bool kTr = false;
  const float* base; unsigned off0; unsigned cst; int t_;
  DEVFN void init(int tid_, const float* b, unsigned row0, unsigned stride, unsigned col0) {
    unsigned tid = tid_; t_ = tid_;
    base = b;
    off0 = (row0 + (tid >> 3)) * stride + col0 + (tid & 7) * 8;
    cst = 32 * stride;
  }
  DEVFN void issue(u16*, int, int) const {}
  DEVFN uint4 load(int c, int kt) const {
    const float4* q = (const float4*)(base + (off0 + c * cst + kt * 64));
    float4 a = q[0], b = q[1];
    uint4 r; r.x = pack2(a.x, a.y); r.y = pack2(a.z, a.w); r.z = pack2(b.x, b.y); r.w = pack2(b.z, b.w);
    return r;
  }
  DEVFN void store(u16* tile, int c, uint4 v) const {
    int idx = t_ + c * 256;
    int row = idx >> 3, kc = idx & 7;
    *(uint4*)(tile + row * 64 + ((kc ^ (row & 7)) << 3)) = v;
  }
};
DEVFN int trf(int r) { return ((r & 3) << 2) | ((r >> 2) & 3); }
template <class TokFn>
struct LdTrans {
  static constexpr bool kDma = false; static constexpr bool kTr = false;
  TokFn tok; int t_;
  DEVFN void issue(u16*, int, int) const {}
  DEVFN uint4 load(int c, int kt) const {
    int idx = t_ + c * 256;
    int kk = idx & 63, cc = idx >> 6;
    const u16* b; unsigned o = tok(kt * 64 + kk, b);
    return *(const uint4*)(b + (o + cc * 8));
  }
  DEVFN void store(u16* tile, int c, uint4 v) const {
    int idx = t_ + c * 256;
    int kk = idx & 63, cc = idx >> 6;
    u16* q = tile + (cc * 8) * 64 + (kk & 7);
    int kc = kk >> 3;
    q[0 * 64 + ((kc ^ 0) << 3)] = (u16)(v.x & 0xffff); q[1 * 64 + ((kc ^ 1) << 3)] = (u16)(v.x >> 16);
    q[2 * 64 + ((kc ^ 2) << 3)] = (u16)(v.y & 0xffff); q[3 * 64 + ((kc ^ 3) << 3)] = (u16)(v.y >> 16);
    q[4 * 64 + ((kc ^ 4) << 3)] = (u16)(v.z & 0xffff); q[5 * 64 + ((kc ^ 5) << 3)] = (u16)(v.z >> 16);
    q[6 * 64 + ((kc ^ 6) << 3)] = (u16)(v.w & 0xffff); q[7 * 64 + ((kc ^ 7) << 3)] = (u16)(v.w >> 16);
  }
};

typedef __attribute__((ext_vector_type(4))) short s16x4;
DEVFN s16x4 lds_tr_read(const u16* q) {
  return __builtin_amdgcn_ds_read_tr16_b64_v4i16((s16x4 __attribute__((address_space(3)))*)(q));
}

DEVFN void zero_acc(f32x4 (&acc)[4][4]) {
#pragma unroll
  for (int i = 0; i < 4; ++i)
#pragma unroll
    for (int j = 0; j < 4; ++j) acc[i][j] = f32x4{0.f, 0.f, 0.f, 0.f};
}

template <class LA, class LB>
DEVFN void gemm_core(int tid, f32x4 (&acc)[4][4], int nk, const LA& la, const LB& lb, u16* smem) {
  const int lane = tid & 63, w = tid >> 6, wm = w >> 1, wn = w & 1;
  const int lr = lane & 15, quad = lane >> 4;
  uint4 ra[4], rb[4];
  if (LA::kDma) {
#pragma unroll
    for (int c = 0; c < 4; ++c) la.issue(smem, c, 0);
  } else {
#pragma unroll
    for (int c = 0; c < 4; ++c) ra[c] = la.load(c, 0);
  }
  if (LB::kDma) {
#pragma unroll
    for (int c = 0; c < 4; ++c) lb.issue(smem + TILE, c, 0);
  } else {
#pragma unroll
    for (int c = 0; c < 4; ++c) rb[c] = lb.load(c, 0);
  }
  if (!LA::kDma) {
#pragma unroll
    for (int c = 0; c < 4; ++c) la.store(smem, c, ra[c]);
  }
  if (!LB::kDma) {
#pragma unroll
    for (int c = 0; c < 4; ++c) lb.store(smem + TILE, c, rb[c]);
  }
  asm volatile("s_waitcnt vmcnt(0)" ::: "memory");
  __syncthreads();
  const int aoff = (wm * 64 + lr) * 64, boff = (wn * 64 + lr) * 64;
  const int sw0 = ((quad) ^ (lr & 7)) << 3, sw1 = ((4 + quad) ^ (lr & 7)) << 3;
  int troff[4][2];
  if (LB::kTr) {
    const int q = lr >> 2, pp = lr & 3;
#pragma unroll
    for (int j = 0; j < 4; ++j)
#pragma unroll
      for (int h = 0; h < 2; ++h) {
        int r = quad * 8 + h * 4 + q;
        int ch = (wn * 8 + j * 2 + (pp >> 1)) ^ trf(r);
        troff[j][h] = r * 128 + ch * 8 + (pp & 1) * 4;
      }
  }
  for (int kt = 0; kt < nk; ++kt) {
    const u16* sA = smem + (kt & 1) * 2 * TILE;
    const u16* sB = sA + TILE;
    u16* nA = smem + ((kt + 1) & 1) * 2 * TILE;
    const bool more = (kt + 1) < nk;
    if (more) {
      if (LA::kDma) {
#pragma unroll
        for (int c = 0; c < 4; ++c) la.issue(nA, c, kt + 1);
      } else {
#pragma unroll
        for (int c = 0; c < 4; ++c) ra[c] = la.load(c, kt + 1);
      }
      if (LB::kDma) {
#pragma unroll
        for (int c = 0; c < 4; ++c) lb.issue(nA + TILE, c, kt + 1);
      } else {
#pragma unroll
        for (int c = 0; c < 4; ++c) rb[c] = lb.load(c, kt + 1);
      }
    }
#pragma unroll
    for (int ks = 0; ks < 2; ++ks) {
      const int sw = ks == 0 ? sw0 : sw1;
      bf16x8 af[4], bfr[4];
#pragma unroll
      for (int i = 0; i < 4; ++i) af[i] = *(const bf16x8*)(sA + aoff + i * 1024 + sw);
      if (LB::kTr) {
#pragma unroll
        for (int j = 0; j < 4; ++j) {
          s16x4 lo = lds_tr_read(sB + troff[j][0] + ks * 4096);
          s16x4 hi = lds_tr_read(sB + troff[j][1] + ks * 4096);
          bfr[j] = __builtin_shufflevector(lo, hi, 0, 1, 2, 3, 4, 5, 6, 7);
        }
      } else {
#pragma unroll
        for (int j = 0; j < 4; ++j) bfr[j] = *(const bf16x8*)(sB + boff + j * 1024 + sw);
      }
      __builtin_amdgcn_s_setprio(1);
#pragma unroll
      for (int i = 0; i < 4; ++i)
#pragma unroll
        for (int j = 0; j < 4; ++j)
          acc[i][j] = __builtin_amdgcn_mfma_f32_16x16x32_bf16(bfr[j], af[i], acc[i][j], 0, 0, 0);
      __builtin_amdgcn_s_setprio(0);
    }
    if (more) {
      if (!LA::kDma) {
#pragma unroll
        for (int c = 0; c < 4; ++c) la.store(nA, c, ra[c]);
      }
      if (!LB::kDma) {
#pragma unroll
        for (int c = 0; c < 4; ++c) lb.store(nA + TILE, c, rb[c]);
      }
    }
    asm volatile("s_waitcnt vmcnt(0)" ::: "memory");
    __syncthreads();
  }
}

struct LdPerm {
  const u16* base; int g0, sst, lg;
  DEVFN unsigned rowoff(int r) const {
    int t = g0 - sst + r;
    int urow = ((t & ((1 << lg) - 1)) << 7) + (t >> lg);
    return (unsigned)(sst + urow) * D;
  }
};
#define GLDS16(gp, lp) __builtin_amdgcn_global_load_lds((const unsigned*)(gp), (unsigned*)(lp), 16, 0, 0)
DEVFN void zero_acc8(f32x4 (&acc)[8][4]) {
#pragma unroll
  for (int i = 0; i < 8; ++i)
#pragma unroll
    for (int j = 0; j < 4; ++j) acc[i][j] = f32x4{0.f, 0.f, 0.f, 0.f};
}
template <class LA, class LB>
DEVFN void gemm_core_b(int tid, f32x4 (&acc)[8][4], int nk, const LA& la, const LB& lb, u16* smem) {
  const int lane = tid & 63, w = tid >> 6, wm = w >> 1, wn = w & 1;
  const int lr = lane & 15, quad = lane >> 4;
  const int r0 = tid >> 2;
  const unsigned sw = (unsigned)(((tid & 3) ^ ((0 - (tid >> 4)) & 3)) << 3);
  const unsigned oa0 = la.rowoff(r0) + sw, oa1 = la.rowoff(r0 + 64) + sw, oa2 = la.rowoff(r0 + 128) + sw, oa3 = la.rowoff(r0 + 192) + sw;
  const unsigned ob0 = lb.rowoff(r0) + sw, ob1 = lb.rowoff(r0 + 64) + sw;
  const u16* ga = la.base; const u16* gb = lb.base;
  u16* l0 = smem + tid * 8;
#define ISSUE_STAGE(st, kt) do { u16* _s = l0 + (st) * 12288; unsigned _k = (unsigned)(kt) * 32u; \
    GLDS16(ga + (oa0 + _k), _s); GLDS16(ga + (oa1 + _k), _s + 2048); GLDS16(ga + (oa2 + _k), _s + 4096); GLDS16(ga + (oa3 + _k), _s + 6144); \
    GLDS16(gb + (ob0 + _k), _s + 8192); GLDS16(gb + (ob1 + _k), _s + 10240); } while (0)
  asm volatile("s_waitcnt vmcnt(0)" ::: "memory");
  ISSUE_STAGE(0, 0);
  ISSUE_STAGE(1, 1);
  const int fsw = (quad ^ ((0 - (lr >> 2)) & 3)) << 3;
  const int aoff = (wm * 128 + lr) * 32 + fsw, boff = 8192 + (wn * 64 + lr) * 32 + fsw;
  int cur = 0, nxt = 2;
  for (int kt = 0; kt < nk; ++kt) {
    if (kt + 1 < nk) asm volatile("s_waitcnt vmcnt(6)" ::: "memory");
    else asm volatile("s_waitcnt vmcnt(0)" ::: "memory");
    __builtin_amdgcn_s_barrier();
    asm volatile("" ::: "memory");
    if (kt + 2 < nk) ISSUE_STAGE(nxt, kt + 2);
    const u16* sb = smem + cur * 12288;
    bf16x8 af[8], bfr[4];
#pragma unroll
    for (int j = 0; j < 4; ++j) bfr[j] = *(const bf16x8*)(sb + boff + j * 512);
#pragma unroll
    for (int i = 0; i < 8; ++i) af[i] = *(const bf16x8*)(sb + aoff + i * 512);
    __builtin_amdgcn_s_setprio(1);
#pragma unroll
    for (int i = 0; i < 8; ++i)
#pragma unroll
      for (int j = 0; j < 4; ++j)
        acc[i][j] = __builtin_amdgcn_mfma_f32_16x16x32_bf16(bfr[j], af[i], acc[i][j], 0, 0, 0);
    __builtin_amdgcn_s_setprio(0);
    cur = cur == 2 ? 0 : cur + 1;
    nxt = nxt == 2 ? 0 : nxt + 1;
  }
  asm volatile("s_waitcnt lgkmcnt(0)" ::: "memory");
  __builtin_amdgcn_s_barrier();
  asm volatile("" ::: "memory");
#undef ISSUE_STAGE
}

DEVFN bool tile_xcd(int it, int ngrp, int ntn, int& mt, int& nt) {
  const int G = gridDim.x, b = blockIdx.x;
  if (G == 512) {
    if (it >= 5 * ngrp) return false;
    int xcd = b & 7, loc = b >> 3;
    mt = xcd * 40 + (it / ngrp) * 8 + (loc >> 3);
    nt = (it % ngrp) * 8 + (loc & 7);
    return true;
  }
  int tile = b + it * G;
  if (tile >= 320 * ntn) return false;
  mt = tile / ntn; nt = tile % ntn;
  return true;
}

DEVFN void transpose_tile(const float* src, long ld, u16* dst, long ldd, float* sT) {
  const int tid = otid();
#pragma unroll
  for (int pss = 0; pss < 4; ++pss) {
    int kk = (tid >> 4) + pss * 16, n4 = (tid & 15) * 4;
    float4 v = *(const float4*)(src + (long)kk * ld + n4);
    sT[kk * 65 + n4 + 0] = v.x; sT[kk * 65 + n4 + 1] = v.y; sT[kk * 65 + n4 + 2] = v.z; sT[kk * 65 + n4 + 3] = v.w;
  }
  __syncthreads();
  {
    int n = tid >> 2, k0 = (tid & 3) * 16;
    unsigned o[8];
#pragma unroll
    for (int e = 0; e < 8; ++e) o[e] = pack2(sT[(k0 + 2 * e) * 65 + n], sT[(k0 + 2 * e + 1) * 65 + n]);
    uint4* q = (uint4*)(dst + (long)n * ldd + k0);
    q[0] = make_uint4(o[0], o[1], o[2], o[3]);
    q[1] = make_uint4(o[4], o[5], o[6], o[7]);
  }
  __syncthreads();
}

DEVFN void phase_prologue(const Params& p, unsigned char* smem_raw) {
  const int tid = otid();
  constexpr int NJ_TR = 4352, NJ_MOD = 96, NJ_TAB = 256;
  for (int job = blockIdx.x; job < NJ_TR + NJ_MOD + NJ_TAB; job += gridDim.x) {
    if (job < NJ_TR) {
      float* sT = (float*)smem_raw;
      int l = job / 2176, r = job % 2176;
      u16* wl = WL(p, l);
      if (r < 1280) {
        int kt = r / 80, ntile = r % 80;
        int orow = ntile * 64;
        int scol;
        if (orow < 2048) scol = orow; else { orow += 2048; scol = orow - 1024; }
        transpose_tile(p.w_in + (long)l * D * D_IN + (long)(kt * 64) * D_IN + scol, D_IN,
                       wl + W_CAT + (long)orow * D + kt * 64, D, sT);
      } else if (r < 2048) {
        int r2 = r - 1280, which = r2 >> 8, t = r2 & 255, kt = t >> 4, ntile = t & 15;
        const float* src = (which == 0 ? p.w_a_out : which == 1 ? p.w_b_out : p.w_o) + (long)l * 1048576;
        long doff = which == 0 ? W_A : which == 1 ? W_B : W_O;
        transpose_tile(src + (long)(kt * 64) * D + ntile * 64, D, wl + doff + (long)(ntile * 64) * D + kt * 64, D, sT);
      } else {
        int r3 = r - 2048, mat = r3 >> 2, t = r3 & 3, kt = t >> 1, ntile = t & 1;
        const float* src = p.w_rg + ((long)l * 32 + mat) * 16384;
        transpose_tile(src + (long)(kt * 64) * 128 + ntile * 64, 128,
                       wl + W_RG + (long)mat * 16384 + (long)(ntile * 64) * 128 + kt * 64, 128, sT);
      }
    } else if (job < NJ_TR + NJ_MOD) {
      int jm = job - NJ_TR, l = jm / 48, cgp = jm % 48;
      float* sc = (float*)smem_raw;
      float* red = sc + 9 * 1024;
      for (int i = tid; i < 9 * 1024; i += 256) {
        int s = i >> 10, k = i & 1023;
        float cv = s == 0 ? p.c_prompt[k] : p.c_sample[(s - 1) * 1024 + k];
        sc[i] = silu(cv);
      }
      __syncthreads();
      int col = cgp * 64 + (tid & 63), kq = tid >> 6;
      float a0 = 0, a1 = 0, a2 = 0, a3 = 0, a4 = 0, a5 = 0, a6 = 0, a7 = 0, a8 = 0;
      const float* wp = p.w_ada + (long)l * D * 3072 + col;
#pragma unroll 4
      for (int k = kq * 256; k < kq * 256 + 256; ++k) {
        float wv = wp[(long)k * 3072];
        a0 += sc[0 * 1024 + k] * wv; a1 += sc[1 * 1024 + k] * wv; a2 += sc[2 * 1024 + k] * wv;
        a3 += sc[3 * 1024 + k] * wv; a4 += sc[4 * 1024 + k] * wv; a5 += sc[5 * 1024 + k] * wv;
        a6 += sc[6 * 1024 + k] * wv; a7 += sc[7 * 1024 + k] * wv; a8 += sc[8 * 1024 + k] * wv;
      }
      float* rq = red + kq * 9 * 64 + (tid & 63);
      rq[0 * 64] = a0; rq[1 * 64] = a1; rq[2 * 64] = a2; rq[3 * 64] = a3; rq[4 * 64] = a4;
      rq[5 * 64] = a5; rq[6 * 64] = a6; rq[7 * 64] = a7; rq[8 * 64] = a8;
      __syncthreads();
      for (int i = tid; i < 9 * 64; i += 256) {
        int s = i >> 6, cc = i & 63;
        float v = red[0 * 576 + i] + red[1 * 576 + i] + red[2 * 576 + i] + red[3 * 576 + i];
        int cf = cgp * 64 + cc;
        MOD(p)[((long)l * 9 + s) * 3072 + cf] = v + p.b_ada[l * 3072 + cf];
      }
      __syncthreads();
    } else {
      int jt = job - NJ_TR - NJ_MOD;
      u16* tab = TAB(p);
#pragma unroll
      for (int e4 = 0; e4 < 4; ++e4) {
        int e = jt * 1024 + e4 * 256 + tid;
        if (e < 65536) {
          int m = e >> 8, k = e & 255;
          int k1 = (m >> 5) * 16 + (m & 15), ro = (m >> 4) & 1, ri = k >> 7, s1 = k & 127;
          float x = 2.f * (float)((k1 * s1) & 127) / 128.f;
          float cs = cospif(x), sn = sinpif(x);
          float v = (ro == ri) ? cs : (ro == 0 ? sn : -sn);
          tab[T_D1A + e] = f2bf(v);
        } else if (e < 65536 + 16384) {
          int e2 = e - 65536;
          int m = e2 >> 7, k = e2 & 127;
          int k1 = (m >> 5) * 16 + (m & 15), ro = (m >> 4) & 1, ri = k >> 6, s1 = k & 63;
          float x = 2.f * (float)((k1 * s1) & 63) / 64.f;
          float cs = cospif(x), sn = sinpif(x);
          float v = (ro == ri) ? cs : (ro == 0 ? sn : -sn);
          tab[T_D1B + e2] = f2bf(v);
        } else if (e < 65536 + 16384 + 32768) {
          int e2 = e - 65536 - 16384;
          int k2 = e2 >> 8, k = e2 & 255, ri = k >> 7, s2 = k & 127;
          float x = 2.f * (float)((k2 * s2) & 127) / 128.f;
          float v = ri == 0 ? cospif(x) : sinpif(x);
          tab[T_D2 + e2] = f2bf(v);
        } else if (e < 65536 + 16384 + 32768 + 131072) {
          int e2 = e - 65536 - 16384 - 32768;
          int row = e2 >> 8, c = e2 & 255, ri = row >> 8, m = row & 255;
          float x = 2.f * (float)((m * c) & 255) / 256.f;
          float v = ri == 0 ? cospif(x) : -sinpif(x);
          tab[T_DC + e2] = f2bf(v);
        } else {
          int e2 = e - (65536 + 16384 + 32768 + 131072);
          if (e2 < 16384) {
            float x = 2.f * (float)e2 / 16384.f;
            TW(p)[e2] = make_float2(cospif(x), sinpif(x));
          }
        }
      }
    }
  }
}

DEVFN void phase_fold(const Params& p, u16* smem) {
  for (int tile = blockIdx.x; tile < 256; tile += gridDim.x) {
    const int tid = otid(), lane = tid & 63, w = tid >> 6, wm = w >> 1, wn = w & 1, lr = lane & 15, quad = lane >> 4;
    int l = tile >> 7, g = (tile >> 5) & 3, mt = (tile >> 3) & 3, nt = tile & 7;
    LdPlain la; la.init(tid, TAB(p) + T_DC, mt * 128, 256);
    LdF32 lb; lb.init(tid, p.w_in + (long)l * D * D_IN, nt * 128, D_IN, 2048 + g * 256);
    f32x4 acc[4][4]; zero_acc(acc);
    gemm_core(tid, acc, 4, la, lb, smem);
    int ri = mt >> 1;
    u16* wc = WL(p, l) + W_CAT;
#pragma unroll
    for (int i = 0; i < 4; ++i) {
      int mrow = (mt & 1) * 128 + wm * 64 + i * 16 + lr;
      unsigned orow = 2048 + ri * 1024 + g * 256 + mrow;
#pragma unroll
      for (int j = 0; j < 4; ++j) {
        int n = nt * 128 + wn * 64 + j * 16 + quad * 4;
        uint2 o; o.x = pack2(acc[i][j][0], acc[i][j][1]); o.y = pack2(acc[i][j][2], acc[i][j][3]);
        *(uint2*)(wc + orow * D + n) = o;
      }
    }
  }
}

DEVFN void phase_h(const Params& p, int l) {
  const int lane = threadIdx.x & 63;
  const int wid = blockIdx.x * 4 + (threadIdx.x >> 6), nw = gridDim.x * 4;
  const float* ng = p.norm_g + l * D;
  const float* modl = MOD(p) + (long)l * 9 * 3072;
  u16* H = U(p, 0);
  float4 v[4], vn[4];
  auto ldrow = [&](int g, float4 (&dst)[4]) {
    const float* xb = (l == 0) ? (g < 16384 ? p.x_prompt : p.x_sample) : p.out;
    const unsigned xo = (unsigned)((l == 0 && g >= 16384) ? g - 16384 : g) * D;
#pragma unroll
    for (int i = 0; i < 4; ++i) dst[i] = *(const float4*)(xb + xo + i * 256 + lane * 4);
  };
  if (wid < T_TOT) ldrow(wid, v);
  for (int g = wid; g < T_TOT; g += nw) {
    if (g + nw < T_TOT) ldrow(g + nw, vn);
    const float* md = modl + seq_of(g) * 3072;
    float ss = 0.f;
#pragma unroll
    for (int i = 0; i < 4; ++i) ss += v[i].x * v[i].x + v[i].y * v[i].y + v[i].z * v[i].z + v[i].w * v[i].w;
#pragma unroll
    for (int o = 32; o >= 1; o >>= 1) ss += __shfl_xor(ss, o, 64);
    float rstd = rsqrtf(ss * (1.f / 1024.f) + 1e-6f);
#pragma unroll
    for (int i = 0; i < 4; ++i) {
      int c = i * 256 + lane * 4;
      float4 g4 = *(const float4*)(ng + c);
      float4 sh = *(const float4*)(md + c);
      float4 sc = *(const float4*)(md + 1024 + c);
      float h0 = v[i].x * rstd * g4.x * (1.f + sc.x) + sh.x;
      float h1 = v[i].y * rstd * g4.y * (1.f + sc.y) + sh.y;
      float h2 = v[i].z * rstd * g4.z * (1.f + sc.z) + sh.z;
      float h3 = v[i].w * rstd * g4.w * (1.f + sc.w) + sh.w;
      uint2 o; o.x = pack2(h0, h1); o.y = pack2(h2, h3);
      *(uint2*)(H + ((unsigned)g * D + c)) = o;
    }
#pragma unroll
    for (int i = 0; i < 4; ++i) v[i] = vn[i];
  }
}

DEVFN void phase_final(const Params& p) {
  const int lane = threadIdx.x & 63;
  const int wid = blockIdx.x * 4 + (threadIdx.x >> 6), nw = gridDim.x * 4;
  float4 v[4], vn[4];
  if (wid < T_TOT) {
#pragma unroll
    for (int i = 0; i < 4; ++i) v[i] = *(const float4*)(p.out + (unsigned)wid * D + i * 256 + lane * 4);
  }
  for (int g = wid; g < T_TOT; g += nw) {
    float* xr = p.out + (unsigned)g * D;
    if (g + nw < T_TOT) {
#pragma unroll
      for (int i = 0; i < 4; ++i) vn[i] = *(const float4*)(p.out + (unsigned)(g + nw) * D + i * 256 + lane * 4);
    }
    float ss = 0.f;
#pragma unroll
    for (int i = 0; i < 4; ++i) ss += v[i].x * v[i].x + v[i].y * v[i].y + v[i].z * v[i].z + v[i].w * v[i].w;
#pragma unroll
    for (int o = 32; o >= 1; o >>= 1) ss += __shfl_xor(ss, o, 64);
    float rstd = rsqrtf(ss * (1.f / 1024.f) + 1e-6f);
#pragma unroll
    for (int i = 0; i < 4; ++i) {
      int c = i * 256 + lane * 4;
      float4 g4 = *(const float4*)(p.final_g + c);
      float4 o;
      o.x = v[i].x * rstd * g4.x; o.y = v[i].y * rstd * g4.y; o.z = v[i].z * rstd * g4.z; o.w = v[i].w * rstd * g4.w;
      *(float4*)(xr + c) = o;
    }
#pragma unroll
    for (int i = 0; i < 4; ++i) v[i] = vn[i];
  }
}

DEVFN void phase_gemm1(const Params& p, int l, u16* smem) {
  const u16* H = U(p, 0);
  const u16* W = WL(p, l) + W_CAT;
  for (int it = 0;; ++it) {
    int mt, nt;
    if (!tile_xcd(it, 5, 40, mt, nt)) break;
    const int tid = otid(), lane = tid & 63, w = tid >> 6, wm = w >> 1, wn = w & 1, lr = lane & 15, quad = lane >> 4;
    LdPlain la; la.init(tid, H, mt * 256, D);
    LdPlain lb; lb.init(tid, W, nt * 128, D);
    f32x4 acc[8][4]; zero_acc8(acc);
    gemm_core_b(tid, acc, 32, la, lb, smem);
    int unit = nt >> 3, col0 = (nt & 7) * 128;
    u16* outp = U(p, 1 + unit);
    bool act = (unit == 1) || (unit == 4);
#pragma unroll
    for (int i = 0; i < 8; ++i) {
      unsigned g = mt * 256 + wm * 128 + i * 16 + lr;
#pragma unroll
      for (int j = 0; j < 4; ++j) {
        unsigned c = col0 + wn * 64 + j * 16 + quad * 4;
        float v0 = acc[i][j][0], v1 = acc[i][j][1], v2 = acc[i][j][2], v3 = acc[i][j][3];
        if (act) { v0 = silu(v0); v1 = silu(v1); v2 = silu(v2); v3 = silu(v3); }
        uint2 o; o.x = pack2(v0, v1); o.y = pack2(v2, v3);
        *(uint2*)(outp + g * D + c) = o;
      }
    }
  }
}

struct TokF1 {
  const u16* zr; const u16* zi; int n1; unsigned off;
  DEVFN unsigned operator()(int k, const u16*& b) const {
    int ri = k >= n1 ? 1 : 0;
    int s1 = k - ri * n1;
    b = ri ? zi : zr;
    return off + (unsigned)(s1 * 128) * D;
  }
};
DEVFN void f1_twiddle(int tid, const Params& p, const f32x4 (&acc)[4][4], int hf, int s2, int smask, int twmul,
                      uint2 (&o1)[2][4], uint2 (&o2)[2][4]) {
  const int lane = tid & 63, w = tid >> 6, wm = w >> 1, lr = lane & 15;
  const float2* tw = TW(p);
#pragma unroll
  for (int b = 0; b < 2; ++b) {
    int k1 = (hf * 4 + wm * 2 + b) * 16 + lr;
    float2 t = tw[((k1 * s2) & smask) * twmul];
#pragma unroll
    for (int j = 0; j < 4; ++j) {
      f32x4 orr = acc[2 * b][j], oii = acc[2 * b + 1][j];
      o1[b][j].x = pack2(orr[0] * t.x + oii[0] * t.y, orr[1] * t.x + oii[1] * t.y);
      o1[b][j].y = pack2(orr[2] * t.x + oii[2] * t.y, orr[3] * t.x + oii[3] * t.y);
      o2[b][j].x = pack2(oii[0] * t.x - orr[0] * t.y, oii[1] * t.x - orr[1] * t.y);
      o2[b][j].y = pack2(oii[2] * t.x - orr[2] * t.y, oii[3] * t.x - orr[3] * t.y);
    }
  }
}
DEVFN void f1_write(int tid, int hf, unsigned off, const uint2 (&o1)[2][4], const uint2 (&o2)[2][4], u16* zr, u16* zi) {
  const int lane = tid & 63, w = tid >> 6, wm = w >> 1, wn = w & 1, lr = lane & 15, quad = lane >> 4;
#pragma unroll
  for (int b = 0; b < 2; ++b) {
    unsigned k1 = (hf * 4 + wm * 2 + b) * 16 + lr;
    unsigned rowoff = off + (k1 * 128) * D + wn * 64 + quad * 4;
#pragma unroll
    for (int j = 0; j < 4; ++j) {
      *(uint2*)(zr + (rowoff + j * 16)) = o1[b][j];
      *(uint2*)(zi + (rowoff + j * 16)) = o2[b][j];
    }
  }
}
DEVFN void phase_fft1(const Params& p, u16* smem) {
  u16* zr = U(p, 3);
  u16* zi = U(p, 4);
  for (int tile = blockIdx.x; tile < 9216; tile += gridDim.x) {
    const int tid = otid();
    int seq, s2, ct, n1;
    if (tile < 1024) { seq = 0; s2 = tile >> 3; ct = tile & 7; n1 = 128; }
    else { int t2 = tile - 1024; seq = 1 + (t2 >> 10); s2 = (t2 >> 3) & 127; ct = t2 & 7; n1 = 64; }
    const unsigned off = (unsigned)(seq_start(seq) + s2) * D + ct * 128;
    LdTrans<TokF1> lb; lb.t_ = tid; lb.tok.zr = zr; lb.tok.zi = zi; lb.tok.n1 = n1; lb.tok.off = off;
    const int K = 2 * n1, nk = K >> 6;
    const u16* tab = TAB(p) + (seq == 0 ? T_D1A : T_D1B);
    const int smask = seq == 0 ? 16383 : 8191, twmul = seq == 0 ? 1 : 2;
    uint2 a1[2][4], a2[2][4];
    {
      f32x4 acc[4][4]; zero_acc(acc);
      LdPlain la; la.init(tid, tab, 0, K); gemm_core(tid, acc, nk, la, lb, smem);
      f1_twiddle(tid, p, acc, 0, s2, smask, twmul, a1, a2);
    }
    if (seq == 0) {
      uint2 b1[2][4], b2[2][4];
      {
        f32x4 acc[4][4]; zero_acc(acc);
        LdPlain la; la.init(tid, tab, 128, K); gemm_core(tid, acc, nk, la, lb, smem);
        f1_twiddle(tid, p, acc, 1, s2, smask, twmul, b1, b2);
      }
      f1_write(tid, 1, off, b1, b2, zr, zi);
    }
    f1_write(tid, 0, off, a1, a2, zr, zi);
  }
}

struct TokF2 {
  const u16* zr; const u16* zi; unsigned off;
  DEVFN unsigned operator()(int k, const u16*& b) const {
    int ri = k >> 7, s2 = k & 127;
    b = ri ? zi : zr;
    return off + (unsigned)s2 * D;
  }
};
DEVFN void phase_fft2(const Params& p, u16* smem) {
  u16* zr = U(p, 3);
  const u16* gbp = U(p, 5);
  for (int tile = blockIdx.x; tile < 5120; tile += gridDim.x) {
    const int tid = otid(), lane = tid & 63, w = tid >> 6, wm = w >> 1, wn = w & 1, lr = lane & 15, quad = lane >> 4;
    int seq, k1, ct, n1;
    if (tile < 1024) { seq = 0; k1 = tile >> 3; ct = tile & 7; n1 = 128; }
    else { int t2 = tile - 1024; seq = 1 + (t2 >> 9); k1 = (t2 >> 3) & 63; ct = t2 & 7; n1 = 64; }
    const int sst = seq_start(seq);
    const unsigned off = (unsigned)(sst + k1 * 128) * D + ct * 128;
    LdTrans<TokF2> lb; lb.t_ = tid; lb.tok.zr = zr; lb.tok.zi = U(p, 4); lb.tok.off = off;
    LdPlain la; la.init(tid, TAB(p) + T_D2, 0, 256);
    f32x4 acc[4][4]; zero_acc(acc);
    gemm_core(tid, acc, 4, la, lb, smem);
    const float nrm = seq == 0 ? (1.f / 2048.f) : 6.9053396600248786e-4f;
#pragma unroll
    for (int i = 0; i < 4; ++i) {
      unsigned k2 = wm * 64 + i * 16 + lr;
      unsigned goff = (unsigned)(sst + k1 + n1 * k2) * D + ct * 128;
#pragma unroll
      for (int j = 0; j < 4; ++j) {
        unsigned cl = wn * 64 + j * 16 + quad * 4;
        uint2 gv = *(const uint2*)(gbp + (goff + cl));
        uint2 o;
        o.x = pack2(acc[i][j][0] * nrm * lo2f(gv.x), acc[i][j][1] * nrm * hi2f(gv.x));
        o.y = pack2(acc[i][j][2] * nrm * lo2f(gv.y), acc[i][j][3] * nrm * hi2f(gv.y));
        *(uint2*)(zr + (off + k2 * D + cl)) = o;
      }
    }
  }
}

constexpr int SA_LD = 128;
template <int PASS>
DEVFN void phase_scan(const Params& p, int l, int dirsel, unsigned char* smem_raw) {
  float* sAf = (float*)smem_raw;
  u16* sBh = (u16*)(smem_raw + 32768);
  u16* sXc = (u16*)(smem_raw + 32768 + 16384);
  const int tid = otid(), lane = tid & 63, w = tid >> 6, lr = lane & 15, quad = lane >> 4;
  const int head = blockIdx.x & 7;
  const int dir = PASS == 1 ? ((blockIdx.x >> 3) & 1) : dirsel;
  const int tstart = PASS == 1 ? (blockIdx.x >> 4) : (blockIdx.x >> 3);
  const int tstep = PASS == 1 ? (gridDim.x >> 4) : (gridDim.x >> 3);
  const u16* xa = U(p, 1);
  u16* ga = U(p, 2);
  u16* hf = U(p, 5);
  float2* agg = (float2*)U(p, 4);
  float* carry = (float*)(agg + 1280L * 2 * 1024);
  bf16x8 bw[4][4];
  {
    const u16* wrg = WL(p, l) + W_RG;
#pragma unroll
    for (int jt = 0; jt < 4; ++jt) {
      int q = jt >> 1, col = w * 32 + (jt & 1) * 16 + lr;
      const u16* bp = wrg + (unsigned)((((dir * 2 + q) * 8 + head) * 128 + col) * 128 + quad * 8);
#pragma unroll
      for (int ks = 0; ks < 4; ++ks) bw[jt][ks] = *(const bf16x8*)(bp + ks * 32);
    }
  }
  float spl[2], brr[2], bii[2];
#pragma unroll
  for (int jc = 0; jc < 2; ++jc) {
    int cgl = head * 128 + w * 32 + jc * 16 + lr;
    float lm = p.lam[(l * 2 + dir) * D + cgl];
    spl[jc] = -8.f * 1.4426950408889634f * log1pf(expf(-lm));
    brr[jc] = -1.4426950408889634f * p.b_rg[((l * 2 + dir) * 2 + 0) * D + cgl];
    bii[jc] = -1.4426950408889634f * p.b_rg[((l * 2 + dir) * 2 + 1) * D + cgl];
  }
  const int c8 = tid & 15, tg = tid >> 4;
  float* sCw = (float*)(smem_raw + 65536);
  for (int i = tid; i < 640; i += 256) {
    int k = i >> 7, c = i & 127;
    sCw[i] = k < 4 ? p.conv_w[(l * 4 + k) * D + head * 128 + c] : p.conv_b[l * D + head * 128 + c];
  }
  __syncthreads();
  uint4 xr[7];
#define LOAD_XROWS(TT) do { const int _g0 = (TT) * 64; const int _sq = seq_of(_g0), _ss = seq_start(_sq), _se = _ss + seq_len(_sq); \
    _Pragma("unroll") for (int r = 0; r < 7; ++r) { int _g = _g0 + tg * 4 - 2 + r; xr[r] = make_uint4(0, 0, 0, 0); \
      if (_g >= _ss && _g < _se) xr[r] = *(const uint4*)(xa + ((unsigned)_g * D + head * 128 + c8 * 8)); } } while (0)
  if (tstart < 1280) LOAD_XROWS(tstart);
  for (int tt = tstart; tt < 1280; tt += tstep) {
    const int g0 = tt * 64;
    const int seq = seq_of(g0), sst = seq_start(seq), send = sst + seq_len(seq);
#pragma unroll
    for (int j = 0; j < 4; ++j) {
      float o[8];
      {
        float4 b0 = *(const float4*)(sCw + 512 + c8 * 8), b1 = *(const float4*)(sCw + 512 + c8 * 8 + 4);
        o[0] = b0.x; o[1] = b0.y; o[2] = b0.z; o[3] = b0.w; o[4] = b1.x; o[5] = b1.y; o[6] = b1.z; o[7] = b1.w;
      }
#pragma unroll
      for (int k = 0; k < 4; ++k) {
        uint4 v = xr[j + k];
        float4 w0 = *(const float4*)(sCw + k * 128 + c8 * 8), w1 = *(const float4*)(sCw + k * 128 + c8 * 8 + 4);
        o[0] += w0.x * lo2f(v.x); o[1] += w0.y * hi2f(v.x);
        o[2] += w0.z * lo2f(v.y); o[3] += w0.w * hi2f(v.y);
        o[4] += w1.x * lo2f(v.z); o[5] += w1.y * hi2f(v.z);
        o[6] += w1.z * lo2f(v.w); o[7] += w1.w * hi2f(v.w);
      }
      uint4 q0;
      q0.x = pack2(o[0], o[1]); q0.y = pack2(o[2], o[3]); q0.z = pack2(o[4], o[5]); q0.w = pack2(o[6], o[7]);
      const int tl = tg * 4 + j;
      *(uint4*)(sXc + tl * 128 + ((c8 ^ (tl & 7)) << 3)) = q0;
    }
    __syncthreads();
    if (tt + tstep < 1280) LOAD_XROWS(tt + tstep);
    const int gstart = dir == 0 ? sst : send - 1;
#pragma unroll 1
    for (int hv = 0; hv < 2; ++hv) {
      f32x4 acc[2][4];
#pragma unroll
      for (int it = 0; it < 2; ++it)
#pragma unroll
        for (int jt = 0; jt < 4; ++jt) acc[it][jt] = f32x4{0.f, 0.f, 0.f, 0.f};
#pragma unroll
      for (int ks = 0; ks < 4; ++ks) {
#pragma unroll
        for (int it = 0; it < 2; ++it) {
          bf16x8 af = *(const bf16x8*)(sXc + ((hv * 2 + it) * 16 + lr) * 128 + (((ks * 4 + quad) ^ (lr & 7)) << 3));
#pragma unroll
          for (int jt = 0; jt < 4; ++jt)
            acc[it][jt] = __builtin_amdgcn_mfma_f32_16x16x32_bf16(af, bw[jt][ks], acc[it][jt], 0, 0, 0);
        }
      }
#pragma unroll
      for (int it = 0; it < 2; ++it)
#pragma unroll
        for (int jc = 0; jc < 2; ++jc) {
#pragma unroll
          for (int r = 0; r < 4; ++r) {
            int tl = (hv * 2 + it) * 16 + quad * 4 + r, c = w * 32 + jc * 16 + lr;
            float er = 1.f + __builtin_amdgcn_exp2f(fminf(fmaf(acc[it][jc][r], -1.4426950408889634f, brr[jc]), 60.f));
            float ei = 1.f + __builtin_amdgcn_exp2f(fminf(fmaf(acc[it][2 + jc][r], -1.4426950408889634f, bii[jc]), 60.f));
            float q = __builtin_amdgcn_rcpf(er * ei);
            float rr = q * ei, ii = q * er;
            float a = __builtin_amdgcn_exp2f(rr * spl[jc]);
            float mult = __builtin_amdgcn_sqrtf((1.f - a) * (1.f + a));
            if (g0 + tl == gstart) mult = 1.f;
            float xv = bf2f(sXc[tl * 128 + (((c >> 3) ^ (tl & 7)) << 3) + (c & 7)]);
            sAf[tl * SA_LD + c] = a;
            sBh[tl * 128 + c] = f2bf(mult * ii * xv);
          }
        }
    }
    __syncthreads();
    if (tid < 128) {
      const int c = tid;
      const unsigned aidx = (unsigned)(tt * 2 + dir) * 1024 + head * 128 + c;
      const float* ap = sAf + c;
      u16* bp = sBh + c;
      if (PASS == 1) {
        float h = 0.f, P = 1.f;
        if (dir == 0) {
#pragma unroll 16
          for (int st = 0; st < 64; ++st) { float a = ap[st * SA_LD]; h = a * h + bf2f(bp[st * 128]); P *= a; }
        } else {
#pragma unroll 16
          for (int st = 63; st >= 0; --st) { float a = ap[st * SA_LD]; h = a * h + bf2f(bp[st * 128]); P *= a; }
        }
        agg[aidx] = make_float2(P, h);
      } else {
        float h = carry[aidx];
        if (dir == 0) {
#pragma unroll 16
          for (int st = 0; st < 64; ++st) { h = ap[st * SA_LD] * h + bf2f(bp[st * 128]); bp[st * 128] = f2bf(h); }
        } else {
#pragma unroll 16
          for (int st = 63; st >= 0; --st) { h = ap[st * SA_LD] * h + bf2f(bp[st * 128]); bp[st * 128] = f2bf(h); }
        }
      }
    }
    if (PASS == 3) {
      __syncthreads();
#pragma unroll
      for (int cch = 0; cch < 4; ++cch) {
        int chunk = tid + cch * 256;
        int t = chunk >> 4, cc = (chunk & 15) * 8;
        unsigned off = (unsigned)(g0 + t) * D + head * 128 + cc;
        uint4 hv = *(const uint4*)(sBh + t * 128 + cc);
        if (dir == 0) {
          *(uint4*)(hf + off) = hv;
        } else {
          uint4 fv = *(const uint4*)(hf + off);
          uint4 gv = *(const uint4*)(ga + off);
          uint4 o;
          o.x = pack2((lo2f(fv.x) + lo2f(hv.x)) * lo2f(gv.x), (hi2f(fv.x) + hi2f(hv.x)) * hi2f(gv.x));
          o.y = pack2((lo2f(fv.y) + lo2f(hv.y)) * lo2f(gv.y), (hi2f(fv.y) + hi2f(hv.y)) * hi2f(gv.y));
          o.z = pack2((lo2f(fv.z) + lo2f(hv.z)) * lo2f(gv.z), (hi2f(fv.z) + hi2f(hv.z)) * hi2f(gv.z));
          o.w = pack2((lo2f(fv.w) + lo2f(hv.w)) * lo2f(gv.w), (hi2f(fv.w) + hi2f(hv.w)) * hi2f(gv.w));
          *(uint4*)(ga + off) = o;
        }
      }
    }
    __syncthreads();
  }
#undef LOAD_XROWS
}

DEVFN void lb_st64(unsigned long long* q, unsigned long long v) { __hip_atomic_store(q, v, __ATOMIC_RELAXED, __HIP_MEMORY_SCOPE_AGENT); }
DEVFN unsigned long long lb_ld64(const unsigned long long* q) { return __hip_atomic_load(q, __ATOMIC_RELAXED, __HIP_MEMORY_SCOPE_AGENT); }
DEVFN void lb_st32(unsigned* q, unsigned v) { __hip_atomic_store(q, v, __ATOMIC_RELAXED, __HIP_MEMORY_SCOPE_AGENT); }
DEVFN unsigned lb_ld32(const unsigned* q) { return __hip_atomic_load(q, __ATOMIC_RELAXED, __HIP_MEMORY_SCOPE_AGENT); }
DEVFN unsigned long long lb_pack(float a, float b) { return (unsigned long long)__float_as_uint(a) | ((unsigned long long)__float_as_uint(b) << 32); }
DEVFN int lb_rank(int seq, int pos) { return seq == 0 ? (pos >> 1) * 10 + ((pos & 1) ? 9 : 0) : pos * 10 + seq; }
DEVFN void lb_decode(int r, int dir, int& seq, int& pos, int& tt) {
  int pair = r / 10, j = r - pair * 10;
  if (j == 0) { seq = 0; pos = 2 * pair; } else if (j == 9) { seq = 0; pos = 2 * pair + 1; } else { seq = j; pos = pair; }
  int len = seq == 0 ? 256 : 128;
  tt = (seq_start(seq) >> 6) + (dir ? len - 1 - pos : pos);
}
DEVFN void phase_scan_lb(const Params& p, int l, unsigned char* smem_raw) {
  float* sAf = (float*)smem_raw;
  u16* sBh = (u16*)(smem_raw + 32768);
  u16* sXc = (u16*)(smem_raw + 32768 + 16384);
  unsigned* sflag = (unsigned*)(smem_raw + 65536 + 2560);
  const int tid = otid(), lane = tid & 63, w = tid >> 6, lr = lane & 15, quad = lane >> 4;
  const int hd = blockIdx.x & 15, head = hd >> 1, dir = hd & 1;
  const int rstart = blockIdx.x >> 4, rstep = gridDim.x >> 4;
  const u16* xa = U(p, 1);
  u16* ga = U(p, 2);
  u16* hown = dir == 0 ? U(p, 5) : U(p, 4);
  const u16* hoth = dir == 0 ? U(p, 4) : U(p, 5);
  unsigned long long* slot = (unsigned long long*)(p.ws + OFF_LB_BYTES);
  unsigned* stat = (unsigned*)(p.ws + OFF_LB_BYTES + LB_SLOT_BYTES);
  unsigned* cnt = stat + 20480;
  const unsigned ep = 2u * (unsigned)l;
  bf16x8 bw[4][4];
  {
    const u16* wrg = WL(p, l) + W_RG;
#pragma unroll
    for (int jt = 0; jt < 4; ++jt) {
      int q = jt >> 1, col = w * 32 + (jt & 1) * 16 + lr;
      const u16* bp = wrg + (unsigned)((((dir * 2 + q) * 8 + head) * 128 + col) * 128 + quad * 8);
#pragma unroll
      for (int ks = 0; ks < 4; ++ks) bw[jt][ks] = *(const bf16x8*)(bp + ks * 32);
    }
  }
  float spl[2], brr[2], bii[2];
#pragma unroll
  for (int jc = 0; jc < 2; ++jc) {
    int cgl = head * 128 + w * 32 + jc * 16 + lr;
    float lm = p.lam[(l * 2 + dir) * D + cgl];
    spl[jc] = -8.f * 1.4426950408889634f * log1pf(expf(-lm));
    brr[jc] = -1.4426950408889634f * p.b_rg[((l * 2 + dir) * 2 + 0) * D + cgl];
    bii[jc] = -1.4426950408889634f * p.b_rg[((l * 2 + dir) * 2 + 1) * D + cgl];
  }
  const int c8 = tid & 15, tg = tid >> 4;
  float* sCw = (float*)(smem_raw + 65536);
  for (int i = tid; i < 640; i += 256) {
    int k = i >> 7, c = i & 127;
    sCw[i] = k < 4 ? p.conv_w[(l * 4 + k) * D + head * 128 + c] : p.conv_b[l * D + head * 128 + c];
  }
  __syncthreads();
  uint4 xr[7];
#define LOAD_XROWS(TT) do { const int _g0 = (TT) * 64; const int _sq = seq_of(_g0), _ss = seq_start(_sq), _se = _ss + seq_len(_sq); \
    _Pragma("unroll") for (int r_ = 0; r_ < 7; ++r_) { int _g = _g0 + tg * 4 - 2 + r_; xr[r_] = make_uint4(0, 0, 0, 0); \
      if (_g >= _ss && _g < _se) xr[r_] = *(const uint4*)(xa + ((unsigned)_g * D + head * 128 + c8 * 8)); } } while (0)
  if (rstart < 1280) { int sq_, ps_, t0_; lb_decode(rstart, dir, sq_, ps_, t0_); LOAD_XROWS(t0_); }
  for (int r = rstart; r < 1280; r += rstep) {
    int seq, pos, tt;
    lb_decode(r, dir, seq, pos, tt);
    const int item = r * 16 + hd;
    const int g0 = tt * 64;
    const int sst = seq_start(seq), send = sst + seq_len(seq);
#pragma unroll
    for (int j = 0; j < 4; ++j) {
      float o[8];
      {
        float4 b0 = *(const float4*)(sCw + 512 + c8 * 8), b1 = *(const float4*)(sCw + 512 + c8 * 8 + 4);
        o[0] = b0.x; o[1] = b0.y; o[2] = b0.z; o[3] = b0.w; o[4] = b1.x; o[5] = b1.y; o[6] = b1.z; o[7] = b1.w;
      }
#pragma unroll
      for (int k = 0; k < 4; ++k) {
        uint4 v = xr[j + k];
        float4 w0 = *(const float4*)(sCw + k * 128 + c8 * 8), w1 = *(const float4*)(sCw + k * 128 + c8 * 8 + 4);
        o[0] += w0.x * lo2f(v.x); o[1] += w0.y * hi2f(v.x);
        o[2] += w0.z * lo2f(v.y); o[3] += w0.w * hi2f(v.y);
        o[4] += w1.x * lo2f(v.z); o[5] += w1.y * hi2f(v.z);
        o[6] += w1.z * lo2f(v.w); o[7] += w1.w * hi2f(v.w);
      }
      uint4 q0;
      q0.x = pack2(o[0], o[1]); q0.y = pack2(o[2], o[3]); q0.z = pack2(o[4], o[5]); q0.w = pack2(o[6], o[7]);
      const int tl = tg * 4 + j;
      *(uint4*)(sXc + tl * 128 + ((c8 ^ (tl & 7)) << 3)) = q0;
    }
    __syncthreads();
    if (r + rstep < 1280) { int sq_, ps_, t1_; lb_decode(r + rstep, dir, sq_, ps_, t1_); LOAD_XROWS(t1_); }
    const int gstart = dir == 0 ? sst : send - 1;
#pragma unroll 1
    for (int hv = 0; hv < 2; ++hv) {
      f32x4 acc[2][4];
#pragma unroll
      for (int it = 0; it < 2; ++it)
#pragma unroll
        for (int jt = 0; jt < 4; ++jt) acc[it][jt] = f32x4{0.f, 0.f, 0.f, 0.f};
#pragma unroll
      for (int ks = 0; ks < 4; ++ks) {
#pragma unroll
        for (int it = 0; it < 2; ++it) {
          bf16x8 af = *(const bf16x8*)(sXc + ((hv * 2 + it) * 16 + lr) * 128 + (((ks * 4 + quad) ^ (lr & 7)) << 3));
#pragma unroll
          for (int jt = 0; jt < 4; ++jt)
            acc[it][jt] = __builtin_amdgcn_mfma_f32_16x16x32_bf16(af, bw[jt][ks], acc[it][jt], 0, 0, 0);
        }
      }
#pragma unroll
      for (int it = 0; it < 2; ++it)
#pragma unroll
        for (int jc = 0; jc < 2; ++jc) {
#pragma unroll
          for (int r = 0; r < 4; ++r) {
            int tl = (hv * 2 + it) * 16 + quad * 4 + r, c = w * 32 + jc * 16 + lr;
            float er = 1.f + __builtin_amdgcn_exp2f(fminf(fmaf(acc[it][jc][r], -1.4426950408889634f, brr[jc]), 60.f));
            float ei = 1.f + __builtin_amdgcn_exp2f(fminf(fmaf(acc[it][2 + jc][r], -1.4426950408889634f, bii[jc]), 60.f));
            float q = __builtin_amdgcn_rcpf(er * ei);
            float rr = q * ei, ii = q * er;
            float a = __builtin_amdgcn_exp2f(rr * spl[jc]);
            float mult = __builtin_amdgcn_sqrtf((1.f - a) * (1.f + a));
            if (g0 + tl == gstart) mult = 1.f;
            float xv = bf2f(sXc[tl * 128 + (((c >> 3) ^ (tl & 7)) << 3) + (c & 7)]);
            sAf[tl * SA_LD + c] = a;
            sBh[tl * 128 + c] = f2bf(mult * ii * xv);
          }
        }
    }
    __syncthreads();
    float aggP = 1.f, aggH = 0.f;
    if (tid < 128) {
      const float* ap = sAf + tid;
      const u16* bp = sBh + tid;
      if (dir == 0) {
#pragma unroll 16
        for (int st = 0; st < 64; ++st) { float a = ap[st * SA_LD]; aggH = a * aggH + bf2f(bp[st * 128]); aggP *= a; }
      } else {
#pragma unroll 16
        for (int st = 63; st >= 0; --st) { float a = ap[st * SA_LD]; aggH = a * aggH + bf2f(bp[st * 128]); aggP *= a; }
      }
      lb_st64(slot + (unsigned)item * 128 + tid, lb_pack(pos == 0 ? 0.f : aggP, aggH));
    }
    asm volatile("s_waitcnt vmcnt(0)" ::: "memory");
    __syncthreads();
    if (tid == 0) lb_st32(stat + item, ep + (pos == 0 ? 2u : 1u));
    float carry = 0.f;
    if (pos > 0) {
      if (tid < 128) {
        float Pr = 1.f, Hr = 0.f;
        int pj = pos - 1;
        for (;;) {
          const int j = lb_rank(seq, pj) * 16 + hd;
          unsigned sv, spins = 0;
          while ((sv = lb_ld32(stat + j)) < ep + 1u) { __builtin_amdgcn_s_sleep(1); if (++spins > (1u << 18)) break; }
          unsigned long long v = lb_ld64(slot + (unsigned)j * 128 + tid);
          float Pj = __uint_as_float((unsigned)v), Hj = __uint_as_float((unsigned)(v >> 32));
          Hr += Pr * Hj;
          Pr *= Pj;
          if (sv >= ep + 2u || pj == 0) break;
          --pj;
        }
        carry = Hr;
        lb_st64(slot + (unsigned)item * 128 + tid, lb_pack(0.f, aggP * carry + aggH));
      }
      asm volatile("s_waitcnt vmcnt(0)" ::: "memory");
      __syncthreads();
      if (tid == 0) lb_st32(stat + item, ep + 2u);
    }
    if (tid < 128) {
      const float* ap = sAf + tid;
      u16* bp = sBh + tid;
      float h = carry;
      if (dir == 0) {
#pragma unroll 16
        for (int st = 0; st < 64; ++st) { h = ap[st * SA_LD] * h + bf2f(bp[st * 128]); bp[st * 128] = f2bf(h); }
      } else {
#pragma unroll 16
        for (int st = 63; st >= 0; --st) { h = ap[st * SA_LD] * h + bf2f(bp[st * 128]); bp[st * 128] = f2bf(h); }
      }
    }
    __syncthreads();
#pragma unroll
    for (int cch = 0; cch < 4; ++cch) {
      int chunk = tid + cch * 256;
      int t = chunk >> 4, cc = (chunk & 15) * 8;
      unsigned off = (unsigned)(g0 + t) * D + head * 128 + cc;
      uint4 hv = *(const uint4*)(sBh + t * 128 + cc);
      unsigned long long* q = (unsigned long long*)(hown + off);
      lb_st64(q, (unsigned long long)hv.x | ((unsigned long long)hv.y << 32));
      lb_st64(q + 1, (unsigned long long)hv.z | ((unsigned long long)hv.w << 32));
    }
    asm volatile("s_waitcnt vmcnt(0)" ::: "memory");
    __syncthreads();
    if (tid == 0) sflag[0] = __hip_atomic_fetch_add(cnt + tt * 8 + head, 1u, __ATOMIC_RELAXED, __HIP_MEMORY_SCOPE_AGENT);
    __syncthreads();
    if (sflag[0] == ep + 1u) {
#pragma unroll
      for (int cch = 0; cch < 4; ++cch) {
        int chunk = tid + cch * 256;
        int t = chunk >> 4, cc = (chunk & 15) * 8;
        unsigned off = (unsigned)(g0 + t) * D + head * 128 + cc;
        uint4 hv = *(const uint4*)(sBh + t * 128 + cc);
        const unsigned long long* q = (const unsigned long long*)(hoth + off);
        unsigned long long f0 = lb_ld64(q), f1 = lb_ld64(q + 1);
        uint4 fv = make_uint4((unsigned)f0, (unsigned)(f0 >> 32), (unsigned)f1, (unsigned)(f1 >> 32));
        uint4 gv = *(const uint4*)(ga + off);
        uint4 o;
        o.x = pack2((lo2f(fv.x) + lo2f(hv.x)) * lo2f(gv.x), (hi2f(fv.x) + hi2f(hv.x)) * hi2f(gv.x));
        o.y = pack2((lo2f(fv.y) + lo2f(hv.y)) * lo2f(gv.y), (hi2f(fv.y) + hi2f(hv.y)) * hi2f(gv.y));
        o.z = pack2((lo2f(fv.z) + lo2f(hv.z)) * lo2f(gv.z), (hi2f(fv.z) + hi2f(hv.z)) * hi2f(gv.z));
        o.w = pack2((lo2f(fv.w) + lo2f(hv.w)) * lo2f(gv.w), (hi2f(fv.w) + hi2f(hv.w)) * hi2f(gv.w));
        *(uint4*)(ga + off) = o;
      }
    }
    __syncthreads();
  }
#undef LOAD_XROWS
}

DEVFN void phase_carry(const Params& p) {
  const float2* __restrict__ agg = (const float2*)U(p, 4);
  float* __restrict__ carry = (float*)(agg + 1280L * 2 * 1024);
  const int lane = threadIdx.x & 63, w = threadIdx.x >> 6;
  for (int u = blockIdx.x + gridDim.x * w; u < 288; u += gridDim.x * 4) {
    int id = u * 64 + lane;
    int seq = id >> 11, dir = (id >> 10) & 1, c = id & 1023;
    int nt = seq_len(seq) >> 6, tile0 = seq_start(seq) >> 6;
    float h = 0.f;
#pragma unroll 8
    for (int k = 0; k < nt; ++k) {
      int tt = tile0 + (dir ? nt - 1 - k : k);
      unsigned ix = (unsigned)(tt * 2 + dir) * 1024 + c;
      float2 v = agg[ix];
      carry[ix] = h;
      h = v.x * h + v.y;
    }
  }
}

DEVFN void phase_merge(const Params& p, int l, u16* smem) {
  const u16* wl = WL(p, l);
  u16* mo = U(p, 1);
  u16* tb = U(p, 5);
  for (int it = 0;; ++it) {
    int mt, nt;
    if (!tile_xcd(it, 1, 8, mt, nt)) break;
    const int g0 = mt * 256;
#pragma unroll 1
    for (int br = 0; br < 2; ++br) {
      {
        const int tid = otid(), lane = tid & 63, w = tid >> 6, wm = w >> 1, wn = w & 1, lr = lane & 15, quad = lane >> 4;
        f32x4 acc[8][4]; zero_acc8(acc);
        LdPlain lb; lb.init(tid, wl + (br == 0 ? W_A : W_B), nt * 128, D);
        if (br == 0) {
          LdPlain la; la.init(tid, U(p, 2), g0, D);
          gemm_core_b(tid, acc, 32, la, lb, smem);
        } else {
          const int seq = seq_of(g0);
          LdPerm la; la.base = U(p, 3); la.g0 = g0; la.sst = seq_start(seq); la.lg = seq == 0 ? 7 : 6;
          gemm_core_b(tid, acc, 32, la, lb, smem);
        }
#pragma unroll
        for (int i = 0; i < 8; ++i) {
          unsigned g = g0 + wm * 128 + i * 16 + lr;
#pragma unroll
          for (int j = 0; j < 4; ++j) {
            unsigned c = nt * 128 + wn * 64 + j * 16 + quad * 4;
            uint2 o; o.x = pack2(acc[i][j][0], acc[i][j][1]); o.y = pack2(acc[i][j][2], acc[i][j][3]);
            *(uint2*)(tb + (g * D + c)) = o;
          }
        }
      }
      {
        const int tid = otid(), lane = tid & 63, w = tid >> 6, wm = w >> 1, wn = w & 1, lr = lane & 15, quad = lane >> 4;
        f32x4 acc[8][4]; zero_acc8(acc);
        LdPlain la; la.init(tid, U(p, 0), g0, D);
        LdPlain lb; lb.init(tid, wl + W_CAT, 5120 + br * 1024 + nt * 128, D);
        gemm_core_b(tid, acc, 32, la, lb, smem);
#pragma unroll
        for (int i = 0; i < 8; ++i) {
          unsigned g = g0 + wm * 128 + i * 16 + lr;
#pragma unroll
          for (int j = 0; j < 4; ++j) {
            unsigned c = nt * 128 + wn * 64 + j * 16 + quad * 4;
            uint2 tv = *(const uint2*)(tb + (g * D + c));
            float v0 = sigm(acc[i][j][0]) * lo2f(tv.x);
            float v1 = sigm(acc[i][j][1]) * hi2f(tv.x);
            float v2 = sigm(acc[i][j][2]) * lo2f(tv.y);
            float v3 = sigm(acc[i][j][3]) * hi2f(tv.y);
            uint2* op = (uint2*)(mo + (g * D + c));
            if (br == 1) {
              uint2 pv = *op;
              v0 += lo2f(pv.x); v1 += hi2f(pv.x); v2 += lo2f(pv.y); v3 += hi2f(pv.y);
            }
            uint2 o; o.x = pack2(v0, v1); o.y = pack2(v2, v3);
            *op = o;
          }
        }
      }
    }
  }
}

DEVFN void phase_out(const Params& p, int l, u16* smem) {
  const u16* wo = WL(p, l) + W_O;
  for (int it = 0;; ++it) {
    int mt, nt;
    if (!tile_xcd(it, 1, 8, mt, nt)) break;
    const int tid = otid(), lane = tid & 63, w = tid >> 6, wm = w >> 1, wn = w & 1, lr = lane & 15, quad = lane >> 4;
    const int g0 = mt * 256;
    LdPlain la; la.init(tid, U(p, 1), g0, D);
    LdPlain lb; lb.init(tid, wo, nt * 128, D);
    f32x4 acc[8][4]; zero_acc8(acc);
    gemm_core_b(tid, acc, 32, la, lb, smem);
    const float* gate = MOD(p) + ((long)l * 9 + seq_of(g0)) * 3072 + 2048;
#pragma unroll
    for (int i = 0; i < 8; ++i) {
      unsigned g = g0 + wm * 128 + i * 16 + lr;
      const float* xb = (l == 0) ? (g0 < 16384 ? p.x_prompt : p.x_sample) : p.out;
      const float* xr = xb + (unsigned)((l == 0 && g0 >= 16384) ? g - 16384 : g) * D;
      float* orow = p.out + g * D;
#pragma unroll
      for (int j = 0; j < 4; ++j) {
        unsigned c = nt * 128 + wn * 64 + j * 16 + quad * 4;
        float4 xv = *(const float4*)(xr + c);
        float4 gt = *(const float4*)(gate + c);
        float4 o;
        o.x = xv.x + gt.x * acc[i][j][0]; o.y = xv.y + gt.y * acc[i][j][1];
        o.z = xv.z + gt.z * acc[i][j][2]; o.w = xv.w + gt.w * acc[i][j][3];
        *(float4*)(orow + c) = o;
      }
    }
  }
}

#define XB_TMO      128
#define XB_XCNT(j)  (256  + 64 * (j))
#define XB_XSUB(j)  (1280 + 64 * (j))
#define XB_XGEN(j)  (2304 + 64 * (j))
#define XB_TOP      3328
#define XB_TOPGEN   3392
#define XCD_BAR_WORDS 3456
#define XB_SPIN_CAP (1u << 18)
#define LAS __attribute__((address_space(3)))

__device__ __forceinline__ unsigned xb_ld(unsigned* p)              { return __hip_atomic_load(p, __ATOMIC_RELAXED, __HIP_MEMORY_SCOPE_AGENT); }
__device__ __forceinline__ unsigned xb_add(unsigned* p, unsigned v) { return __hip_atomic_fetch_add(p, v, __ATOMIC_RELAXED, __HIP_MEMORY_SCOPE_AGENT); }
__device__ __forceinline__ unsigned xb_xcc_id() { return (unsigned)__builtin_amdgcn_s_getreg((3 << 11) | 20) & 0xFu; }
#define XB_SPIN(cond, bar) do { unsigned _sp = 0; while (cond) { __builtin_amdgcn_s_sleep(1); \
    if ((++_sp & 255u) == 0u) { if (xb_ld(&(bar)[XB_TMO])) break; if (_sp > XB_SPIN_CAP) { atomicAdd(&(bar)[XB_TMO], 1u); break; } } } } while (0)

struct XcdBarrier {
    unsigned* bar; unsigned x;
    volatile LAS unsigned* st;
};

__device__ __forceinline__ XcdBarrier xcd_barrier_post(unsigned* bar, volatile LAS unsigned* st) {
    XcdBarrier b; b.bar = bar; b.x = xb_xcc_id(); b.st = st;
    if (threadIdx.x == 0) (void)xb_add(&bar[XB_XCNT(b.x)], 1u);
    return b;
}
__device__ __forceinline__ void xcd_barrier_complete(unsigned* bar, unsigned x, unsigned& nloc, unsigned& nx) {
    const unsigned G = gridDim.x * gridDim.y * gridDim.z;
    unsigned sum, cnt, mine, sp = 0u;
    for (;;) {
        sum = 0u; cnt = 0u; mine = 0u;
#pragma unroll
        for (unsigned j = 0; j < 16; ++j) { const unsigned c = xb_ld(&bar[XB_XCNT(j)]); sum += c; cnt += (c > 0u) ? 1u : 0u; mine = (j == x) ? c : mine; }
        if (sum == G) break;
        __builtin_amdgcn_s_sleep(1);
        if ((++sp & 255u) == 0u) { if (xb_ld(&bar[XB_TMO])) break; if (sp > XB_SPIN_CAP) { atomicAdd(&bar[XB_TMO], 1u); break; } }
    }
    nloc = mine > 0u ? mine : 1u; nx = cnt > 0u ? cnt : 1u;
}

__device__ __forceinline__ void xcd_barrier(const XcdBarrier& b) {
    asm volatile("s_waitcnt vmcnt(0)" ::: "memory");
    __syncthreads();
    if (threadIdx.x == 0) {
        unsigned* bar = b.bar;
        __builtin_amdgcn_s_waitcnt(0);
        unsigned nloc = b.st[0], nx = b.st[1];
        if (nloc == 0u) { xcd_barrier_complete(bar, b.x, nloc, nx); b.st[0] = nloc; b.st[1] = nx; }
        const unsigned old = xb_add(&bar[XB_XSUB(b.x)], 1u);
        const unsigned gen = old / nloc;
        if (old + 1u == (gen + 1u) * nloc) {
            __builtin_amdgcn_fence(__ATOMIC_RELEASE, "agent");
            asm volatile("s_waitcnt vmcnt(0)" ::: "memory");
            const unsigned og = xb_add(&bar[XB_TOP], 1u);
            const unsigned tg = og / nx;
            if (og + 1u == (tg + 1u) * nx) xb_add(&bar[XB_TOPGEN], 1u);
            else XB_SPIN(xb_ld(&bar[XB_TOPGEN]) == tg, bar);
            __builtin_amdgcn_fence(__ATOMIC_ACQUIRE, "agent");
            xb_add(&bar[XB_XGEN(b.x)], 1u);
            asm volatile("s_waitcnt vmcnt(0)" ::: "memory");
        } else {
            XB_SPIN(xb_ld(&bar[XB_XGEN(b.x)]) == gen, bar);
            __builtin_amdgcn_fence(__ATOMIC_ACQUIRE, "agent");
            asm volatile("s_waitcnt vmcnt(0)" ::: "memory");
        }
    }
    __syncthreads();
}


__global__ void __launch_bounds__(256, 2) hawk_fnet_megakernel(Params p) {
  extern __shared__ __attribute__((aligned(16))) unsigned char smem_raw[];
  cg::grid_group grid = cg::this_grid();
  u16* smem = (u16*)smem_raw;

  __shared__ unsigned xb_st[4];
  unsigned* bar = (unsigned*)(p.ws + OFF_BAR_BYTES);
  if (blockIdx.x == 0) {
    for (int i = threadIdx.x; i < XCD_BAR_WORDS; i += 256) __hip_atomic_store(&bar[i], 0u, __ATOMIC_RELAXED, __HIP_MEMORY_SCOPE_AGENT);
  }
  if (threadIdx.x < 4) xb_st[threadIdx.x] = 0u;
  {
    unsigned* lbs = (unsigned*)(p.ws + OFF_LB_BYTES + LB_SLOT_BYTES);
    for (int i = blockIdx.x * 256 + threadIdx.x; i < 20480 + 10240; i += gridDim.x * 256)
      __hip_atomic_store(&lbs[i], 0u, __ATOMIC_RELAXED, __HIP_MEMORY_SCOPE_AGENT);
  }
  phase_prologue(p, smem_raw);
  grid.sync();
  XcdBarrier xb = xcd_barrier_post(bar, (volatile LAS unsigned*)xb_st);
  phase_fold(p, smem);
  phase_h(p, 0);
  xcd_barrier(xb);
  for (int l = 0; l < 2; ++l) {
    phase_gemm1(p, l, smem);
    xcd_barrier(xb);
    phase_fft1(p, smem);
    xcd_barrier(xb);
    phase_fft2(p, smem);
    xcd_barrier(xb);
    phase_scan_lb(p, l, smem_raw);
    xcd_barrier(xb);
    phase_merge(p, l, smem);
    xcd_barrier(xb);
    phase_out(p, l, smem);
    xcd_barrier(xb);
    if (l == 0) { phase_h(p, 1); xcd_barrier(xb); }
  }
  phase_final(p);
}

extern "C" void kernel_launch(void* const* d_in, const int* in_sizes, int n_in,
                              void* d_out, int out_size, void* d_ws, size_t ws_size,
                              hipStream_t stream) {
  (void)in_sizes; (void)n_in; (void)out_size;
  if (ws_size < (size_t)WS_NEED) {
    fprintf(stderr, "workspace too small: %zu < %ld\n", ws_size, (long)WS_NEED);
    return;
  }
  static int grid_blocks = 0;
  if (!grid_blocks) {
    hipFuncSetAttribute((const void*)hawk_fnet_megakernel, hipFuncAttributeMaxDynamicSharedMemorySize, SMEM_BYTES);
    int dev = 0, cus = 0, per_cu = 0;
    hipGetDevice(&dev);
    hipDeviceGetAttribute(&cus, hipDeviceAttributeMultiprocessorCount, dev);
    hipOccupancyMaxActiveBlocksPerMultiprocessor(&per_cu, hawk_fnet_megakernel, 256, SMEM_BYTES);
    if (per_cu > 2) per_cu = 2;
    if (per_cu < 1) per_cu = 1;
    grid_blocks = (cus * per_cu) & ~15;
  }
  Params p{};
  p.x_prompt = (const float*)d_in[0]; p.x_sample = (const float*)d_in[1];
  p.c_prompt = (const float*)d_in[2]; p.c_sample = (const float*)d_in[3];
  p.norm_g = (const float*)d_in[4]; p.w_ada = (const float*)d_in[5]; p.b_ada = (const float*)d_in[6];
  p.w_in = (const float*)d_in[7]; p.conv_w = (const float*)d_in[8]; p.conv_b = (const float*)d_in[9];
  p.w_rg = (const float*)d_in[10]; p.b_rg = (const float*)d_in[11]; p.lam = (const float*)d_in[12];
  p.w_a_out = (const float*)d_in[13]; p.w_b_out = (const float*)d_in[14]; p.w_o = (const float*)d_in[15];
  p.final_g = (const float*)d_in[16];
  p.out = (float*)d_out; p.ws = (unsigned char*)d_ws;
  void* args[] = {&p};
  hipError_t e = hipLaunchCooperativeKernel((void*)hawk_fnet_megakernel, dim3(grid_blocks), dim3(256), args, SMEM_BYTES, stream);
  if (e != hipSuccess) fprintf(stderr, "cooperative launch failed: %s (grid %d)\n", hipGetErrorString(e), grid_blocks);
}
```

```cpp
#include <hip/hip_runtime.h>
#include <hip/hip_cooperative_groups.h>
#include <cstdio>
namespace cg = cooperative_groups;

typedef unsigned short u16;
typedef __attribute__((ext_vector_type(8))) short bf16x8;
typedef __attribute__((ext_vector_type(4))) float f32x4;

#define DEVFN __device__ __forceinline__

constexpr int D = 1024;
constexpr int T_TOT = 81920;
constexpr long UNIT = (long)T_TOT * D;
constexpr int D_IN = 6144;

constexpr long OFF_W = 6 * UNIT;
constexpr long W_CAT = 0;
constexpr long W_A = 7168L * 1024;
constexpr long W_B = W_A + 1048576;
constexpr long W_O = W_B + 1048576;
constexpr long W_RG = W_O + 1048576;
constexpr long LW = W_RG + 524288;
constexpr long OFF_TAB = OFF_W + 2 * LW;
constexpr long T_D1A = 0;
constexpr long T_D1B = 65536;
constexpr long T_D2 = T_D1B + 16384;
constexpr long T_DC = T_D2 + 32768;
constexpr long TAB_ELEMS = T_DC + 131072;
constexpr long OFF_TW_BYTES = (OFF_TAB + TAB_ELEMS) * 2;
constexpr long OFF_MOD_BYTES = OFF_TW_BYTES + 131072;
constexpr long OFF_BAR_BYTES = OFF_MOD_BYTES + 221184;
constexpr long OFF_LB_BYTES = OFF_BAR_BYTES + 16384;
constexpr long LB_SLOT_BYTES = 20480L * 128 * 8;
constexpr long WS_NEED = OFF_LB_BYTES + LB_SLOT_BYTES + 20480 * 4 + 10240 * 4;
static_assert(WS_NEED <= (1L << 30), "workspace map exceeds the guaranteed 1 GiB");

constexpr int TILE = 128 * 64;
constexpr int SMEM_BYTES = 73728;

struct Params {
  const float* x_prompt; const float* x_sample; const float* c_prompt; const float* c_sample;
  const float* norm_g; const float* w_ada; const float* b_ada; const float* w_in;
  const float* conv_w; const float* conv_b; const float* w_rg; const float* b_rg; const float* lam;
  const float* w_a_out; const float* w_b_out; const float* w_o; const float* final_g;
  float* out; unsigned char* ws;
};

typedef __attribute__((ext_vector_type(2))) float f32x2_t;
typedef __attribute__((ext_vector_type(2))) __bf16 bf16x2_t;
DEVFN u16 f2bf(float f) {
  __bf16 h = (__bf16)f;
  return *(u16*)&h;
}
DEVFN float bf2f(u16 h) { return __uint_as_float(((unsigned)h) << 16); }
DEVFN unsigned pack2(float a, float b) {
  f32x2_t v = {a, b};
  bf16x2_t r = __builtin_convertvector(v, bf16x2_t);
  return *(unsigned*)&r;
}
DEVFN float lo2f(unsigned v) { return __uint_as_float(v << 16); }
DEVFN float hi2f(unsigned v) { return __uint_as_float(v & 0xffff0000u); }
DEVFN float sigm(float x) { return __builtin_amdgcn_rcpf(1.f + __expf(-x)); }
DEVFN float silu(float x) { return x * __builtin_amdgcn_rcpf(1.f + __expf(-x)); }
DEVFN float one_minus_exp(float x) {
  float pl = -x * (1.f + x * (0.5f + x * (1.f / 6.f + x * (1.f / 24.f + x * (1.f / 120.f + x * (1.f / 720.f))))));
  float dr = 1.f - __expf(x);
  return x > -0.3f ? pl : dr;
}

DEVFN int otid() { int t = threadIdx.x; asm volatile("" : "+v"(t)); return t; }
DEVFN int seq_of(int g) { int seg = g >> 13; return seg < 2 ? 0 : seg - 1; }
DEVFN int seq_start(int s) { return s == 0 ? 0 : 16384 + (s - 1) * 8192; }
DEVFN int seq_len(int s) { return s == 0 ? 16384 : 8192; }

DEVFN u16* U(const Params& p, int i) { return (u16*)(p.ws) + (long)i * UNIT; }
DEVFN u16* WL(const Params& p, int l) { return (u16*)(p.ws) + OFF_W + (long)l * LW; }
DEVFN u16* TAB(const Params& p) { return (u16*)(p.ws) + OFF_TAB; }
DEVFN float2* TW(const Params& p) { return (float2*)(p.ws + OFF_TW_BYTES); }
DEVFN float* MOD(const Params& p) { return (float*)(p.ws + OFF_MOD_BYTES); }
DEVFN const float* xrow(const Params& p, int g) {
  return g < 16384 ? p.x_prompt + (long)g * D : p.x_sample + (long)(g - 16384) * D;
}

struct LdPlain {
  static constexpr bool kDma = true; static constexpr bool kTr = false;
  const u16* base; unsigned off0; unsigned cst; int t_; unsigned row0_, stride_;
  DEVFN unsigned rowoff(int r) const { return (row0_ + r) * stride_; }
  DEVFN void init(int tid_, const u16* b, unsigned row0, unsigned stride) {
    unsigned tid = tid_; t_ = tid_; row0_ = row0; stride_ = stride;
    base = b;
    off0 = (row0 + (tid >> 3)) * stride + (((tid & 7) ^ ((tid >> 3) & 7)) << 3);
    cst = 32 * stride;
  }
  DEVFN void issue(u16* tile, int c, int kt) const {
    __builtin_amdgcn_global_load_lds((const unsigned*)(base + (off0 + c * cst + kt * 64)),
                                     (unsigned*)(tile + (t_ + c * 256) * 8), 16, 0, 0);
  }
  DEVFN uint4 load(int, int) const { return make_uint4(0, 0, 0, 0); }
  DEVFN void store(u16*, int, uint4) const {}
};
struct LdRows4 {
  static constexpr bool kDma = true; static constexpr bool kTr = false;
  const u16* base; unsigned off[4]; int t_;
  DEVFN void issue(u16* tile, int c, int kt) const {
    __builtin_amdgcn_global_load_lds((const unsigned*)(base + (off[c] + kt * 64)),
                                     (unsigned*)(tile + (t_ + c * 256) * 8), 16, 0, 0);
  }
  DEVFN uint4 load(int, int) const { return make_uint4(0, 0, 0, 0); }
  DEVFN void store(u16*, int, uint4) const {}
};
struct LdF32 {
  static constexpr bool kDma = false; static constexpr bool kTr = false;
  const float* base; unsigned off0; unsigned cst; int t_;
  DEVFN void init(int tid_, const float* b, unsigned row0, unsigned stride, unsigned col0) {
    unsigned tid = tid_; t_ = tid_;
    base = b;
    off0 = (row0 + (tid >> 3)) * stride + col0 + (tid & 7) * 8;
    cst = 32 * stride;
  }
  DEVFN void issue(u16*, int, int) const {}
  DEVFN uint4 load(int c, int kt) const {
    const float4* q = (const float4*)(base + (off0 + c * cst + kt * 64));
    float4 a = q[0], b = q[1];
    uint4 r; r.x = pack2(a.x, a.y); r.y = pack2(a.z, a.w); r.z = pack2(b.x, b.y); r.w = pack2(b.z, b.w);
    return r;
  }
  DEVFN void store(u16* tile, int c, uint4 v) const {
    int idx = t_ + c * 256;
    int row = idx >> 3, kc = idx & 7;
    *(uint4*)(tile + row * 64 + ((kc ^ (row & 7)) << 3)) = v;
  }
};
DEVFN int trf(int r) { return ((r & 3) << 2) | ((r >> 2) & 3); }
template <class TokFn>
struct LdTrans {
  static constexpr bool kDma = false; static constexpr bool kTr = false;
  TokFn tok; int t_;
  DEVFN void issue(u16*, int, int) const {}
  DEVFN uint4 load(int c, int kt) const {
    int idx = t_ + c * 256;
    int kk = idx & 63, cc = idx >> 6;
    const u16* b; unsigned o = tok(kt * 64 + kk, b);
    return *(const uint4*)(b + (o + cc * 8));
  }
  DEVFN void store(u16* tile, int c, uint4 v) const {
    int idx = t_ + c * 256;
    int kk = idx & 63, cc = idx >> 6;
    u16* q = tile + (cc * 8) * 64 + (kk & 7);
    int kc = kk >> 3;
    q[0 * 64 + ((kc ^ 0) << 3)] = (u16)(v.x & 0xffff); q[1 * 64 + ((kc ^ 1) << 3)] = (u16)(v.x >> 16);
    q[2 * 64 + ((kc ^ 2) << 3)] = (u16)(v.y & 0xffff); q[3 * 64 + ((kc ^ 3) << 3)] = (u16)(v.y >> 16);
    q[4 * 64 + ((kc ^ 4) << 3)] = (u16)(v.z & 0xffff); q[5 * 64 + ((kc ^ 5) << 3)] = (u16)(v.z >> 16);
    q[6 * 64 + ((kc ^ 6) << 3)] = (u16)(v.w & 0xffff); q[7 * 64 + ((kc ^ 7) << 3)] = (u16)(v.w >> 16);
  }
};

typedef __attribute__((ext_vector_type(4))) short s16x4;
DEVFN s16x4 lds_tr_read(const u16* q) {
  return __builtin_amdgcn_ds_read_tr16_b64_v4i16((s16x4 __attribute__((address_space(3)))*)(q));
}

DEVFN void zero_acc(f32x4 (&acc)[4][4]) {
#pragma unroll
  for (int i = 0; i < 4; ++i)
#pragma unroll
    for (int j = 0; j < 4; ++j) acc[i][j] = f32x4{0.f, 0.f, 0.f, 0.f};
}

template <class LA, class LB>
DEVFN void gemm_core(int tid, f32x4 (&acc)[4][4], int nk, const LA& la, const LB& lb, u16* smem) {
  const int lane = tid & 63, w = tid >> 6, wm = w >> 1, wn = w & 1;
  const int lr = lane & 15, quad = lane >> 4;
  uint4 ra[4], rb[4];
  if (LA::kDma) {
#pragma unroll
    for (int c = 0; c < 4; ++c) la.issue(smem, c, 0);
  } else {
#pragma unroll
    for (int c = 0; c < 4; ++c) ra[c] = la.load(c, 0);
  }
  if (LB::kDma) {
#pragma unroll
    for (int c = 0; c < 4; ++c) lb.issue(smem + TILE, c, 0);
  } else {
#pragma unroll
    for (int c = 0; c < 4; ++c) rb[c] = lb.load(c, 0);
  }
  if (!LA::kDma) {
#pragma unroll
    for (int c = 0; c < 4; ++c) la.store(smem, c, ra[c]);
  }
  if (!LB::kDma) {
#pragma unroll
    for (int c = 0; c < 4; ++c) lb.store(smem + TILE, c, rb[c]);
  }
  asm volatile("s_waitcnt vmcnt(0)" ::: "memory");
  __syncthreads();
  const int aoff = (wm * 64 + lr) * 64, boff = (wn * 64 + lr) * 64;
  const int sw0 = ((quad) ^ (lr & 7)) << 3, sw1 = ((4 + quad) ^ (lr & 7)) << 3;
  int troff[4][2];
  if (LB::kTr) {
    const int q = lr >> 2, pp = lr & 3;
#pragma unroll
    for (int j = 0; j < 4; ++j)
#pragma unroll
      for (int h = 0; h < 2; ++h) {
        int r = quad * 8 + h * 4 + q;
        int ch = (wn * 8 + j * 2 + (pp >> 1)) ^ trf(r);
        troff[j][h] = r * 128 + ch * 8 + (pp & 1) * 4;
      }
  }
  for (int kt = 0; kt < nk; ++kt) {
    const u16* sA = smem + (kt & 1) * 2 * TILE;
    const u16* sB = sA + TILE;
    u16* nA = smem + ((kt + 1) & 1) * 2 * TILE;
    const bool more = (kt + 1) < nk;
    if (more) {
      if (LA::kDma) {
#pragma unroll
        for (int c = 0; c < 4; ++c) la.issue(nA, c, kt + 1);
      } else {
#pragma unroll
        for (int c = 0; c < 4; ++c) ra[c] = la.load(c, kt + 1);
      }
      if (LB::kDma) {
#pragma unroll
        for (int c = 0; c < 4; ++c) lb.issue(nA + TILE, c, kt + 1);
      } else {
#pragma unroll
        for (int c = 0; c < 4; ++c) rb[c] = lb.load(c, kt + 1);
      }
    }
#pragma unroll
    for (int ks = 0; ks < 2; ++ks) {
      const int sw = ks == 0 ? sw0 : sw1;
      bf16x8 af[4], bfr[4];
#pragma unroll
      for (int i = 0; i < 4; ++i) af[i] = *(const bf16x8*)(sA + aoff + i * 1024 + sw);
      if (LB::kTr) {
#pragma unroll
        for (int j = 0; j < 4; ++j) {
          s16x4 lo = lds_tr_read(sB + troff[j][0] + ks * 4096);
          s16x4 hi = lds_tr_read(sB + troff[j][1] + ks * 4096);
          bfr[j] = __builtin_shufflevector(lo, hi, 0, 1, 2, 3, 4, 5, 6, 7);
        }
      } else {
#pragma unroll
        for (int j = 0; j < 4; ++j) bfr[j] = *(const bf16x8*)(sB + boff + j * 1024 + sw);
      }
      __builtin_amdgcn_s_setprio(1);
#pragma unroll
      for (int i = 0; i < 4; ++i)
#pragma unroll
        for (int j = 0; j < 4; ++j)
          acc[i][j] = __builtin_amdgcn_mfma_f32_16x16x32_bf16(bfr[j], af[i], acc[i][j], 0, 0, 0);
      __builtin_amdgcn_s_setprio(0);
    }
    if (more) {
      if (!LA::kDma) {
#pragma unroll
        for (int c = 0; c < 4; ++c) la.store(nA, c, ra[c]);
      }
      if (!LB::kDma) {
#pragma unroll
        for (int c = 0; c < 4; ++c) lb.store(nA + TILE, c, rb[c]);
      }
    }
    asm volatile("s_waitcnt vmcnt(0)" ::: "memory");
    __syncthreads();
  }
}

struct LdPerm {
  const u16* base; int g0, sst, lg;
  DEVFN unsigned rowoff(int r) const {
    int t = g0 - sst + r;
    int urow = ((t & ((1 << lg) - 1)) << 7) + (t >> lg);
    return (unsigned)(sst + urow) * D;
  }
};
#define GLDS16(gp, lp) __builtin_amdgcn_global_load_lds((const unsigned*)(gp), (unsigned*)(lp), 16, 0, 0)
DEVFN void zero_acc8(f32x4 (&acc)[8][4]) {
#pragma unroll
  for (int i = 0; i < 8; ++i)
#pragma unroll
    for (int j = 0; j < 4; ++j) acc[i][j] = f32x4{0.f, 0.f, 0.f, 0.f};
}
template <class LA, class LB>
DEVFN void gemm_core_b(int tid, f32x4 (&acc)[8][4], int nk, const LA& la, const LB& lb, u16* smem) {
  const int lane = tid & 63, w = tid >> 6, wm = w >> 1, wn = w & 1;
  const int lr = lane & 15, quad = lane >> 4;
  const int r0 = tid >> 2;
  const unsigned sw = (unsigned)(((tid & 3) ^ ((0 - (tid >> 4)) & 3)) << 3);
  const unsigned oa0 = la.rowoff(r0) + sw, oa1 = la.rowoff(r0 + 64) + sw, oa2 = la.rowoff(r0 + 128) + sw, oa3 = la.rowoff(r0 + 192) + sw;
  const unsigned ob0 = lb.rowoff(r0) + sw, ob1 = lb.rowoff(r0 + 64) + sw;
  const u16* ga = la.base; const u16* gb = lb.base;
  u16* l0 = smem + tid * 8;
#define ISSUE_STAGE(st, kt) do { u16* _s = l0 + (st) * 12288; unsigned _k = (unsigned)(kt) * 32u; \
    GLDS16(ga + (oa0 + _k), _s); GLDS16(ga + (oa1 + _k), _s + 2048); GLDS16(ga + (oa2 + _k), _s + 4096); GLDS16(ga + (oa3 + _k), _s + 6144); \
    GLDS16(gb + (ob0 + _k), _s + 8192); GLDS16(gb + (ob1 + _k), _s + 10240); } while (0)
  asm volatile("s_waitcnt vmcnt(0)" ::: "memory");
  ISSUE_STAGE(0, 0);
  ISSUE_STAGE(1, 1);
  const int fsw = (quad ^ ((0 - (lr >> 2)) & 3)) << 3;
  const int aoff = (wm * 128 + lr) * 32 + fsw, boff = 8192 + (wn * 64 + lr) * 32 + fsw;
  int cur = 0, nxt = 2;
  for (int kt = 0; kt < nk; ++kt) {
    if (kt + 1 < nk) asm volatile("s_waitcnt vmcnt(6)" ::: "memory");
    else asm volatile("s_waitcnt vmcnt(0)" ::: "memory");
    __builtin_amdgcn_s_barrier();
    asm volatile("" ::: "memory");
    if (kt + 2 < nk) ISSUE_STAGE(nxt, kt + 2);
    const u16* sb = smem + cur * 12288;
    bf16x8 af[8], bfr[4];
#pragma unroll
    for (int j = 0; j < 4; ++j) bfr[j] = *(const bf16x8*)(sb + boff + j * 512);
#pragma unroll
    for (int i = 0; i < 8; ++i) af[i] = *(const bf16x8*)(sb + aoff + i * 512);
    __builtin_amdgcn_s_setprio(1);
#pragma unroll
    for (int i = 0; i < 8; ++i)
#pragma unroll
      for (int j = 0; j < 4; ++j)
        acc[i][j] = __builtin_amdgcn_mfma_f32_16x16x32_bf16(bfr[j], af[i], acc[i][j], 0, 0, 0);
    __builtin_amdgcn_s_setprio(0);
    cur = cur == 2 ? 0 : cur + 1;
    nxt = nxt == 2 ? 0 : nxt + 1;
  }
  asm volatile("s_waitcnt lgkmcnt(0)" ::: "memory");
  __builtin_amdgcn_s_barrier();
  asm volatile("" ::: "memory");
#undef ISSUE_STAGE
}

DEVFN bool tile_xcd(int it, int ngrp, int ntn, int& mt, int& nt) {
  const int G = gridDim.x, b = blockIdx.x;
  if (G == 512) {
    if (it >= 5 * ngrp) return false;
    int xcd = b & 7, loc = b >> 3;
    mt = xcd * 40 + (it / ngrp) * 8 + (loc >> 3);
    nt = (it % ngrp) * 8 + (loc & 7);
    return true;
  }
  int tile = b + it * G;
  if (tile >= 320 * ntn) return false;
  mt = tile / ntn; nt = tile % ntn;
  return true;
}

DEVFN void transpose_tile(const float* src, long ld, u16* dst, long ldd, float* sT) {
  const int tid = otid();
#pragma unroll
  for (int pss = 0; pss < 4; ++pss) {
    int kk = (tid >> 4) + pss * 16, n4 = (tid & 15) * 4;
    float4 v = *(const float4*)(src + (long)kk * ld + n4);
    sT[kk * 65 + n4 + 0] = v.x; sT[kk * 65 + n4 + 1] = v.y; sT[kk * 65 + n4 + 2] = v.z; sT[kk * 65 + n4 + 3] = v.w;
  }
  __syncthreads();
  {
    int n = tid >> 2, k0 = (tid & 3) * 16;
    unsigned o[8];
#pragma unroll
    for (int e = 0; e < 8; ++e) o[e] = pack2(sT[(k0 + 2 * e) * 65 + n], sT[(k0 + 2 * e + 1) * 65 + n]);
    uint4* q = (uint4*)(dst + (long)n * ldd + k0);
    q[0] = make_uint4(o[0], o[1], o[2], o[3]);
    q[1] = make_uint4(o[4], o[5], o[6], o[7]);
  }
  __syncthreads();
}

DEVFN void phase_prologue(const Params& p, unsigned char* smem_raw) {
  const int tid = otid();
  constexpr int NJ_TR = 4352, NJ_MOD = 96, NJ_TAB = 256;
  for (int job = blockIdx.x; job < NJ_TR + NJ_MOD + NJ_TAB; job += gridDim.x) {
    if (job < NJ_TR) {
      float* sT = (float*)smem_raw;
      int l = job / 2176, r = job % 2176;
      u16* wl = WL(p, l);
      if (r < 1280) {
        int kt = r / 80, ntile = r % 80;
        int orow = ntile * 64;
        int scol;
        if (orow < 2048) scol = orow; else { orow += 2048; scol = orow - 1024; }
        transpose_tile(p.w_in + (long)l * D * D_IN + (long)(kt * 64) * D_IN + scol, D_IN,
                       wl + W_CAT + (long)orow * D + kt * 64, D, sT);
      } else if (r < 2048) {
        int r2 = r - 1280, which = r2 >> 8, t = r2 & 255, kt = t >> 4, ntile = t & 15;
        const float* src = (which == 0 ? p.w_a_out : which == 1 ? p.w_b_out : p.w_o) + (long)l * 1048576;
        long doff = which == 0 ? W_A : which == 1 ? W_B : W_O;
        transpose_tile(src + (long)(kt * 64) * D + ntile * 64, D, wl + doff + (long)(ntile * 64) * D + kt * 64, D, sT);
      } else {
        int r3 = r - 2048, mat = r3 >> 2, t = r3 & 3, kt = t >> 1, ntile = t & 1;
        const float* src = p.w_rg + ((long)l * 32 + mat) * 16384;
        transpose_tile(src + (long)(kt * 64) * 128 + ntile * 64, 128,
                       wl + W_RG + (long)mat * 16384 + (long)(ntile * 64) * 128 + kt * 64, 128, sT);
      }
    } else if (job < NJ_TR + NJ_MOD) {
      int jm = job - NJ_TR, l = jm / 48, cgp = jm % 48;
      float* sc = (float*)smem_raw;
      float* red = sc + 9 * 1024;
      for (int i = tid; i < 9 * 1024; i += 256) {
        int s = i >> 10, k = i & 1023;
        float cv = s == 0 ? p.c_prompt[k] : p.c_sample[(s - 1) * 1024 + k];
        sc[i] = silu(cv);
      }
      __syncthreads();
      int col = cgp * 64 + (tid & 63), kq = tid >> 6;
      float a0 = 0, a1 = 0, a2 = 0, a3 = 0, a4 = 0, a5 = 0, a6 = 0, a7 = 0, a8 = 0;
      const float* wp = p.w_ada + (long)l * D * 3072 + col;
#pragma unroll 4
      for (int k = kq * 256; k < kq * 256 + 256; ++k) {
        float wv = wp[(long)k * 3072];
        a0 += sc[0 * 1024 + k] * wv; a1 += sc[1 * 1024 + k] * wv; a2 += sc[2 * 1024 + k] * wv;
        a3 += sc[3 * 1024 + k] * wv; a4 += sc[4 * 1024 + k] * wv; a5 += sc[5 * 1024 + k] * wv;
        a6 += sc[6 * 1024 + k] * wv; a7 += sc[7 * 1024 + k] * wv; a8 += sc[8 * 1024 + k] * wv;
      }
      float* rq = red + kq * 9 * 64 + (tid & 63);
      rq[0 * 64] = a0; rq[1 * 64] = a1; rq[2 * 64] = a2; rq[3 * 64] = a3; rq[4 * 64] = a4;
      rq[5 * 64] = a5; rq[6 * 64] = a6; rq[7 * 64] = a7; rq[8 * 64] = a8;
      __syncthreads();
      for (int i = tid; i < 9 * 64; i += 256) {
        int s = i >> 6, cc = i & 63;
        float v = red[0 * 576 + i] + red[1 * 576 + i] + red[2 * 576 + i] + red[3 * 576 + i];
        int cf = cgp * 64 + cc;
        MOD(p)[((long)l * 9 + s) * 3072 + cf] = v + p.b_ada[l * 3072 + cf];
      }
      __syncthreads();
    } else {
      int jt = job - NJ_TR - NJ_MOD;
      u16* tab = TAB(p);
#pragma unroll
      for (int e4 = 0; e4 < 4; ++e4) {
        int e = jt * 1024 + e4 * 256 + tid;
        if (e < 65536) {
          int m = e >> 8, k = e & 255;
          int k1 = (m >> 5) * 16 + (m & 15), ro = (m >> 4) & 1, ri = k >> 7, s1 = k & 127;
          float x = 2.f * (float)((k1 * s1) & 127) / 128.f;
          float cs = cospif(x), sn = sinpif(x);
          float v = (ro == ri) ? cs : (ro == 0 ? sn : -sn);
          tab[T_D1A + e] = f2bf(v);
        } else if (e < 65536 + 16384) {
          int e2 = e - 65536;
          int m = e2 >> 7, k = e2 & 127;
          int k1 = (m >> 5) * 16 + (m & 15), ro = (m >> 4) & 1, ri = k >> 6, s1 = k & 63;
          float x = 2.f * (float)((k1 * s1) & 63) / 64.f;
          float cs = cospif(x), sn = sinpif(x);
          float v = (ro == ri) ? cs : (ro == 0 ? sn : -sn);
          tab[T_D1B + e2] = f2bf(v);
        } else if (e < 65536 + 16384 + 32768) {
          int e2 = e - 65536 - 16384;
          int k2 = e2 >> 8, k = e2 & 255, ri = k >> 7, s2 = k & 127;
          float x = 2.f * (float)((k2 * s2) & 127) / 128.f;
          float v = ri == 0 ? cospif(x) : sinpif(x);
          tab[T_D2 + e2] = f2bf(v);
        } else if (e < 65536 + 16384 + 32768 + 131072) {
          int e2 = e - 65536 - 16384 - 32768;
          int row = e2 >> 8, c = e2 & 255, ri = row >> 8, m = row & 255;
          float x = 2.f * (float)((m * c) & 255) / 256.f;
          float v = ri == 0 ? cospif(x) : -sinpif(x);
          tab[T_DC + e2] = f2bf(v);
        } else {
          int e2 = e - (65536 + 16384 + 32768 + 131072);
          if (e2 < 16384) {
            float x = 2.f * (float)e2 / 16384.f;
            TW(p)[e2] = make_float2(cospif(x), sinpif(x));
          }
        }
      }
    }
  }
}

DEVFN void phase_fold(const Params& p, u16* smem) {
  for (int tile = blockIdx.x; tile < 256; tile += gridDim.x) {
    const int tid = otid(), lane = tid & 63, w = tid >> 6, wm = w >> 1, wn = w & 1, lr = lane & 15, quad = lane >> 4;
    int l = tile >> 7, g = (tile >> 5) & 3, mt = (tile >> 3) & 3, nt = tile & 7;
    LdPlain la; la.init(tid, TAB(p) + T_DC, mt * 128, 256);
    LdF32 lb; lb.init(tid, p.w_in + (long)l * D * D_IN, nt * 128, D_IN, 2048 + g * 256);
    f32x4 acc[4][4]; zero_acc(acc);
    gemm_core(tid, acc, 4, la, lb, smem);
    int ri = mt >> 1;
    u16* wc = WL(p, l) + W_CAT;
#pragma unroll
    for (int i = 0; i < 4; ++i) {
      int mrow = (mt & 1) * 128 + wm * 64 + i * 16 + lr;
      unsigned orow = 2048 + ri * 1024 + g * 256 + mrow;
#pragma unroll
      for (int j = 0; j < 4; ++j) {
        int n = nt * 128 + wn * 64 + j * 16 + quad * 4;
        uint2 o; o.x = pack2(acc[i][j][0], acc[i][j][1]); o.y = pack2(acc[i][j][2], acc[i][j][3]);
        *(uint2*)(wc + orow * D + n) = o;
      }
    }
  }
}

DEVFN void phase_h(const Params& p, int l) {
  const int lane = threadIdx.x & 63;
  const int wid = blockIdx.x * 4 + (threadIdx.x >> 6), nw = gridDim.x * 4;
  const float* ng = p.norm_g + l * D;
  const float* modl = MOD(p) + (long)l * 9 * 3072;
  u16* H = U(p, 0);
  float4 v[4], vn[4];
  auto ldrow = [&](int g, float4 (&dst)[4]) {
    const float* xb = (l == 0) ? (g < 16384 ? p.x_prompt : p.x_sample) : p.out;
    const unsigned xo = (unsigned)((l == 0 && g >= 16384) ? g - 16384 : g) * D;
#pragma unroll
    for (int i = 0; i < 4; ++i) dst[i] = *(const float4*)(xb + xo + i * 256 + lane * 4);
  };
  if (wid < T_TOT) ldrow(wid, v);
  for (int g = wid; g < T_TOT; g += nw) {
    if (g + nw < T_TOT) ldrow(g + nw, vn);
    const float* md = modl + seq_of(g) * 3072;
    float ss = 0.f;
#pragma unroll
    for (int i = 0; i < 4; ++i) ss += v[i].x * v[i].x + v[i].y * v[i].y + v[i].z * v[i].z + v[i].w * v[i].w;
#pragma unroll
    for (int o = 32; o >= 1; o >>= 1) ss += __shfl_xor(ss, o, 64);
    float rstd = rsqrtf(ss * (1.f / 1024.f) + 1e-6f);
#pragma unroll
    for (int i = 0; i < 4; ++i) {
      int c = i * 256 + lane * 4;
      float4 g4 = *(const float4*)(ng + c);
      float4 sh = *(const float4*)(md + c);
      float4 sc = *(const float4*)(md + 1024 + c);
      float h0 = v[i].x * rstd * g4.x * (1.f + sc.x) + sh.x;
      float h1 = v[i].y * rstd * g4.y * (1.f + sc.y) + sh.y;
      float h2 = v[i].z * rstd * g4.z * (1.f + sc.z) + sh.z;
      float h3 = v[i].w * rstd * g4.w * (1.f + sc.w) + sh.w;
      uint2 o; o.x = pack2(h0, h1); o.y = pack2(h2, h3);
      *(uint2*)(H + ((unsigned)g * D + c)) = o;
    }
#pragma unroll
    for (int i = 0; i < 4; ++i) v[i] = vn[i];
  }
}

DEVFN void phase_final(const Params& p) {
  const int lane = threadIdx.x & 63;
  const int wid = blockIdx.x * 4 + (threadIdx.x >> 6), nw = gridDim.x * 4;
  float4 v[4], vn[4];
  if (wid < T_TOT) {
#pragma unroll
    for (int i = 0; i < 4; ++i) v[i] = *(const float4*)(p.out + (unsigned)wid * D + i * 256 + lane * 4);
  }
  for (int g = wid; g < T_TOT; g += nw) {
    float* xr = p.out + (unsigned)g * D;
    if (g + nw < T_TOT) {
#pragma unroll
      for (int i = 0; i < 4; ++i) vn[i] = *(const float4*)(p.out + (unsigned)(g + nw) * D + i * 256 + lane * 4);
    }
    float ss = 0.f;
#pragma unroll
    for (int i = 0; i < 4; ++i) ss += v[i].x * v[i].x + v[i].y * v[i].y + v[i].z * v[i].z + v[i].w * v[i].w;
#pragma unroll
    for (int o = 32; o >= 1; o >>= 1) ss += __shfl_xor(ss, o, 64);
    float rstd = rsqrtf(ss * (1.f / 1024.f) + 1e-6f);
#pragma unroll
    for (int i = 0; i < 4; ++i) {
      int c = i * 256 + lane * 4;
      float4 g4 = *(const float4*)(p.final_g + c);
      float4 o;
      o.x = v[i].x * rstd * g4.x; o.y = v[i].y * rstd * g4.y; o.z = v[i].z * rstd * g4.z; o.w = v[i].w * rstd * g4.w;
      *(float4*)(xr + c) = o;
    }
#pragma unroll
    for (int i = 0; i < 4; ++i) v[i] = vn[i];
  }
}

DEVFN void phase_gemm1(const Params& p, int l, u16* smem) {
  const u16* H = U(p, 0);
  const u16* W = WL(p, l) + W_CAT;
  for (int it = 0;; ++it) {
    int mt, nt;
    if (!tile_xcd(it, 5, 40, mt, nt)) break;
    const int tid = otid(), lane = tid & 63, w = tid >> 6, wm = w >> 1, wn = w & 1, lr = lane & 15, quad = lane >> 4;
    LdPlain la; la.init(tid, H, mt * 256, D);
    LdPlain lb; lb.init(tid, W, nt * 128, D);
    f32x4 acc[8][4]; zero_acc8(acc);
    gemm_core_b(tid, acc, 32, la, lb, smem);
    int unit = nt >> 3, col0 = (nt & 7) * 128;
    u16* outp = U(p, 1 + unit);
    bool act = (unit == 1) || (unit == 4);
    {
      u16* so = smem;
#pragma unroll
      for (int i = 0; i < 8; ++i) {
        const int m = wm * 128 + i * 16 + lr;
#pragma unroll
        for (int j = 0; j < 4; ++j) {
          const int n = wn * 64 + j * 16 + quad * 4;
          float v0 = acc[i][j][0], v1 = acc[i][j][1], v2 = acc[i][j][2], v3 = acc[i][j][3];
          if (act) { v0 = silu(v0); v1 = silu(v1); v2 = silu(v2); v3 = silu(v3); }
          uint2 o; o.x = pack2(v0, v1); o.y = pack2(v2, v3);
          *(uint2*)(so + m * 136 + n) = o;
        }
      }
      __syncthreads();
#pragma unroll
      for (int c = 0; c < 16; ++c) {
        const int idx = tid + c * 256;
        const int row = idx >> 4, ch = idx & 15;
        uint4 v = *(const uint4*)(so + row * 136 + ch * 8);
        *(uint4*)(outp + ((unsigned)(mt * 256 + row) * D + col0 + ch * 8)) = v;
      }
      __syncthreads();
    }
  }
}

struct TokF1 {
  const u16* zr; const u16* zi; int n1; unsigned off;
  DEVFN unsigned operator()(int k, const u16*& b) const {
    int ri = k >= n1 ? 1 : 0;
    int s1 = k - ri * n1;
    b = ri ? zi : zr;
    return off + (unsigned)(s1 * 128) * D;
  }
};
DEVFN void f1_twiddle(int tid, const Params& p, const f32x4 (&acc)[4][4], int hf, int s2, int smask, int twmul,
                      uint2 (&o1)[2][4], uint2 (&o2)[2][4]) {
  const int lane = tid & 63, w = tid >> 6, wm = w >> 1, lr = lane & 15;
  const float2* tw = TW(p);
#pragma unroll
  for (int b = 0; b < 2; ++b) {
    int k1 = (hf * 4 + wm * 2 + b) * 16 + lr;
    float2 t = tw[((k1 * s2) & smask) * twmul];
#pragma unroll
    for (int j = 0; j < 4; ++j) {
      f32x4 orr = acc[2 * b][j], oii = acc[2 * b + 1][j];
      o1[b][j].x = pack2(orr[0] * t.x + oii[0] * t.y, orr[1] * t.x + oii[1] * t.y);
      o1[b][j].y = pack2(orr[2] * t.x + oii[2] * t.y, orr[3] * t.x + oii[3] * t.y);
      o2[b][j].x = pack2(oii[0] * t.x - orr[0] * t.y, oii[1] * t.x - orr[1] * t.y);
      o2[b][j].y = pack2(oii[2] * t.x - orr[2] * t.y, oii[3] * t.x - orr[3] * t.y);
    }
  }
}
DEVFN void f1_write(int tid, int hf, unsigned off, const uint2 (&o1)[2][4], const uint2 (&o2)[2][4], u16* zr, u16* zi, u16* so) {
  const int lane = tid & 63, w = tid >> 6, wm = w >> 1, wn = w & 1, lr = lane & 15, quad = lane >> 4;
#pragma unroll
  for (int b = 0; b < 2; ++b) {
    const int rl = (wm * 2 + b) * 16 + lr;
#pragma unroll
    for (int j = 0; j < 4; ++j) {
      const int n = wn * 64 + j * 16 + quad * 4;
      *(uint2*)(so + rl * 136 + n) = o1[b][j];
      *(uint2*)(so + (64 + rl) * 136 + n) = o2[b][j];
    }
  }
  __syncthreads();
#pragma unroll
  for (int c = 0; c < 8; ++c) {
    const int idx = tid + c * 256;
    const int pl = idx >> 10, row = (idx >> 4) & 63, ch = idx & 15;
    const unsigned k1 = hf * 64 + row;
    uint4 v = *(const uint4*)(so + (pl * 64 + row) * 136 + ch * 8);
    *(uint4*)((pl ? zi : zr) + (off + (k1 * 128) * D + ch * 8)) = v;
  }
  __syncthreads();
}
DEVFN void phase_fft1(const Params& p, u16* smem) {
  u16* zr = U(p, 3);
  u16* zi = U(p, 4);
  for (int tile = blockIdx.x; tile < 9216; tile += gridDim.x) {
    const int tid = otid();
    int seq, s2, ct, n1;
    if (tile < 1024) { seq = 0; s2 = tile >> 3; ct = tile & 7; n1 = 128; }
    else { int t2 = tile - 1024; seq = 1 + (t2 >> 10); s2 = (t2 >> 3) & 127; ct = t2 & 7; n1 = 64; }
    const unsigned off = (unsigned)(seq_start(seq) + s2) * D + ct * 128;
    LdTrans<TokF1> lb; lb.t_ = tid; lb.tok.zr = zr; lb.tok.zi = zi; lb.tok.n1 = n1; lb.tok.off = off;
    const int K = 2 * n1, nk = K >> 6;
    const u16* tab = TAB(p) + (seq == 0 ? T_D1A : T_D1B);
    const int smask = seq == 0 ? 16383 : 8191, twmul = seq == 0 ? 1 : 2;
    uint2 a1[2][4], a2[2][4];
    {
      f32x4 acc[4][4]; zero_acc(acc);
      LdPlain la; la.init(tid, tab, 0, K); gemm_core(tid, acc, nk, la, lb, smem);
      f1_twiddle(tid, p, acc, 0, s2, smask, twmul, a1, a2);
    }
    if (seq == 0) {
      uint2 b1[2][4], b2[2][4];
      {
        f32x4 acc[4][4]; zero_acc(acc);
        LdPlain la; la.init(tid, tab, 128, K); gemm_core(tid, acc, nk, la, lb, smem);
        f1_twiddle(tid, p, acc, 1, s2, smask, twmul, b1, b2);
      }
      f1_write(tid, 1, off, b1, b2, zr, zi, smem);
    }
    f1_write(tid, 0, off, a1, a2, zr, zi, smem);
  }
}

struct TokF2 {
  const u16* zr; const u16* zi; unsigned off;
  DEVFN unsigned operator()(int k, const u16*& b) const {
    int ri = k >> 7, s2 = k & 127;
    b = ri ? zi : zr;
    return off + (unsigned)s2 * D;
  }
};
DEVFN void phase_fft2(const Params& p, u16* smem) {
  u16* zr = U(p, 3);
  const u16* gbp = U(p, 5);
  for (int tile = blockIdx.x; tile < 5120; tile += gridDim.x) {
    const int tid = otid(), lane = tid & 63, w = tid >> 6, wm = w >> 1, wn = w & 1, lr = lane & 15, quad = lane >> 4;
    int seq, k1, ct, n1;
    if (tile < 1024) { seq = 0; k1 = tile >> 3; ct = tile & 7; n1 = 128; }
    else { int t2 = tile - 1024; seq = 1 + (t2 >> 9); k1 = (t2 >> 3) & 63; ct = t2 & 7; n1 = 64; }
    const int sst = seq_start(seq);
    const unsigned off = (unsigned)(sst + k1 * 128) * D + ct * 128;
    LdTrans<TokF2> lb; lb.t_ = tid; lb.tok.zr = zr; lb.tok.zi = U(p, 4); lb.tok.off = off;
    LdPlain la; la.init(tid, TAB(p) + T_D2, 0, 256);
    f32x4 acc[4][4]; zero_acc(acc);
    gemm_core(tid, acc, 4, la, lb, smem);
    const float nrm = seq == 0 ? (1.f / 2048.f) : 6.9053396600248786e-4f;
    u16* so = smem;
#pragma unroll
    for (int c = 0; c < 8; ++c) {
      const int idx = tid + c * 256;
      const int row = idx >> 4, ch = idx & 15;
      *(uint4*)(so + row * 136 + ch * 8) = *(const uint4*)(gbp + ((unsigned)(sst + k1 + n1 * row) * D + ct * 128 + ch * 8));
    }
    __syncthreads();
#pragma unroll
    for (int i = 0; i < 4; ++i) {
      const int k2 = wm * 64 + i * 16 + lr;
#pragma unroll
      for (int j = 0; j < 4; ++j) {
        const int cl = wn * 64 + j * 16 + quad * 4;
        uint2 gv = *(const uint2*)(so + k2 * 136 + cl);
        uint2 o;
        o.x = pack2(acc[i][j][0] * nrm * lo2f(gv.x), acc[i][j][1] * nrm * hi2f(gv.x));
        o.y = pack2(acc[i][j][2] * nrm * lo2f(gv.y), acc[i][j][3] * nrm * hi2f(gv.y));
        *(uint2*)(so + k2 * 136 + cl) = o;
      }
    }
    __syncthreads();
#pragma unroll
    for (int c = 0; c < 8; ++c) {
      const int idx = tid + c * 256;
      const int row = idx >> 4, ch = idx & 15;
      *(uint4*)(zr + (off + (unsigned)row * D + ch * 8)) = *(const uint4*)(so + row * 136 + ch * 8);
    }
    __syncthreads();
  }
}

constexpr int SA_LD = 128;
template <int PASS>
DEVFN void phase_scan(const Params& p, int l, int dirsel, unsigned char* smem_raw) {
  float* sAf = (float*)smem_raw;
  u16* sBh = (u16*)(smem_raw + 32768);
  u16* sXc = (u16*)(smem_raw + 32768 + 16384);
  const int tid = otid(), lane = tid & 63, w = tid >> 6, lr = lane & 15, quad = lane >> 4;
  const int head = blockIdx.x & 7;
  const int dir = PASS == 1 ? ((blockIdx.x >> 3) & 1) : dirsel;
  const int tstart = PASS == 1 ? (blockIdx.x >> 4) : (blockIdx.x >> 3);
  const int tstep = PASS == 1 ? (gridDim.x >> 4) : (gridDim.x >> 3);
  const u16* xa = U(p, 1);
  u16* ga = U(p, 2);
  u16* hf = U(p, 5);
  float2* agg = (float2*)U(p, 4);
  float* carry = (float*)(agg + 1280L * 2 * 1024);
  bf16x8 bw[4][4];
  {
    const u16* wrg = WL(p, l) + W_RG;
#pragma unroll
    for (int jt = 0; jt < 4; ++jt) {
      int q = jt >> 1, col = w * 32 + (jt & 1) * 16 + lr;
      const u16* bp = wrg + (unsigned)((((dir * 2 + q) * 8 + head) * 128 + col) * 128 + quad * 8);
#pragma unroll
      for (int ks = 0; ks < 4; ++ks) bw[jt][ks] = *(const bf16x8*)(bp + ks * 32);
    }
  }
  float spl[2], brr[2], bii[2];
#pragma unroll
  for (int jc = 0; jc < 2; ++jc) {
    int cgl = head * 128 + w * 32 + jc * 16 + lr;
    float lm = p.lam[(l * 2 + dir) * D + cgl];
    spl[jc] = -8.f * 1.4426950408889634f * log1pf(expf(-lm));
    brr[jc] = -1.4426950408889634f * p.b_rg[((l * 2 + dir) * 2 + 0) * D + cgl];
    bii[jc] = -1.4426950408889634f * p.b_rg[((l * 2 + dir) * 2 + 1) * D + cgl];
  }
  const int c8 = tid & 15, tg = tid >> 4;
  float* sCw = (float*)(smem_raw + 65536);
  for (int i = tid; i < 640; i += 256) {
    int k = i >> 7, c = i & 127;
    sCw[i] = k < 4 ? p.conv_w[(l * 4 + k) * D + head * 128 + c] : p.conv_b[l * D + head * 128 + c];
  }
  __syncthreads();
  uint4 xr[7];
#define LOAD_XROWS(TT) do { const int _g0 = (TT) * 64; const int _sq = seq_of(_g0), _ss = seq_start(_sq), _se = _ss + seq_len(_sq); \
    _Pragma("unroll") for (int r = 0; r < 7; ++r) { int _g = _g0 + tg * 4 - 2 + r; xr[r] = make_uint4(0, 0, 0, 0); \
      if (_g >= _ss && _g < _se) xr[r] = *(const uint4*)(xa + ((unsigned)_g * D + head * 128 + c8 * 8)); } } while (0)
  if (tstart < 1280) LOAD_XROWS(tstart);
  for (int tt = tstart; tt < 1280; tt += tstep) {
    const int g0 = tt * 64;
    const int seq = seq_of(g0), sst = seq_start(seq), send = sst + seq_len(seq);
#pragma unroll
    for (int j = 0; j < 4; ++j) {
      float o[8];
      {
        float4 b0 = *(const float4*)(sCw + 512 + c8 * 8), b1 = *(const float4*)(sCw + 512 + c8 * 8 + 4);
        o[0] = b0.x; o[1] = b0.y; o[2] = b0.z; o[3] = b0.w; o[4] = b1.x; o[5] = b1.y; o[6] = b1.z; o[7] = b1.w;
      }
#pragma unroll
      for (int k = 0; k < 4; ++k) {
        uint4 v = xr[j + k];
        float4 w0 = *(const float4*)(sCw + k * 128 + c8 * 8), w1 = *(const float4*)(sCw + k * 128 + c8 * 8 + 4);
        o[0] += w0.x * lo2f(v.x); o[1] += w0.y * hi2f(v.x);
        o[2] += w0.z * lo2f(v.y); o[3] += w0.w * hi2f(v.y);
        o[4] += w1.x * lo2f(v.z); o[5] += w1.y * hi2f(v.z);
        o[6] += w1.z * lo2f(v.w); o[7] += w1.w * hi2f(v.w);
      }
      uint4 q0;
      q0.x = pack2(o[0], o[1]); q0.y = pack2(o[2], o[3]); q0.z = pack2(o[4], o[5]); q0.w = pack2(o[6], o[7]);
      const int tl = tg * 4 + j;
      *(uint4*)(sXc + tl * 128 + ((c8 ^ (tl & 7)) << 3)) = q0;
    }
    __syncthreads();
    if (tt + tstep < 1280) LOAD_XROWS(tt + tstep);
    const int gstart = dir == 0 ? sst : send - 1;
#pragma unroll 1
    for (int hv = 0; hv < 2; ++hv) {
      f32x4 acc[2][4];
#pragma unroll
      for (int it = 0; it < 2; ++it)
#pragma unroll
        for (int jt = 0; jt < 4; ++jt) acc[it][jt] = f32x4{0.f, 0.f, 0.f, 0.f};
#pragma unroll
      for (int ks = 0; ks < 4; ++ks) {
#pragma unroll
        for (int it = 0; it < 2; ++it) {
          bf16x8 af = *(const bf16x8*)(sXc + ((hv * 2 + it) * 16 + lr) * 128 + (((ks * 4 + quad) ^ (lr & 7)) << 3));
#pragma unroll
          for (int jt = 0; jt < 4; ++jt)
            acc[it][jt] = __builtin_amdgcn_mfma_f32_16x16x32_bf16(af, bw[jt][ks], acc[it][jt], 0, 0, 0);
        }
      }
#pragma unroll
      for (int it = 0; it < 2; ++it)
#pragma unroll
        for (int jc = 0; jc < 2; ++jc) {
#pragma unroll
          for (int r = 0; r < 4; ++r) {
            int tl = (hv * 2 + it) * 16 + quad * 4 + r, c = w * 32 + jc * 16 + lr;
            float er = 1.f + __builtin_amdgcn_exp2f(fminf(fmaf(acc[it][jc][r], -1.4426950408889634f, brr[jc]), 60.f));
            float ei = 1.f + __builtin_amdgcn_exp2f(fminf(fmaf(acc[it][2 + jc][r], -1.4426950408889634f, bii[jc]), 60.f));
            float q = __builtin_amdgcn_rcpf(er * ei);
            float rr = q * ei, ii = q * er;
            float a = __builtin_amdgcn_exp2f(rr * spl[jc]);
            float mult = __builtin_amdgcn_sqrtf((1.f - a) * (1.f + a));
            if (g0 + tl == gstart) mult = 1.f;
            float xv = bf2f(sXc[tl * 128 + (((c >> 3) ^ (tl & 7)) << 3) + (c & 7)]);
            sAf[tl * SA_LD + c] = a;
            sBh[tl * 128 + c] = f2bf(mult * ii * xv);
          }
        }
    }
    __syncthreads();
    if (tid < 128) {
      const int c = tid;
      const unsigned aidx = (unsigned)(tt * 2 + dir) * 1024 + head * 128 + c;
      const float* ap = sAf + c;
      u16* bp = sBh + c;
      if (PASS == 1) {
        float h = 0.f, P = 1.f;
        if (dir == 0) {
#pragma unroll 16
          for (int st = 0; st < 64; ++st) { float a = ap[st * SA_LD]; h = a * h + bf2f(bp[st * 128]); P *= a; }
        } else {
#pragma unroll 16
          for (int st = 63; st >= 0; --st) { float a = ap[st * SA_LD]; h = a * h + bf2f(bp[st * 128]); P *= a; }
        }
        agg[aidx] = make_float2(P, h);
      } else {
        float h = carry[aidx];
        if (dir == 0) {
#pragma unroll 16
          for (int st = 0; st < 64; ++st) { h = ap[st * SA_LD] * h + bf2f(bp[st * 128]); bp[st * 128] = f2bf(h); }
        } else {
#pragma unroll 16
          for (int st = 63; st >= 0; --st) { h = ap[st * SA_LD] * h + bf2f(bp[st * 128]); bp[st * 128] = f2bf(h); }
        }
      }
    }
    if (PASS == 3) {
      __syncthreads();
#pragma unroll
      for (int cch = 0; cch < 4; ++cch) {
        int chunk = tid + cch * 256;
        int t = chunk >> 4, cc = (chunk & 15) * 8;
        unsigned off = (unsigned)(g0 + t) * D + head * 128 + cc;
        uint4 hv = *(const uint4*)(sBh + t * 128 + cc);
        if (dir == 0) {
          *(uint4*)(hf + off) = hv;
        } else {
          uint4 fv = *(const uint4*)(hf + off);
          uint4 gv = *(const uint4*)(ga + off);
          uint4 o;
          o.x = pack2((lo2f(fv.x) + lo2f(hv.x)) * lo2f(gv.x), (hi2f(fv.x) + hi2f(hv.x)) * hi2f(gv.x));
          o.y = pack2((lo2f(fv.y) + lo2f(hv.y)) * lo2f(gv.y), (hi2f(fv.y) + hi2f(hv.y)) * hi2f(gv.y));
          o.z = pack2((lo2f(fv.z) + lo2f(hv.z)) * lo2f(gv.z), (hi2f(fv.z) + hi2f(hv.z)) * hi2f(gv.z));
          o.w = pack2((lo2f(fv.w) + lo2f(hv.w)) * lo2f(gv.w), (hi2f(fv.w) + hi2f(hv.w)) * hi2f(gv.w));
          *(uint4*)(ga + off) = o;
        }
      }
    }
    __syncthreads();
  }
#undef LOAD_XROWS
}

DEVFN void lb_st64(unsigned long long* q, unsigned long long v) { __hip_atomic_store(q, v, __ATOMIC_RELAXED, __HIP_MEMORY_SCOPE_AGENT); }
DEVFN unsigned long long lb_ld64(const unsigned long long* q) { return __hip_atomic_load(q, __ATOMIC_RELAXED, __HIP_MEMORY_SCOPE_AGENT); }
DEVFN void lb_st32(unsigned* q, unsigned v) { __hip_atomic_store(q, v, __ATOMIC_RELAXED, __HIP_MEMORY_SCOPE_AGENT); }
DEVFN unsigned lb_ld32(const unsigned* q) { return __hip_atomic_load(q, __ATOMIC_RELAXED, __HIP_MEMORY_SCOPE_AGENT); }
DEVFN unsigned long long lb_pack(float a, float b) { return (unsigned long long)__float_as_uint(a) | ((unsigned long long)__float_as_uint(b) << 32); }
DEVFN int lb_rank(int seq, int pos) { return seq == 0 ? (pos >> 1) * 10 + ((pos & 1) ? 9 : 0) : pos * 10 + seq; }
DEVFN void lb_decode(int r, int dir, int& seq, int& pos, int& tt) {
  int pair = r / 10, j = r - pair * 10;
  if (j == 0) { seq = 0; pos = 2 * pair; } else if (j == 9) { seq = 0; pos = 2 * pair + 1; } else { seq = j; pos = pair; }
  int len = seq == 0 ? 256 : 128;
  tt = (seq_start(seq) >> 6) + (dir ? len - 1 - pos : pos);
}
DEVFN void phase_scan_lb(const Params& p, int l, unsigned char* smem_raw) {
  float* sAf = (float*)smem_raw;
  u16* sBh = (u16*)(smem_raw + 32768);
  u16* sXc = (u16*)(smem_raw + 32768 + 16384);
  unsigned* sflag = (unsigned*)(smem_raw + 65536 + 2560);
  const int tid = otid(), lane = tid & 63, w = tid >> 6, lr = lane & 15, quad = lane >> 4;
  const int hd = blockIdx.x & 15, head = hd >> 1, dir = hd & 1;
  const int rstart = blockIdx.x >> 4, rstep = gridDim.x >> 4;
  const u16* xa = U(p, 1);
  u16* ga = U(p, 2);
  u16* hown = dir == 0 ? U(p, 5) : U(p, 4);
  const u16* hoth = dir == 0 ? U(p, 4) : U(p, 5);
  unsigned long long* slot = (unsigned long long*)(p.ws + OFF_LB_BYTES);
  unsigned* stat = (unsigned*)(p.ws + OFF_LB_BYTES + LB_SLOT_BYTES);
  unsigned* cnt = stat + 20480;
  const unsigned ep = 2u * (unsigned)l;
  bf16x8 bw[4][4];
  {
    const u16* wrg = WL(p, l) + W_RG;
#pragma unroll
    for (int jt = 0; jt < 4; ++jt) {
      int q = jt >> 1, col = w * 32 + (jt & 1) * 16 + lr;
      const u16* bp = wrg + (unsigned)((((dir * 2 + q) * 8 + head) * 128 + col) * 128 + quad * 8);
#pragma unroll
      for (int ks = 0; ks < 4; ++ks) bw[jt][ks] = *(const bf16x8*)(bp + ks * 32);
    }
  }
  float spl[2], brr[2], bii[2];
#pragma unroll
  for (int jc = 0; jc < 2; ++jc) {
    int cgl = head * 128 + w * 32 + jc * 16 + lr;
    float lm = p.lam[(l * 2 + dir) * D + cgl];
    spl[jc] = -8.f * 1.4426950408889634f * log1pf(expf(-lm));
    brr[jc] = -1.4426950408889634f * p.b_rg[((l * 2 + dir) * 2 + 0) * D + cgl];
    bii[jc] = -1.4426950408889634f * p.b_rg[((l * 2 + dir) * 2 + 1) * D + cgl];
  }
  const int c8 = tid & 15, tg = tid >> 4;
  float* sCw = (float*)(smem_raw + 65536);
  for (int i = tid; i < 640; i += 256) {
    int k = i >> 7, c = i & 127;
    sCw[i] = k < 4 ? p.conv_w[(l * 4 + k) * D + head * 128 + c] : p.conv_b[l * D + head * 128 + c];
  }
  __syncthreads();
  uint4 xr[7];
#define LOAD_XROWS(TT) do { const int _g0 = (TT) * 64; const int _sq = seq_of(_g0), _ss = seq_start(_sq), _se = _ss + seq_len(_sq); \
    _Pragma("unroll") for (int r_ = 0; r_ < 7; ++r_) { int _g = _g0 + tg * 4 - 2 + r_; xr[r_] = make_uint4(0, 0, 0, 0); \
      if (_g >= _ss && _g < _se) xr[r_] = *(const uint4*)(xa + ((unsigned)_g * D + head * 128 + c8 * 8)); } } while (0)
  if (rstart < 1280) { int sq_, ps_, t0_; lb_decode(rstart, dir, sq_, ps_, t0_); LOAD_XROWS(t0_); }
  for (int r = rstart; r < 1280; r += rstep) {
    int seq, pos, tt;
    lb_decode(r, dir, seq, pos, tt);
    const int item = r * 16 + hd;
    const int g0 = tt * 64;
    const int sst = seq_start(seq), send = sst + seq_len(seq);
#pragma unroll
    for (int j = 0; j < 4; ++j) {
      float o[8];
      {
        float4 b0 = *(const float4*)(sCw + 512 + c8 * 8), b1 = *(const float4*)(sCw + 512 + c8 * 8 + 4);
        o[0] = b0.x; o[1] = b0.y; o[2] = b0.z; o[3] = b0.w; o[4] = b1.x; o[5] = b1.y; o[6] = b1.z; o[7] = b1.w;
      }
#pragma unroll
      for (int k = 0; k < 4; ++k) {
        uint4 v = xr[j + k];
        float4 w0 = *(const float4*)(sCw + k * 128 + c8 * 8), w1 = *(const float4*)(sCw + k * 128 + c8 * 8 + 4);
        o[0] += w0.x * lo2f(v.x); o[1] += w0.y * hi2f(v.x);
        o[2] += w0.z * lo2f(v.y); o[3] += w0.w * hi2f(v.y);
        o[4] += w1.x * lo2f(v.z); o[5] += w1.y * hi2f(v.z);
        o[6] += w1.z * lo2f(v.w); o[7] += w1.w * hi2f(v.w);
      }
      uint4 q0;
      q0.x = pack2(o[0], o[1]); q0.y = pack2(o[2], o[3]); q0.z = pack2(o[4], o[5]); q0.w = pack2(o[6], o[7]);
      const int tl = tg * 4 + j;
      *(uint4*)(sXc + tl * 128 + ((c8 ^ (tl & 7)) << 3)) = q0;
    }
    __syncthreads();
    if (r + rstep < 1280) { int sq_, ps_, t1_; lb_decode(r + rstep, dir, sq_, ps_, t1_); LOAD_XROWS(t1_); }
    const int gstart = dir == 0 ? sst : send - 1;
#pragma unroll 1
    for (int hv = 0; hv < 2; ++hv) {
      f32x4 acc[2][4];
#pragma unroll
      for (int it = 0; it < 2; ++it)
#pragma unroll
        for (int jt = 0; jt < 4; ++jt) acc[it][jt] = f32x4{0.f, 0.f, 0.f, 0.f};
#pragma unroll
      for (int ks = 0; ks < 4; ++ks) {
#pragma unroll
        for (int it = 0; it < 2; ++it) {
          bf16x8 af = *(const bf16x8*)(sXc + ((hv * 2 + it) * 16 + lr) * 128 + (((ks * 4 + quad) ^ (lr & 7)) << 3));
#pragma unroll
          for (int jt = 0; jt < 4; ++jt)
            acc[it][jt] = __builtin_amdgcn_mfma_f32_16x16x32_bf16(af, bw[jt][ks], acc[it][jt], 0, 0, 0);
        }
      }
#pragma unroll
      for (int it = 0; it < 2; ++it)
#pragma unroll
        for (int jc = 0; jc < 2; ++jc) {
#pragma unroll
          for (int r = 0; r < 4; ++r) {
            int tl = (hv * 2 + it) * 16 + quad * 4 + r, c = w * 32 + jc * 16 + lr;
            float er = 1.f + __builtin_amdgcn_exp2f(fminf(fmaf(acc[it][jc][r], -1.4426950408889634f, brr[jc]), 60.f));
            float ei = 1.f + __builtin_amdgcn_exp2f(fminf(fmaf(acc[it][2 + jc][r], -1.4426950408889634f, bii[jc]), 60.f));
            float q = __builtin_amdgcn_rcpf(er * ei);
            float rr = q * ei, ii = q * er;
            float a = __builtin_amdgcn_exp2f(rr * spl[jc]);
            float mult = __builtin_amdgcn_sqrtf((1.f - a) * (1.f + a));
            if (g0 + tl == gstart) mult = 1.f;
            float xv = bf2f(sXc[tl * 128 + (((c >> 3) ^ (tl & 7)) << 3) + (c & 7)]);
            sAf[tl * SA_LD + c] = a;
            sBh[tl * 128 + c] = f2bf(mult * ii * xv);
          }
        }
    }
    __syncthreads();
    float aggP = 1.f, aggH = 0.f;
    if (tid < 128) {
      const float* ap = sAf + tid;
      const u16* bp = sBh + tid;
      if (dir == 0) {
#pragma unroll 16
        for (int st = 0; st < 64; ++st) { float a = ap[st * SA_LD]; aggH = a * aggH + bf2f(bp[st * 128]); aggP *= a; }
      } else {
#pragma unroll 16
        for (int st = 63; st >= 0; --st) { float a = ap[st * SA_LD]; aggH = a * aggH + bf2f(bp[st * 128]); aggP *= a; }
      }
      lb_st64(slot + (unsigned)item * 128 + tid, lb_pack(pos == 0 ? 0.f : aggP, aggH));
    }
    asm volatile("s_waitcnt vmcnt(0)" ::: "memory");
    __syncthreads();
    if (tid == 0) lb_st32(stat + item, ep + (pos == 0 ? 2u : 1u));
    float carry = 0.f;
    if (pos > 0) {
      if (tid < 128) {
        float Pr = 1.f, Hr = 0.f;
        int pj = pos - 1;
        for (;;) {
          const int j = lb_rank(seq, pj) * 16 + hd;
          unsigned sv, spins = 0;
          while ((sv = lb_ld32(stat + j)) < ep + 1u) { __builtin_amdgcn_s_sleep(1); if (++spins > (1u << 18)) break; }
          unsigned long long v = lb_ld64(slot + (unsigned)j * 128 + tid);
          float Pj = __uint_as_float((unsigned)v), Hj = __uint_as_float((unsigned)(v >> 32));
          Hr += Pr * Hj;
          Pr *= Pj;
          if (sv >= ep + 2u || pj == 0) break;
          --pj;
        }
        carry = Hr;
        lb_st64(slot + (unsigned)item * 128 + tid, lb_pack(0.f, aggP * carry + aggH));
      }
      asm volatile("s_waitcnt vmcnt(0)" ::: "memory");
      __syncthreads();
      if (tid == 0) lb_st32(stat + item, ep + 2u);
    }
    if (tid < 128) {
      const float* ap = sAf + tid;
      u16* bp = sBh + tid;
      float h = carry;
      if (dir == 0) {
#pragma unroll 16
        for (int st = 0; st < 64; ++st) { h = ap[st * SA_LD] * h + bf2f(bp[st * 128]); bp[st * 128] = f2bf(h); }
      } else {
#pragma unroll 16
        for (int st = 63; st >= 0; --st) { h = ap[st * SA_LD] * h + bf2f(bp[st * 128]); bp[st * 128] = f2bf(h); }
      }
    }
    __syncthreads();
#pragma unroll
    for (int cch = 0; cch < 4; ++cch) {
      int chunk = tid + cch * 256;
      int t = chunk >> 4, cc = (chunk & 15) * 8;
      unsigned off = (unsigned)(g0 + t) * D + head * 128 + cc;
      uint4 hv = *(const uint4*)(sBh + t * 128 + cc);
      unsigned long long* q = (unsigned long long*)(hown + off);
      lb_st64(q, (unsigned long long)hv.x | ((unsigned long long)hv.y << 32));
      lb_st64(q + 1, (unsigned long long)hv.z | ((unsigned long long)hv.w << 32));
    }
    asm volatile("s_waitcnt vmcnt(0)" ::: "memory");
    __syncthreads();
    if (tid == 0) sflag[0] = __hip_atomic_fetch_add(cnt + tt * 8 + head, 1u, __ATOMIC_RELAXED, __HIP_MEMORY_SCOPE_AGENT);
    __syncthreads();
    if (sflag[0] == ep + 1u) {
#pragma unroll
      for (int cch = 0; cch < 4; ++cch) {
        int chunk = tid + cch * 256;
        int t = chunk >> 4, cc = (chunk & 15) * 8;
        unsigned off = (unsigned)(g0 + t) * D + head * 128 + cc;
        uint4 hv = *(const uint4*)(sBh + t * 128 + cc);
        const unsigned long long* q = (const unsigned long long*)(hoth + off);
        unsigned long long f0 = lb_ld64(q), f1 = lb_ld64(q + 1);
        uint4 fv = make_uint4((unsigned)f0, (unsigned)(f0 >> 32), (unsigned)f1, (unsigned)(f1 >> 32));
        uint4 gv = *(const uint4*)(ga + off);
        uint4 o;
        o.x = pack2((lo2f(fv.x) + lo2f(hv.x)) * lo2f(gv.x), (hi2f(fv.x) + hi2f(hv.x)) * hi2f(gv.x));
        o.y = pack2((lo2f(fv.y) + lo2f(hv.y)) * lo2f(gv.y), (hi2f(fv.y) + hi2f(hv.y)) * hi2f(gv.y));
        o.z = pack2((lo2f(fv.z) + lo2f(hv.z)) * lo2f(gv.z), (hi2f(fv.z) + hi2f(hv.z)) * hi2f(gv.z));
        o.w = pack2((lo2f(fv.w) + lo2f(hv.w)) * lo2f(gv.w), (hi2f(fv.w) + hi2f(hv.w)) * hi2f(gv.w));
        *(uint4*)(ga + off) = o;
      }
    }
    __syncthreads();
  }
#undef LOAD_XROWS
}

DEVFN void phase_carry(const Params& p) {
  const float2* __restrict__ agg = (const float2*)U(p, 4);
  float* __restrict__ carry = (float*)(agg + 1280L * 2 * 1024);
  const int lane = threadIdx.x & 63, w = threadIdx.x >> 6;
  for (int u = blockIdx.x + gridDim.x * w; u < 288; u += gridDim.x * 4) {
    int id = u * 64 + lane;
    int seq = id >> 11, dir = (id >> 10) & 1, c = id & 1023;
    int nt = seq_len(seq) >> 6, tile0 = seq_start(seq) >> 6;
    float h = 0.f;
#pragma unroll 8
    for (int k = 0; k < nt; ++k) {
      int tt = tile0 + (dir ? nt - 1 - k : k);
      unsigned ix = (unsigned)(tt * 2 + dir) * 1024 + c;
      float2 v = agg[ix];
      carry[ix] = h;
      h = v.x * h + v.y;
    }
  }
}

DEVFN void phase_merge(const Params& p, int l, u16* smem) {
  const u16* wl = WL(p, l);
  u16* mo = U(p, 1);
  u16* tb = U(p, 5);
  u16* so = smem;
  for (int it = 0;; ++it) {
    int mt, nt;
    if (!tile_xcd(it, 1, 8, mt, nt)) break;
    const int g0 = mt * 256;
#pragma unroll 1
    for (int br = 0; br < 2; ++br) {
      {
        const int tid = otid(), lane = tid & 63, w = tid >> 6, wm = w >> 1, wn = w & 1, lr = lane & 15, quad = lane >> 4;
        f32x4 acc[8][4]; zero_acc8(acc);
        LdPlain lb; lb.init(tid, wl + (br == 0 ? W_A : W_B), nt * 128, D);
        if (br == 0) {
          LdPlain la; la.init(tid, U(p, 2), g0, D);
          gemm_core_b(tid, acc, 32, la, lb, smem);
        } else {
          const int seq = seq_of(g0);
          LdPerm la; la.base = U(p, 3); la.g0 = g0; la.sst = seq_start(seq); la.lg = seq == 0 ? 7 : 6;
          gemm_core_b(tid, acc, 32, la, lb, smem);
        }
#pragma unroll
        for (int i = 0; i < 8; ++i) {
          const int m = wm * 128 + i * 16 + lr;
#pragma unroll
          for (int j = 0; j < 4; ++j) {
            const int n = wn * 64 + j * 16 + quad * 4;
            uint2 o; o.x = pack2(acc[i][j][0], acc[i][j][1]); o.y = pack2(acc[i][j][2], acc[i][j][3]);
            *(uint2*)(so + m * 136 + n) = o;
          }
        }
        __syncthreads();
#pragma unroll
        for (int c = 0; c < 16; ++c) {
          const int idx = tid + c * 256;
          const int row = idx >> 4, ch = idx & 15;
          *(uint4*)(tb + ((unsigned)(g0 + row) * D + nt * 128 + ch * 8)) = *(const uint4*)(so + row * 136 + ch * 8);
        }
        __syncthreads();
      }
      {
        const int tid = otid(), lane = tid & 63, w = tid >> 6, wm = w >> 1, wn = w & 1, lr = lane & 15, quad = lane >> 4;
        f32x4 acc[8][4]; zero_acc8(acc);
        LdPlain la; la.init(tid, U(p, 0), g0, D);
        LdPlain lb; lb.init(tid, wl + W_CAT, 5120 + br * 1024 + nt * 128, D);
        gemm_core_b(tid, acc, 32, la, lb, smem);
#pragma unroll
        for (int c = 0; c < 16; ++c) {
          const int idx = tid + c * 256;
          const int row = idx >> 4, ch = idx & 15;
          *(uint4*)(so + row * 136 + ch * 8) = *(const uint4*)(tb + ((unsigned)(g0 + row) * D + nt * 128 + ch * 8));
        }
        __syncthreads();
#pragma unroll
        for (int i = 0; i < 8; ++i) {
          const int m = wm * 128 + i * 16 + lr;
#pragma unroll
          for (int j = 0; j < 4; ++j) {
            const int n = wn * 64 + j * 16 + quad * 4;
            uint2 tv = *(const uint2*)(so + m * 136 + n);
            acc[i][j][0] = sigm(acc[i][j][0]) * lo2f(tv.x);
            acc[i][j][1] = sigm(acc[i][j][1]) * hi2f(tv.x);
            acc[i][j][2] = sigm(acc[i][j][2]) * lo2f(tv.y);
            acc[i][j][3] = sigm(acc[i][j][3]) * hi2f(tv.y);
          }
        }
        if (br == 1) {
          __syncthreads();
#pragma unroll
          for (int c = 0; c < 16; ++c) {
            const int idx = tid + c * 256;
            const int row = idx >> 4, ch = idx & 15;
            *(uint4*)(so + row * 136 + ch * 8) = *(const uint4*)(mo + ((unsigned)(g0 + row) * D + nt * 128 + ch * 8));
          }
          __syncthreads();
#pragma unroll
          for (int i = 0; i < 8; ++i) {
            const int m = wm * 128 + i * 16 + lr;
#pragma unroll
            for (int j = 0; j < 4; ++j) {
              const int n = wn * 64 + j * 16 + quad * 4;
              uint2 pv = *(const uint2*)(so + m * 136 + n);
              acc[i][j][0] += lo2f(pv.x); acc[i][j][1] += hi2f(pv.x);
              acc[i][j][2] += lo2f(pv.y); acc[i][j][3] += hi2f(pv.y);
            }
          }
        }
        __syncthreads();
#pragma unroll
        for (int i = 0; i < 8; ++i) {
          const int m = wm * 128 + i * 16 + lr;
#pragma unroll
          for (int j = 0; j < 4; ++j) {
            const int n = wn * 64 + j * 16 + quad * 4;
            uint2 o; o.x = pack2(acc[i][j][0], acc[i][j][1]); o.y = pack2(acc[i][j][2], acc[i][j][3]);
            *(uint2*)(so + m * 136 + n) = o;
          }
        }
        __syncthreads();
#pragma unroll
        for (int c = 0; c < 16; ++c) {
          const int idx = tid + c * 256;
          const int row = idx >> 4, ch = idx & 15;
          *(uint4*)(mo + ((unsigned)(g0 + row) * D + nt * 128 + ch * 8)) = *(const uint4*)(so + row * 136 + ch * 8);
        }
        __syncthreads();
      }
    }
  }
}

DEVFN void phase_out(const Params& p, int l, u16* smem) {
  const u16* wo = WL(p, l) + W_O;
  for (int it = 0;; ++it) {
    int mt, nt;
    if (!tile_xcd(it, 1, 8, mt, nt)) break;
    const int tid = otid(), lane = tid & 63, w = tid >> 6, wm = w >> 1, wn = w & 1, lr = lane & 15, quad = lane >> 4;
    const int g0 = mt * 256;
    LdPlain la; la.init(tid, U(p, 1), g0, D);
    LdPlain lb; lb.init(tid, wo, nt * 128, D);
    f32x4 acc[8][4]; zero_acc8(acc);
    gemm_core_b(tid, acc, 32, la, lb, smem);
    const float* gate = MOD(p) + ((long)l * 9 + seq_of(g0)) * 3072 + 2048;
#pragma unroll
    for (int i = 0; i < 8; ++i) {
      unsigned g = g0 + wm * 128 + i * 16 + lr;
      const float* xb = (l == 0) ? (g0 < 16384 ? p.x_prompt : p.x_sample) : p.out;
      const float* xr = xb + (unsigned)((l == 0 && g0 >= 16384) ? g - 16384 : g) * D;
      float* orow = p.out + g * D;
#pragma unroll
      for (int j = 0; j < 4; ++j) {
        unsigned c = nt * 128 + wn * 64 + j * 16 + quad * 4;
        float4 xv = *(const float4*)(xr + c);
        float4 gt = *(const float4*)(gate + c);
        float4 o;
        o.x = xv.x + gt.x * acc[i][j][0]; o.y = xv.y + gt.y * acc[i][j][1];
        o.z = xv.z + gt.z * acc[i][j][2]; o.w = xv.w + gt.w * acc[i][j][3];
        *(float4*)(orow + c) = o;
      }
    }
  }
}

#define XB_TMO      128
#define XB_XCNT(j)  (256  + 64 * (j))
#define XB_XSUB(j)  (1280 + 64 * (j))
#define XB_XGEN(j)  (2304 + 64 * (j))
#define XB_TOP      3328
#define XB_TOPGEN   3392
#define XCD_BAR_WORDS 3456
#define XB_SPIN_CAP (1u << 18)
#define LAS __attribute__((address_space(3)))

__device__ __forceinline__ unsigned xb_ld(unsigned* p)              { return __hip_atomic_load(p, __ATOMIC_RELAXED, __HIP_MEMORY_SCOPE_AGENT); }
__device__ __forceinline__ unsigned xb_add(unsigned* p, unsigned v) { return __hip_atomic_fetch_add(p, v, __ATOMIC_RELAXED, __HIP_MEMORY_SCOPE_AGENT); }
__device__ __forceinline__ unsigned xb_xcc_id() { return (unsigned)__builtin_amdgcn_s_getreg((3 << 11) | 20) & 0xFu; }
#define XB_SPIN(cond, bar) do { unsigned _sp = 0; while (cond) { __builtin_amdgcn_s_sleep(1); \
    if ((++_sp & 255u) == 0u) { if (xb_ld(&(bar)[XB_TMO])) break; if (_sp > XB_SPIN_CAP) { atomicAdd(&(bar)[XB_TMO], 1u); break; } } } } while (0)

struct XcdBarrier {
    unsigned* bar; unsigned x;
    volatile LAS unsigned* st;
};

__device__ __forceinline__ XcdBarrier xcd_barrier_post(unsigned* bar, volatile LAS unsigned* st) {
    XcdBarrier b; b.bar = bar; b.x = xb_xcc_id(); b.st = st;
    if (threadIdx.x == 0) (void)xb_add(&bar[XB_XCNT(b.x)], 1u);
    return b;
}
__device__ __forceinline__ void xcd_barrier_complete(unsigned* bar, unsigned x, unsigned& nloc, unsigned& nx) {
    const unsigned G = gridDim.x * gridDim.y * gridDim.z;
    unsigned sum, cnt, mine, sp = 0u;
    for (;;) {
        sum = 0u; cnt = 0u; mine = 0u;
#pragma unroll
        for (unsigned j = 0; j < 16; ++j) { const unsigned c = xb_ld(&bar[XB_XCNT(j)]); sum += c; cnt += (c > 0u) ? 1u : 0u; mine = (j == x) ? c : mine; }
        if (sum == G) break;
        __builtin_amdgcn_s_sleep(1);
        if ((++sp & 255u) == 0u) { if (xb_ld(&bar[XB_TMO])) break; if (sp > XB_SPIN_CAP) { atomicAdd(&bar[XB_TMO], 1u); break; } }
    }
    nloc = mine > 0u ? mine : 1u; nx = cnt > 0u ? cnt : 1u;
}

__device__ __forceinline__ void xcd_barrier(const XcdBarrier& b) {
    asm volatile("s_waitcnt vmcnt(0)" ::: "memory");
    __syncthreads();
    if (threadIdx.x == 0) {
        unsigned* bar = b.bar;
        __builtin_amdgcn_s_waitcnt(0);
        unsigned nloc = b.st[0], nx = b.st[1];
        if (nloc == 0u) { xcd_barrier_complete(bar, b.x, nloc, nx); b.st[0] = nloc; b.st[1] = nx; }
        const unsigned old = xb_add(&bar[XB_XSUB(b.x)], 1u);
        const unsigned gen = old / nloc;
        if (old + 1u == (gen + 1u) * nloc) {
            __builtin_amdgcn_fence(__ATOMIC_RELEASE, "agent");
            asm volatile("s_waitcnt vmcnt(0)" ::: "memory");
            const unsigned og = xb_add(&bar[XB_TOP], 1u);
            const unsigned tg = og / nx;
            if (og + 1u == (tg + 1u) * nx) xb_add(&bar[XB_TOPGEN], 1u);
            else XB_SPIN(xb_ld(&bar[XB_TOPGEN]) == tg, bar);
            __builtin_amdgcn_fence(__ATOMIC_ACQUIRE, "agent");
            xb_add(&bar[XB_XGEN(b.x)], 1u);
            asm volatile("s_waitcnt vmcnt(0)" ::: "memory");
        } else {
            XB_SPIN(xb_ld(&bar[XB_XGEN(b.x)]) == gen, bar);
            __builtin_amdgcn_fence(__ATOMIC_ACQUIRE, "agent");
            asm volatile("s_waitcnt vmcnt(0)" ::: "memory");
        }
    }
    __syncthreads();
}


__global__ void __launch_bounds__(256, 2) hawk_fnet_megakernel(Params p) {
  extern __shared__ __attribute__((aligned(16))) unsigned char smem_raw[];
  cg::grid_group grid = cg::this_grid();
  u16* smem = (u16*)smem_raw;

  __shared__ unsigned xb_st[4];
  unsigned* bar = (unsigned*)(p.ws + OFF_BAR_BYTES);
  if (blockIdx.x == 0) {
    for (int i = threadIdx.x; i < XCD_BAR_WORDS; i += 256) __hip_atomic_store(&bar[i], 0u, __ATOMIC_RELAXED, __HIP_MEMORY_SCOPE_AGENT);
  }
  if (threadIdx.x < 4) xb_st[threadIdx.x] = 0u;
  {
    unsigned* lbs = (unsigned*)(p.ws + OFF_LB_BYTES + LB_SLOT_BYTES);
    for (int i = blockIdx.x * 256 + threadIdx.x; i < 20480 + 10240; i += gridDim.x * 256)
      __hip_atomic_store(&lbs[i], 0u, __ATOMIC_RELAXED, __HIP_MEMORY_SCOPE_AGENT);
  }
  phase_prologue(p, smem_raw);
  grid.sync();
  XcdBarrier xb = xcd_barrier_post(bar, (volatile LAS unsigned*)xb_st);
  phase_fold(p, smem);
  phase_h(p, 0);
  xcd_barrier(xb);
  for (int l = 0; l < 2; ++l) {
    phase_gemm1(p, l, smem);
    xcd_barrier(xb);
    phase_fft1(p, smem);
    xcd_barrier(xb);
    phase_fft2(p, smem);
    xcd_barrier(xb);
    phase_scan_lb(p, l, smem_raw);
    xcd_barrier(xb);
    phase_merge(p, l, smem);
    xcd_barrier(xb);
    phase_out(p, l, smem);
    xcd_barrier(xb);
    if (l == 0) { phase_h(p, 1); xcd_barrier(xb); }
  }
  phase_final(p);
}

extern "C" void kernel_launch(void* const* d_in, const int* in_sizes, int n_in,
                              void* d_out, int out_size, void* d_ws, size_t ws_size,
                              hipStream_t stream) {
  (void)in_sizes; (void)n_in; (void)out_size;
  if (ws_size < (size_t)WS_NEED) {
    fprintf(stderr, "workspace too small: %zu < %ld\n", ws_size, (long)WS_NEED);
    return;
  }
  static int grid_blocks = 0;
  if (!grid_blocks) {
    hipFuncSetAttribute((const void*)hawk_fnet_megakernel, hipFuncAttributeMaxDynamicSharedMemorySize, SMEM_BYTES);
    int dev = 0, cus = 0, per_cu = 0;
    hipGetDevice(&dev);
    hipDeviceGetAttribute(&cus, hipDeviceAttributeMultiprocessorCount, dev);
    hipOccupancyMaxActiveBlocksPerMultiprocessor(&per_cu, hawk_fnet_megakernel, 256, SMEM_BYTES);
    if (per_cu > 2) per_cu = 2;
    if (per_cu < 1) per_cu = 1;
    grid_blocks = (cus * per_cu) & ~15;
  }
  Params p{};
  p.x_prompt = (const float*)d_in[0]; p.x_sample = (const float*)d_in[1];
  p.c_prompt = (const float*)d_in[2]; p.c_sample = (const float*)d_in[3];
  p.norm_g = (const float*)d_in[4]; p.w_ada = (const float*)d_in[5]; p.b_ada = (const float*)d_in[6];
  p.w_in = (const float*)d_in[7]; p.conv_w = (const float*)d_in[8]; p.conv_b = (const float*)d_in[9];
  p.w_rg = (const float*)d_in[10]; p.b_rg = (const float*)d_in[11]; p.lam = (const float*)d_in[12];
  p.w_a_out = (const float*)d_in[13]; p.w_b_out = (const float*)d_in[14]; p.w_o = (const float*)d_in[15];
  p.final_g = (const float*)d_in[16];
  p.out = (float*)d_out; p.ws = (unsigned char*)d_ws;
  void* args[] = {&p};
  hipError_t e = hipLaunchCooperativeKernel((void*)hawk_fnet_megakernel, dim3(grid_blocks), dim3(256), args, SMEM_BYTES, stream);
  if (e != hipSuccess) fprintf(stderr, "cooperative launch failed: %s (grid %d)\n", hipGetErrorString(e), grid_blocks);
}
```

```cpp
#include <hip/hip_runtime.h>
#include <hip/hip_cooperative_groups.h>
#include <cstdio>
namespace cg = cooperative_groups;

typedef unsigned short u16;
typedef __attribute__((ext_vector_type(8))) short bf16x8;
typedef __attribute__((ext_vector_type(4))) float f32x4;

#define DEVFN __device__ __forceinline__

constexpr int D = 1024;
constexpr int T_TOT = 81920;
constexpr long UNIT = (long)T_TOT * D;
constexpr int D_IN = 6144;

constexpr long OFF_W = 6 * UNIT;
constexpr long W_CAT = 0;
constexpr long W_A = 7168L * 1024;
constexpr long W_B = W_A + 1048576;
constexpr long W_O = W_B + 1048576;
constexpr long W_RG = W_O + 1048576;
constexpr long LW = W_RG + 524288;
constexpr long OFF_TAB = OFF_W + 2 * LW;
constexpr long T_D1A = 0;
constexpr long T_D1B = 65536;
constexpr long T_D2 = T_D1B + 16384;
constexpr long T_DC = T_D2 + 32768;
constexpr long TAB_ELEMS = T_DC + 131072;
constexpr long OFF_TW_BYTES = (OFF_TAB + TAB_ELEMS) * 2;
constexpr long OFF_MOD_BYTES = OFF_TW_BYTES + 131072;
constexpr long OFF_BAR_BYTES = OFF_MOD_BYTES + 221184;
constexpr long OFF_LB_BYTES = OFF_BAR_BYTES + 16384;
constexpr long LB_SLOT_BYTES = 20480L * 128 * 8;
constexpr long WS_NEED = OFF_LB_BYTES + LB_SLOT_BYTES + 20480 * 4 + 10240 * 4;
static_assert(WS_NEED <= (1L << 30), "workspace map exceeds the guaranteed 1 GiB");

constexpr int TILE = 128 * 64;
constexpr int SMEM_BYTES = 73728;

struct Params {
  const float* x_prompt; const float* x_sample; const float* c_prompt; const float* c_sample;
  const float* norm_g; const float* w_ada; const float* b_ada; const float* w_in;
  const float* conv_w; const float* conv_b; const float* w_rg; const float* b_rg; const float* lam;
  const float* w_a_out; const float* w_b_out; const float* w_o; const float* final_g;
  float* out; unsigned char* ws;
};

typedef __attribute__((ext_vector_type(2))) float f32x2_t;
typedef __attribute__((ext_vector_type(2))) __bf16 bf16x2_t;
DEVFN u16 f2bf(float f) {
  __bf16 h = (__bf16)f;
  return *(u16*)&h;
}
DEVFN float bf2f(u16 h) { return __uint_as_float(((unsigned)h) << 16); }
DEVFN unsigned pack2(float a, float b) {
  f32x2_t v = {a, b};
  bf16x2_t r = __builtin_convertvector(v, bf16x2_t);
  return *(unsigned*)&r;
}
DEVFN float lo2f(unsigned v) { return __uint_as_float(v << 16); }
DEVFN float hi2f(unsigned v) { return __uint_as_float(v & 0xffff0000u); }
DEVFN float sigm(float x) { return __builtin_amdgcn_rcpf(1.f + __expf(-x)); }
DEVFN float silu(float x) { return x * __builtin_amdgcn_rcpf(1.f + __expf(-x)); }
DEVFN float one_minus_exp(float x) {
  float pl = -x * (1.f + x * (0.5f + x * (1.f / 6.f + x * (1.f / 24.f + x * (1.f / 120.f + x * (1.f / 720.f))))));
  float dr = 1.f - __expf(x);
  return x > -0.3f ? pl : dr;
}

DEVFN int otid() { int t = threadIdx.x; asm volatile("" : "+v"(t)); return t; }
DEVFN int seq_of(int g) { int seg = g >> 13; return seg < 2 ? 0 : seg - 1; }
DEVFN int seq_start(int s) { return s == 0 ? 0 : 16384 + (s - 1) * 8192; }
DEVFN int seq_len(int s) { return s == 0 ? 16384 : 8192; }

DEVFN u16* U(const Params& p, int i) { return (u16*)(p.ws) + (long)i * UNIT; }
DEVFN u16* WL(const Params& p, int l) { return (u16*)(p.ws) + OFF_W + (long)l * LW; }
DEVFN u16* TAB(const Params& p) { return (u16*)(p.ws) + OFF_TAB; }
DEVFN float2* TW(const Params& p) { return (float2*)(p.ws + OFF_TW_BYTES); }
DEVFN float* MOD(const Params& p) { return (float*)(p.ws + OFF_MOD_BYTES); }
DEVFN const float* xrow(const Params& p, int g) {
  return g < 16384 ? p.x_prompt + (long)g * D : p.x_sample + (long)(g - 16384) * D;
}

struct LdPlain {
  static constexpr bool kDma = true; static constexpr bool kTr = false;
  const u16* base; unsigned off0; unsigned cst; int t_; unsigned row0_, stride_;
  DEVFN unsigned rowoff(int r) const { return (row0_ + r) * stride_; }
  DEVFN void init(int tid_, const u16* b, unsigned row0, unsigned stride) {
    unsigned tid = tid_; t_ = tid_; row0_ = row0; stride_ = stride;
    base = b;
    off0 = (row0 + (tid >> 3)) * stride + (((tid & 7) ^ ((tid >> 3) & 7)) << 3);
    cst = 32 * stride;
  }
  DEVFN void issue(u16* tile, int c, int kt) const {
    __builtin_amdgcn_global_load_lds((const unsigned*)(base + (off0 + c * cst + kt * 64)),
                                     (unsigned*)(tile + (t_ + c * 256) * 8), 16, 0, 0);
  }
  DEVFN uint4 load(int, int) const { return make_uint4(0, 0, 0, 0); }
  DEVFN void store(u16*, int, uint4) const {}
};
struct LdRows4 {
  static constexpr bool kDma = true; static constexpr bool kTr = false;
  const u16* base; unsigned off[4]; int t_;
  DEVFN void issue(u16* tile, int c, int kt) const {
    __builtin_amdgcn_global_load_lds((const unsigned*)(base + (off[c] + kt * 64)),
                                     (unsigned*)(tile + (t_ + c * 256) * 8), 16, 0, 0);
  }
  DEVFN uint4 load(int, int) const { return make_uint4(0, 0, 0, 0); }
  DEVFN void store(u16*, int, uint4) const {}
};
struct LdF32 {
  static constexpr bool kDma = false; static constexpr bool kTr = false;
  const float* base; unsigned off0; unsigned cst; int t_;
  DEVFN void init(int tid_, const float* b, unsigned row0, unsigned stride, unsigned col0) {
    unsigned tid = tid_; t_ = tid_;
    base = b;
    off0 = (row0 + (tid >> 3)) * stride + col0 + (tid & 7) * 8;
    cst = 32 * stride;
  }
  DEVFN void issue(u16*, int, int) const {}
  DEVFN uint4 load(int c, int kt) const {
    const float4* q = (const float4*)(base + (off0 + c * cst + kt * 64));
    float4 a = q[0], b = q[1];
    uint4 r; r.x = pack2(a.x, a.y); r.y = pack2(a.z, a.w); r.z = pack2(b.x, b.y); r.w = pack2(b.z, b.w);
    return r;
  }
  DEVFN void store(u16* tile, int c, uint4 v) const {
    int idx = t_ + c * 256;
    int row = idx >> 3, kc = idx & 7;
    *(uint4*)(tile + row * 64 + ((kc ^ (row & 7)) << 3)) = v;
  }
};
DEVFN int trf(int r) { return ((r & 3) << 2) | ((r >> 2) & 3); }
template <class TokFn>
struct LdTrans {
  static constexpr bool kDma = false; static constexpr bool kTr = false;
  TokFn tok; int t_;
  DEVFN void issue(u16*, int, int) const {}
  DEVFN uint4 load(int c, int kt) const {
    int idx = t_ + c * 256;
    int kk = idx & 63, cc = idx >> 6;
    const u16* b; unsigned o = tok(kt * 64 + kk, b);
    return *(const uint4*)(b + (o + cc * 8));
  }
  DEVFN void store(u16* tile, int c, uint4 v) const {
    int idx = t_ + c * 256;
    int kk = idx & 63, cc = idx >> 6;
    u16* q = tile + (cc * 8) * 64 + (kk & 7);
    int kc = kk >> 3;
    q[0 * 64 + ((kc ^ 0) << 3)] = (u16)(v.x & 0xffff); q[1 * 64 + ((kc ^ 1) << 3)] = (u16)(v.x >> 16);
    q[2 * 64 + ((kc ^ 2) << 3)] = (u16)(v.y & 0xffff); q[3 * 64 + ((kc ^ 3) << 3)] = (u16)(v.y >> 16);
    q[4 * 64 + ((kc ^ 4) << 3)] = (u16)(v.z & 0xffff); q[5 * 64 + ((kc ^ 5) << 3)] = (u16)(v.z >> 16);
    q[6 * 64 + ((kc ^ 6) << 3)] = (u16)(v.w & 0xffff); q[7 * 64 + ((kc ^ 7) << 3)] = (u16)(v.w >> 16);
  }
};

typedef __attribute__((ext_vector_type(4))) short s16x4;
DEVFN s16x4 lds_tr_read(const u16* q) {
  return __builtin_amdgcn_ds_read_tr16_b64_v4i16((s16x4 __attribute__((address_space(3)))*)(q));
}

DEVFN void zero_acc(f32x4 (&acc)[4][4]) {
#pragma unroll
  for (int i = 0; i < 4; ++i)
#pragma unroll
    for (int j = 0; j < 4; ++j) acc[i][j] = f32x4{0.f, 0.f, 0.f, 0.f};
}

template <class LA, class LB>
DEVFN void gemm_core(int tid, f32x4 (&acc)[4][4], int nk, const LA& la, const LB& lb, u16* smem) {
  const int lane = tid & 63, w = tid >> 6, wm = w >> 1, wn = w & 1;
  const int lr = lane & 15, quad = lane >> 4;
  uint4 ra[4], rb[4];
  if (LA::kDma) {
#pragma unroll
    for (int c = 0; c < 4; ++c) la.issue(smem, c, 0);
  } else {
#pragma unroll
    for (int c = 0; c < 4; ++c) ra[c] = la.load(c, 0);
  }
  if (LB::kDma) {
#pragma unroll
    for (int c = 0; c < 4; ++c) lb.issue(smem + TILE, c, 0);
  } else {
#pragma unroll
    for (int c = 0; c < 4; ++c) rb[c] = lb.load(c, 0);
  }
  if (!LA::kDma) {
#pragma unroll
    for (int c = 0; c < 4; ++c) la.store(smem, c, ra[c]);
  }
  if (!LB::kDma) {
#pragma unroll
    for (int c = 0; c < 4; ++c) lb.store(smem + TILE, c, rb[c]);
  }
  asm volatile("s_waitcnt vmcnt(0)" ::: "memory");
  __syncthreads();
  const int aoff = (wm * 64 + lr) * 64, boff = (wn * 64 + lr) * 64;
  const int sw0 = ((quad) ^ (lr & 7)) << 3, sw1 = ((4 + quad) ^ (lr & 7)) << 3;
  int troff[4][2];
  if (LB::kTr) {
    const int q = lr >> 2, pp = lr & 3;
#pragma unroll
    for (int j = 0; j < 4; ++j)
#pragma unroll
      for (int h = 0; h < 2; ++h) {
        int r = quad * 8 + h * 4 + q;
        int ch = (wn * 8 + j * 2 + (pp >> 1)) ^ trf(r);
        troff[j][h] = r * 128 + ch * 8 + (pp & 1) * 4;
      }
  }
  for (int kt = 0; kt < nk; ++kt) {
    const u16* sA = smem + (kt & 1) * 2 * TILE;
    const u16* sB = sA + TILE;
    u16* nA = smem + ((kt + 1) & 1) * 2 * TILE;
    const bool more = (kt + 1) < nk;
    if (more) {
      if (LA::kDma) {
#pragma unroll
        for (int c = 0; c < 4; ++c) la.issue(nA, c, kt + 1);
      } else {
#pragma unroll
        for (int c = 0; c < 4; ++c) ra[c] = la.load(c, kt + 1);
      }
      if (LB::kDma) {
#pragma unroll
        for (int c = 0; c < 4; ++c) lb.issue(nA + TILE, c, kt + 1);
      } else {
#pragma unroll
        for (int c = 0; c < 4; ++c) rb[c] = lb.load(c, kt + 1);
      }
    }
#pragma unroll
    for (int ks = 0; ks < 2; ++ks) {
      const int sw = ks == 0 ? sw0 : sw1;
      bf16x8 af[4], bfr[4];
#pragma unroll
      for (int i = 0; i < 4; ++i) af[i] = *(const bf16x8*)(sA + aoff + i * 1024 + sw);
      if (LB::kTr) {
#pragma unroll
        for (int j = 0; j < 4; ++j) {
          s16x4 lo = lds_tr_read(sB + troff[j][0] + ks * 4096);
          s16x4 hi = lds_tr_read(sB + troff[j][1] + ks * 4096);
          bfr[j] = __builtin_shufflevector(lo, hi, 0, 1, 2, 3, 4, 5, 6, 7);
        }
      } else {
#pragma unroll
        for (int j = 0; j < 4; ++j) bfr[j] = *(const bf16x8*)(sB + boff + j * 1024 + sw);
      }
      __builtin_amdgcn_s_setprio(1);
#pragma unroll
      for (int i = 0; i < 4; ++i)
#pragma unroll
        for (int j = 0; j < 4; ++j)
          acc[i][j] = __builtin_amdgcn_mfma_f32_16x16x32_bf16(bfr[j], af[i], acc[i][j], 0, 0, 0);
      __builtin_amdgcn_s_setprio(0);
    }
    if (more) {
      if (!LA::kDma) {
#pragma unroll
        for (int c = 0; c < 4; ++c) la.store(nA, c, ra[c]);
      }
      if (!LB::kDma) {
#pragma unroll
        for (int c = 0; c < 4; ++c) lb.store(nA + TILE, c, rb[c]);
      }
    }
    asm volatile("s_waitcnt vmcnt(0)" ::: "memory");
    __syncthreads();
  }
}

struct LdPerm {
  const u16* base; int g0, sst, lg;
  DEVFN unsigned rowoff(int r) const {
    int t = g0 - sst + r;
    int urow = ((t & ((1 << lg) - 1)) << 7) + (t >> lg);
    return (unsigned)(sst + urow) * D;
  }
};
#define GLDS16(gp, lp) __builtin_amdgcn_global_load_lds((const unsigned*)(gp), (unsigned*)(lp), 16, 0, 0)
DEVFN void zero_acc8(f32x4 (&acc)[8][4]) {
#pragma unroll
  for (int i = 0; i < 8; ++i)
#pragma unroll
    for (int j = 0; j < 4; ++j) acc[i][j] = f32x4{0.f, 0.f, 0.f, 0.f};
}
template <class LA, class LB>
DEVFN void gemm_core_b(int tid, f32x4 (&acc)[8][4], int nk, const LA& la, const LB& lb, u16* smem) {
  const int lane = tid & 63, w = tid >> 6, wm = w >> 1, wn = w & 1;
  const int lr = lane & 15, quad = lane >> 4;
  const int r0 = tid >> 2;
  const unsigned sw = (unsigned)(((tid & 3) ^ ((0 - (tid >> 4)) & 3)) << 3);
  const unsigned oa0 = la.rowoff(r0) + sw, oa1 = la.rowoff(r0 + 64) + sw, oa2 = la.rowoff(r0 + 128) + sw, oa3 = la.rowoff(r0 + 192) + sw;
  const unsigned ob0 = lb.rowoff(r0) + sw, ob1 = lb.rowoff(r0 + 64) + sw;
  const u16* ga = la.base; const u16* gb = lb.base;
  u16* l0 = smem + tid * 8;
#define ISSUE_STAGE(st, kt) do { u16* _s = l0 + (st) * 12288; unsigned _k = (unsigned)(kt) * 32u; \
    GLDS16(ga + (oa0 + _k), _s); GLDS16(ga + (oa1 + _k), _s + 2048); GLDS16(ga + (oa2 + _k), _s + 4096); GLDS16(ga + (oa3 + _k), _s + 6144); \
    GLDS16(gb + (ob0 + _k), _s + 8192); GLDS16(gb + (ob1 + _k), _s + 10240); } while (0)
  asm volatile("s_waitcnt vmcnt(0)" ::: "memory");
  ISSUE_STAGE(0, 0);
  ISSUE_STAGE(1, 1);
  const int fsw = (quad ^ ((0 - (lr >> 2)) & 3)) << 3;
  const int aoff = (wm * 128 + lr) * 32 + fsw, boff = 8192 + (wn * 64 + lr) * 32 + fsw;
  int cur = 0, nxt = 2;
  for (int kt = 0; kt < nk; ++kt) {
    if (kt + 1 < nk) asm volatile("s_waitcnt vmcnt(6)" ::: "memory");
    else asm volatile("s_waitcnt vmcnt(0)" ::: "memory");
    __builtin_amdgcn_s_barrier();
    asm volatile("" ::: "memory");
    if (kt + 2 < nk) ISSUE_STAGE(nxt, kt + 2);
    const u16* sb = smem + cur * 12288;
    bf16x8 af[8], bfr[4];
#pragma unroll
    for (int j = 0; j < 4; ++j) bfr[j] = *(const bf16x8*)(sb + boff + j * 512);
#pragma unroll
    for (int i = 0; i < 8; ++i) af[i] = *(const bf16x8*)(sb + aoff + i * 512);
    __builtin_amdgcn_s_setprio(1);
#pragma unroll
    for (int i = 0; i < 8; ++i)
#pragma unroll
      for (int j = 0; j < 4; ++j)
        acc[i][j] = __builtin_amdgcn_mfma_f32_16x16x32_bf16(bfr[j], af[i], acc[i][j], 0, 0, 0);
    __builtin_amdgcn_s_setprio(0);
    cur = cur == 2 ? 0 : cur + 1;
    nxt = nxt == 2 ? 0 : nxt + 1;
  }
  asm volatile("s_waitcnt lgkmcnt(0)" ::: "memory");
  __builtin_amdgcn_s_barrier();
  asm volatile("" ::: "memory");
#undef ISSUE_STAGE
}

DEVFN bool tile_xcd(int it, int ngrp, int ntn, int& mt, int& nt) {
  const int G = gridDim.x, b = blockIdx.x;
  if (G == 512) {
    if (it >= 5 * ngrp) return false;
    int xcd = b & 7, loc = b >> 3;
    mt = xcd * 40 + (it / ngrp) * 8 + (loc >> 3);
    nt = (it % ngrp) * 8 + (loc & 7);
    return true;
  }
  int tile = b + it * G;
  if (tile >= 320 * ntn) return false;
  mt = tile / ntn; nt = tile % ntn;
  return true;
}

DEVFN void transpose_tile(const float* src, long ld, u16* dst, long ldd, float* sT) {
  const int tid = otid();
#pragma unroll
  for (int pss = 0; pss < 4; ++pss) {
    int kk = (tid >> 4) + pss * 16, n4 = (tid & 15) * 4;
    float4 v = *(const float4*)(src + (long)kk * ld + n4);
    sT[kk * 65 + n4 + 0] = v.x; sT[kk * 65 + n4 + 1] = v.y; sT[kk * 65 + n4 + 2] = v.z; sT[kk * 65 + n4 + 3] = v.w;
  }
  __syncthreads();
  {
    int n = tid >> 2, k0 = (tid & 3) * 16;
    unsigned o[8];
#pragma unroll
    for (int e = 0; e < 8; ++e) o[e] = pack2(sT[(k0 + 2 * e) * 65 + n], sT[(k0 + 2 * e + 1) * 65 + n]);
    uint4* q = (uint4*)(dst + (long)n * ldd + k0);
    q[0] = make_uint4(o[0], o[1], o[2], o[3]);
    q[1] = make_uint4(o[4], o[5], o[6], o[7]);
  }
  __syncthreads();
}

DEVFN void phase_prologue(const Params& p, unsigned char* smem_raw) {
  const int tid = otid();
  constexpr int NJ_TR = 4352, NJ_MOD = 384, NJ_TAB = 256;
  for (int job = blockIdx.x; job < NJ_TR + NJ_MOD + NJ_TAB; job += gridDim.x) {
    if (job < NJ_TR) {
      float* sT = (float*)smem_raw;
      int l = job / 2176, r = job % 2176;
      u16* wl = WL(p, l);
      if (r < 1280) {
        int kt = r / 80, ntile = r % 80;
        int orow = ntile * 64;
        int scol;
        if (orow < 2048) scol = orow; else { orow += 2048; scol = orow - 1024; }
        transpose_tile(p.w_in + (long)l * D * D_IN + (long)(kt * 64) * D_IN + scol, D_IN,
                       wl + W_CAT + (long)orow * D + kt * 64, D, sT);
      } else if (r < 2048) {
        int r2 = r - 1280, which = r2 >> 8, t = r2 & 255, kt = t >> 4, ntile = t & 15;
        const float* src = (which == 0 ? p.w_a_out : which == 1 ? p.w_b_out : p.w_o) + (long)l * 1048576;
        long doff = which == 0 ? W_A : which == 1 ? W_B : W_O;
        transpose_tile(src + (long)(kt * 64) * D + ntile * 64, D, wl + doff + (long)(ntile * 64) * D + kt * 64, D, sT);
      } else {
        int r3 = r - 2048, mat = r3 >> 2, t = r3 & 3, kt = t >> 1, ntile = t & 1;
        const float* src = p.w_rg + ((long)l * 32 + mat) * 16384;
        transpose_tile(src + (long)(kt * 64) * 128 + ntile * 64, 128,
                       wl + W_RG + (long)mat * 16384 + (long)(ntile * 64) * 128 + kt * 64, 128, sT);
      }
    } else if (job < NJ_TR + NJ_MOD) {
      int jm = job - NJ_TR, l = jm / 192, cgp = jm % 192;
      float* sc = (float*)smem_raw;
      float* red = sc + 9 * 1024;
      for (int i = tid; i < 9 * 1024; i += 256) {
        int s_ = i >> 10, k = i & 1023;
        float cv = s_ == 0 ? p.c_prompt[k] : p.c_sample[(s_ - 1) * 1024 + k];
        sc[i] = silu(cv);
      }
      __syncthreads();
      int col = cgp * 16 + (tid & 15), kq = tid >> 4;
      float a0 = 0, a1 = 0, a2 = 0, a3 = 0, a4 = 0, a5 = 0, a6 = 0, a7 = 0, a8 = 0;
      const float* wp = p.w_ada + (long)l * D * 3072 + col;
#pragma unroll 8
      for (int k = kq * 64; k < kq * 64 + 64; ++k) {
        float wv = wp[(long)k * 3072];
        a0 += sc[0 * 1024 + k] * wv; a1 += sc[1 * 1024 + k] * wv; a2 += sc[2 * 1024 + k] * wv;
        a3 += sc[3 * 1024 + k] * wv; a4 += sc[4 * 1024 + k] * wv; a5 += sc[5 * 1024 + k] * wv;
        a6 += sc[6 * 1024 + k] * wv; a7 += sc[7 * 1024 + k] * wv; a8 += sc[8 * 1024 + k] * wv;
      }
      float* rq = red + kq * 144 + (tid & 15);
      rq[0 * 16] = a0; rq[1 * 16] = a1; rq[2 * 16] = a2; rq[3 * 16] = a3; rq[4 * 16] = a4;
      rq[5 * 16] = a5; rq[6 * 16] = a6; rq[7 * 16] = a7; rq[8 * 16] = a8;
      __syncthreads();
      if (tid < 144) {
        int s_ = tid >> 4, cc = tid & 15;
        float v = 0.f;
#pragma unroll
        for (int q = 0; q < 16; ++q) v += red[q * 144 + tid];
        int cf = cgp * 16 + cc;
        MOD(p)[((long)l * 9 + s_) * 3072 + cf] = v + p.b_ada[l * 3072 + cf];
      }
      __syncthreads();
    } else {
      int jt = job - NJ_TR - NJ_MOD;
      u16* tab = TAB(p);
#pragma unroll
      for (int e4 = 0; e4 < 4; ++e4) {
        int e = jt * 1024 + e4 * 256 + tid;
        if (e < 65536) {
          int m = e >> 8, k = e & 255;
          int k1 = (m >> 5) * 16 + (m & 15), ro = (m >> 4) & 1, ri = k >> 7, s1 = k & 127;
          float x = 2.f * (float)((k1 * s1) & 127) / 128.f;
          float cs = cospif(x), sn = sinpif(x);
          float v = (ro == ri) ? cs : (ro == 0 ? sn : -sn);
          tab[T_D1A + e] = f2bf(v);
        } else if (e < 65536 + 16384) {
          int e2 = e - 65536;
          int m = e2 >> 7, k = e2 & 127;
          int k1 = (m >> 5) * 16 + (m & 15), ro = (m >> 4) & 1, ri = k >> 6, s1 = k & 63;
          float x = 2.f * (float)((k1 * s1) & 63) / 64.f;
          float cs = cospif(x), sn = sinpif(x);
          float v = (ro == ri) ? cs : (ro == 0 ? sn : -sn);
          tab[T_D1B + e2] = f2bf(v);
        } else if (e < 65536 + 16384 + 32768) {
          int e2 = e - 65536 - 16384;
          int k2 = e2 >> 8, k = e2 & 255, ri = k >> 7, s2 = k & 127;
          float x = 2.f * (float)((k2 * s2) & 127) / 128.f;
          float v = ri == 0 ? cospif(x) : sinpif(x);
          tab[T_D2 + e2] = f2bf(v);
        } else if (e < 65536 + 16384 + 32768 + 131072) {
          int e2 = e - 65536 - 16384 - 32768;
          int row = e2 >> 8, c = e2 & 255, ri = row >> 8, m = row & 255;
          float x = 2.f * (float)((m * c) & 255) / 256.f;
          float v = ri == 0 ? cospif(x) : -sinpif(x);
          tab[T_DC + e2] = f2bf(v);
        } else {
          int e2 = e - (65536 + 16384 + 32768 + 131072);
          if (e2 < 16384) {
            float x = 2.f * (float)e2 / 16384.f;
            TW(p)[e2] = make_float2(cospif(x), sinpif(x));
          }
        }
      }
    }
  }
}

DEVFN void phase_fold(const Params& p, u16* smem) {
  for (int tile = blockIdx.x; tile < 256; tile += gridDim.x) {
    const int tid = otid(), lane = tid & 63, w = tid >> 6, wm = w >> 1, wn = w & 1, lr = lane & 15, quad = lane >> 4;
    int l = tile >> 7, g = (tile >> 5) & 3, mt = (tile >> 3) & 3, nt = tile & 7;
    LdPlain la; la.init(tid, TAB(p) + T_DC, mt * 128, 256);
    LdF32 lb; lb.init(tid, p.w_in + (long)l * D * D_IN, nt * 128, D_IN, 2048 + g * 256);
    f32x4 acc[4][4]; zero_acc(acc);
    gemm_core(tid, acc, 4, la, lb, smem);
    int ri = mt >> 1;
    u16* wc = WL(p, l) + W_CAT;
#pragma unroll
    for (int i = 0; i < 4; ++i) {
      int mrow = (mt & 1) * 128 + wm * 64 + i * 16 + lr;
      unsigned orow = 2048 + ri * 1024 + g * 256 + mrow;
#pragma unroll
      for (int j = 0; j < 4; ++j) {
        int n = nt * 128 + wn * 64 + j * 16 + quad * 4;
        uint2 o; o.x = pack2(acc[i][j][0], acc[i][j][1]); o.y = pack2(acc[i][j][2], acc[i][j][3]);
        *(uint2*)(wc + orow * D + n) = o;
      }
    }
  }
}

DEVFN void phase_h(const Params& p, int l) {
  const int lane = threadIdx.x & 63;
  const int wid = blockIdx.x * 4 + (threadIdx.x >> 6), nw = gridDim.x * 4;
  const float* ng = p.norm_g + l * D;
  const float* modl = MOD(p) + (long)l * 9 * 3072;
  u16* H = U(p, 0);
  float4 v[4], vn[4];
  auto ldrow = [&](int g, float4 (&dst)[4]) {
    const float* xb = (l == 0) ? (g < 16384 ? p.x_prompt : p.x_sample) : p.out;
    const unsigned xo = (unsigned)((l == 0 && g >= 16384) ? g - 16384 : g) * D;
#pragma unroll
    for (int i = 0; i < 4; ++i) dst[i] = *(const float4*)(xb + xo + i * 256 + lane * 4);
  };
  if (wid < T_TOT) ldrow(wid, v);
  for (int g = wid; g < T_TOT; g += nw) {
    if (g + nw < T_TOT) ldrow(g + nw, vn);
    const float* md = modl + seq_of(g) * 3072;
    float ss = 0.f;
#pragma unroll
    for (int i = 0; i < 4; ++i) ss += v[i].x * v[i].x + v[i].y * v[i].y + v[i].z * v[i].z + v[i].w * v[i].w;
#pragma unroll
    for (int o = 32; o >= 1; o >>= 1) ss += __shfl_xor(ss, o, 64);
    float rstd = rsqrtf(ss * (1.f / 1024.f) + 1e-6f);
#pragma unroll
    for (int i = 0; i < 4; ++i) {
      int c = i * 256 + lane * 4;
      float4 g4 = *(const float4*)(ng + c);
      float4 sh = *(const float4*)(md + c);
      float4 sc = *(const float4*)(md + 1024 + c);
      float h0 = v[i].x * rstd * g4.x * (1.f + sc.x) + sh.x;
      float h1 = v[i].y * rstd * g4.y * (1.f + sc.y) + sh.y;
      float h2 = v[i].z * rstd * g4.z * (1.f + sc.z) + sh.z;
      float h3 = v[i].w * rstd * g4.w * (1.f + sc.w) + sh.w;
      uint2 o; o.x = pack2(h0, h1); o.y = pack2(h2, h3);
      *(uint2*)(H + ((unsigned)g * D + c)) = o;
    }
#pragma unroll
    for (int i = 0; i < 4; ++i) v[i] = vn[i];
  }
}

DEVFN void phase_final(const Params& p) {
  const int lane = threadIdx.x & 63;
  const int wid = blockIdx.x * 4 + (threadIdx.x >> 6), nw = gridDim.x * 4;
  float4 v[4], vn[4];
  if (wid < T_TOT) {
#pragma unroll
    for (int i = 0; i < 4; ++i) v[i] = *(const float4*)(p.out + (unsigned)wid * D + i * 256 + lane * 4);
  }
  for (int g = wid; g < T_TOT; g += nw) {
    float* xr = p.out + (unsigned)g * D;
    if (g + nw < T_TOT) {
#pragma unroll
      for (int i = 0; i < 4; ++i) vn[i] = *(const float4*)(p.out + (unsigned)(g + nw) * D + i * 256 + lane * 4);
    }
    float ss = 0.f;
#pragma unroll
    for (int i = 0; i < 4; ++i) ss += v[i].x * v[i].x + v[i].y * v[i].y + v[i].z * v[i].z + v[i].w * v[i].w;
#pragma unroll
    for (int o = 32; o >= 1; o >>= 1) ss += __shfl_xor(ss, o, 64);
    float rstd = rsqrtf(ss * (1.f / 1024.f) + 1e-6f);
#pragma unroll
    for (int i = 0; i < 4; ++i) {
      int c = i * 256 + lane * 4;
      float4 g4 = *(const float4*)(p.final_g + c);
      float4 o;
      o.x = v[i].x * rstd * g4.x; o.y = v[i].y * rstd * g4.y; o.z = v[i].z * rstd * g4.z; o.w = v[i].w * rstd * g4.w;
      *(float4*)(xr + c) = o;
    }
#pragma unroll
    for (int i = 0; i < 4; ++i) v[i] = vn[i];
  }
}

DEVFN void phase_gemm1(const Params& p, int l, u16* smem) {
  const u16* H = U(p, 0);
  const u16* W = WL(p, l) + W_CAT;
  for (int it = 0;; ++it) {
    int mt, nt;
    if (!tile_xcd(it, 5, 40, mt, nt)) break;
    const int tid = otid(), lane = tid & 63, w = tid >> 6, wm = w >> 1, wn = w & 1, lr = lane & 15, quad = lane >> 4;
    LdPlain la; la.init(tid, H, mt * 256, D);
    LdPlain lb; lb.init(tid, W, nt * 128, D);
    f32x4 acc[8][4]; zero_acc8(acc);
    gemm_core_b(tid, acc, 32, la, lb, smem);
    int unit = nt >> 3, col0 = (nt & 7) * 128;
    u16* outp = U(p, 1 + unit);
    bool act = (unit == 1) || (unit == 4);
    {
      u16* so = smem;
#pragma unroll
      for (int i = 0; i < 8; ++i) {
        const int m = wm * 128 + i * 16 + lr;
#pragma unroll
        for (int j = 0; j < 4; ++j) {
          const int n = wn * 64 + j * 16 + quad * 4;
          float v0 = acc[i][j][0], v1 = acc[i][j][1], v2 = acc[i][j][2], v3 = acc[i][j][3];
          if (act) { v0 = silu(v0); v1 = silu(v1); v2 = silu(v2); v3 = silu(v3); }
          uint2 o; o.x = pack2(v0, v1); o.y = pack2(v2, v3);
          *(uint2*)(so + m * 136 + n) = o;
        }
      }
      __syncthreads();
#pragma unroll
      for (int c = 0; c < 16; ++c) {
        const int idx = tid + c * 256;
        const int row = idx >> 4, ch = idx & 15;
        uint4 v = *(const uint4*)(so + row * 136 + ch * 8);
        *(uint4*)(outp + ((unsigned)(mt * 256 + row) * D + col0 + ch * 8)) = v;
      }
      __syncthreads();
    }
  }
}

struct TokF1 {
  const u16* zr; const u16* zi; int n1; unsigned off;
  DEVFN unsigned operator()(int k, const u16*& b) const {
    int ri = k >= n1 ? 1 : 0;
    int s1 = k - ri * n1;
    b = ri ? zi : zr;
    return off + (unsigned)(s1 * 128) * D;
  }
};
DEVFN void f1_twiddle(int tid, const Params& p, const f32x4 (&acc)[4][4], int hf, int s2, int smask, int twmul,
                      uint2 (&o1)[2][4], uint2 (&o2)[2][4]) {
  const int lane = tid & 63, w = tid >> 6, wm = w >> 1, lr = lane & 15;
  const float2* tw = TW(p);
#pragma unroll
  for (int b = 0; b < 2; ++b) {
    int k1 = (hf * 4 + wm * 2 + b) * 16 + lr;
    float2 t = tw[((k1 * s2) & smask) * twmul];
#pragma unroll
    for (int j = 0; j < 4; ++j) {
      f32x4 orr = acc[2 * b][j], oii = acc[2 * b + 1][j];
      o1[b][j].x = pack2(orr[0] * t.x + oii[0] * t.y, orr[1] * t.x + oii[1] * t.y);
      o1[b][j].y = pack2(orr[2] * t.x + oii[2] * t.y, orr[3] * t.x + oii[3] * t.y);
      o2[b][j].x = pack2(oii[0] * t.x - orr[0] * t.y, oii[1] * t.x - orr[1] * t.y);
      o2[b][j].y = pack2(oii[2] * t.x - orr[2] * t.y, oii[3] * t.x - orr[3] * t.y);
    }
  }
}
DEVFN void f1_write(int tid, int hf, unsigned off, const uint2 (&o1)[2][4], const uint2 (&o2)[2][4], u16* zr, u16* zi, u16* so) {
  const int lane = tid & 63, w = tid >> 6, wm = w >> 1, wn = w & 1, lr = lane & 15, quad = lane >> 4;
#pragma unroll
  for (int b = 0; b < 2; ++b) {
    const int rl = (wm * 2 + b) * 16 + lr;
#pragma unroll
    for (int j = 0; j < 4; ++j) {
      const int n = wn * 64 + j * 16 + quad * 4;
      *(uint2*)(so + rl * 136 + n) = o1[b][j];
      *(uint2*)(so + (64 + rl) * 136 + n) = o2[b][j];
    }
  }
  __syncthreads();
#pragma unroll
  for (int c = 0; c < 8; ++c) {
    const int idx = tid + c * 256;
    const int pl = idx >> 10, row = (idx >> 4) & 63, ch = idx & 15;
    const unsigned k1 = hf * 64 + row;
    uint4 v = *(const uint4*)(so + (pl * 64 + row) * 136 + ch * 8);
    *(uint4*)((pl ? zi : zr) + (off + (k1 * 128) * D + ch * 8)) = v;
  }
  __syncthreads();
}
DEVFN void phase_fft1(const Params& p, u16* smem) {
  u16* zr = U(p, 3);
  u16* zi = U(p, 4);
  for (int tile = blockIdx.x; tile < 9216; tile += gridDim.x) {
    const int tid = otid();
    int seq, s2, ct, n1;
    if (tile < 1024) { seq = 0; s2 = tile >> 3; ct = tile & 7; n1 = 128; }
    else { int t2 = tile - 1024; seq = 1 + (t2 >> 10); s2 = (t2 >> 3) & 127; ct = t2 & 7; n1 = 64; }
    const unsigned off = (unsigned)(seq_start(seq) + s2) * D + ct * 128;
    LdTrans<TokF1> lb; lb.t_ = tid; lb.tok.zr = zr; lb.tok.zi = zi; lb.tok.n1 = n1; lb.tok.off = off;
    const int K = 2 * n1, nk = K >> 6;
    const u16* tab = TAB(p) + (seq == 0 ? T_D1A : T_D1B);
    const int smask = seq == 0 ? 16383 : 8191, twmul = seq == 0 ? 1 : 2;
    uint2 a1[2][4], a2[2][4];
    {
      f32x4 acc[4][4]; zero_acc(acc);
      LdPlain la; la.init(tid, tab, 0, K); gemm_core(tid, acc, nk, la, lb, smem);
      f1_twiddle(tid, p, acc, 0, s2, smask, twmul, a1, a2);
    }
    if (seq == 0) {
      uint2 b1[2][4], b2[2][4];
      {
        f32x4 acc[4][4]; zero_acc(acc);
        LdPlain la; la.init(tid, tab, 128, K); gemm_core(tid, acc, nk, la, lb, smem);
        f1_twiddle(tid, p, acc, 1, s2, smask, twmul, b1, b2);
      }
      f1_write(tid, 1, off, b1, b2, zr, zi, smem);
    }
    f1_write(tid, 0, off, a1, a2, zr, zi, smem);
  }
}

struct TokF2 {
  const u16* zr; const u16* zi; unsigned off;
  DEVFN unsigned operator()(int k, const u16*& b) const {
    int ri = k >> 7, s2 = k & 127;
    b = ri ? zi : zr;
    return off + (unsigned)s2 * D;
  }
};
DEVFN void phase_fft2(const Params& p, u16* smem) {
  u16* zr = U(p, 3);
  const u16* gbp = U(p, 5);
  for (int tile = blockIdx.x; tile < 5120; tile += gridDim.x) {
    const int tid = otid(), lane = tid & 63, w = tid >> 6, wm = w >> 1, wn = w & 1, lr = lane & 15, quad = lane >> 4;
    int seq, k1, ct, n1;
    if (tile < 1024) { seq = 0; k1 = tile >> 3; ct = tile & 7; n1 = 128; }
    else { int t2 = tile - 1024; seq = 1 + (t2 >> 9); k1 = (t2 >> 3) & 63; ct = t2 & 7; n1 = 64; }
    const int sst = seq_start(seq);
    const unsigned off = (unsigned)(sst + k1 * 128) * D + ct * 128;
    LdTrans<TokF2> lb; lb.t_ = tid; lb.tok.zr = zr; lb.tok.zi = U(p, 4); lb.tok.off = off;
    LdPlain la; la.init(tid, TAB(p) + T_D2, 0, 256);
    f32x4 acc[4][4]; zero_acc(acc);
    gemm_core(tid, acc, 4, la, lb, smem);
    const float nrm = seq == 0 ? (1.f / 2048.f) : 6.9053396600248786e-4f;
    u16* so = smem;
#pragma unroll
    for (int c = 0; c < 8; ++c) {
      const int idx = tid + c * 256;
      const int row = idx >> 4, ch = idx & 15;
      *(uint4*)(so + row * 136 + ch * 8) = *(const uint4*)(gbp + ((unsigned)(sst + k1 + n1 * row) * D + ct * 128 + ch * 8));
    }
    __syncthreads();
#pragma unroll
    for (int i = 0; i < 4; ++i) {
      const int k2 = wm * 64 + i * 16 + lr;
#pragma unroll
      for (int j = 0; j < 4; ++j) {
        const int cl = wn * 64 + j * 16 + quad * 4;
        uint2 gv = *(const uint2*)(so + k2 * 136 + cl);
        uint2 o;
        o.x = pack2(acc[i][j][0] * nrm * lo2f(gv.x), acc[i][j][1] * nrm * hi2f(gv.x));
        o.y = pack2(acc[i][j][2] * nrm * lo2f(gv.y), acc[i][j][3] * nrm * hi2f(gv.y));
        *(uint2*)(so + k2 * 136 + cl) = o;
      }
    }
    __syncthreads();
#pragma unroll
    for (int c = 0; c < 8; ++c) {
      const int idx = tid + c * 256;
      const int row = idx >> 4, ch = idx & 15;
      *(uint4*)(zr + (off + (unsigned)row * D + ch * 8)) = *(const uint4*)(so + row * 136 + ch * 8);
    }
    __syncthreads();
  }
}

constexpr int SA_LD = 128;
template <int PASS>
DEVFN void phase_scan(const Params& p, int l, int dirsel, unsigned char* smem_raw) {
  float* sAf = (float*)smem_raw;
  u16* sBh = (u16*)(smem_raw + 32768);
  u16* sXc = (u16*)(smem_raw + 32768 + 16384);
  const int tid = otid(), lane = tid & 63, w = tid >> 6, lr = lane & 15, quad = lane >> 4;
  const int head = blockIdx.x & 7;
  const int dir = PASS == 1 ? ((blockIdx.x >> 3) & 1) : dirsel;
  const int tstart = PASS == 1 ? (blockIdx.x >> 4) : (blockIdx.x >> 3);
  const int tstep = PASS == 1 ? (gridDim.x >> 4) : (gridDim.x >> 3);
  const u16* xa = U(p, 1);
  u16* ga = U(p, 2);
  u16* hf = U(p, 5);
  float2* agg = (float2*)U(p, 4);
  float* carry = (float*)(agg + 1280L * 2 * 1024);
  bf16x8 bw[4][4];
  {
    const u16* wrg = WL(p, l) + W_RG;
#pragma unroll
    for (int jt = 0; jt < 4; ++jt) {
      int q = jt >> 1, col = w * 32 + (jt & 1) * 16 + lr;
      const u16* bp = wrg + (unsigned)((((dir * 2 + q) * 8 + head) * 128 + col) * 128 + quad * 8);
#pragma unroll
      for (int ks = 0; ks < 4; ++ks) bw[jt][ks] = *(const bf16x8*)(bp + ks * 32);
    }
  }
  float spl[2], brr[2], bii[2];
#pragma unroll
  for (int jc = 0; jc < 2; ++jc) {
    int cgl = head * 128 + w * 32 + jc * 16 + lr;
    float lm = p.lam[(l * 2 + dir) * D + cgl];
    spl[jc] = -8.f * 1.4426950408889634f * log1pf(expf(-lm));
    brr[jc] = -1.4426950408889634f * p.b_rg[((l * 2 + dir) * 2 + 0) * D + cgl];
    bii[jc] = -1.4426950408889634f * p.b_rg[((l * 2 + dir) * 2 + 1) * D + cgl];
  }
  const int c8 = tid & 15, tg = tid >> 4;
  float* sCw = (float*)(smem_raw + 65536);
  for (int i = tid; i < 640; i += 256) {
    int k = i >> 7, c = i & 127;
    sCw[i] = k < 4 ? p.conv_w[(l * 4 + k) * D + head * 128 + c] : p.conv_b[l * D + head * 128 + c];
  }
  __syncthreads();
  uint4 xr[7];
#define LOAD_XROWS(TT) do { const int _g0 = (TT) * 64; const int _sq = seq_of(_g0), _ss = seq_start(_sq), _se = _ss + seq_len(_sq); \
    _Pragma("unroll") for (int r = 0; r < 7; ++r) { int _g = _g0 + tg * 4 - 2 + r; xr[r] = make_uint4(0, 0, 0, 0); \
      if (_g >= _ss && _g < _se) xr[r] = *(const uint4*)(xa + ((unsigned)_g * D + head * 128 + c8 * 8)); } } while (0)
  if (tstart < 1280) LOAD_XROWS(tstart);
  for (int tt = tstart; tt < 1280; tt += tstep) {
    const int g0 = tt * 64;
    const int seq = seq_of(g0), sst = seq_start(seq), send = sst + seq_len(seq);
#pragma unroll
    for (int j = 0; j < 4; ++j) {
      float o[8];
      {
        float4 b0 = *(const float4*)(sCw + 512 + c8 * 8), b1 = *(const float4*)(sCw + 512 + c8 * 8 + 4);
        o[0] = b0.x; o[1] = b0.y; o[2] = b0.z; o[3] = b0.w; o[4] = b1.x; o[5] = b1.y; o[6] = b1.z; o[7] = b1.w;
      }
#pragma unroll
      for (int k = 0; k < 4; ++k) {
        uint4 v = xr[j + k];
        float4 w0 = *(const float4*)(sCw + k * 128 + c8 * 8), w1 = *(const float4*)(sCw + k * 128 + c8 * 8 + 4);
        o[0] += w0.x * lo2f(v.x); o[1] += w0.y * hi2f(v.x);
        o[2] += w0.z * lo2f(v.y); o[3] += w0.w * hi2f(v.y);
        o[4] += w1.x * lo2f(v.z); o[5] += w1.y * hi2f(v.z);
        o[6] += w1.z * lo2f(v.w); o[7] += w1.w * hi2f(v.w);
      }
      uint4 q0;
      q0.x = pack2(o[0], o[1]); q0.y = pack2(o[2], o[3]); q0.z = pack2(o[4], o[5]); q0.w = pack2(o[6], o[7]);
      const int tl = tg * 4 + j;
      *(uint4*)(sXc + tl * 128 + ((c8 ^ (tl & 7)) << 3)) = q0;
    }
    __syncthreads();
    if (tt + tstep < 1280) LOAD_XROWS(tt + tstep);
    const int gstart = dir == 0 ? sst : send - 1;
#pragma unroll 1
    for (int hv = 0; hv < 2; ++hv) {
      f32x4 acc[2][4];
#pragma unroll
      for (int it = 0; it < 2; ++it)
#pragma unroll
        for (int jt = 0; jt < 4; ++jt) acc[it][jt] = f32x4{0.f, 0.f, 0.f, 0.f};
#pragma unroll
      for (int ks = 0; ks < 4; ++ks) {
#pragma unroll
        for (int it = 0; it < 2; ++it) {
          bf16x8 af = *(const bf16x8*)(sXc + ((hv * 2 + it) * 16 + lr) * 128 + (((ks * 4 + quad) ^ (lr & 7)) << 3));
#pragma unroll
          for (int jt = 0; jt < 4; ++jt)
            acc[it][jt] = __builtin_amdgcn_mfma_f32_16x16x32_bf16(af, bw[jt][ks], acc[it][jt], 0, 0, 0);
        }
      }
#pragma unroll
      for (int it = 0; it < 2; ++it)
#pragma unroll
        for (int jc = 0; jc < 2; ++jc) {
#pragma unroll
          for (int r = 0; r < 4; ++r) {
            int tl = (hv * 2 + it) * 16 + quad * 4 + r, c = w * 32 + jc * 16 + lr;
            float er = 1.f + __builtin_amdgcn_exp2f(fminf(fmaf(acc[it][jc][r], -1.4426950408889634f, brr[jc]), 60.f));
            float ei = 1.f + __builtin_amdgcn_exp2f(fminf(fmaf(acc[it][2 + jc][r], -1.4426950408889634f, bii[jc]), 60.f));
            float q = __builtin_amdgcn_rcpf(er * ei);
            float rr = q * ei, ii = q * er;
            float a = __builtin_amdgcn_exp2f(rr * spl[jc]);
            float mult = __builtin_amdgcn_sqrtf((1.f - a) * (1.f + a));
            if (g0 + tl == gstart) mult = 1.f;
            float xv = bf2f(sXc[tl * 128 + (((c >> 3) ^ (tl & 7)) << 3) + (c & 7)]);
            sAf[tl * SA_LD + c] = a;
            sBh[tl * 128 + c] = f2bf(mult * ii * xv);
          }
        }
    }
    __syncthreads();
    if (tid < 128) {
      const int c = tid;
      const unsigned aidx = (unsigned)(tt * 2 + dir) * 1024 + head * 128 + c;
      const float* ap = sAf + c;
      u16* bp = sBh + c;
      if (PASS == 1) {
        float h = 0.f, P = 1.f;
        if (dir == 0) {
#pragma unroll 16
          for (int st = 0; st < 64; ++st) { float a = ap[st * SA_LD]; h = a * h + bf2f(bp[st * 128]); P *= a; }
        } else {
#pragma unroll 16
          for (int st = 63; st >= 0; --st) { float a = ap[st * SA_LD]; h = a * h + bf2f(bp[st * 128]); P *= a; }
        }
        agg[aidx] = make_float2(P, h);
      } else {
        float h = carry[aidx];
        if (dir == 0) {
#pragma unroll 16
          for (int st = 0; st < 64; ++st) { h = ap[st * SA_LD] * h + bf2f(bp[st * 128]); bp[st * 128] = f2bf(h); }
        } else {
#pragma unroll 16
          for (int st = 63; st >= 0; --st) { h = ap[st * SA_LD] * h + bf2f(bp[st * 128]); bp[st * 128] = f2bf(h); }
        }
      }
    }
    if (PASS == 3) {
      __syncthreads();
#pragma unroll
      for (int cch = 0; cch < 4; ++cch) {
        int chunk = tid + cch * 256;
        int t = chunk >> 4, cc = (chunk & 15) * 8;
        unsigned off = (unsigned)(g0 + t) * D + head * 128 + cc;
        uint4 hv = *(const uint4*)(sBh + t * 128 + cc);
        if (dir == 0) {
          *(uint4*)(hf + off) = hv;
        } else {
          uint4 fv = *(const uint4*)(hf + off);
          uint4 gv = *(const uint4*)(ga + off);
          uint4 o;
          o.x = pack2((lo2f(fv.x) + lo2f(hv.x)) * lo2f(gv.x), (hi2f(fv.x) + hi2f(hv.x)) * hi2f(gv.x));
          o.y = pack2((lo2f(fv.y) + lo2f(hv.y)) * lo2f(gv.y), (hi2f(fv.y) + hi2f(hv.y)) * hi2f(gv.y));
          o.z = pack2((lo2f(fv.z) + lo2f(hv.z)) * lo2f(gv.z), (hi2f(fv.z) + hi2f(hv.z)) * hi2f(gv.z));
          o.w = pack2((lo2f(fv.w) + lo2f(hv.w)) * lo2f(gv.w), (hi2f(fv.w) + hi2f(hv.w)) * hi2f(gv.w));
          *(uint4*)(ga + off) = o;
        }
      }
    }
    __syncthreads();
  }
#undef LOAD_XROWS
}

DEVFN void lb_st64(unsigned long long* q, unsigned long long v) { __hip_atomic_store(q, v, __ATOMIC_RELAXED, __HIP_MEMORY_SCOPE_AGENT); }
DEVFN unsigned long long lb_ld64(const unsigned long long* q) { return __hip_atomic_load(q, __ATOMIC_RELAXED, __HIP_MEMORY_SCOPE_AGENT); }
DEVFN void lb_st32(unsigned* q, unsigned v) { __hip_atomic_store(q, v, __ATOMIC_RELAXED, __HIP_MEMORY_SCOPE_AGENT); }
DEVFN unsigned lb_ld32(const unsigned* q) { return __hip_atomic_load(q, __ATOMIC_RELAXED, __HIP_MEMORY_SCOPE_AGENT); }
DEVFN unsigned long long lb_pack(float a, float b) { return (unsigned long long)__float_as_uint(a) | ((unsigned long long)__float_as_uint(b) << 32); }
DEVFN unsigned long long lb_gran(float P, float H, unsigned tag) {
  return ((unsigned long long)__float_as_uint(H) << 32) | (unsigned long long)((__float_as_uint(P) & 0xffffff00u) | tag);
}
DEVFN int lb_rank(int seq, int pos) { return seq == 0 ? (pos >> 1) * 10 + ((pos & 1) ? 9 : 0) : pos * 10 + seq; }
DEVFN void lb_decode(int r, int dir, int& seq, int& pos, int& tt) {
  int pair = r / 10, j = r - pair * 10;
  if (j == 0) { seq = 0; pos = 2 * pair; } else if (j == 9) { seq = 0; pos = 2 * pair + 1; } else { seq = j; pos = pair; }
  int len = seq == 0 ? 256 : 128;
  tt = (seq_start(seq) >> 6) + (dir ? len - 1 - pos : pos);
}
DEVFN void phase_scan_lb(const Params& p, int l, unsigned char* smem_raw) {
  float* sAf = (float*)smem_raw;
  u16* sBh = (u16*)(smem_raw + 32768);
  u16* sXc = (u16*)(smem_raw + 32768 + 16384);
  unsigned* sflag = (unsigned*)(smem_raw + 65536 + 2560);
  const int tid = otid(), lane = tid & 63, w = tid >> 6, lr = lane & 15, quad = lane >> 4;
  const int hd = blockIdx.x & 15, head = hd >> 1, dir = hd & 1;
  const int rstart = blockIdx.x >> 4, rstep = gridDim.x >> 4;
  const u16* xa = U(p, 1);
  u16* ga = U(p, 2);
  u16* hown = dir == 0 ? U(p, 5) : U(p, 4);
  const u16* hoth = dir == 0 ? U(p, 4) : U(p, 5);
  unsigned long long* slot = (unsigned long long*)(p.ws + OFF_LB_BYTES);
  unsigned* stat = (unsigned*)(p.ws + OFF_LB_BYTES + LB_SLOT_BYTES);
  unsigned* cnt = stat + 20480;
  const unsigned ep = 2u * (unsigned)l;
  const unsigned tagb = ((unsigned)l + 1u) * 4u;
  bf16x8 bw[4][4];
  {
    const u16* wrg = WL(p, l) + W_RG;
#pragma unroll
    for (int jt = 0; jt < 4; ++jt) {
      int q = jt >> 1, col = w * 32 + (jt & 1) * 16 + lr;
      const u16* bp = wrg + (unsigned)((((dir * 2 + q) * 8 + head) * 128 + col) * 128 + quad * 8);
#pragma unroll
      for (int ks = 0; ks < 4; ++ks) bw[jt][ks] = *(const bf16x8*)(bp + ks * 32);
    }
  }
  float spl[2], brr[2], bii[2];
#pragma unroll
  for (int jc = 0; jc < 2; ++jc) {
    int cgl = head * 128 + w * 32 + jc * 16 + lr;
    float lm = p.lam[(l * 2 + dir) * D + cgl];
    spl[jc] = -8.f * 1.4426950408889634f * log1pf(expf(-lm));
    brr[jc] = -1.4426950408889634f * p.b_rg[((l * 2 + dir) * 2 + 0) * D + cgl];
    bii[jc] = -1.4426950408889634f * p.b_rg[((l * 2 + dir) * 2 + 1) * D + cgl];
  }
  const int c8 = tid & 15, tg = tid >> 4;
  float* sCw = (float*)(smem_raw + 65536);
  for (int i = tid; i < 640; i += 256) {
    int k = i >> 7, c = i & 127;
    sCw[i] = k < 4 ? p.conv_w[(l * 4 + k) * D + head * 128 + c] : p.conv_b[l * D + head * 128 + c];
  }
  __syncthreads();
  uint4 xr[7];
#define LOAD_XROWS(TT) do { const int _g0 = (TT) * 64; const int _sq = seq_of(_g0), _ss = seq_start(_sq), _se = _ss + seq_len(_sq); \
    _Pragma("unroll") for (int r_ = 0; r_ < 7; ++r_) { int _g = _g0 + tg * 4 - 2 + r_; xr[r_] = make_uint4(0, 0, 0, 0); \
      if (_g >= _ss && _g < _se) xr[r_] = *(const uint4*)(xa + ((unsigned)_g * D + head * 128 + c8 * 8)); } } while (0)
  if (rstart < 1280) { int sq_, ps_, t0_; lb_decode(rstart, dir, sq_, ps_, t0_); LOAD_XROWS(t0_); }
  for (int r = rstart; r < 1280; r += rstep) {
    int seq, pos, tt;
    lb_decode(r, dir, seq, pos, tt);
    const int item = r * 16 + hd;
    const int g0 = tt * 64;
    const int sst = seq_start(seq), send = sst + seq_len(seq);
#pragma unroll
    for (int j = 0; j < 4; ++j) {
      float o[8];
      {
        float4 b0 = *(const float4*)(sCw + 512 + c8 * 8), b1 = *(const float4*)(sCw + 512 + c8 * 8 + 4);
        o[0] = b0.x; o[1] = b0.y; o[2] = b0.z; o[3] = b0.w; o[4] = b1.x; o[5] = b1.y; o[6] = b1.z; o[7] = b1.w;
      }
#pragma unroll
      for (int k = 0; k < 4; ++k) {
        uint4 v = xr[j + k];
        float4 w0 = *(const float4*)(sCw + k * 128 + c8 * 8), w1 = *(const float4*)(sCw + k * 128 + c8 * 8 + 4);
        o[0] += w0.x * lo2f(v.x); o[1] += w0.y * hi2f(v.x);
        o[2] += w0.z * lo2f(v.y); o[3] += w0.w * hi2f(v.y);
        o[4] += w1.x * lo2f(v.z); o[5] += w1.y * hi2f(v.z);
        o[6] += w1.z * lo2f(v.w); o[7] += w1.w * hi2f(v.w);
      }
      uint4 q0;
      q0.x = pack2(o[0], o[1]); q0.y = pack2(o[2], o[3]); q0.z = pack2(o[4], o[5]); q0.w = pack2(o[6], o[7]);
      const int tl = tg * 4 + j;
      *(uint4*)(sXc + tl * 128 + ((c8 ^ (tl & 7)) << 3)) = q0;
    }
    __syncthreads();
    if (r + rstep < 1280) { int sq_, ps_, t1_; lb_decode(r + rstep, dir, sq_, ps_, t1_); LOAD_XROWS(t1_); }
    const int gstart = dir == 0 ? sst : send - 1;
#pragma unroll 1
    for (int hv = 0; hv < 2; ++hv) {
      f32x4 acc[2][4];
#pragma unroll
      for (int it = 0; it < 2; ++it)
#pragma unroll
        for (int jt = 0; jt < 4; ++jt) acc[it][jt] = f32x4{0.f, 0.f, 0.f, 0.f};
#pragma unroll
      for (int ks = 0; ks < 4; ++ks) {
#pragma unroll
        for (int it = 0; it < 2; ++it) {
          bf16x8 af = *(const bf16x8*)(sXc + ((hv * 2 + it) * 16 + lr) * 128 + (((ks * 4 + quad) ^ (lr & 7)) << 3));
#pragma unroll
          for (int jt = 0; jt < 4; ++jt)
            acc[it][jt] = __builtin_amdgcn_mfma_f32_16x16x32_bf16(af, bw[jt][ks], acc[it][jt], 0, 0, 0);
        }
      }
#pragma unroll
      for (int it = 0; it < 2; ++it)
#pragma unroll
        for (int jc = 0; jc < 2; ++jc) {
#pragma unroll
          for (int r = 0; r < 4; ++r) {
            int tl = (hv * 2 + it) * 16 + quad * 4 + r, c = w * 32 + jc * 16 + lr;
            float er = 1.f + __builtin_amdgcn_exp2f(fminf(fmaf(acc[it][jc][r], -1.4426950408889634f, brr[jc]), 60.f));
            float ei = 1.f + __builtin_amdgcn_exp2f(fminf(fmaf(acc[it][2 + jc][r], -1.4426950408889634f, bii[jc]), 60.f));
            float q = __builtin_amdgcn_rcpf(er * ei);
            float rr = q * ei, ii = q * er;
            float a = __builtin_amdgcn_exp2f(rr * spl[jc]);
            float mult = __builtin_amdgcn_sqrtf((1.f - a) * (1.f + a));
            if (g0 + tl == gstart) mult = 1.f;
            float xv = bf2f(sXc[tl * 128 + (((c >> 3) ^ (tl & 7)) << 3) + (c & 7)]);
            sAf[tl * SA_LD + c] = a;
            sBh[tl * 128 + c] = f2bf(mult * ii * xv);
          }
        }
    }
    __syncthreads();
    float aggP = 1.f, aggH = 0.f;
    if (tid < 128) {
      const float* ap = sAf + tid;
      const u16* bp = sBh + tid;
      if (dir == 0) {
#pragma unroll 16
        for (int st = 0; st < 64; ++st) { float a = ap[st * SA_LD]; aggH = a * aggH + bf2f(bp[st * 128]); aggP *= a; }
      } else {
#pragma unroll 16
        for (int st = 63; st >= 0; --st) { float a = ap[st * SA_LD]; aggH = a * aggH + bf2f(bp[st * 128]); aggP *= a; }
      }
      lb_st64(slot + (unsigned)item * 128 + tid, lb_gran(pos == 0 ? 0.f : aggP, aggH, tagb + (pos == 0 ? 2u : 1u)));
    }
    float carry = 0.f;
    if (pos > 0) {
      if (tid < 128) {
        float Pr = 1.f, Hr = 0.f;
        int pj = pos - 1;
        for (;;) {
          const int j = lb_rank(seq, pj) * 16 + hd;
          unsigned long long v;
          unsigned spins = 0;
          for (;;) {
            v = lb_ld64(slot + (unsigned)j * 128 + tid);
            unsigned tg_ = (unsigned)v & 0xffu;
            if ((tg_ >> 2) == (tagb >> 2) && (tg_ & 3u) != 0u) break;
            __builtin_amdgcn_s_sleep(1);
            if (++spins > (1u << 18)) break;
          }
          float Pj = __uint_as_float((unsigned)v & 0xffffff00u), Hj = __uint_as_float((unsigned)(v >> 32));
          Hr += Pr * Hj;
          Pr *= Pj;
          if (((unsigned)v & 3u) == 2u || pj == 0) break;
          --pj;
        }
        carry = Hr;
        lb_st64(slot + (unsigned)item * 128 + tid, lb_gran(0.f, aggP * carry + aggH, tagb + 2u));
      }
    }
    if (tid < 128) {
      const float* ap = sAf + tid;
      u16* bp = sBh + tid;
      float h = carry;
      if (dir == 0) {
#pragma unroll 16
        for (int st = 0; st < 64; ++st) { h = ap[st * SA_LD] * h + bf2f(bp[st * 128]); bp[st * 128] = f2bf(h); }
      } else {
#pragma unroll 16
        for (int st = 63; st >= 0; --st) { h = ap[st * SA_LD] * h + bf2f(bp[st * 128]); bp[st * 128] = f2bf(h); }
      }
    }
    __syncthreads();
#pragma unroll
    for (int cch = 0; cch < 4; ++cch) {
      int chunk = tid + cch * 256;
      int t = chunk >> 4, cc = (chunk & 15) * 8;
      unsigned off = (unsigned)(g0 + t) * D + head * 128 + cc;
      uint4 hv = *(const uint4*)(sBh + t * 128 + cc);
      unsigned long long* q = (unsigned long long*)(hown + off);
      lb_st64(q, (unsigned long long)hv.x | ((unsigned long long)hv.y << 32));
      lb_st64(q + 1, (unsigned long long)hv.z | ((unsigned long long)hv.w << 32));
    }
    asm volatile("s_waitcnt vmcnt(0)" ::: "memory");
    __syncthreads();
    if (tid == 0) sflag[0] = __hip_atomic_fetch_add(cnt + tt * 8 + head, 1u, __ATOMIC_RELAXED, __HIP_MEMORY_SCOPE_AGENT);
    __syncthreads();
    if (sflag[0] == ep + 1u) {
#pragma unroll
      for (int cch = 0; cch < 4; ++cch) {
        int chunk = tid + cch * 256;
        int t = chunk >> 4, cc = (chunk & 15) * 8;
        unsigned off = (unsigned)(g0 + t) * D + head * 128 + cc;
        uint4 hv = *(const uint4*)(sBh + t * 128 + cc);
        const unsigned long long* q = (const unsigned long long*)(hoth + off);
        unsigned long long f0 = lb_ld64(q), f1 = lb_ld64(q + 1);
        uint4 fv = make_uint4((unsigned)f0, (unsigned)(f0 >> 32), (unsigned)f1, (unsigned)(f1 >> 32));
        uint4 gv = *(const uint4*)(ga + off);
        uint4 o;
        o.x = pack2((lo2f(fv.x) + lo2f(hv.x)) * lo2f(gv.x), (hi2f(fv.x) + hi2f(hv.x)) * hi2f(gv.x));
        o.y = pack2((lo2f(fv.y) + lo2f(hv.y)) * lo2f(gv.y), (hi2f(fv.y) + hi2f(hv.y)) * hi2f(gv.y));
        o.z = pack2((lo2f(fv.z) + lo2f(hv.z)) * lo2f(gv.z), (hi2f(fv.z) + hi2f(hv.z)) * hi2f(gv.z));
        o.w = pack2((lo2f(fv.w) + lo2f(hv.w)) * lo2f(gv.w), (hi2f(fv.w) + hi2f(hv.w)) * hi2f(gv.w));
        *(uint4*)(ga + off) = o;
      }
    }
    __syncthreads();
  }
#undef LOAD_XROWS
}

DEVFN void phase_carry(const Params& p) {
  const float2* __restrict__ agg = (const float2*)U(p, 4);
  float* __restrict__ carry = (float*)(agg + 1280L * 2 * 1024);
  const int lane = threadIdx.x & 63, w = threadIdx.x >> 6;
  for (int u = blockIdx.x + gridDim.x * w; u < 288; u += gridDim.x * 4) {
    int id = u * 64 + lane;
    int seq = id >> 11, dir = (id >> 10) & 1, c = id & 1023;
    int nt = seq_len(seq) >> 6, tile0 = seq_start(seq) >> 6;
    float h = 0.f;
#pragma unroll 8
    for (int k = 0; k < nt; ++k) {
      int tt = tile0 + (dir ? nt - 1 - k : k);
      unsigned ix = (unsigned)(tt * 2 + dir) * 1024 + c;
      float2 v = agg[ix];
      carry[ix] = h;
      h = v.x * h + v.y;
    }
  }
}

DEVFN void phase_merge(const Params& p, int l, u16* smem) {
  const u16* wl = WL(p, l);
  u16* mo = U(p, 1);
  u16* tb = U(p, 5);
  u16* so = smem;
  for (int it = 0;; ++it) {
    int mt, nt;
    if (!tile_xcd(it, 1, 8, mt, nt)) break;
    const int g0 = mt * 256;
#pragma unroll 1
    for (int br = 0; br < 2; ++br) {
      {
        const int tid = otid(), lane = tid & 63, w = tid >> 6, wm = w >> 1, wn = w & 1, lr = lane & 15, quad = lane >> 4;
        f32x4 acc[8][4]; zero_acc8(acc);
        LdPlain lb; lb.init(tid, wl + (br == 0 ? W_A : W_B), nt * 128, D);
        if (br == 0) {
          LdPlain la; la.init(tid, U(p, 2), g0, D);
          gemm_core_b(tid, acc, 32, la, lb, smem);
        } else {
          const int seq = seq_of(g0);
          LdPerm la; la.base = U(p, 3); la.g0 = g0; la.sst = seq_start(seq); la.lg = seq == 0 ? 7 : 6;
          gemm_core_b(tid, acc, 32, la, lb, smem);
        }
#pragma unroll
        for (int i = 0; i < 8; ++i) {
          const int m = wm * 128 + i * 16 + lr;
#pragma unroll
          for (int j = 0; j < 4; ++j) {
            const int n = wn * 64 + j * 16 + quad * 4;
            uint2 o; o.x = pack2(acc[i][j][0], acc[i][j][1]); o.y = pack2(acc[i][j][2], acc[i][j][3]);
            *(uint2*)(so + m * 136 + n) = o;
          }
        }
        __syncthreads();
#pragma unroll
        for (int c = 0; c < 16; ++c) {
          const int idx = tid + c * 256;
          const int row = idx >> 4, ch = idx & 15;
          *(uint4*)(tb + ((unsigned)(g0 + row) * D + nt * 128 + ch * 8)) = *(const uint4*)(so + row * 136 + ch * 8);
        }
        __syncthreads();
      }
      {
        const int tid = otid(), lane = tid & 63, w = tid >> 6, wm = w >> 1, wn = w & 1, lr = lane & 15, quad = lane >> 4;
        f32x4 acc[8][4]; zero_acc8(acc);
        LdPlain la; la.init(tid, U(p, 0), g0, D);
        LdPlain lb; lb.init(tid, wl + W_CAT, 5120 + br * 1024 + nt * 128, D);
        gemm_core_b(tid, acc, 32, la, lb, smem);
#pragma unroll
        for (int c = 0; c < 16; ++c) {
          const int idx = tid + c * 256;
          const int row = idx >> 4, ch = idx & 15;
          *(uint4*)(so + row * 136 + ch * 8) = *(const uint4*)(tb + ((unsigned)(g0 + row) * D + nt * 128 + ch * 8));
        }
        __syncthreads();
#pragma unroll
        for (int i = 0; i < 8; ++i) {
          const int m = wm * 128 + i * 16 + lr;
#pragma unroll
          for (int j = 0; j < 4; ++j) {
            const int n = wn * 64 + j * 16 + quad * 4;
            uint2 tv = *(const uint2*)(so + m * 136 + n);
            acc[i][j][0] = sigm(acc[i][j][0]) * lo2f(tv.x);
            acc[i][j][1] = sigm(acc[i][j][1]) * hi2f(tv.x);
            acc[i][j][2] = sigm(acc[i][j][2]) * lo2f(tv.y);
            acc[i][j][3] = sigm(acc[i][j][3]) * hi2f(tv.y);
          }
        }
        if (br == 1) {
          __syncthreads();
#pragma unroll
          for (int c = 0; c < 16; ++c) {
            const int idx = tid + c * 256;
            const int row = idx >> 4, ch = idx & 15;
            *(uint4*)(so + row * 136 + ch * 8) = *(const uint4*)(mo + ((unsigned)(g0 + row) * D + nt * 128 + ch * 8));
          }
          __syncthreads();
#pragma unroll
          for (int i = 0; i < 8; ++i) {
            const int m = wm * 128 + i * 16 + lr;
#pragma unroll
            for (int j = 0; j < 4; ++j) {
              const int n = wn * 64 + j * 16 + quad * 4;
              uint2 pv = *(const uint2*)(so + m * 136 + n);
              acc[i][j][0] += lo2f(pv.x); acc[i][j][1] += hi2f(pv.x);
              acc[i][j][2] += lo2f(pv.y); acc[i][j][3] += hi2f(pv.y);
            }
          }
        }
        __syncthreads();
#pragma unroll
        for (int i = 0; i < 8; ++i) {
          const int m = wm * 128 + i * 16 + lr;
#pragma unroll
          for (int j = 0; j < 4; ++j) {
            const int n = wn * 64 + j * 16 + quad * 4;
            uint2 o; o.x = pack2(acc[i][j][0], acc[i][j][1]); o.y = pack2(acc[i][j][2], acc[i][j][3]);
            *(uint2*)(so + m * 136 + n) = o;
          }
        }
        __syncthreads();
#pragma unroll
        for (int c = 0; c < 16; ++c) {
          const int idx = tid + c * 256;
          const int row = idx >> 4, ch = idx & 15;
          *(uint4*)(mo + ((unsigned)(g0 + row) * D + nt * 128 + ch * 8)) = *(const uint4*)(so + row * 136 + ch * 8);
        }
        __syncthreads();
      }
    }
  }
}

DEVFN void phase_out(const Params& p, int l, u16* smem) {
  const u16* wo = WL(p, l) + W_O;
  for (int it = 0;; ++it) {
    int mt, nt;
    if (!tile_xcd(it, 1, 8, mt, nt)) break;
    const int tid = otid(), lane = tid & 63, w = tid >> 6, wm = w >> 1, wn = w & 1, lr = lane & 15, quad = lane >> 4;
    const int g0 = mt * 256;
    LdPlain la; la.init(tid, U(p, 1), g0, D);
    LdPlain lb; lb.init(tid, wo, nt * 128, D);
    f32x4 acc[8][4]; zero_acc8(acc);
    gemm_core_b(tid, acc, 32, la, lb, smem);
    const float* gate = MOD(p) + ((long)l * 9 + seq_of(g0)) * 3072 + 2048;
#pragma unroll
    for (int i = 0; i < 8; ++i) {
      unsigned g = g0 + wm * 128 + i * 16 + lr;
      const float* xb = (l == 0) ? (g0 < 16384 ? p.x_prompt : p.x_sample) : p.out;
      const float* xr = xb + (unsigned)((l == 0 && g0 >= 16384) ? g - 16384 : g) * D;
      float* orow = p.out + g * D;
#pragma unroll
      for (int j = 0; j < 4; ++j) {
        unsigned c = nt * 128 + wn * 64 + j * 16 + quad * 4;
        float4 xv = *(const float4*)(xr + c);
        float4 gt = *(const float4*)(gate + c);
        float4 o;
        o.x = xv.x + gt.x * acc[i][j][0]; o.y = xv.y + gt.y * acc[i][j][1];
        o.z = xv.z + gt.z * acc[i][j][2]; o.w = xv.w + gt.w * acc[i][j][3];
        *(float4*)(orow + c) = o;
      }
    }
  }
}

#define XB_TMO      128
#define XB_XCNT(j)  (256  + 64 * (j))
#define XB_XSUB(j)  (1280 + 64 * (j))
#define XB_XGEN(j)  (2304 + 64 * (j))
#define XB_TOP      3328
#define XB_TOPGEN   3392
#define XCD_BAR_WORDS 3456
#define XB_SPIN_CAP (1u << 18)
#define LAS __attribute__((address_space(3)))

__device__ __forceinline__ unsigned xb_ld(unsigned* p)              { return __hip_atomic_load(p, __ATOMIC_RELAXED, __HIP_MEMORY_SCOPE_AGENT); }
__device__ __forceinline__ unsigned xb_add(unsigned* p, unsigned v) { return __hip_atomic_fetch_add(p, v, __ATOMIC_RELAXED, __HIP_MEMORY_SCOPE_AGENT); }
__device__ __forceinline__ unsigned xb_xcc_id() { return (unsigned)__builtin_amdgcn_s_getreg((3 << 11) | 20) & 0xFu; }
#define XB_SPIN(cond, bar) do { unsigned _sp = 0; while (cond) { __builtin_amdgcn_s_sleep(1); \
    if ((++_sp & 255u) == 0u) { if (xb_ld(&(bar)[XB_TMO])) break; if (_sp > XB_SPIN_CAP) { atomicAdd(&(bar)[XB_TMO], 1u); break; } } } } while (0)

struct XcdBarrier {
    unsigned* bar; unsigned x;
    volatile LAS unsigned* st;
};

__device__ __forceinline__ XcdBarrier xcd_barrier_post(unsigned* bar, volatile LAS unsigned* st) {
    XcdBarrier b; b.bar = bar; b.x = xb_xcc_id(); b.st = st;
    if (threadIdx.x == 0) (void)xb_add(&bar[XB_XCNT(b.x)], 1u);
    return b;
}
__device__ __forceinline__ void xcd_barrier_complete(unsigned* bar, unsigned x, unsigned& nloc, unsigned& nx) {
    const unsigned G = gridDim.x * gridDim.y * gridDim.z;
    unsigned sum, cnt, mine, sp = 0u;
    for (;;) {
        sum = 0u; cnt = 0u; mine = 0u;
#pragma unroll
        for (unsigned j = 0; j < 16; ++j) { const unsigned c = xb_ld(&bar[XB_XCNT(j)]); sum += c; cnt += (c > 0u) ? 1u : 0u; mine = (j == x) ? c : mine; }
        if (sum == G) break;
        __builtin_amdgcn_s_sleep(1);
        if ((++sp & 255u) == 0u) { if (xb_ld(&bar[XB_TMO])) break; if (sp > XB_SPIN_CAP) { atomicAdd(&bar[XB_TMO], 1u); break; } }
    }
    nloc = mine > 0u ? mine : 1u; nx = cnt > 0u ? cnt : 1u;
}

__device__ __forceinline__ void xcd_barrier(const XcdBarrier& b) {
    asm volatile("s_waitcnt vmcnt(0)" ::: "memory");
    __syncthreads();
    if (threadIdx.x == 0) {
        unsigned* bar = b.bar;
        __builtin_amdgcn_s_waitcnt(0);
        unsigned nloc = b.st[0], nx = b.st[1];
        if (nloc == 0u) { xcd_barrier_complete(bar, b.x, nloc, nx); b.st[0] = nloc; b.st[1] = nx; }
        const unsigned old = xb_add(&bar[XB_XSUB(b.x)], 1u);
        const unsigned gen = old / nloc;
        if (old + 1u == (gen + 1u) * nloc) {
            __builtin_amdgcn_fence(__ATOMIC_RELEASE, "agent");
            asm volatile("s_waitcnt vmcnt(0)" ::: "memory");
            const unsigned og = xb_add(&bar[XB_TOP], 1u);
            const unsigned tg = og / nx;
            if (og + 1u == (tg + 1u) * nx) xb_add(&bar[XB_TOPGEN], 1u);
            else XB_SPIN(xb_ld(&bar[XB_TOPGEN]) == tg, bar);
            __builtin_amdgcn_fence(__ATOMIC_ACQUIRE, "agent");
            xb_add(&bar[XB_XGEN(b.x)], 1u);
            asm volatile("s_waitcnt vmcnt(0)" ::: "memory");
        } else {
            XB_SPIN(xb_ld(&bar[XB_XGEN(b.x)]) == gen, bar);
            __builtin_amdgcn_fence(__ATOMIC_ACQUIRE, "agent");
            asm volatile("s_waitcnt vmcnt(0)" ::: "memory");
        }
    }
    __syncthreads();
}


__global__ void __launch_bounds__(256, 2) hawk_fnet_megakernel(Params p) {
  extern __shared__ __attribute__((aligned(16))) unsigned char smem_raw[];
  cg::grid_group grid = cg::this_grid();
  u16* smem = (u16*)smem_raw;

  __shared__ unsigned xb_st[4];
  unsigned* bar = (unsigned*)(p.ws + OFF_BAR_BYTES);
  if (blockIdx.x == 0) {
    for (int i = threadIdx.x; i < XCD_BAR_WORDS; i += 256) __hip_atomic_store(&bar[i], 0u, __ATOMIC_RELAXED, __HIP_MEMORY_SCOPE_AGENT);
  }
  if (threadIdx.x < 4) xb_st[threadIdx.x] = 0u;
  {
    unsigned* lbs = (unsigned*)(p.ws + OFF_LB_BYTES + LB_SLOT_BYTES);
    for (int i = blockIdx.x * 256 + threadIdx.x; i < 20480 + 10240; i += gridDim.x * 256)
      __hip_atomic_store(&lbs[i], 0u, __ATOMIC_RELAXED, __HIP_MEMORY_SCOPE_AGENT);
    unsigned long long* lbq = (unsigned long long*)(p.ws + OFF_LB_BYTES);
    for (int i = blockIdx.x * 256 + threadIdx.x; i < (int)(LB_SLOT_BYTES / 8); i += gridDim.x * 256)
      __hip_atomic_store(&lbq[i], 0ull, __ATOMIC_RELAXED, __HIP_MEMORY_SCOPE_AGENT);
  }
  phase_prologue(p, smem_raw);
  grid.sync();
  XcdBarrier xb = xcd_barrier_post(bar, (volatile LAS unsigned*)xb_st);
  phase_fold(p, smem);
  phase_h(p, 0);
  xcd_barrier(xb);
  for (int l = 0; l < 2; ++l) {
    phase_gemm1(p, l, smem);
    xcd_barrier(xb);
    phase_fft1(p, smem);
    xcd_barrier(xb);
    phase_fft2(p, smem);
    xcd_barrier(xb);
    phase_scan_lb(p, l, smem_raw);
    xcd_barrier(xb);
    phase_merge(p, l, smem);
    xcd_barrier(xb);
    phase_out(p, l, smem);
    xcd_barrier(xb);
    if (l == 0) { phase_h(p, 1); xcd_barrier(xb); }
  }
  phase_final(p);
}

extern "C" void kernel_launch(void* const* d_in, const int* in_sizes, int n_in,
                              void* d_out, int out_size, void* d_ws, size_t ws_size,
                              hipStream_t stream) {
  (void)in_sizes; (void)n_in; (void)out_size;
  if (ws_size < (size_t)WS_NEED) {
    fprintf(stderr, "workspace too small: %zu < %ld\n", ws_size, (long)WS_NEED);
    return;
  }
  static int grid_blocks = 0;
  if (!grid_blocks) {
    hipFuncSetAttribute((const void*)hawk_fnet_megakernel, hipFuncAttributeMaxDynamicSharedMemorySize, SMEM_BYTES);
    int dev = 0, cus = 0, per_cu = 0;
    hipGetDevice(&dev);
    hipDeviceGetAttribute(&cus, hipDeviceAttributeMultiprocessorCount, dev);
    hipOccupancyMaxActiveBlocksPerMultiprocessor(&per_cu, hawk_fnet_megakernel, 256, SMEM_BYTES);
    if (per_cu > 2) per_cu = 2;
    if (per_cu < 1) per_cu = 1;
    grid_blocks = (cus * per_cu) & ~15;
  }
  Params p{};
  p.x_prompt = (const float*)d_in[0]; p.x_sample = (const float*)d_in[1];
  p.c_prompt = (const float*)d_in[2]; p.c_sample = (const float*)d_in[3];
  p.norm_g = (const float*)d_in[4]; p.w_ada = (const float*)d_in[5]; p.b_ada = (const float*)d_in[6];
  p.w_in = (const float*)d_in[7]; p.conv_w = (const float*)d_in[8]; p.conv_b = (const float*)d_in[9];
  p.w_rg = (const float*)d_in[10]; p.b_rg = (const float*)d_in[11]; p.lam = (const float*)d_in[12];
  p.w_a_out = (const float*)d_in[13]; p.w_b_out = (const float*)d_in[14]; p.w_o = (const float*)d_in[15];
  p.final_g = (const float*)d_in[16];
  p.out = (float*)d_out; p.ws = (unsigned char*)d_ws;
  void* args[] = {&p};
  hipError_t e = hipLaunchCooperativeKernel((void*)hawk_fnet_megakernel, dim3(grid_blocks), dim3(256), args, SMEM_BYTES, stream);
  if (e != hipSuccess) fprintf(stderr, "cooperative launch failed: %s (grid %d)\n", hipGetErrorString(e), grid_blocks);
}
```

```cpp
#include <hip/hip_runtime.h>
#include <hip/hip_cooperative_groups.h>
#include <cstdio>
namespace cg = cooperative_groups;

typedef unsigned short u16;
typedef __attribute__((ext_vector_type(8))) short bf16x8;
typedef __attribute__((ext_vector_type(4))) float f32x4;

#define DEVFN __device__ __forceinline__

constexpr int D = 1024;
constexpr int T_TOT = 81920;
constexpr long UNIT = (long)T_TOT * D;
constexpr int D_IN = 6144;

constexpr long OFF_W = 6 * UNIT;
constexpr long W_CAT = 0;
constexpr long W_A = 7168L * 1024;
constexpr long W_B = W_A + 1048576;
constexpr long W_O = W_B + 1048576;
constexpr long W_RG = W_O + 1048576;
constexpr long LW = W_RG + 524288;
constexpr long OFF_TAB = OFF_W + 2 * LW;
constexpr long T_D1A = 0;
constexpr long T_D1B = 65536;
constexpr long T_D2 = T_D1B + 16384;
constexpr long T_DC = T_D2 + 32768;
constexpr long TAB_ELEMS = T_DC + 131072;
constexpr long OFF_TW_BYTES = (OFF_TAB + TAB_ELEMS) * 2;
constexpr long OFF_MOD_BYTES = OFF_TW_BYTES + 131072;
constexpr long OFF_BAR_BYTES = OFF_MOD_BYTES + 221184;
constexpr long OFF_LB_BYTES = OFF_BAR_BYTES + 16384;
constexpr long LB_SLOT_BYTES = 20480L * 128 * 8;
constexpr long WS_NEED = OFF_LB_BYTES + LB_SLOT_BYTES + 20480 * 4 + 10240 * 4;
static_assert(WS_NEED <= (1L << 30), "workspace map exceeds the guaranteed 1 GiB");

constexpr int TILE = 128 * 64;
constexpr int SMEM_BYTES = 73728;

struct Params {
  const float* x_prompt; const float* x_sample; const float* c_prompt; const float* c_sample;
  const float* norm_g; const float* w_ada; const float* b_ada; const float* w_in;
  const float* conv_w; const float* conv_b; const float* w_rg; const float* b_rg; const float* lam;
  const float* w_a_out; const float* w_b_out; const float* w_o; const float* final_g;
  float* out; unsigned char* ws;
};

typedef __attribute__((ext_vector_type(2))) float f32x2_t;
typedef __attribute__((ext_vector_type(2))) __bf16 bf16x2_t;
DEVFN u16 f2bf(float f) {
  __bf16 h = (__bf16)f;
  return *(u16*)&h;
}
DEVFN float bf2f(u16 h) { return __uint_as_float(((unsigned)h) << 16); }
DEVFN unsigned pack2(float a, float b) {
  f32x2_t v = {a, b};
  bf16x2_t r = __builtin_convertvector(v, bf16x2_t);
  return *(unsigned*)&r;
}
DEVFN float lo2f(unsigned v) { return __uint_as_float(v << 16); }
DEVFN float hi2f(unsigned v) { return __uint_as_float(v & 0xffff0000u); }
DEVFN float sigm(float x) { return __builtin_amdgcn_rcpf(1.f + __expf(-x)); }
DEVFN float silu(float x) { return x * __builtin_amdgcn_rcpf(1.f + __expf(-x)); }
DEVFN float one_minus_exp(float x) {
  float pl = -x * (1.f + x * (0.5f + x * (1.f / 6.f + x * (1.f / 24.f + x * (1.f / 120.f + x * (1.f / 720.f))))));
  float dr = 1.f - __expf(x);
  return x > -0.3f ? pl : dr;
}

DEVFN int otid() { int t = threadIdx.x; asm volatile("" : "+v"(t)); return t; }
DEVFN int seq_of(int g) { int seg = g >> 13; return seg < 2 ? 0 : seg - 1; }
DEVFN int seq_start(int s) { return s == 0 ? 0 : 16384 + (s - 1) * 8192; }
DEVFN int seq_len(int s) { return s == 0 ? 16384 : 8192; }

DEVFN u16* U(const Params& p, int i) { return (u16*)(p.ws) + (long)i * UNIT; }
DEVFN u16* WL(const Params& p, int l) { return (u16*)(p.ws) + OFF_W + (long)l * LW; }
DEVFN u16* TAB(const Params& p) { return (u16*)(p.ws) + OFF_TAB; }
DEVFN float2* TW(const Params& p) { return (float2*)(p.ws + OFF_TW_BYTES); }
DEVFN float* MOD(const Params& p) { return (float*)(p.ws + OFF_MOD_BYTES); }
DEVFN const float* xrow(const Params& p, int g) {
  return g < 16384 ? p.x_prompt + (long)g * D : p.x_sample + (long)(g - 16384) * D;
}

struct LdPlain {
  static constexpr bool kDma = true; static constexpr bool kTr = false;
  const u16* base; unsigned off0; unsigned cst; int t_; unsigned row0_, stride_;
  DEVFN unsigned rowoff(int r) const { return (row0_ + r) * stride_; }
  DEVFN void init(int tid_, const u16* b, unsigned row0, unsigned stride) {
    unsigned tid = tid_; t_ = tid_; row0_ = row0; stride_ = stride;
    base = b;
    off0 = (row0 + (tid >> 3)) * stride + (((tid & 7) ^ ((tid >> 3) & 7)) << 3);
    cst = 32 * stride;
  }
  DEVFN void issue(u16* tile, int c, int kt) const {
    __builtin_amdgcn_global_load_lds((const unsigned*)(base + (off0 + c * cst + kt * 64)),
                                     (unsigned*)(tile + (t_ + c * 256) * 8), 16, 0, 0);
  }
  DEVFN uint4 load(int, int) const { return make_uint4(0, 0, 0, 0); }
  DEVFN void store(u16*, int, uint4) const {}
};
struct LdRows4 {
  static constexpr bool kDma = true; static constexpr bool kTr = false;
  const u16* base; unsigned off[4]; int t_;
  DEVFN void issue(u16* tile, int c, int kt) const {
    __builtin_amdgcn_global_load_lds((const unsigned*)(base + (off[c] + kt * 64)),
                                     (unsigned*)(tile + (t_ + c * 256) * 8), 16, 0, 0);
  }
  DEVFN uint4 load(int, int) const { return make_uint4(0, 0, 0, 0); }
  DEVFN void store(u16*, int, uint4) const {}
};
struct LdF32 {
  static constexpr bool kDma = false; static constexpr bool kTr = false;
  const float* base; unsigned off0; unsigned cst; int t_;
  DEVFN void init(int tid_, const float* b, unsigned row0, unsigned stride, unsigned col0) {
    unsigned tid = tid_; t_ = tid_;
    base = b;
    off0 = (row0 + (tid >> 3)) * stride + col0 + (tid & 7) * 8;
    cst = 32 * stride;
  }
  DEVFN void issue(u16*, int, int) const {}
  DEVFN uint4 load(int c, int kt) const {
    const float4* q = (const float4*)(base + (off0 + c * cst + kt * 64));
    float4 a = q[0], b = q[1];
    uint4 r; r.x = pack2(a.x, a.y); r.y = pack2(a.z, a.w); r.z = pack2(b.x, b.y); r.w = pack2(b.z, b.w);
    return r;
  }
  DEVFN void store(u16* tile, int c, uint4 v) const {
    int idx = t_ + c * 256;
    int row = idx >> 3, kc = idx & 7;
    *(uint4*)(tile + row * 64 + ((kc ^ (row & 7)) << 3)) = v;
  }
};
DEVFN int trf(int r) { return ((r & 3) << 2) | ((r >> 2) & 3); }
template <class TokFn>
struct LdTrans {
  static constexpr bool kDma = false; static constexpr bool kTr = false;
  TokFn tok; int t_;
  DEVFN void issue(u16*, int, int) const {}
  DEVFN uint4 load(int c, int kt) const {
    int idx = t_ + c * 256;
    int kk = idx & 63, cc = idx >> 6;
    const u16* b; unsigned o = tok(kt * 64 + kk, b);
    return *(const uint4*)(b + (o + cc * 8));
  }
  DEVFN void store(u16* tile, int c, uint4 v) const {
    int idx = t_ + c * 256;
    int kk = idx & 63, cc = idx >> 6;
    u16* q = tile + (cc * 8) * 64 + (kk & 7);
    int kc = kk >> 3;
    q[0 * 64 + ((kc ^ 0) << 3)] = (u16)(v.x & 0xffff); q[1 * 64 + ((kc ^ 1) << 3)] = (u16)(v.x >> 16);
    q[2 * 64 + ((kc ^ 2) << 3)] = (u16)(v.y & 0xffff); q[3 * 64 + ((kc ^ 3) << 3)] = (u16)(v.y >> 16);
    q[4 * 64 + ((kc ^ 4) << 3)] = (u16)(v.z & 0xffff); q[5 * 64 + ((kc ^ 5) << 3)] = (u16)(v.z >> 16);
    q[6 * 64 + ((kc ^ 6) << 3)] = (u16)(v.w & 0xffff); q[7 * 64 + ((kc ^ 7) << 3)] = (u16)(v.w >> 16);
  }
};

typedef __attribute__((ext_vector_type(4))) short s16x4;
DEVFN s16x4 lds_tr_read(const u16* q) {
  return __builtin_amdgcn_ds_read_tr16_b64_v4i16((s16x4 __attribute__((address_space(3)))*)(q));
}

DEVFN void zero_acc(f32x4 (&acc)[4][4]) {
#pragma unroll
  for (int i = 0; i < 4; ++i)
#pragma unroll
    for (int j = 0; j < 4; ++j) acc[i][j] = f32x4{0.f, 0.f, 0.f, 0.f};
}

template <class LA, class LB>
DEVFN void gemm_core(int tid, f32x4 (&acc)[4][4], int nk, const LA& la, const LB& lb, u16* smem) {
  const int lane = tid & 63, w = tid >> 6, wm = w >> 1, wn = w & 1;
  const int lr = lane & 15, quad = lane >> 4;
  uint4 ra[4], rb[4];
  if (LA::kDma) {
#pragma unroll
    for (int c = 0; c < 4; ++c) la.issue(smem, c, 0);
  } else {
#pragma unroll
    for (int c = 0; c < 4; ++c) ra[c] = la.load(c, 0);
  }
  if (LB::kDma) {
#pragma unroll
    for (int c = 0; c < 4; ++c) lb.issue(smem + TILE, c, 0);
  } else {
#pragma unroll
    for (int c = 0; c < 4; ++c) rb[c] = lb.load(c, 0);
  }
  if (!LA::kDma) {
#pragma unroll
    for (int c = 0; c < 4; ++c) la.store(smem, c, ra[c]);
  }
  if (!LB::kDma) {
#pragma unroll
    for (int c = 0; c < 4; ++c) lb.store(smem + TILE, c, rb[c]);
  }
  asm volatile("s_waitcnt vmcnt(0)" ::: "memory");
  __syncthreads();
  const int aoff = (wm * 64 + lr) * 64, boff = (wn * 64 + lr) * 64;
  const int sw0 = ((quad) ^ (lr & 7)) << 3, sw1 = ((4 + quad) ^ (lr & 7)) << 3;
  int troff[4][2];
  if (LB::kTr) {
    const int q = lr >> 2, pp = lr & 3;
#pragma unroll
    for (int j = 0; j < 4; ++j)
#pragma unroll
      for (int h = 0; h < 2; ++h) {
        int r = quad * 8 + h * 4 + q;
        int ch = (wn * 8 + j * 2 + (pp >> 1)) ^ trf(r);
        troff[j][h] = r * 128 + ch * 8 + (pp & 1) * 4;
      }
  }
  for (int kt = 0; kt < nk; ++kt) {
    const u16* sA = smem + (kt & 1) * 2 * TILE;
    const u16* sB = sA + TILE;
    u16* nA = smem + ((kt + 1) & 1) * 2 * TILE;
    const bool more = (kt + 1) < nk;
    if (more) {
      if (LA::kDma) {
#pragma unroll
        for (int c = 0; c < 4; ++c) la.issue(nA, c, kt + 1);
      } else {
#pragma unroll
        for (int c = 0; c < 4; ++c) ra[c] = la.load(c, kt + 1);
      }
      if (LB::kDma) {
#pragma unroll
        for (int c = 0; c < 4; ++c) lb.issue(nA + TILE, c, kt + 1);
      } else {
#pragma unroll
        for (int c = 0; c < 4; ++c) rb[c] = lb.load(c, kt + 1);
      }
    }
#pragma unroll
    for (int ks = 0; ks < 2; ++ks) {
      const int sw = ks == 0 ? sw0 : sw1;
      bf16x8 af[4], bfr[4];
#pragma unroll
      for (int i = 0; i < 4; ++i) af[i] = *(const bf16x8*)(sA + aoff + i * 1024 + sw);
      if (LB::kTr) {
#pragma unroll
        for (int j = 0; j < 4; ++j) {
          s16x4 lo = lds_tr_read(sB + troff[j][0] + ks * 4096);
          s16x4 hi = lds_tr_read(sB + troff[j][1] + ks * 4096);
          bfr[j] = __builtin_shufflevector(lo, hi, 0, 1, 2, 3, 4, 5, 6, 7);
        }
      } else {
#pragma unroll
        for (int j = 0; j < 4; ++j) bfr[j] = *(const bf16x8*)(sB + boff + j * 1024 + sw);
      }
      __builtin_amdgcn_s_setprio(1);
#pragma unroll
      for (int i = 0; i < 4; ++i)
#pragma unroll
        for (int j = 0; j < 4; ++j)
          acc[i][j] = __builtin_amdgcn_mfma_f32_16x16x32_bf16(bfr[j], af[i], acc[i][j], 0, 0, 0);
      __builtin_amdgcn_s_setprio(0);
    }
    if (more) {
      if (!LA::kDma) {
#pragma unroll
        for (int c = 0; c < 4; ++c) la.store(nA, c, ra[c]);
      }
      if (!LB::kDma) {
#pragma unroll
        for (int c = 0; c < 4; ++c) lb.store(nA + TILE, c, rb[c]);
      }
    }
    asm volatile("s_waitcnt vmcnt(0)" ::: "memory");
    __syncthreads();
  }
}

struct LdPerm {
  const u16* base; int g0, sst, lg;
  DEVFN unsigned rowoff(int r) const {
    int t = g0 - sst + r;
    int urow = ((t & ((1 << lg) - 1)) << 7) + (t >> lg);
    return (unsigned)(sst + urow) * D;
  }
};
#define GLDS16(gp, lp) __builtin_amdgcn_global_load_lds((const unsigned*)(gp), (unsigned*)(lp), 16, 0, 0)
DEVFN void zero_acc8(f32x4 (&acc)[8][4]) {
#pragma unroll
  for (int i = 0; i < 8; ++i)
#pragma unroll
    for (int j = 0; j < 4; ++j) acc[i][j] = f32x4{0.f, 0.f, 0.f, 0.f};
}
template <class LA, class LB>
DEVFN void gemm_core_b(int tid, f32x4 (&acc)[8][4], int nk, const LA& la, const LB& lb, u16* smem) {
  const int lane = tid & 63, w = tid >> 6, wm = w >> 1, wn = w & 1;
  const int lr = lane & 15, quad = lane >> 4;
  const int r0 = tid >> 2;
  const unsigned sw = (unsigned)(((tid & 3) ^ ((0 - (tid >> 4)) & 3)) << 3);
  const unsigned oa0 = la.rowoff(r0) + sw, oa1 = la.rowoff(r0 + 64) + sw, oa2 = la.rowoff(r0 + 128) + sw, oa3 = la.rowoff(r0 + 192) + sw;
  const unsigned ob0 = lb.rowoff(r0) + sw, ob1 = lb.rowoff(r0 + 64) + sw;
  const u16* ga = la.base; const u16* gb = lb.base;
  u16* l0 = smem + tid * 8;
#define ISSUE_STAGE(st, kt) do { u16* _s = l0 + (st) * 12288; unsigned _k = (unsigned)(kt) * 32u; \
    GLDS16(ga + (oa0 + _k), _s); GLDS16(ga + (oa1 + _k), _s + 2048); GLDS16(ga + (oa2 + _k), _s + 4096); GLDS16(ga + (oa3 + _k), _s + 6144); \
    GLDS16(gb + (ob0 + _k), _s + 8192); GLDS16(gb + (ob1 + _k), _s + 10240); } while (0)
  asm volatile("s_waitcnt vmcnt(0)" ::: "memory");
  ISSUE_STAGE(0, 0);
  ISSUE_STAGE(1, 1);
  const int fsw = (quad ^ ((0 - (lr >> 2)) & 3)) << 3;
  const int aoff = (wm * 128 + lr) * 32 + fsw, boff = 8192 + (wn * 64 + lr) * 32 + fsw;
  int cur = 0, nxt = 2;
  for (int kt = 0; kt < nk; ++kt) {
    if (kt + 1 < nk) asm volatile("s_waitcnt vmcnt(6)" ::: "memory");
    else asm volatile("s_waitcnt vmcnt(0)" ::: "memory");
    __builtin_amdgcn_s_barrier();
    asm volatile("" ::: "memory");
    if (kt + 2 < nk) ISSUE_STAGE(nxt, kt + 2);
    const u16* sb = smem + cur * 12288;
    bf16x8 af[8], bfr[4];
#pragma unroll
    for (int j = 0; j < 4; ++j) bfr[j] = *(const bf16x8*)(sb + boff + j * 512);
#pragma unroll
    for (int i = 0; i < 8; ++i) af[i] = *(const bf16x8*)(sb + aoff + i * 512);
    __builtin_amdgcn_s_setprio(1);
#pragma unroll
    for (int i = 0; i < 8; ++i)
#pragma unroll
      for (int j = 0; j < 4; ++j)
        acc[i][j] = __builtin_amdgcn_mfma_f32_16x16x32_bf16(bfr[j], af[i], acc[i][j], 0, 0, 0);
    __builtin_amdgcn_s_setprio(0);
    cur = cur == 2 ? 0 : cur + 1;
    nxt = nxt == 2 ? 0 : nxt + 1;
  }
  asm volatile("s_waitcnt lgkmcnt(0)" ::: "memory");
  __builtin_amdgcn_s_barrier();
  asm volatile("" ::: "memory");
#undef ISSUE_STAGE
}

DEVFN bool tile_xcd(int it, int ngrp, int ntn, int& mt, int& nt) {
  const int G = gridDim.x, b = blockIdx.x;
  if (G == 512) {
    if (it >= 5 * ngrp) return false;
    int xcd = b & 7, loc = b >> 3;
    mt = xcd * 40 + (it / ngrp) * 8 + (loc >> 3);
    nt = (it % ngrp) * 8 + (loc & 7);
    return true;
  }
  int tile = b + it * G;
  if (tile >= 320 * ntn) return false;
  mt = tile / ntn; nt = tile % ntn;
  return true;
}

DEVFN void transpose_tile(const float* src, long ld, u16* dst, long ldd, float* sT) {
  const int tid = otid();
#pragma unroll
  for (int pss = 0; pss < 4; ++pss) {
    int kk = (tid >> 4) + pss * 16, n4 = (tid & 15) * 4;
    float4 v = *(const float4*)(src + (long)kk * ld + n4);
    sT[kk * 65 + n4 + 0] = v.x; sT[kk * 65 + n4 + 1] = v.y; sT[kk * 65 + n4 + 2] = v.z; sT[kk * 65 + n4 + 3] = v.w;
  }
  __syncthreads();
  {
    int n = tid >> 2, k0 = (tid & 3) * 16;
    unsigned o[8];
#pragma unroll
    for (int e = 0; e < 8; ++e) o[e] = pack2(sT[(k0 + 2 * e) * 65 + n], sT[(k0 + 2 * e + 1) * 65 + n]);
    uint4* q = (uint4*)(dst + (long)n * ldd + k0);
    q[0] = make_uint4(o[0], o[1], o[2], o[3]);
    q[1] = make_uint4(o[4], o[5], o[6], o[7]);
  }
  __syncthreads();
}

DEVFN void phase_prologue(const Params& p, unsigned char* smem_raw) {
  const int tid = otid();
  constexpr int NJ_TR = 4352, NJ_MOD = 384, NJ_TAB = 256;
  for (int job = blockIdx.x; job < NJ_TR + NJ_MOD + NJ_TAB; job += gridDim.x) {
    if (job < NJ_TR) {
      float* sT = (float*)smem_raw;
      int l = job / 2176, r = job % 2176;
      u16* wl = WL(p, l);
      if (r < 1280) {
        int kt = r / 80, ntile = r % 80;
        int orow = ntile * 64;
        int scol;
        if (orow < 2048) scol = orow; else { orow += 2048; scol = orow - 1024; }
        transpose_tile(p.w_in + (long)l * D * D_IN + (long)(kt * 64) * D_IN + scol, D_IN,
                       wl + W_CAT + (long)orow * D + kt * 64, D, sT);
      } else if (r < 2048) {
        int r2 = r - 1280, which = r2 >> 8, t = r2 & 255, kt = t >> 4, ntile = t & 15;
        const float* src = (which == 0 ? p.w_a_out : which == 1 ? p.w_b_out : p.w_o) + (long)l * 1048576;
        long doff = which == 0 ? W_A : which == 1 ? W_B : W_O;
        transpose_tile(src + (long)(kt * 64) * D + ntile * 64, D, wl + doff + (long)(ntile * 64) * D + kt * 64, D, sT);
      } else {
        int r3 = r - 2048, mat = r3 >> 2, t = r3 & 3, kt = t >> 1, ntile = t & 1;
        const float* src = p.w_rg + ((long)l * 32 + mat) * 16384;
        transpose_tile(src + (long)(kt * 64) * 128 + ntile * 64, 128,
                       wl + W_RG + (long)mat * 16384 + (long)(ntile * 64) * 128 + kt * 64, 128, sT);
      }
    } else if (job < NJ_TR + NJ_MOD) {
      int jm = job - NJ_TR, l = jm / 192, cgp = jm % 192;
      float* sc = (float*)smem_raw;
      float* red = sc + 9 * 1024;
      for (int i = tid; i < 9 * 1024; i += 256) {
        int s_ = i >> 10, k = i & 1023;
        float cv = s_ == 0 ? p.c_prompt[k] : p.c_sample[(s_ - 1) * 1024 + k];
        sc[i] = silu(cv);
      }
      __syncthreads();
      int col = cgp * 16 + (tid & 15), kq = tid >> 4;
      float a0 = 0, a1 = 0, a2 = 0, a3 = 0, a4 = 0, a5 = 0, a6 = 0, a7 = 0, a8 = 0;
      const float* wp = p.w_ada + (long)l * D * 3072 + col;
#pragma unroll 8
      for (int k = kq * 64; k < kq * 64 + 64; ++k) {
        float wv = wp[(long)k * 3072];
        a0 += sc[0 * 1024 + k] * wv; a1 += sc[1 * 1024 + k] * wv; a2 += sc[2 * 1024 + k] * wv;
        a3 += sc[3 * 1024 + k] * wv; a4 += sc[4 * 1024 + k] * wv; a5 += sc[5 * 1024 + k] * wv;
        a6 += sc[6 * 1024 + k] * wv; a7 += sc[7 * 1024 + k] * wv; a8 += sc[8 * 1024 + k] * wv;
      }
      float* rq = red + kq * 144 + (tid & 15);
      rq[0 * 16] = a0; rq[1 * 16] = a1; rq[2 * 16] = a2; rq[3 * 16] = a3; rq[4 * 16] = a4;
      rq[5 * 16] = a5; rq[6 * 16] = a6; rq[7 * 16] = a7; rq[8 * 16] = a8;
      __syncthreads();
      if (tid < 144) {
        int s_ = tid >> 4, cc = tid & 15;
        float v = 0.f;
#pragma unroll
        for (int q = 0; q < 16; ++q) v += red[q * 144 + tid];
        int cf = cgp * 16 + cc;
        MOD(p)[((long)l * 9 + s_) * 3072 + cf] = v + p.b_ada[l * 3072 + cf];
      }
      __syncthreads();
    } else {
      int jt = job - NJ_TR - NJ_MOD;
      u16* tab = TAB(p);
#pragma unroll
      for (int e4 = 0; e4 < 4; ++e4) {
        int e = jt * 1024 + e4 * 256 + tid;
        if (e < 65536) {
          int m = e >> 8, k = e & 255;
          int k1 = (m >> 5) * 16 + (m & 15), ro = (m >> 4) & 1, ri = k >> 7, s1 = k & 127;
          float x = 2.f * (float)((k1 * s1) & 127) / 128.f;
          float cs = cospif(x), sn = sinpif(x);
          float v = (ro == ri) ? cs : (ro == 0 ? sn : -sn);
          tab[T_D1A + e] = f2bf(v);
        } else if (e < 65536 + 16384) {
          int e2 = e - 65536;
          int m = e2 >> 7, k = e2 & 127;
          int k1 = (m >> 5) * 16 + (m & 15), ro = (m >> 4) & 1, ri = k >> 6, s1 = k & 63;
          float x = 2.f * (float)((k1 * s1) & 63) / 64.f;
          float cs = cospif(x), sn = sinpif(x);
          float v = (ro == ri) ? cs : (ro == 0 ? sn : -sn);
          tab[T_D1B + e2] = f2bf(v);
        } else if (e < 65536 + 16384 + 32768) {
          int e2 = e - 65536 - 16384;
          int k2 = e2 >> 8, k = e2 & 255, ri = k >> 7, s2 = k & 127;
          float x = 2.f * (float)((k2 * s2) & 127) / 128.f;
          float v = ri == 0 ? cospif(x) : sinpif(x);
          tab[T_D2 + e2] = f2bf(v);
        } else if (e < 65536 + 16384 + 32768 + 131072) {
          int e2 = e - 65536 - 16384 - 32768;
          int row = e2 >> 8, c = e2 & 255, ri = row >> 8, m = row & 255;
          float x = 2.f * (float)((m * c) & 255) / 256.f;
          float v = ri == 0 ? cospif(x) : -sinpif(x);
          tab[T_DC + e2] = f2bf(v);
        } else {
          int e2 = e - (65536 + 16384 + 32768 + 131072);
          if (e2 < 16384) {
            float x = 2.f * (float)e2 / 16384.f;
            TW(p)[e2] = make_float2(cospif(x), sinpif(x));
          }
        }
      }
    }
  }
}

DEVFN void phase_fold(const Params& p, u16* smem) {
  for (int tile = blockIdx.x; tile < 256; tile += gridDim.x) {
    const int tid = otid(), lane = tid & 63, w = tid >> 6, wm = w >> 1, wn = w & 1, lr = lane & 15, quad = lane >> 4;
    int l = tile >> 7, g = (tile >> 5) & 3, mt = (tile >> 3) & 3, nt = tile & 7;
    LdPlain la; la.init(tid, TAB(p) + T_DC, mt * 128, 256);
    LdF32 lb; lb.init(tid, p.w_in + (long)l * D * D_IN, nt * 128, D_IN, 2048 + g * 256);
    f32x4 acc[4][4]; zero_acc(acc);
    gemm_core(tid, acc, 4, la, lb, smem);
    int ri = mt >> 1;
    u16* wc = WL(p, l) + W_CAT;
#pragma unroll
    for (int i = 0; i < 4; ++i) {
      int mrow = (mt & 1) * 128 + wm * 64 + i * 16 + lr;
      unsigned orow = 2048 + ri * 1024 + g * 256 + mrow;
#pragma unroll
      for (int j = 0; j < 4; ++j) {
        int n = nt * 128 + wn * 64 + j * 16 + quad * 4;
        uint2 o; o.x = pack2(acc[i][j][0], acc[i][j][1]); o.y = pack2(acc[i][j][2], acc[i][j][3]);
        *(uint2*)(wc + orow * D + n) = o;
      }
    }
  }
}

DEVFN void phase_h(const Params& p, int l) {
  const int lane = threadIdx.x & 63;
  const int wid = blockIdx.x * 4 + (threadIdx.x >> 6), nw = gridDim.x * 4;
  const float* ng = p.norm_g + l * D;
  const float* modl = MOD(p) + (long)l * 9 * 3072;
  u16* H = U(p, 0);
  float4 v[4], vn[4];
  auto ldrow = [&](int g, float4 (&dst)[4]) {
    const float* xb = (l == 0) ? (g < 16384 ? p.x_prompt : p.x_sample) : p.out;
    const unsigned xo = (unsigned)((l == 0 && g >= 16384) ? g - 16384 : g) * D;
#pragma unroll
    for (int i = 0; i < 4; ++i) dst[i] = *(const float4*)(xb + xo + i * 256 + lane * 4);
  };
  if (wid < T_TOT) ldrow(wid, v);
  for (int g = wid; g < T_TOT; g += nw) {
    if (g + nw < T_TOT) ldrow(g + nw, vn);
    const float* md = modl + seq_of(g) * 3072;
    float ss = 0.f;
#pragma unroll
    for (int i = 0; i < 4; ++i) ss += v[i].x * v[i].x + v[i].y * v[i].y + v[i].z * v[i].z + v[i].w * v[i].w;
#pragma unroll
    for (int o = 32; o >= 1; o >>= 1) ss += __shfl_xor(ss, o, 64);
    float rstd = rsqrtf(ss * (1.f / 1024.f) + 1e-6f);
#pragma unroll
    for (int i = 0; i < 4; ++i) {
      int c = i * 256 + lane * 4;
      float4 g4 = *(const float4*)(ng + c);
      float4 sh = *(const float4*)(md + c);
      float4 sc = *(const float4*)(md + 1024 + c);
      float h0 = v[i].x * rstd * g4.x * (1.f + sc.x) + sh.x;
      float h1 = v[i].y * rstd * g4.y * (1.f + sc.y) + sh.y;
      float h2 = v[i].z * rstd * g4.z * (1.f + sc.z) + sh.z;
      float h3 = v[i].w * rstd * g4.w * (1.f + sc.w) + sh.w;
      uint2 o; o.x = pack2(h0, h1); o.y = pack2(h2, h3);
      *(uint2*)(H + ((unsigned)g * D + c)) = o;
    }
#pragma unroll
    for (int i = 0; i < 4; ++i) v[i] = vn[i];
  }
}

DEVFN void phase_final(const Params& p) {
  const int lane = threadIdx.x & 63;
  const int wid = blockIdx.x * 4 + (threadIdx.x >> 6), nw = gridDim.x * 4;
  float4 v[4], vn[4];
  if (wid < T_TOT) {
#pragma unroll
    for (int i = 0; i < 4; ++i) v[i] = *(const float4*)(p.out + (unsigned)wid * D + i * 256 + lane * 4);
  }
  for (int g = wid; g < T_TOT; g += nw) {
    float* xr = p.out + (unsigned)g * D;
    if (g + nw < T_TOT) {
#pragma unroll
      for (int i = 0; i < 4; ++i) vn[i] = *(const float4*)(p.out + (unsigned)(g + nw) * D + i * 256 + lane * 4);
    }
    float ss = 0.f;
#pragma unroll
    for (int i = 0; i < 4; ++i) ss += v[i].x * v[i].x + v[i].y * v[i].y + v[i].z * v[i].z + v[i].w * v[i].w;
#pragma unroll
    for (int o = 32; o >= 1; o >>= 1) ss += __shfl_xor(ss, o, 64);
    float rstd = rsqrtf(ss * (1.f / 1024.f) + 1e-6f);
#pragma unroll
    for (int i = 0; i < 4; ++i) {
      int c = i * 256 + lane * 4;
      float4 g4 = *(const float4*)(p.final_g + c);
      float4 o;
      o.x = v[i].x * rstd * g4.x; o.y = v[i].y * rstd * g4.y; o.z = v[i].z * rstd * g4.z; o.w = v[i].w * rstd * g4.w;
      *(float4*)(xr + c) = o;
    }
#pragma unroll
    for (int i = 0; i < 4; ++i) v[i] = vn[i];
  }
}

DEVFN void phase_gemm1(const Params& p, int l, u16* smem) {
  const u16* H = U(p, 0);
  const u16* W = WL(p, l) + W_CAT;
  for (int it = 0;; ++it) {
    int mt, nt;
    if (!tile_xcd(it, 5, 40, mt, nt)) break;
    const int tid = otid(), lane = tid & 63, w = tid >> 6, wm = w >> 1, wn = w & 1, lr = lane & 15, quad = lane >> 4;
    LdPlain la; la.init(tid, H, mt * 256, D);
    LdPlain lb; lb.init(tid, W, nt * 128, D);
    f32x4 acc[8][4]; zero_acc8(acc);
    gemm_core_b(tid, acc, 32, la, lb, smem);
    int unit = nt >> 3, col0 = (nt & 7) * 128;
    u16* outp = U(p, 1 + unit);
    bool act = (unit == 1) || (unit == 4);
    {
      u16* so = smem;
#pragma unroll
      for (int i = 0; i < 8; ++i) {
        const int m = wm * 128 + i * 16 + lr;
#pragma unroll
        for (int j = 0; j < 4; ++j) {
          const int n = wn * 64 + j * 16 + quad * 4;
          float v0 = acc[i][j][0], v1 = acc[i][j][1], v2 = acc[i][j][2], v3 = acc[i][j][3];
          if (act) { v0 = silu(v0); v1 = silu(v1); v2 = silu(v2); v3 = silu(v3); }
          uint2 o; o.x = pack2(v0, v1); o.y = pack2(v2, v3);
          *(uint2*)(so + m * 136 + n) = o;
        }
      }
      __syncthreads();
#pragma unroll
      for (int c = 0; c < 16; ++c) {
        const int idx = tid + c * 256;
        const int row = idx >> 4, ch = idx & 15;
        uint4 v = *(const uint4*)(so + row * 136 + ch * 8);
        *(uint4*)(outp + ((unsigned)(mt * 256 + row) * D + col0 + ch * 8)) = v;
      }
      __syncthreads();
    }
  }
}

struct TokF1 {
  const u16* zr; const u16* zi; int n1; unsigned off;
  DEVFN unsigned operator()(int k, const u16*& b) const {
    int ri = k >= n1 ? 1 : 0;
    int s1 = k - ri * n1;
    b = ri ? zi : zr;
    return off + (unsigned)(s1 * 128) * D;
  }
};
DEVFN void f1_twiddle(int tid, const Params& p, const f32x4 (&acc)[4][4], int hf, int s2, int smask, int twmul,
                      uint2 (&o1)[2][4], uint2 (&o2)[2][4]) {
  const int lane = tid & 63, w = tid >> 6, wm = w >> 1, lr = lane & 15;
  const float2* tw = TW(p);
#pragma unroll
  for (int b = 0; b < 2; ++b) {
    int k1 = (hf * 4 + wm * 2 + b) * 16 + lr;
    float2 t = tw[((k1 * s2) & smask) * twmul];
#pragma unroll
    for (int j = 0; j < 4; ++j) {
      f32x4 orr = acc[2 * b][j], oii = acc[2 * b + 1][j];
      o1[b][j].x = pack2(orr[0] * t.x + oii[0] * t.y, orr[1] * t.x + oii[1] * t.y);
      o1[b][j].y = pack2(orr[2] * t.x + oii[2] * t.y, orr[3] * t.x + oii[3] * t.y);
      o2[b][j].x = pack2(oii[0] * t.x - orr[0] * t.y, oii[1] * t.x - orr[1] * t.y);
      o2[b][j].y = pack2(oii[2] * t.x - orr[2] * t.y, oii[3] * t.x - orr[3] * t.y);
    }
  }
}
DEVFN void f1_write(int tid, int hf, unsigned off, const uint2 (&o1)[2][4], const uint2 (&o2)[2][4], u16* zr, u16* zi, u16* so) {
  const int lane = tid & 63, w = tid >> 6, wm = w >> 1, wn = w & 1, lr = lane & 15, quad = lane >> 4;
#pragma unroll
  for (int b = 0; b < 2; ++b) {
    const int rl = (wm * 2 + b) * 16 + lr;
#pragma unroll
    for (int j = 0; j < 4; ++j) {
      const int n = wn * 64 + j * 16 + quad * 4;
      *(uint2*)(so + rl * 136 + n) = o1[b][j];
      *(uint2*)(so + (64 + rl) * 136 + n) = o2[b][j];
    }
  }
  __syncthreads();
#pragma unroll
  for (int c = 0; c < 8; ++c) {
    const int idx = tid + c * 256;
    const int pl = idx >> 10, row = (idx >> 4) & 63, ch = idx & 15;
    const unsigned k1 = hf * 64 + row;
    uint4 v = *(const uint4*)(so + (pl * 64 + row) * 136 + ch * 8);
    *(uint4*)((pl ? zi : zr) + (off + (k1 * 128) * D + ch * 8)) = v;
  }
  __syncthreads();
}
DEVFN void phase_fft1(const Params& p, u16* smem) {
  u16* zr = U(p, 3);
  u16* zi = U(p, 4);
  for (int tile = blockIdx.x; tile < 9216; tile += gridDim.x) {
    const int tid = otid();
    int seq, s2, ct, n1;
    if (tile < 1024) { seq = 0; s2 = tile >> 3; ct = tile & 7; n1 = 128; }
    else { int t2 = tile - 1024; seq = 1 + (t2 >> 10); s2 = (t2 >> 3) & 127; ct = t2 & 7; n1 = 64; }
    const unsigned off = (unsigned)(seq_start(seq) + s2) * D + ct * 128;
    LdTrans<TokF1> lb; lb.t_ = tid; lb.tok.zr = zr; lb.tok.zi = zi; lb.tok.n1 = n1; lb.tok.off = off;
    const int K = 2 * n1, nk = K >> 6;
    const u16* tab = TAB(p) + (seq == 0 ? T_D1A : T_D1B);
    const int smask = seq == 0 ? 16383 : 8191, twmul = seq == 0 ? 1 : 2;
    uint2 a1[2][4], a2[2][4];
    {
      f32x4 acc[4][4]; zero_acc(acc);
      LdPlain la; la.init(tid, tab, 0, K); gemm_core(tid, acc, nk, la, lb, smem);
      f1_twiddle(tid, p, acc, 0, s2, smask, twmul, a1, a2);
    }
    if (seq == 0) {
      uint2 b1[2][4], b2[2][4];
      {
        f32x4 acc[4][4]; zero_acc(acc);
        LdPlain la; la.init(tid, tab, 128, K); gemm_core(tid, acc, nk, la, lb, smem);
        f1_twiddle(tid, p, acc, 1, s2, smask, twmul, b1, b2);
      }
      f1_write(tid, 1, off, b1, b2, zr, zi, smem);
    }
    f1_write(tid, 0, off, a1, a2, zr, zi, smem);
  }
}

struct TokF2 {
  const u16* zr; const u16* zi; unsigned off;
  DEVFN unsigned operator()(int k, const u16*& b) const {
    int ri = k >> 7, s2 = k & 127;
    b = ri ? zi : zr;
    return off + (unsigned)s2 * D;
  }
};
DEVFN void phase_fft2(const Params& p, u16* smem) {
  u16* zr = U(p, 3);
  const u16* gbp = U(p, 5);
  for (int tile = blockIdx.x; tile < 5120; tile += gridDim.x) {
    const int tid = otid(), lane = tid & 63, w = tid >> 6, wm = w >> 1, wn = w & 1, lr = lane & 15, quad = lane >> 4;
    int seq, k1, ct, n1;
    if (tile < 1024) { seq = 0; k1 = tile >> 3; ct = tile & 7; n1 = 128; }
    else { int t2 = tile - 1024; seq = 1 + (t2 >> 9); k1 = (t2 >> 3) & 63; ct = t2 & 7; n1 = 64; }
    const int sst = seq_start(seq);
    const unsigned off = (unsigned)(sst + k1 * 128) * D + ct * 128;
    LdTrans<TokF2> lb; lb.t_ = tid; lb.tok.zr = zr; lb.tok.zi = U(p, 4); lb.tok.off = off;
    LdPlain la; la.init(tid, TAB(p) + T_D2, 0, 256);
    f32x4 acc[4][4]; zero_acc(acc);
    gemm_core(tid, acc, 4, la, lb, smem);
    const float nrm = seq == 0 ? (1.f / 2048.f) : 6.9053396600248786e-4f;
    u16* so = smem;
#pragma unroll
    for (int c = 0; c < 8; ++c) {
      const int idx = tid + c * 256;
      const int row = idx >> 4, ch = idx & 15;
      *(uint4*)(so + row * 136 + ch * 8) = *(const uint4*)(gbp + ((unsigned)(sst + k1 + n1 * row) * D + ct * 128 + ch * 8));
    }
    __syncthreads();
#pragma unroll
    for (int i = 0; i < 4; ++i) {
      const int k2 = wm * 64 + i * 16 + lr;
#pragma unroll
      for (int j = 0; j < 4; ++j) {
        const int cl = wn * 64 + j * 16 + quad * 4;
        uint2 gv = *(const uint2*)(so + k2 * 136 + cl);
        uint2 o;
        o.x = pack2(acc[i][j][0] * nrm * lo2f(gv.x), acc[i][j][1] * nrm * hi2f(gv.x));
        o.y = pack2(acc[i][j][2] * nrm * lo2f(gv.y), acc[i][j][3] * nrm * hi2f(gv.y));
        *(uint2*)(so + k2 * 136 + cl) = o;
      }
    }
    __syncthreads();
#pragma unroll
    for (int c = 0; c < 8; ++c) {
      const int idx = tid + c * 256;
      const int row = idx >> 4, ch = idx & 15;
      *(uint4*)(zr + (off + (unsigned)row * D + ch * 8)) = *(const uint4*)(so + row * 136 + ch * 8);
    }
    __syncthreads();
  }
}

constexpr int SA_LD = 128;
template <int PASS>
DEVFN void phase_scan(const Params& p, int l, int dirsel, unsigned char* smem_raw) {
  float* sAf = (float*)smem_raw;
  u16* sBh = (u16*)(smem_raw + 32768);
  u16* sXc = (u16*)(smem_raw + 32768 + 16384);
  const int tid = otid(), lane = tid & 63, w = tid >> 6, lr = lane & 15, quad = lane >> 4;
  const int head = blockIdx.x & 7;
  const int dir = PASS == 1 ? ((blockIdx.x >> 3) & 1) : dirsel;
  const int tstart = PASS == 1 ? (blockIdx.x >> 4) : (blockIdx.x >> 3);
  const int tstep = PASS == 1 ? (gridDim.x >> 4) : (gridDim.x >> 3);
  const u16* xa = U(p, 1);
  u16* ga = U(p, 2);
  u16* hf = U(p, 5);
  float2* agg = (float2*)U(p, 4);
  float* carry = (float*)(agg + 1280L * 2 * 1024);
  bf16x8 bw[4][4];
  {
    const u16* wrg = WL(p, l) + W_RG;
#pragma unroll
    for (int jt = 0; jt < 4; ++jt) {
      int q = jt >> 1, col = w * 32 + (jt & 1) * 16 + lr;
      const u16* bp = wrg + (unsigned)((((dir * 2 + q) * 8 + head) * 128 + col) * 128 + quad * 8);
#pragma unroll
      for (int ks = 0; ks < 4; ++ks) bw[jt][ks] = *(const bf16x8*)(bp + ks * 32);
    }
  }
  float spl[2], brr[2], bii[2];
#pragma unroll
  for (int jc = 0; jc < 2; ++jc) {
    int cgl = head * 128 + w * 32 + jc * 16 + lr;
    float lm = p.lam[(l * 2 + dir) * D + cgl];
    spl[jc] = -8.f * 1.4426950408889634f * log1pf(expf(-lm));
    brr[jc] = -1.4426950408889634f * p.b_rg[((l * 2 + dir) * 2 + 0) * D + cgl];
    bii[jc] = -1.4426950408889634f * p.b_rg[((l * 2 + dir) * 2 + 1) * D + cgl];
  }
  const int c8 = tid & 15, tg = tid >> 4;
  float* sCw = (float*)(smem_raw + 65536);
  for (int i = tid; i < 640; i += 256) {
    int k = i >> 7, c = i & 127;
    sCw[i] = k < 4 ? p.conv_w[(l * 4 + k) * D + head * 128 + c] : p.conv_b[l * D + head * 128 + c];
  }
  __syncthreads();
  uint4 xr[7];
#define LOAD_XROWS(TT) do { const int _g0 = (TT) * 64; const int _sq = seq_of(_g0), _ss = seq_start(_sq), _se = _ss + seq_len(_sq); \
    _Pragma("unroll") for (int r = 0; r < 7; ++r) { int _g = _g0 + tg * 4 - 2 + r; xr[r] = make_uint4(0, 0, 0, 0); \
      if (_g >= _ss && _g < _se) xr[r] = *(const uint4*)(xa + ((unsigned)_g * D + head * 128 + c8 * 8)); } } while (0)
  if (tstart < 1280) LOAD_XROWS(tstart);
  for (int tt = tstart; tt < 1280; tt += tstep) {
    const int g0 = tt * 64;
    const int seq = seq_of(g0), sst = seq_start(seq), send = sst + seq_len(seq);
#pragma unroll
    for (int j = 0; j < 4; ++j) {
      float o[8];
      {
        float4 b0 = *(const float4*)(sCw + 512 + c8 * 8), b1 = *(const float4*)(sCw + 512 + c8 * 8 + 4);
        o[0] = b0.x; o[1] = b0.y; o[2] = b0.z; o[3] = b0.w; o[4] = b1.x; o[5] = b1.y; o[6] = b1.z; o[7] = b1.w;
      }
#pragma unroll
      for (int k = 0; k < 4; ++k) {
        uint4 v = xr[j + k];
        float4 w0 = *(const float4*)(sCw + k * 128 + c8 * 8), w1 = *(const float4*)(sCw + k * 128 + c8 * 8 + 4);
        o[0] += w0.x * lo2f(v.x); o[1] += w0.y * hi2f(v.x);
        o[2] += w0.z * lo2f(v.y); o[3] += w0.w * hi2f(v.y);
        o[4] += w1.x * lo2f(v.z); o[5] += w1.y * hi2f(v.z);
        o[6] += w1.z * lo2f(v.w); o[7] += w1.w * hi2f(v.w);
      }
      uint4 q0;
      q0.x = pack2(o[0], o[1]); q0.y = pack2(o[2], o[3]); q0.z = pack2(o[4], o[5]); q0.w = pack2(o[6], o[7]);
      const int tl = tg * 4 + j;
      *(uint4*)(sXc + tl * 128 + ((c8 ^ (tl & 7)) << 3)) = q0;
    }
    __syncthreads();
    if (tt + tstep < 1280) LOAD_XROWS(tt + tstep);
    const int gstart = dir == 0 ? sst : send - 1;
#pragma unroll 1
    for (int hv = 0; hv < 2; ++hv) {
      f32x4 acc[2][4];
#pragma unroll
      for (int it = 0; it < 2; ++it)
#pragma unroll
        for (int jt = 0; jt < 4; ++jt) acc[it][jt] = f32x4{0.f, 0.f, 0.f, 0.f};
#pragma unroll
      for (int ks = 0; ks < 4; ++ks) {
#pragma unroll
        for (int it = 0; it < 2; ++it) {
          bf16x8 af = *(const bf16x8*)(sXc + ((hv * 2 + it) * 16 + lr) * 128 + (((ks * 4 + quad) ^ (lr & 7)) << 3));
#pragma unroll
          for (int jt = 0; jt < 4; ++jt)
            acc[it][jt] = __builtin_amdgcn_mfma_f32_16x16x32_bf16(af, bw[jt][ks], acc[it][jt], 0, 0, 0);
        }
      }
#pragma unroll
      for (int it = 0; it < 2; ++it)
#pragma unroll
        for (int jc = 0; jc < 2; ++jc) {
#pragma unroll
          for (int r = 0; r < 4; ++r) {
            int tl = (hv * 2 + it) * 16 + quad * 4 + r, c = w * 32 + jc * 16 + lr;
            float er = 1.f + __builtin_amdgcn_exp2f(fminf(fmaf(acc[it][jc][r], -1.4426950408889634f, brr[jc]), 60.f));
            float ei = 1.f + __builtin_amdgcn_exp2f(fminf(fmaf(acc[it][2 + jc][r], -1.4426950408889634f, bii[jc]), 60.f));
            float q = __builtin_amdgcn_rcpf(er * ei);
            float rr = q * ei, ii = q * er;
            float a = __builtin_amdgcn_exp2f(rr * spl[jc]);
            float mult = __builtin_amdgcn_sqrtf((1.f - a) * (1.f + a));
            if (g0 + tl == gstart) mult = 1.f;
            float xv = bf2f(sXc[tl * 128 + (((c >> 3) ^ (tl & 7)) << 3) + (c & 7)]);
            sAf[tl * SA_LD + c] = a;
            sBh[tl * 128 + c] = f2bf(mult * ii * xv);
          }
        }
    }
    __syncthreads();
    if (tid < 128) {
      const int c = tid;
      const unsigned aidx = (unsigned)(tt * 2 + dir) * 1024 + head * 128 + c;
      const float* ap = sAf + c;
      u16* bp = sBh + c;
      if (PASS == 1) {
        float h = 0.f, P = 1.f;
        if (dir == 0) {
#pragma unroll 16
          for (int st = 0; st < 64; ++st) { float a = ap[st * SA_LD]; h = a * h + bf2f(bp[st * 128]); P *= a; }
        } else {
#pragma unroll 16
          for (int st = 63; st >= 0; --st) { float a = ap[st * SA_LD]; h = a * h + bf2f(bp[st * 128]); P *= a; }
        }
        agg[aidx] = make_float2(P, h);
      } else {
        float h = carry[aidx];
        if (dir == 0) {
#pragma unroll 16
          for (int st = 0; st < 64; ++st) { h = ap[st * SA_LD] * h + bf2f(bp[st * 128]); bp[st * 128] = f2bf(h); }
        } else {
#pragma unroll 16
          for (int st = 63; st >= 0; --st) { h = ap[st * SA_LD] * h + bf2f(bp[st * 128]); bp[st * 128] = f2bf(h); }
        }
      }
    }
    if (PASS == 3) {
      __syncthreads();
#pragma unroll
      for (int cch = 0; cch < 4; ++cch) {
        int chunk = tid + cch * 256;
        int t = chunk >> 4, cc = (chunk & 15) * 8;
        unsigned off = (unsigned)(g0 + t) * D + head * 128 + cc;
        uint4 hv = *(const uint4*)(sBh + t * 128 + cc);
        if (dir == 0) {
          *(uint4*)(hf + off) = hv;
        } else {
          uint4 fv = *(const uint4*)(hf + off);
          uint4 gv = *(const uint4*)(ga + off);
          uint4 o;
          o.x = pack2((lo2f(fv.x) + lo2f(hv.x)) * lo2f(gv.x), (hi2f(fv.x) + hi2f(hv.x)) * hi2f(gv.x));
          o.y = pack2((lo2f(fv.y) + lo2f(hv.y)) * lo2f(gv.y), (hi2f(fv.y) + hi2f(hv.y)) * hi2f(gv.y));
          o.z = pack2((lo2f(fv.z) + lo2f(hv.z)) * lo2f(gv.z), (hi2f(fv.z) + hi2f(hv.z)) * hi2f(gv.z));
          o.w = pack2((lo2f(fv.w) + lo2f(hv.w)) * lo2f(gv.w), (hi2f(fv.w) + hi2f(hv.w)) * hi2f(gv.w));
          *(uint4*)(ga + off) = o;
        }
      }
    }
    __syncthreads();
  }
#undef LOAD_XROWS
}

DEVFN void lb_st64(unsigned long long* q, unsigned long long v) { __hip_atomic_store(q, v, __ATOMIC_RELAXED, __HIP_MEMORY_SCOPE_AGENT); }
DEVFN unsigned long long lb_ld64(const unsigned long long* q) { return __hip_atomic_load(q, __ATOMIC_RELAXED, __HIP_MEMORY_SCOPE_AGENT); }
DEVFN void lb_st32(unsigned* q, unsigned v) { __hip_atomic_store(q, v, __ATOMIC_RELAXED, __HIP_MEMORY_SCOPE_AGENT); }
DEVFN unsigned lb_ld32(const unsigned* q) { return __hip_atomic_load(q, __ATOMIC_RELAXED, __HIP_MEMORY_SCOPE_AGENT); }
DEVFN unsigned long long lb_pack(float a, float b) { return (unsigned long long)__float_as_uint(a) | ((unsigned long long)__float_as_uint(b) << 32); }
DEVFN unsigned long long lb_gran(float P, float H, unsigned tag) {
  return ((unsigned long long)__float_as_uint(H) << 32) | (unsigned long long)((__float_as_uint(P) & 0xffffff00u) | tag);
}
DEVFN int lb_rank(int seq, int pos) { return seq == 0 ? (pos >> 1) * 10 + ((pos & 1) ? 9 : 0) : pos * 10 + seq; }
DEVFN void lb_decode(int r, int dir, int& seq, int& pos, int& tt) {
  int pair = r / 10, j = r - pair * 10;
  if (j == 0) { seq = 0; pos = 2 * pair; } else if (j == 9) { seq = 0; pos = 2 * pair + 1; } else { seq = j; pos = pair; }
  int len = seq == 0 ? 256 : 128;
  tt = (seq_start(seq) >> 6) + (dir ? len - 1 - pos : pos);
}
DEVFN void phase_scan_lb(const Params& p, int l, unsigned char* smem_raw) {
  float* sAf = (float*)smem_raw;
  u16* sBh = (u16*)(smem_raw + 32768);
  u16* sXc = (u16*)(smem_raw + 32768 + 16384);
  unsigned* sflag = (unsigned*)(smem_raw + 65536 + 2560);
  const int tid = otid(), lane = tid & 63, w = tid >> 6, lr = lane & 15, quad = lane >> 4;
  const int hd = blockIdx.x & 15, head = hd >> 1, dir = hd & 1;
  const int rstart = blockIdx.x >> 4, rstep = gridDim.x >> 4;
  const u16* xa = U(p, 1);
  u16* ga = U(p, 2);
  u16* hown = dir == 0 ? U(p, 5) : U(p, 4);
  const u16* hoth = dir == 0 ? U(p, 4) : U(p, 5);
  unsigned long long* slot = (unsigned long long*)(p.ws + OFF_LB_BYTES);
  unsigned* stat = (unsigned*)(p.ws + OFF_LB_BYTES + LB_SLOT_BYTES);
  unsigned* cnt = stat + 20480;
  const unsigned ep = 2u * (unsigned)l;
  const unsigned tagb = ((unsigned)l + 1u) * 4u;
  bf16x8 bw[4][4];
  {
    const u16* wrg = WL(p, l) + W_RG;
#pragma unroll
    for (int jt = 0; jt < 4; ++jt) {
      int q = jt >> 1, col = w * 32 + (jt & 1) * 16 + lr;
      const u16* bp = wrg + (unsigned)((((dir * 2 + q) * 8 + head) * 128 + col) * 128 + quad * 8);
#pragma unroll
      for (int ks = 0; ks < 4; ++ks) bw[jt][ks] = *(const bf16x8*)(bp + ks * 32);
    }
  }
  float spl[2], brr[2], bii[2];
#pragma unroll
  for (int jc = 0; jc < 2; ++jc) {
    int cgl = head * 128 + w * 32 + jc * 16 + lr;
    float lm = p.lam[(l * 2 + dir) * D + cgl];
    spl[jc] = -8.f * 1.4426950408889634f * log1pf(expf(-lm));
    brr[jc] = -1.4426950408889634f * p.b_rg[((l * 2 + dir) * 2 + 0) * D + cgl];
    bii[jc] = -1.4426950408889634f * p.b_rg[((l * 2 + dir) * 2 + 1) * D + cgl];
  }
  const int c8 = tid & 15, tg = tid >> 4;
  float* sCw = (float*)(smem_raw + 65536);
  for (int i = tid; i < 640; i += 256) {
    int k = i >> 7, c = i & 127;
    sCw[i] = k < 4 ? p.conv_w[(l * 4 + k) * D + head * 128 + c] : p.conv_b[l * D + head * 128 + c];
  }
  __syncthreads();
  uint4 xr[7];
#define LOAD_XROWS(TT) do { const int _g0 = (TT) * 64; const int _sq = seq_of(_g0), _ss = seq_start(_sq), _se = _ss + seq_len(_sq); \
    _Pragma("unroll") for (int r_ = 0; r_ < 7; ++r_) { int _g = _g0 + tg * 4 - 2 + r_; xr[r_] = make_uint4(0, 0, 0, 0); \
      if (_g >= _ss && _g < _se) xr[r_] = *(const uint4*)(xa + ((unsigned)_g * D + head * 128 + c8 * 8)); } } while (0)
  if (rstart < 1280) { int sq_, ps_, t0_; lb_decode(rstart, dir, sq_, ps_, t0_); LOAD_XROWS(t0_); }
  for (int r = rstart; r < 1280; r += rstep) {
    int seq, pos, tt;
    lb_decode(r, dir, seq, pos, tt);
    const int item = r * 16 + hd;
    const int g0 = tt * 64;
    const int sst = seq_start(seq), send = sst + seq_len(seq);
#pragma unroll
    for (int j = 0; j < 4; ++j) {
      float o[8];
      {
        float4 b0 = *(const float4*)(sCw + 512 + c8 * 8), b1 = *(const float4*)(sCw + 512 + c8 * 8 + 4);
        o[0] = b0.x; o[1] = b0.y; o[2] = b0.z; o[3] = b0.w; o[4] = b1.x; o[5] = b1.y; o[6] = b1.z; o[7] = b1.w;
      }
#pragma unroll
      for (int k = 0; k < 4; ++k) {
        uint4 v = xr[j + k];
        float4 w0 = *(const float4*)(sCw + k * 128 + c8 * 8), w1 = *(const float4*)(sCw + k * 128 + c8 * 8 + 4);
        o[0] += w0.x * lo2f(v.x); o[1] += w0.y * hi2f(v.x);
        o[2] += w0.z * lo2f(v.y); o[3] += w0.w * hi2f(v.y);
        o[4] += w1.x * lo2f(v.z); o[5] += w1.y * hi2f(v.z);
        o[6] += w1.z * lo2f(v.w); o[7] += w1.w * hi2f(v.w);
      }
      uint4 q0;
      q0.x = pack2(o[0], o[1]); q0.y = pack2(o[2], o[3]); q0.z = pack2(o[4], o[5]); q0.w = pack2(o[6], o[7]);
      const int tl = tg * 4 + j;
      *(uint4*)(sXc + tl * 128 + ((c8 ^ (tl & 7)) << 3)) = q0;
    }
    __syncthreads();
    if (r + rstep < 1280) { int sq_, ps_, t1_; lb_decode(r + rstep, dir, sq_, ps_, t1_); LOAD_XROWS(t1_); }
    const int gstart = dir == 0 ? sst : send - 1;
#pragma unroll 1
    for (int hv = 0; hv < 2; ++hv) {
      f32x4 acc[2][4];
#pragma unroll
      for (int it = 0; it < 2; ++it)
#pragma unroll
        for (int jt = 0; jt < 4; ++jt) acc[it][jt] = f32x4{0.f, 0.f, 0.f, 0.f};
#pragma unroll
      for (int ks = 0; ks < 4; ++ks) {
#pragma unroll
        for (int it = 0; it < 2; ++it) {
          bf16x8 af = *(const bf16x8*)(sXc + ((hv * 2 + it) * 16 + lr) * 128 + (((ks * 4 + quad) ^ (lr & 7)) << 3));
#pragma unroll
          for (int jt = 0; jt < 4; ++jt)
            acc[it][jt] = __builtin_amdgcn_mfma_f32_16x16x32_bf16(af, bw[jt][ks], acc[it][jt], 0, 0, 0);
        }
      }
#pragma unroll
      for (int it = 0; it < 2; ++it)
#pragma unroll
        for (int jc = 0; jc < 2; ++jc) {
#pragma unroll
          for (int r = 0; r < 4; ++r) {
            int tl = (hv * 2 + it) * 16 + quad * 4 + r, c = w * 32 + jc * 16 + lr;
            float er = 1.f + __builtin_amdgcn_exp2f(fminf(fmaf(acc[it][jc][r], -1.4426950408889634f, brr[jc]), 60.f));
            float ei = 1.f + __builtin_amdgcn_exp2f(fminf(fmaf(acc[it][2 + jc][r], -1.4426950408889634f, bii[jc]), 60.f));
            float q = __builtin_amdgcn_rcpf(er * ei);
            float rr = q * ei, ii = q * er;
            float a = __builtin_amdgcn_exp2f(rr * spl[jc]);
            float mult = __builtin_amdgcn_sqrtf((1.f - a) * (1.f + a));
            if (g0 + tl == gstart) mult = 1.f;
            float xv = bf2f(sXc[tl * 128 + (((c >> 3) ^ (tl & 7)) << 3) + (c & 7)]);
            sAf[tl * SA_LD + c] = a;
            sBh[tl * 128 + c] = f2bf(mult * ii * xv);
          }
        }
    }
    __syncthreads();
    float aggP = 1.f, aggH = 0.f;
    if (tid < 128) {
      const float* ap = sAf + tid;
      const u16* bp = sBh + tid;
      if (dir == 0) {
#pragma unroll 16
        for (int st = 0; st < 64; ++st) { float a = ap[st * SA_LD]; aggH = a * aggH + bf2f(bp[st * 128]); aggP *= a; }
      } else {
#pragma unroll 16
        for (int st = 63; st >= 0; --st) { float a = ap[st * SA_LD]; aggH = a * aggH + bf2f(bp[st * 128]); aggP *= a; }
      }
      lb_st64(slot + (unsigned)item * 128 + tid, lb_gran(pos == 0 ? 0.f : aggP, aggH, tagb + (pos == 0 ? 2u : 1u)));
    }
    float carry = 0.f;
    if (pos > 0) {
      if (tid < 128) {
        float Pr = 1.f, Hr = 0.f;
        int pj = pos - 1;
        for (;;) {
          const int j = lb_rank(seq, pj) * 16 + hd;
          unsigned long long v;
          unsigned spins = 0;
          for (;;) {
            v = lb_ld64(slot + (unsigned)j * 128 + tid);
            unsigned tg_ = (unsigned)v & 0xffu;
            if ((tg_ >> 2) == (tagb >> 2) && (tg_ & 3u) != 0u) break;
            __builtin_amdgcn_s_sleep(1);
            if (++spins > (1u << 18)) break;
          }
          float Pj = __uint_as_float((unsigned)v & 0xffffff00u), Hj = __uint_as_float((unsigned)(v >> 32));
          Hr += Pr * Hj;
          Pr *= Pj;
          if (((unsigned)v & 3u) == 2u || pj == 0) break;
          --pj;
        }
        carry = Hr;
        lb_st64(slot + (unsigned)item * 128 + tid, lb_gran(0.f, aggP * carry + aggH, tagb + 2u));
      }
    }
    if (tid < 128) {
      const float* ap = sAf + tid;
      u16* bp = sBh + tid;
      float h = carry;
      if (dir == 0) {
#pragma unroll 16
        for (int st = 0; st < 64; ++st) { h = ap[st * SA_LD] * h + bf2f(bp[st * 128]); bp[st * 128] = f2bf(h); }
      } else {
#pragma unroll 16
        for (int st = 63; st >= 0; --st) { h = ap[st * SA_LD] * h + bf2f(bp[st * 128]); bp[st * 128] = f2bf(h); }
      }
    }
    __syncthreads();
    const int len_ = seq == 0 ? 256 : 128;
    const int ppos = len_ - 1 - pos;
    if (pos < ppos) {
#pragma unroll
      for (int cch = 0; cch < 4; ++cch) {
        int chunk = tid + cch * 256;
        int t = chunk >> 4, cc = (chunk & 15) * 8;
        unsigned off = (unsigned)(g0 + t) * D + head * 128 + cc;
        uint4 hv = *(const uint4*)(sBh + t * 128 + cc);
        unsigned long long* q = (unsigned long long*)(hown + off);
        lb_st64(q, (unsigned long long)hv.x | ((unsigned long long)hv.y << 32));
        lb_st64(q + 1, (unsigned long long)hv.z | ((unsigned long long)hv.w << 32));
      }
      asm volatile("s_waitcnt vmcnt(0)" ::: "memory");
      __syncthreads();
      if (tid == 0) lb_st32(stat + item, (unsigned)l + 1u);
    } else {
      const int pit = lb_rank(seq, ppos) * 16 + (hd ^ 1);
      unsigned spins = 0;
      while (lb_ld32(stat + pit) != (unsigned)l + 1u) { __builtin_amdgcn_s_sleep(1); if (++spins > (1u << 18)) break; }
#pragma unroll
      for (int cch = 0; cch < 4; ++cch) {
        int chunk = tid + cch * 256;
        int t = chunk >> 4, cc = (chunk & 15) * 8;
        unsigned off = (unsigned)(g0 + t) * D + head * 128 + cc;
        uint4 hv = *(const uint4*)(sBh + t * 128 + cc);
        const unsigned long long* q = (const unsigned long long*)(hoth + off);
        unsigned long long f0 = lb_ld64(q), f1 = lb_ld64(q + 1);
        uint4 fv = make_uint4((unsigned)f0, (unsigned)(f0 >> 32), (unsigned)f1, (unsigned)(f1 >> 32));
        uint4 gv = *(const uint4*)(ga + off);
        uint4 o;
        o.x = pack2((lo2f(fv.x) + lo2f(hv.x)) * lo2f(gv.x), (hi2f(fv.x) + hi2f(hv.x)) * hi2f(gv.x));
        o.y = pack2((lo2f(fv.y) + lo2f(hv.y)) * lo2f(gv.y), (hi2f(fv.y) + hi2f(hv.y)) * hi2f(gv.y));
        o.z = pack2((lo2f(fv.z) + lo2f(hv.z)) * lo2f(gv.z), (hi2f(fv.z) + hi2f(hv.z)) * hi2f(gv.z));
        o.w = pack2((lo2f(fv.w) + lo2f(hv.w)) * lo2f(gv.w), (hi2f(fv.w) + hi2f(hv.w)) * hi2f(gv.w));
        *(uint4*)(ga + off) = o;
      }
    }
    __syncthreads();
  }
#undef LOAD_XROWS
}

DEVFN void phase_carry(const Params& p) {
  const float2* __restrict__ agg = (const float2*)U(p, 4);
  float* __restrict__ carry = (float*)(agg + 1280L * 2 * 1024);
  const int lane = threadIdx.x & 63, w = threadIdx.x >> 6;
  for (int u = blockIdx.x + gridDim.x * w; u < 288; u += gridDim.x * 4) {
    int id = u * 64 + lane;
    int seq = id >> 11, dir = (id >> 10) & 1, c = id & 1023;
    int nt = seq_len(seq) >> 6, tile0 = seq_start(seq) >> 6;
    float h = 0.f;
#pragma unroll 8
    for (int k = 0; k < nt; ++k) {
      int tt = tile0 + (dir ? nt - 1 - k : k);
      unsigned ix = (unsigned)(tt * 2 + dir) * 1024 + c;
      float2 v = agg[ix];
      carry[ix] = h;
      h = v.x * h + v.y;
    }
  }
}

DEVFN void phase_merge(const Params& p, int l, u16* smem) {
  const u16* wl = WL(p, l);
  u16* mo = U(p, 1);
  u16* tb = U(p, 5);
  u16* so = smem;
  for (int it = 0;; ++it) {
    int mt, nt;
    if (!tile_xcd(it, 1, 8, mt, nt)) break;
    const int g0 = mt * 256;
#pragma unroll 1
    for (int br = 0; br < 2; ++br) {
      {
        const int tid = otid(), lane = tid & 63, w = tid >> 6, wm = w >> 1, wn = w & 1, lr = lane & 15, quad = lane >> 4;
        f32x4 acc[8][4]; zero_acc8(acc);
        LdPlain lb; lb.init(tid, wl + (br == 0 ? W_A : W_B), nt * 128, D);
        if (br == 0) {
          LdPlain la; la.init(tid, U(p, 2), g0, D);
          gemm_core_b(tid, acc, 32, la, lb, smem);
        } else {
          const int seq = seq_of(g0);
          LdPerm la; la.base = U(p, 3); la.g0 = g0; la.sst = seq_start(seq); la.lg = seq == 0 ? 7 : 6;
          gemm_core_b(tid, acc, 32, la, lb, smem);
        }
#pragma unroll
        for (int i = 0; i < 8; ++i) {
          const int m = wm * 128 + i * 16 + lr;
#pragma unroll
          for (int j = 0; j < 4; ++j) {
            const int n = wn * 64 + j * 16 + quad * 4;
            uint2 o; o.x = pack2(acc[i][j][0], acc[i][j][1]); o.y = pack2(acc[i][j][2], acc[i][j][3]);
            *(uint2*)(so + m * 136 + n) = o;
          }
        }
        __syncthreads();
#pragma unroll
        for (int c = 0; c < 16; ++c) {
          const int idx = tid + c * 256;
          const int row = idx >> 4, ch = idx & 15;
          *(uint4*)(tb + ((unsigned)(g0 + row) * D + nt * 128 + ch * 8)) = *(const uint4*)(so + row * 136 + ch * 8);
        }
        __syncthreads();
      }
      {
        const int tid = otid(), lane = tid & 63, w = tid >> 6, wm = w >> 1, wn = w & 1, lr = lane & 15, quad = lane >> 4;
        f32x4 acc[8][4]; zero_acc8(acc);
        LdPlain la; la.init(tid, U(p, 0), g0, D);
        LdPlain lb; lb.init(tid, wl + W_CAT, 5120 + br * 1024 + nt * 128, D);
        gemm_core_b(tid, acc, 32, la, lb, smem);
#pragma unroll
        for (int c = 0; c < 16; ++c) {
          const int idx = tid + c * 256;
          const int row = idx >> 4, ch = idx & 15;
          *(uint4*)(so + row * 136 + ch * 8) = *(const uint4*)(tb + ((unsigned)(g0 + row) * D + nt * 128 + ch * 8));
        }
        __syncthreads();
#pragma unroll
        for (int i = 0; i < 8; ++i) {
          const int m = wm * 128 + i * 16 + lr;
#pragma unroll
          for (int j = 0; j < 4; ++j) {
            const int n = wn * 64 + j * 16 + quad * 4;
            uint2 tv = *(const uint2*)(so + m * 136 + n);
            acc[i][j][0] = sigm(acc[i][j][0]) * lo2f(tv.x);
            acc[i][j][1] = sigm(acc[i][j][1]) * hi2f(tv.x);
            acc[i][j][2] = sigm(acc[i][j][2]) * lo2f(tv.y);
            acc[i][j][3] = sigm(acc[i][j][3]) * hi2f(tv.y);
          }
        }
        if (br == 1) {
          __syncthreads();
#pragma unroll
          for (int c = 0; c < 16; ++c) {
            const int idx = tid + c * 256;
            const int row = idx >> 4, ch = idx & 15;
            *(uint4*)(so + row * 136 + ch * 8) = *(const uint4*)(mo + ((unsigned)(g0 + row) * D + nt * 128 + ch * 8));
          }
          __syncthreads();
#pragma unroll
          for (int i = 0; i < 8; ++i) {
            const int m = wm * 128 + i * 16 + lr;
#pragma unroll
            for (int j = 0; j < 4; ++j) {
              const int n = wn * 64 + j * 16 + quad * 4;
              uint2 pv = *(const uint2*)(so + m * 136 + n);
              acc[i][j][0] += lo2f(pv.x); acc[i][j][1] += hi2f(pv.x);
              acc[i][j][2] += lo2f(pv.y); acc[i][j][3] += hi2f(pv.y);
            }
          }
        }
        __syncthreads();
#pragma unroll
        for (int i = 0; i < 8; ++i) {
          const int m = wm * 128 + i * 16 + lr;
#pragma unroll
          for (int j = 0; j < 4; ++j) {
            const int n = wn * 64 + j * 16 + quad * 4;
            uint2 o; o.x = pack2(acc[i][j][0], acc[i][j][1]); o.y = pack2(acc[i][j][2], acc[i][j][3]);
            *(uint2*)(so + m * 136 + n) = o;
          }
        }
        __syncthreads();
#pragma unroll
        for (int c = 0; c < 16; ++c) {
          const int idx = tid + c * 256;
          const int row = idx >> 4, ch = idx & 15;
          *(uint4*)(mo + ((unsigned)(g0 + row) * D + nt * 128 + ch * 8)) = *(const uint4*)(so + row * 136 + ch * 8);
        }
        __syncthreads();
      }
    }
  }
}

DEVFN void phase_out(const Params& p, int l, u16* smem) {
  const u16* wo = WL(p, l) + W_O;
  for (int it = 0;; ++it) {
    int mt, nt;
    if (!tile_xcd(it, 1, 8, mt, nt)) break;
    const int tid = otid(), lane = tid & 63, w = tid >> 6, wm = w >> 1, wn = w & 1, lr = lane & 15, quad = lane >> 4;
    const int g0 = mt * 256;
    LdPlain la; la.init(tid, U(p, 1), g0, D);
    LdPlain lb; lb.init(tid, wo, nt * 128, D);
    f32x4 acc[8][4]; zero_acc8(acc);
    gemm_core_b(tid, acc, 32, la, lb, smem);
    const float* gate = MOD(p) + ((long)l * 9 + seq_of(g0)) * 3072 + 2048;
#pragma unroll
    for (int i = 0; i < 8; ++i) {
      unsigned g = g0 + wm * 128 + i * 16 + lr;
      const float* xb = (l == 0) ? (g0 < 16384 ? p.x_prompt : p.x_sample) : p.out;
      const float* xr = xb + (unsigned)((l == 0 && g0 >= 16384) ? g - 16384 : g) * D;
      float* orow = p.out + g * D;
#pragma unroll
      for (int j = 0; j < 4; ++j) {
        unsigned c = nt * 128 + wn * 64 + j * 16 + quad * 4;
        float4 xv = *(const float4*)(xr + c);
        float4 gt = *(const float4*)(gate + c);
        float4 o;
        o.x = xv.x + gt.x * acc[i][j][0]; o.y = xv.y + gt.y * acc[i][j][1];
        o.z = xv.z + gt.z * acc[i][j][2]; o.w = xv.w + gt.w * acc[i][j][3];
        *(float4*)(orow + c) = o;
      }
    }
  }
}

#define XB_TMO      128
#define XB_XCNT(j)  (256  + 64 * (j))
#define XB_XSUB(j)  (1280 + 64 * (j))
#define XB_XGEN(j)  (2304 + 64 * (j))
#define XB_TOP      3328
#define XB_TOPGEN   3392
#define XCD_BAR_WORDS 3456
#define XB_SPIN_CAP (1u << 18)
#define LAS __attribute__((address_space(3)))

__device__ __forceinline__ unsigned xb_ld(unsigned* p)              { return __hip_atomic_load(p, __ATOMIC_RELAXED, __HIP_MEMORY_SCOPE_AGENT); }
__device__ __forceinline__ unsigned xb_add(unsigned* p, unsigned v) { return __hip_atomic_fetch_add(p, v, __ATOMIC_RELAXED, __HIP_MEMORY_SCOPE_AGENT); }
__device__ __forceinline__ unsigned xb_xcc_id() { return (unsigned)__builtin_amdgcn_s_getreg((3 << 11) | 20) & 0xFu; }
#define XB_SPIN(cond, bar) do { unsigned _sp = 0; while (cond) { __builtin_amdgcn_s_sleep(1); \
    if ((++_sp & 255u) == 0u) { if (xb_ld(&(bar)[XB_TMO])) break; if (_sp > XB_SPIN_CAP) { atomicAdd(&(bar)[XB_TMO], 1u); break; } } } } while (0)

struct XcdBarrier {
    unsigned* bar; unsigned x;
    volatile LAS unsigned* st;
};

__device__ __forceinline__ XcdBarrier xcd_barrier_post(unsigned* bar, volatile LAS unsigned* st) {
    XcdBarrier b; b.bar = bar; b.x = xb_xcc_id(); b.st = st;
    if (threadIdx.x == 0) (void)xb_add(&bar[XB_XCNT(b.x)], 1u);
    return b;
}
__device__ __forceinline__ void xcd_barrier_complete(unsigned* bar, unsigned x, unsigned& nloc, unsigned& nx) {
    const unsigned G = gridDim.x * gridDim.y * gridDim.z;
    unsigned sum, cnt, mine, sp = 0u;
    for (;;) {
        sum = 0u; cnt = 0u; mine = 0u;
#pragma unroll
        for (unsigned j = 0; j < 16; ++j) { const unsigned c = xb_ld(&bar[XB_XCNT(j)]); sum += c; cnt += (c > 0u) ? 1u : 0u; mine = (j == x) ? c : mine; }
        if (sum == G) break;
        __builtin_amdgcn_s_sleep(1);
        if ((++sp & 255u) == 0u) { if (xb_ld(&bar[XB_TMO])) break; if (sp > XB_SPIN_CAP) { atomicAdd(&bar[XB_TMO], 1u); break; } }
    }
    nloc = mine > 0u ? mine : 1u; nx = cnt > 0u ? cnt : 1u;
}

__device__ __forceinline__ void xcd_barrier(const XcdBarrier& b) {
    asm volatile("s_waitcnt vmcnt(0)" ::: "memory");
    __syncthreads();
    if (threadIdx.x == 0) {
        unsigned* bar = b.bar;
        __builtin_amdgcn_s_waitcnt(0);
        unsigned nloc = b.st[0], nx = b.st[1];
        if (nloc == 0u) { xcd_barrier_complete(bar, b.x, nloc, nx); b.st[0] = nloc; b.st[1] = nx; }
        const unsigned old = xb_add(&bar[XB_XSUB(b.x)], 1u);
        const unsigned gen = old / nloc;
        if (old + 1u == (gen + 1u) * nloc) {
            __builtin_amdgcn_fence(__ATOMIC_RELEASE, "agent");
            asm volatile("s_waitcnt vmcnt(0)" ::: "memory");
            const unsigned og = xb_add(&bar[XB_TOP], 1u);
            const unsigned tg = og / nx;
            if (og + 1u == (tg + 1u) * nx) xb_add(&bar[XB_TOPGEN], 1u);
            else XB_SPIN(xb_ld(&bar[XB_TOPGEN]) == tg, bar);
            __builtin_amdgcn_fence(__ATOMIC_ACQUIRE, "agent");
            xb_add(&bar[XB_XGEN(b.x)], 1u);
            asm volatile("s_waitcnt vmcnt(0)" ::: "memory");
        } else {
            XB_SPIN(xb_ld(&bar[XB_XGEN(b.x)]) == gen, bar);
            __builtin_amdgcn_fence(__ATOMIC_ACQUIRE, "agent");
            asm volatile("s_waitcnt vmcnt(0)" ::: "memory");
        }
    }
    __syncthreads();
}


__global__ void __launch_bounds__(256, 2) hawk_fnet_megakernel(Params p) {
  extern __shared__ __attribute__((aligned(16))) unsigned char smem_raw[];
  cg::grid_group grid = cg::this_grid();
  u16* smem = (u16*)smem_raw;

  __shared__ unsigned xb_st[4];
  unsigned* bar = (unsigned*)(p.ws + OFF_BAR_BYTES);
  if (blockIdx.x == 0) {
    for (int i = threadIdx.x; i < XCD_BAR_WORDS; i += 256) __hip_atomic_store(&bar[i], 0u, __ATOMIC_RELAXED, __HIP_MEMORY_SCOPE_AGENT);
  }
  if (threadIdx.x < 4) xb_st[threadIdx.x] = 0u;
  {
    unsigned* lbs = (unsigned*)(p.ws + OFF_LB_BYTES + LB_SLOT_BYTES);
    for (int i = blockIdx.x * 256 + threadIdx.x; i < 20480 + 10240; i += gridDim.x * 256)
      __hip_atomic_store(&lbs[i], 0u, __ATOMIC_RELAXED, __HIP_MEMORY_SCOPE_AGENT);
    unsigned long long* lbq = (unsigned long long*)(p.ws + OFF_LB_BYTES);
    for (int i = blockIdx.x * 256 + threadIdx.x; i < (int)(LB_SLOT_BYTES / 8); i += gridDim.x * 256)
      __hip_atomic_store(&lbq[i], 0ull, __ATOMIC_RELAXED, __HIP_MEMORY_SCOPE_AGENT);
  }
  phase_prologue(p, smem_raw);
  grid.sync();
  XcdBarrier xb = xcd_barrier_post(bar, (volatile LAS unsigned*)xb_st);
  phase_fold(p, smem);
  phase_h(p, 0);
  xcd_barrier(xb);
  for (int l = 0; l < 2; ++l) {
    phase_gemm1(p, l, smem);
    xcd_barrier(xb);
    phase_fft1(p, smem);
    xcd_barrier(xb);
    phase_fft2(p, smem);
    xcd_barrier(xb);
    phase_scan_lb(p, l, smem_raw);
    xcd_barrier(xb);
    phase_merge(p, l, smem);
    xcd_barrier(xb);
    phase_out(p, l, smem);
    xcd_barrier(xb);
    if (l == 0) { phase_h(p, 1); xcd_barrier(xb); }
  }
  phase_final(p);
}

extern "C" void kernel_launch(void* const* d_in, const int* in_sizes, int n_in,
                              void* d_out, int out_size, void* d_ws, size_t ws_size,
                              hipStream_t stream) {
  (void)in_sizes; (void)n_in; (void)out_size;
  if (ws_size < (size_t)WS_NEED) {
    fprintf(stderr, "workspace too small: %zu < %ld\n", ws_size, (long)WS_NEED);
    return;
  }
  static int grid_blocks = 0;
  if (!grid_blocks) {
    hipFuncSetAttribute((const void*)hawk_fnet_megakernel, hipFuncAttributeMaxDynamicSharedMemorySize, SMEM_BYTES);
    int dev = 0, cus = 0, per_cu = 0;
    hipGetDevice(&dev);
    hipDeviceGetAttribute(&cus, hipDeviceAttributeMultiprocessorCount, dev);
    hipOccupancyMaxActiveBlocksPerMultiprocessor(&per_cu, hawk_fnet_megakernel, 256, SMEM_BYTES);
    if (per_cu > 2) per_cu = 2;
    if (per_cu < 1) per_cu = 1;
    grid_blocks = (cus * per_cu) & ~15;
  }
  Params p{};
  p.x_prompt = (const float*)d_in[0]; p.x_sample = (const float*)d_in[1];
  p.c_prompt = (const float*)d_in[2]; p.c_sample = (const float*)d_in[3];
  p.norm_g = (const float*)d_in[4]; p.w_ada = (const float*)d_in[5]; p.b_ada = (const float*)d_in[6];
  p.w_in = (const float*)d_in[7]; p.conv_w = (const float*)d_in[8]; p.conv_b = (const float*)d_in[9];
  p.w_rg = (const float*)d_in[10]; p.b_rg = (const float*)d_in[11]; p.lam = (const float*)d_in[12];
  p.w_a_out = (const float*)d_in[13]; p.w_b_out = (const float*)d_in[14]; p.w_o = (const float*)d_in[15];
  p.final_g = (const float*)d_in[16];
  p.out = (float*)d_out; p.ws = (unsigned char*)d_ws;
  void* args[] = {&p};
  hipError_t e = hipLaunchCooperativeKernel((void*)hawk_fnet_megakernel, dim3(grid_blocks), dim3(256), args, SMEM_BYTES, stream);
  if (e != hipSuccess) fprintf(stderr, "cooperative launch failed: %s (grid %d)\n", hipGetErrorString(e), grid_blocks);
}
```

```cpp
#include <hip/hip_runtime.h>
#include <hip/hip_cooperative_groups.h>
#include <cstdio>
namespace cg = cooperative_groups;

typedef unsigned short u16;
typedef __attribute__((ext_vector_type(8))) short bf16x8;
typedef __attribute__((ext_vector_type(4))) float f32x4;

#define DEVFN __device__ __forceinline__

constexpr int D = 1024;
constexpr int T_TOT = 81920;
constexpr long UNIT = (long)T_TOT * D;
constexpr int D_IN = 6144;

constexpr long OFF_W = 6 * UNIT;
constexpr long W_CAT = 0;
constexpr long W_A = 7168L * 1024;
constexpr long W_B = W_A + 1048576;
constexpr long W_O = W_B + 1048576;
constexpr long W_RG = W_O + 1048576;
constexpr long LW = W_RG + 524288;
constexpr long OFF_TAB = OFF_W + 2 * LW;
constexpr long T_D1A = 0;
constexpr long T_D1B = 65536;
constexpr long T_D2 = T_D1B + 16384;
constexpr long T_DC = T_D2 + 32768;
constexpr long TAB_ELEMS = T_DC + 131072;
constexpr long OFF_TW_BYTES = (OFF_TAB + TAB_ELEMS) * 2;
constexpr long OFF_MOD_BYTES = OFF_TW_BYTES + 131072;
constexpr long OFF_BAR_BYTES = OFF_MOD_BYTES + 221184;
constexpr long OFF_LB_BYTES = OFF_BAR_BYTES + 16384;
constexpr long LB_SLOT_BYTES = 20480L * 128 * 8;
constexpr long WS_NEED = OFF_LB_BYTES + LB_SLOT_BYTES + 20480 * 4 + 10240 * 4;
static_assert(WS_NEED <= (1L << 30), "workspace map exceeds the guaranteed 1 GiB");

constexpr int TILE = 128 * 64;
constexpr int SMEM_BYTES = 73728;

struct Params {
  const float* x_prompt; const float* x_sample; const float* c_prompt; const float* c_sample;
  const float* norm_g; const float* w_ada; const float* b_ada; const float* w_in;
  const float* conv_w; const float* conv_b; const float* w_rg; const float* b_rg; const float* lam;
  const float* w_a_out; const float* w_b_out; const float* w_o; const float* final_g;
  float* out; unsigned char* ws;
};

typedef __attribute__((ext_vector_type(2))) float f32x2_t;
typedef __attribute__((ext_vector_type(2))) __bf16 bf16x2_t;
DEVFN u16 f2bf(float f) {
  __bf16 h = (__bf16)f;
  return *(u16*)&h;
}
DEVFN float bf2f(u16 h) { return __uint_as_float(((unsigned)h) << 16); }
DEVFN unsigned pack2(float a, float b) {
  f32x2_t v = {a, b};
  bf16x2_t r = __builtin_convertvector(v, bf16x2_t);
  return *(unsigned*)&r;
}
DEVFN float lo2f(unsigned v) { return __uint_as_float(v << 16); }
DEVFN float hi2f(unsigned v) { return __uint_as_float(v & 0xffff0000u); }
DEVFN float sigm(float x) { return __builtin_amdgcn_rcpf(1.f + __expf(-x)); }
DEVFN float silu(float x) { return x * __builtin_amdgcn_rcpf(1.f + __expf(-x)); }
DEVFN float one_minus_exp(float x) {
  float pl = -x * (1.f + x * (0.5f + x * (1.f / 6.f + x * (1.f / 24.f + x * (1.f / 120.f + x * (1.f / 720.f))))));
  float dr = 1.f - __expf(x);
  return x > -0.3f ? pl : dr;
}

DEVFN int otid() { int t = threadIdx.x; asm volatile("" : "+v"(t)); return t; }
DEVFN int seq_of(int g) { int seg = g >> 13; return seg < 2 ? 0 : seg - 1; }
DEVFN int seq_start(int s) { return s == 0 ? 0 : 16384 + (s - 1) * 8192; }
DEVFN int seq_len(int s) { return s == 0 ? 16384 : 8192; }

DEVFN u16* U(const Params& p, int i) { return (u16*)(p.ws) + (long)i * UNIT; }
DEVFN u16* WL(const Params& p, int l) { return (u16*)(p.ws) + OFF_W + (long)l * LW; }
DEVFN u16* TAB(const Params& p) { return (u16*)(p.ws) + OFF_TAB; }
DEVFN float2* TW(const Params& p) { return (float2*)(p.ws + OFF_TW_BYTES); }
DEVFN float* MOD(const Params& p) { return (float*)(p.ws + OFF_MOD_BYTES); }
DEVFN const float* xrow(const Params& p, int g) {
  return g < 16384 ? p.x_prompt + (long)g * D : p.x_sample + (long)(g - 16384) * D;
}

struct LdPlain {
  static constexpr bool kDma = true; static constexpr bool kTr = false;
  const u16* base; unsigned off0; unsigned cst; int t_; unsigned row0_, stride_;
  DEVFN unsigned rowoff(int r) const { return (row0_ + r) * stride_; }
  DEVFN void init(int tid_, const u16* b, unsigned row0, unsigned stride) {
    unsigned tid = tid_; t_ = tid_; row0_ = row0; stride_ = stride;
    base = b;
    off0 = (row0 + (tid >> 3)) * stride + (((tid & 7) ^ ((tid >> 3) & 7)) << 3);
    cst = 32 * stride;
  }
  DEVFN void issue(u16* tile, int c, int kt) const {
    __builtin_amdgcn_global_load_lds((const unsigned*)(base + (off0 + c * cst + kt * 64)),
                                     (unsigned*)(tile + (t_ + c * 256) * 8), 16, 0, 0);
  }
  DEVFN uint4 load(int, int) const { return make_uint4(0, 0, 0, 0); }
  DEVFN void store(u16*, int, uint4) const {}
};
struct LdRows4 {
  static constexpr bool kDma = true; static constexpr bool kTr = false;
  const u16* base; unsigned off[4]; int t_;
  DEVFN void issue(u16* tile, int c, int kt) const {
    __builtin_amdgcn_global_load_lds((const unsigned*)(base + (off[c] + kt * 64)),
                                     (unsigned*)(tile + (t_ + c * 256) * 8), 16, 0, 0);
  }
  DEVFN uint4 load(int, int) const { return make_uint4(0, 0, 0, 0); }
  DEVFN void store(u16*, int, uint4) const {}
};
struct LdF32 {
  static constexpr bool kDma = false; static constexpr bool kTr = false;
  const float* base; unsigned off0; unsigned cst; int t_;
  DEVFN void init(int tid_, const float* b, unsigned row0, unsigned stride, unsigned col0) {
    unsigned tid = tid_; t_ = tid_;
    base = b;
    off0 = (row0 + (tid >> 3)) * stride + col0 + (tid & 7) * 8;
    cst = 32 * stride;
  }
  DEVFN void issue(u16*, int, int) const {}
  DEVFN uint4 load(int c, int kt) const {
    const float4* q = (const float4*)(base + (off0 + c * cst + kt * 64));
    float4 a = q[0], b = q[1];
    uint4 r; r.x = pack2(a.x, a.y); r.y = pack2(a.z, a.w); r.z = pack2(b.x, b.y); r.w = pack2(b.z, b.w);
    return r;
  }
  DEVFN void store(u16* tile, int c, uint4 v) const {
    int idx = t_ + c * 256;
    int row = idx >> 3, kc = idx & 7;
    *(uint4*)(tile + row * 64 + ((kc ^ (row & 7)) << 3)) = v;
  }
};
DEVFN int trf(int r) { return ((r & 3) << 2) | ((r >> 2) & 3); }
template <class TokFn>
struct LdTrans {
  static constexpr bool kDma = false; static constexpr bool kTr = false;
  TokFn tok; int t_;
  DEVFN void issue(u16*, int, int) const {}
  DEVFN uint4 load(int c, int kt) const {
    int idx = t_ + c * 256;
    int kk = idx & 63, cc = idx >> 6;
    const u16* b; unsigned o = tok(kt * 64 + kk, b);
    return *(const uint4*)(b + (o + cc * 8));
  }
  DEVFN void store(u16* tile, int c, uint4 v) const {
    int idx = t_ + c * 256;
    int kk = idx & 63, cc = idx >> 6;
    u16* q = tile + (cc * 8) * 64 + (kk & 7);
    int kc = kk >> 3;
    q[0 * 64 + ((kc ^ 0) << 3)] = (u16)(v.x & 0xffff); q[1 * 64 + ((kc ^ 1) << 3)] = (u16)(v.x >> 16);
    q[2 * 64 + ((kc ^ 2) << 3)] = (u16)(v.y & 0xffff); q[3 * 64 + ((kc ^ 3) << 3)] = (u16)(v.y >> 16);
    q[4 * 64 + ((kc ^ 4) << 3)] = (u16)(v.z & 0xffff); q[5 * 64 + ((kc ^ 5) << 3)] = (u16)(v.z >> 16);
    q[6 * 64 + ((kc ^ 6) << 3)] = (u16)(v.w & 0xffff); q[7 * 64 + ((kc ^ 7) << 3)] = (u16)(v.w >> 16);
  }
};

typedef __attribute__((ext_vector_type(4))) short s16x4;
DEVFN s16x4 lds_tr_read(const u16* q) {
  return __builtin_amdgcn_ds_read_tr16_b64_v4i16((s16x4 __attribute__((address_space(3)))*)(q));
}

DEVFN void zero_acc(f32x4 (&acc)[4][4]) {
#pragma unroll
  for (int i = 0; i < 4; ++i)
#pragma unroll
    for (int j = 0; j < 4; ++j) acc[i][j] = f32x4{0.f, 0.f, 0.f, 0.f};
}

template <class LA, class LB>
DEVFN void gemm_core(int tid, f32x4 (&acc)[4][4], int nk, const LA& la, const LB& lb, u16* smem) {
  const int lane = tid & 63, w = tid >> 6, wm = w >> 1, wn = w & 1;
  const int lr = lane & 15, quad = lane >> 4;
  uint4 ra[4], rb[4];
  if (LA::kDma) {
#pragma unroll
    for (int c = 0; c < 4; ++c) la.issue(smem, c, 0);
  } else {
#pragma unroll
    for (int c = 0; c < 4; ++c) ra[c] = la.load(c, 0);
  }
  if (LB::kDma) {
#pragma unroll
    for (int c = 0; c < 4; ++c) lb.issue(smem + TILE, c, 0);
  } else {
#pragma unroll
    for (int c = 0; c < 4; ++c) rb[c] = lb.load(c, 0);
  }
  if (!LA::kDma) {
#pragma unroll
    for (int c = 0; c < 4; ++c) la.store(smem, c, ra[c]);
  }
  if (!LB::kDma) {
#pragma unroll
    for (int c = 0; c < 4; ++c) lb.store(smem + TILE, c, rb[c]);
  }
  asm volatile("s_waitcnt vmcnt(0)" ::: "memory");
  __syncthreads();
  const int aoff = (wm * 64 + lr) * 64, boff = (wn * 64 + lr) * 64;
  const int sw0 = ((quad) ^ (lr & 7)) << 3, sw1 = ((4 + quad) ^ (lr & 7)) << 3;
  int troff[4][2];
  if (LB::kTr) {
    const int q = lr >> 2, pp = lr & 3;
#pragma unroll
    for (int j = 0; j < 4; ++j)
#pragma unroll
      for (int h = 0; h < 2; ++h) {
        int r = quad * 8 + h * 4 + q;
        int ch = (wn * 8 + j * 2 + (pp >> 1)) ^ trf(r);
        troff[j][h] = r * 128 + ch * 8 + (pp & 1) * 4;
      }
  }
  for (int kt = 0; kt < nk; ++kt) {
    const u16* sA = smem + (kt & 1) * 2 * TILE;
    const u16* sB = sA + TILE;
    u16* nA = smem + ((kt + 1) & 1) * 2 * TILE;
    const bool more = (kt + 1) < nk;
    if (more) {
      if (LA::kDma) {
#pragma unroll
        for (int c = 0; c < 4; ++c) la.issue(nA, c, kt + 1);
      } else {
#pragma unroll
        for (int c = 0; c < 4; ++c) ra[c] = la.load(c, kt + 1);
      }
      if (LB::kDma) {
#pragma unroll
        for (int c = 0; c < 4; ++c) lb.issue(nA + TILE, c, kt + 1);
      } else {
#pragma unroll
        for (int c = 0; c < 4; ++c) rb[c] = lb.load(c, kt + 1);
      }
    }
#pragma unroll
    for (int ks = 0; ks < 2; ++ks) {
      const int sw = ks == 0 ? sw0 : sw1;
      bf16x8 af[4], bfr[4];
#pragma unroll
      for (int i = 0; i < 4; ++i) af[i] = *(const bf16x8*)(sA + aoff + i * 1024 + sw);
      if (LB::kTr) {
#pragma unroll
        for (int j = 0; j < 4; ++j) {
          s16x4 lo = lds_tr_read(sB + troff[j][0] + ks * 4096);
          s16x4 hi = lds_tr_read(sB + troff[j][1] + ks * 4096);
          bfr[j] = __builtin_shufflevector(lo, hi, 0, 1, 2, 3, 4, 5, 6, 7);
        }
      } else {
#pragma unroll
        for (int j = 0; j < 4; ++j) bfr[j] = *(const bf16x8*)(sB + boff + j * 1024 + sw);
      }
      __builtin_amdgcn_s_setprio(1);
#pragma unroll
      for (int i = 0; i < 4; ++i)
#pragma unroll
        for (int j = 0; j < 4; ++j)
          acc[i][j] = __builtin_amdgcn_mfma_f32_16x16x32_bf16(bfr[j], af[i], acc[i][j], 0, 0, 0);
      __builtin_amdgcn_s_setprio(0);
    }
    if (more) {
      if (!LA::kDma) {
#pragma unroll
        for (int c = 0; c < 4; ++c) la.store(nA, c, ra[c]);
      }
      if (!LB::kDma) {
#pragma unroll
        for (int c = 0; c < 4; ++c) lb.store(nA + TILE, c, rb[c]);
      }
    }
    asm volatile("s_waitcnt vmcnt(0)" ::: "memory");
    __syncthreads();
  }
}

struct LdPerm {
  const u16* base; int g0, sst, lg;
  DEVFN unsigned rowoff(int r) const {
    int t = g0 - sst + r;
    int urow = ((t & ((1 << lg) - 1)) << 7) + (t >> lg);
    return (unsigned)(sst + urow) * D;
  }
};
#define GLDS16(gp, lp) __builtin_amdgcn_global_load_lds((const unsigned*)(gp), (unsigned*)(lp), 16, 0, 0)
DEVFN void zero_acc8(f32x4 (&acc)[8][4]) {
#pragma unroll
  for (int i = 0; i < 8; ++i)
#pragma unroll
    for (int j = 0; j < 4; ++j) acc[i][j] = f32x4{0.f, 0.f, 0.f, 0.f};
}
template <class LA, class LB>
DEVFN void gemm_core_b(int tid, f32x4 (&acc)[8][4], int nk, const LA& la, const LB& lb, u16* smem) {
  const int lane = tid & 63, w = tid >> 6, wm = w >> 1, wn = w & 1;
  const int lr = lane & 15, quad = lane >> 4;
  const int r0 = tid >> 2;
  const unsigned sw = (unsigned)(((tid & 3) ^ ((0 - (tid >> 4)) & 3)) << 3);
  const unsigned oa0 = la.rowoff(r0) + sw, oa1 = la.rowoff(r0 + 64) + sw, oa2 = la.rowoff(r0 + 128) + sw, oa3 = la.rowoff(r0 + 192) + sw;
  const unsigned ob0 = lb.rowoff(r0) + sw, ob1 = lb.rowoff(r0 + 64) + sw;
  const u16* ga = la.base; const u16* gb = lb.base;
  u16* l0 = smem + tid * 8;
#define ISSUE_STAGE(st, kt) do { u16* _s = l0 + (st) * 12288; unsigned _k = (unsigned)(kt) * 32u; \
    GLDS16(ga + (oa0 + _k), _s); GLDS16(ga + (oa1 + _k), _s + 2048); GLDS16(ga + (oa2 + _k), _s + 4096); GLDS16(ga + (oa3 + _k), _s + 6144); \
    GLDS16(gb + (ob0 + _k), _s + 8192); GLDS16(gb + (ob1 + _k), _s + 10240); } while (0)
  asm volatile("s_waitcnt vmcnt(0)" ::: "memory");
  ISSUE_STAGE(0, 0);
  ISSUE_STAGE(1, 1);
  const int fsw = (quad ^ ((0 - (lr >> 2)) & 3)) << 3;
  const int aoff = (wm * 128 + lr) * 32 + fsw, boff = 8192 + (wn * 64 + lr) * 32 + fsw;
  int cur = 0, nxt = 2;
  for (int kt = 0; kt < nk; ++kt) {
    if (kt + 1 < nk) asm volatile("s_waitcnt vmcnt(6)" ::: "memory");
    else asm volatile("s_waitcnt vmcnt(0)" ::: "memory");
    __builtin_amdgcn_s_barrier();
    asm volatile("" ::: "memory");
    if (kt + 2 < nk) ISSUE_STAGE(nxt, kt + 2);
    const u16* sb = smem + cur * 12288;
    bf16x8 af[8], bfr[4];
#pragma unroll
    for (int j = 0; j < 4; ++j) bfr[j] = *(const bf16x8*)(sb + boff + j * 512);
#pragma unroll
    for (int i = 0; i < 8; ++i) af[i] = *(const bf16x8*)(sb + aoff + i * 512);
    __builtin_amdgcn_s_setprio(1);
#pragma unroll
    for (int i = 0; i < 8; ++i)
#pragma unroll
      for (int j = 0; j < 4; ++j)
        acc[i][j] = __builtin_amdgcn_mfma_f32_16x16x32_bf16(bfr[j], af[i], acc[i][j], 0, 0, 0);
    __builtin_amdgcn_s_setprio(0);
    cur = cur == 2 ? 0 : cur + 1;
    nxt = nxt == 2 ? 0 : nxt + 1;
  }
  asm volatile("s_waitcnt lgkmcnt(0)" ::: "memory");
  __builtin_amdgcn_s_barrier();
  asm volatile("" ::: "memory");
#undef ISSUE_STAGE
}

DEVFN bool tile_xcd(int it, int ngrp, int ntn, int& mt, int& nt) {
  const int G = gridDim.x, b = blockIdx.x;
  if (G == 512) {
    if (it >= 5 * ngrp) return false;
    int xcd = b & 7, loc = b >> 3;
    mt = xcd * 40 + (it / ngrp) * 8 + (loc >> 3);
    nt = (it % ngrp) * 8 + (loc & 7);
    return true;
  }
  int tile = b + it * G;
  if (tile >= 320 * ntn) return false;
  mt = tile / ntn; nt = tile % ntn;
  return true;
}

DEVFN void transpose_tile(const float* src, long ld, u16* dst, long ldd, float* sT) {
  const int tid = otid();
#pragma unroll
  for (int pss = 0; pss < 4; ++pss) {
    int kk = (tid >> 4) + pss * 16, n4 = (tid & 15) * 4;
    float4 v = *(const float4*)(src + (long)kk * ld + n4);
    sT[kk * 65 + n4 + 0] = v.x; sT[kk * 65 + n4 + 1] = v.y; sT[kk * 65 + n4 + 2] = v.z; sT[kk * 65 + n4 + 3] = v.w;
  }
  __syncthreads();
  {
    int n = tid >> 2, k0 = (tid & 3) * 16;
    unsigned o[8];
#pragma unroll
    for (int e = 0; e < 8; ++e) o[e] = pack2(sT[(k0 + 2 * e) * 65 + n], sT[(k0 + 2 * e + 1) * 65 + n]);
    uint4* q = (uint4*)(dst + (long)n * ldd + k0);
    q[0] = make_uint4(o[0], o[1], o[2], o[3]);
    q[1] = make_uint4(o[4], o[5], o[6], o[7]);
  }
  __syncthreads();
}

DEVFN void phase_prologue(const Params& p, unsigned char* smem_raw) {
  const int tid = otid();
  constexpr int NJ_TR = 4352, NJ_MOD = 384, NJ_TAB = 256;
  for (int job = blockIdx.x; job < NJ_TR + NJ_MOD + NJ_TAB; job += gridDim.x) {
    if (job < NJ_TR) {
      float* sT = (float*)smem_raw;
      int l = job / 2176, r = job % 2176;
      u16* wl = WL(p, l);
      if (r < 1280) {
        int kt = r / 80, ntile = r % 80;
        int orow = ntile * 64;
        int scol;
        if (orow < 2048) scol = orow; else { orow += 2048; scol = orow - 1024; }
        transpose_tile(p.w_in + (long)l * D * D_IN + (long)(kt * 64) * D_IN + scol, D_IN,
                       wl + W_CAT + (long)orow * D + kt * 64, D, sT);
      } else if (r < 2048) {
        int r2 = r - 1280, which = r2 >> 8, t = r2 & 255, kt = t >> 4, ntile = t & 15;
        const float* src = (which == 0 ? p.w_a_out : which == 1 ? p.w_b_out : p.w_o) + (long)l * 1048576;
        long doff = which == 0 ? W_A : which == 1 ? W_B : W_O;
        transpose_tile(src + (long)(kt * 64) * D + ntile * 64, D, wl + doff + (long)(ntile * 64) * D + kt * 64, D, sT);
      } else {
        int r3 = r - 2048, mat = r3 >> 2, t = r3 & 3, kt = t >> 1, ntile = t & 1;
        const float* src = p.w_rg + ((long)l * 32 + mat) * 16384;
        transpose_tile(src + (long)(kt * 64) * 128 + ntile * 64, 128,
                       wl + W_RG + (long)mat * 16384 + (long)(ntile * 64) * 128 + kt * 64, 128, sT);
      }
    } else if (job < NJ_TR + NJ_MOD) {
      int jm = job - NJ_TR, l = jm / 192, cgp = jm % 192;
      float* sc = (float*)smem_raw;
      float* red = sc + 9 * 1024;
      for (int i = tid; i < 9 * 1024; i += 256) {
        int s_ = i >> 10, k = i & 1023;
        float cv = s_ == 0 ? p.c_prompt[k] : p.c_sample[(s_ - 1) * 1024 + k];
        sc[i] = silu(cv);
      }
      __syncthreads();
      int col = cgp * 16 + (tid & 15), kq = tid >> 4;
      float a0 = 0, a1 = 0, a2 = 0, a3 = 0, a4 = 0, a5 = 0, a6 = 0, a7 = 0, a8 = 0;
      const float* wp = p.w_ada + (long)l * D * 3072 + col;
#pragma unroll 8
      for (int k = kq * 64; k < kq * 64 + 64; ++k) {
        float wv = wp[(long)k * 3072];
        a0 += sc[0 * 1024 + k] * wv; a1 += sc[1 * 1024 + k] * wv; a2 += sc[2 * 1024 + k] * wv;
        a3 += sc[3 * 1024 + k] * wv; a4 += sc[4 * 1024 + k] * wv; a5 += sc[5 * 1024 + k] * wv;
        a6 += sc[6 * 1024 + k] * wv; a7 += sc[7 * 1024 + k] * wv; a8 += sc[8 * 1024 + k] * wv;
      }
      float* rq = red + kq * 144 + (tid & 15);
      rq[0 * 16] = a0; rq[1 * 16] = a1; rq[2 * 16] = a2; rq[3 * 16] = a3; rq[4 * 16] = a4;
      rq[5 * 16] = a5; rq[6 * 16] = a6; rq[7 * 16] = a7; rq[8 * 16] = a8;
      __syncthreads();
      if (tid < 144) {
        int s_ = tid >> 4, cc = tid & 15;
        float v = 0.f;
#pragma unroll
        for (int q = 0; q < 16; ++q) v += red[q * 144 + tid];
        int cf = cgp * 16 + cc;
        MOD(p)[((long)l * 9 + s_) * 3072 + cf] = v + p.b_ada[l * 3072 + cf];
      }
      __syncthreads();
    } else {
      int jt = job - NJ_TR - NJ_MOD;
      u16* tab = TAB(p);
#pragma unroll
      for (int e4 = 0; e4 < 4; ++e4) {
        int e = jt * 1024 + e4 * 256 + tid;
        if (e < 65536) {
          int m = e >> 8, k = e & 255;
          int k1 = (m >> 5) * 16 + (m & 15), ro = (m >> 4) & 1, ri = k >> 7, s1 = k & 127;
          float x = 2.f * (float)((k1 * s1) & 127) / 128.f;
          float cs = cospif(x), sn = sinpif(x);
          float v = (ro == ri) ? cs : (ro == 0 ? sn : -sn);
          tab[T_D1A + e] = f2bf(v);
        } else if (e < 65536 + 16384) {
          int e2 = e - 65536;
          int m = e2 >> 7, k = e2 & 127;
          int k1 = (m >> 5) * 16 + (m & 15), ro = (m >> 4) & 1, ri = k >> 6, s1 = k & 63;
          float x = 2.f * (float)((k1 * s1) & 63) / 64.f;
          float cs = cospif(x), sn = sinpif(x);
          float v = (ro == ri) ? cs : (ro == 0 ? sn : -sn);
          tab[T_D1B + e2] = f2bf(v);
        } else if (e < 65536 + 16384 + 32768) {
          int e2 = e - 65536 - 16384;
          int k2 = e2 >> 8, k = e2 & 255, ri = k >> 7, s2 = k & 127;
          float x = 2.f * (float)((k2 * s2) & 127) / 128.f;
          float v = ri == 0 ? cospif(x) : sinpif(x);
          tab[T_D2 + e2] = f2bf(v);
        } else if (e < 65536 + 16384 + 32768 + 131072) {
          int e2 = e - 65536 - 16384 - 32768;
          int row = e2 >> 8, c = e2 & 255, ri = row >> 8, m = row & 255;
          float x = 2.f * (float)((m * c) & 255) / 256.f;
          float v = ri == 0 ? cospif(x) : -sinpif(x);
          tab[T_DC + e2] = f2bf(v);
        } else {
          int e2 = e - (65536 + 16384 + 32768 + 131072);
          if (e2 < 16384) {
            float x = 2.f * (float)e2 / 16384.f;
            TW(p)[e2] = make_float2(cospif(x), sinpif(x));
          }
        }
      }
    }
  }
}

DEVFN void phase_fold(const Params& p, u16* smem) {
  for (int tile = blockIdx.x; tile < 256; tile += gridDim.x) {
    const int tid = otid(), lane = tid & 63, w = tid >> 6, wm = w >> 1, wn = w & 1, lr = lane & 15, quad = lane >> 4;
    int l = tile >> 7, g = (tile >> 5) & 3, mt = (tile >> 3) & 3, nt = tile & 7;
    LdPlain la; la.init(tid, TAB(p) + T_DC, mt * 128, 256);
    LdF32 lb; lb.init(tid, p.w_in + (long)l * D * D_IN, nt * 128, D_IN, 2048 + g * 256);
    f32x4 acc[4][4]; zero_acc(acc);
    gemm_core(tid, acc, 4, la, lb, smem);
    int ri = mt >> 1;
    u16* wc = WL(p, l) + W_CAT;
#pragma unroll
    for (int i = 0; i < 4; ++i) {
      int mrow = (mt & 1) * 128 + wm * 64 + i * 16 + lr;
      unsigned orow = 2048 + ri * 1024 + g * 256 + mrow;
#pragma unroll
      for (int j = 0; j < 4; ++j) {
        int n = nt * 128 + wn * 64 + j * 16 + quad * 4;
        uint2 o; o.x = pack2(acc[i][j][0], acc[i][j][1]); o.y = pack2(acc[i][j][2], acc[i][j][3]);
        *(uint2*)(wc + orow * D + n) = o;
      }
    }
  }
}

DEVFN void phase_h(const Params& p, int l) {
  const int lane = threadIdx.x & 63;
  const int wid = blockIdx.x * 4 + (threadIdx.x >> 6), nw = gridDim.x * 4;
  const float* ng = p.norm_g + l * D;
  const float* modl = MOD(p) + (long)l * 9 * 3072;
  u16* H = U(p, 0);
  float4 v[4], vn[4];
  auto ldrow = [&](int g, float4 (&dst)[4]) {
    const float* xb = (l == 0) ? (g < 16384 ? p.x_prompt : p.x_sample) : p.out;
    const unsigned xo = (unsigned)((l == 0 && g >= 16384) ? g - 16384 : g) * D;
#pragma unroll
    for (int i = 0; i < 4; ++i) dst[i] = *(const float4*)(xb + xo + i * 256 + lane * 4);
  };
  if (wid < T_TOT) ldrow(wid, v);
  for (int g = wid; g < T_TOT; g += nw) {
    if (g + nw < T_TOT) ldrow(g + nw, vn);
    const float* md = modl + seq_of(g) * 3072;
    float ss = 0.f;
#pragma unroll
    for (int i = 0; i < 4; ++i) ss += v[i].x * v[i].x + v[i].y * v[i].y + v[i].z * v[i].z + v[i].w * v[i].w;
#pragma unroll
    for (int o = 32; o >= 1; o >>= 1) ss += __shfl_xor(ss, o, 64);
    float rstd = rsqrtf(ss * (1.f / 1024.f) + 1e-6f);
#pragma unroll
    for (int i = 0; i < 4; ++i) {
      int c = i * 256 + lane * 4;
      float4 g4 = *(const float4*)(ng + c);
      float4 sh = *(const float4*)(md + c);
      float4 sc = *(const float4*)(md + 1024 + c);
      float h0 = v[i].x * rstd * g4.x * (1.f + sc.x) + sh.x;
      float h1 = v[i].y * rstd * g4.y * (1.f + sc.y) + sh.y;
      float h2 = v[i].z * rstd * g4.z * (1.f + sc.z) + sh.z;
      float h3 = v[i].w * rstd * g4.w * (1.f + sc.w) + sh.w;
      uint2 o; o.x = pack2(h0, h1); o.y = pack2(h2, h3);
      *(uint2*)(H + ((unsigned)g * D + c)) = o;
    }
#pragma unroll
    for (int i = 0; i < 4; ++i) v[i] = vn[i];
  }
}

DEVFN void phase_final(const Params& p) {
  const int lane = threadIdx.x & 63;
  const int wid = blockIdx.x * 4 + (threadIdx.x >> 6), nw = gridDim.x * 4;
  float4 v[4], vn[4];
  if (wid < T_TOT) {
#pragma unroll
    for (int i = 0; i < 4; ++i) v[i] = *(const float4*)(p.out + (unsigned)wid * D + i * 256 + lane * 4);
  }
  for (int g = wid; g < T_TOT; g += nw) {
    float* xr = p.out + (unsigned)g * D;
    if (g + nw < T_TOT) {
#pragma unroll
      for (int i = 0; i < 4; ++i) vn[i] = *(const float4*)(p.out + (unsigned)(g + nw) * D + i * 256 + lane * 4);
    }
    float ss = 0.f;
#pragma unroll
    for (int i = 0; i < 4; ++i) ss += v[i].x * v[i].x + v[i].y * v[i].y + v[i].z * v[i].z + v[i].w * v[i].w;
#pragma unroll
    for (int o = 32; o >= 1; o >>= 1) ss += __shfl_xor(ss, o, 64);
    float rstd = rsqrtf(ss * (1.f / 1024.f) + 1e-6f);
#pragma unroll
    for (int i = 0; i < 4; ++i) {
      int c = i * 256 + lane * 4;
      float4 g4 = *(const float4*)(p.final_g + c);
      float4 o;
      o.x = v[i].x * rstd * g4.x; o.y = v[i].y * rstd * g4.y; o.z = v[i].z * rstd * g4.z; o.w = v[i].w * rstd * g4.w;
      *(float4*)(xr + c) = o;
    }
#pragma unroll
    for (int i = 0; i < 4; ++i) v[i] = vn[i];
  }
}

DEVFN void phase_gemm1(const Params& p, int l, u16* smem) {
  const u16* H = U(p, 0);
  const u16* W = WL(p, l) + W_CAT;
  for (int it = 0;; ++it) {
    int mt, nt;
    if (!tile_xcd(it, 5, 40, mt, nt)) break;
    const int tid = otid(), lane = tid & 63, w = tid >> 6, wm = w >> 1, wn = w & 1, lr = lane & 15, quad = lane >> 4;
    LdPlain la; la.init(tid, H, mt * 256, D);
    LdPlain lb; lb.init(tid, W, nt * 128, D);
    f32x4 acc[8][4]; zero_acc8(acc);
    gemm_core_b(tid, acc, 32, la, lb, smem);
    int unit = nt >> 3, col0 = (nt & 7) * 128;
    u16* outp = U(p, 1 + unit);
    bool act = (unit == 1) || (unit == 4);
    {
      u16* so = smem;
#pragma unroll
      for (int i = 0; i < 8; ++i) {
        const int m = wm * 128 + i * 16 + lr;
#pragma unroll
        for (int j = 0; j < 4; ++j) {
          const int n = wn * 64 + j * 16 + quad * 4;
          float v0 = acc[i][j][0], v1 = acc[i][j][1], v2 = acc[i][j][2], v3 = acc[i][j][3];
          if (act) { v0 = silu(v0); v1 = silu(v1); v2 = silu(v2); v3 = silu(v3); }
          uint2 o; o.x = pack2(v0, v1); o.y = pack2(v2, v3);
          *(uint2*)(so + m * 136 + n) = o;
        }
      }
      __syncthreads();
#pragma unroll
      for (int c = 0; c < 16; ++c) {
        const int idx = tid + c * 256;
        const int row = idx >> 4, ch = idx & 15;
        uint4 v = *(const uint4*)(so + row * 136 + ch * 8);
        *(uint4*)(outp + ((unsigned)(mt * 256 + row) * D + col0 + ch * 8)) = v;
      }
      __syncthreads();
    }
  }
}

struct TokF1 {
  const u16* zr; const u16* zi; int n1; unsigned off;
  DEVFN unsigned operator()(int k, const u16*& b) const {
    int ri = k >= n1 ? 1 : 0;
    int s1 = k - ri * n1;
    b = ri ? zi : zr;
    return off + (unsigned)(s1 * 128) * D;
  }
};
DEVFN void f1_twiddle(int tid, const Params& p, const f32x4 (&acc)[4][4], int hf, int s2, int smask, int twmul,
                      uint2 (&o1)[2][4], uint2 (&o2)[2][4]) {
  const int lane = tid & 63, w = tid >> 6, wm = w >> 1, lr = lane & 15;
  const float2* tw = TW(p);
#pragma unroll
  for (int b = 0; b < 2; ++b) {
    int k1 = (hf * 4 + wm * 2 + b) * 16 + lr;
    float2 t = tw[((k1 * s2) & smask) * twmul];
#pragma unroll
    for (int j = 0; j < 4; ++j) {
      f32x4 orr = acc[2 * b][j], oii = acc[2 * b + 1][j];
      o1[b][j].x = pack2(orr[0] * t.x + oii[0] * t.y, orr[1] * t.x + oii[1] * t.y);
      o1[b][j].y = pack2(orr[2] * t.x + oii[2] * t.y, orr[3] * t.x + oii[3] * t.y);
      o2[b][j].x = pack2(oii[0] * t.x - orr[0] * t.y, oii[1] * t.x - orr[1] * t.y);
      o2[b][j].y = pack2(oii[2] * t.x - orr[2] * t.y, oii[3] * t.x - orr[3] * t.y);
    }
  }
}
DEVFN void f1_write(int tid, int hf, unsigned off, const uint2 (&o1)[2][4], const uint2 (&o2)[2][4], u16* zr, u16* zi, u16* so) {
  const int lane = tid & 63, w = tid >> 6, wm = w >> 1, wn = w & 1, lr = lane & 15, quad = lane >> 4;
#pragma unroll
  for (int b = 0; b < 2; ++b) {
    const int rl = (wm * 2 + b) * 16 + lr;
#pragma unroll
    for (int j = 0; j < 4; ++j) {
      const int n = wn * 64 + j * 16 + quad * 4;
      *(uint2*)(so + rl * 136 + n) = o1[b][j];
      *(uint2*)(so + (64 + rl) * 136 + n) = o2[b][j];
    }
  }
  __syncthreads();
#pragma unroll
  for (int c = 0; c < 8; ++c) {
    const int idx = tid + c * 256;
    const int pl = idx >> 10, row = (idx >> 4) & 63, ch = idx & 15;
    const unsigned k1 = hf * 64 + row;
    uint4 v = *(const uint4*)(so + (pl * 64 + row) * 136 + ch * 8);
    *(uint4*)((pl ? zi : zr) + (off + (k1 * 128) * D + ch * 8)) = v;
  }
  __syncthreads();
}
DEVFN void phase_fft1(const Params& p, u16* smem) {
  u16* zr = U(p, 3);
  u16* zi = U(p, 4);
  for (int tile = blockIdx.x; tile < 9216; tile += gridDim.x) {
    const int tid = otid();
    int seq, s2, ct, n1;
    if (tile < 1024) { seq = 0; s2 = tile >> 3; ct = tile & 7; n1 = 128; }
    else { int t2 = tile - 1024; seq = 1 + (t2 >> 10); s2 = (t2 >> 3) & 127; ct = t2 & 7; n1 = 64; }
    const unsigned off = (unsigned)(seq_start(seq) + s2) * D + ct * 128;
    LdTrans<TokF1> lb; lb.t_ = tid; lb.tok.zr = zr; lb.tok.zi = zi; lb.tok.n1 = n1; lb.tok.off = off;
    const int K = 2 * n1, nk = K >> 6;
    const u16* tab = TAB(p) + (seq == 0 ? T_D1A : T_D1B);
    const int smask = seq == 0 ? 16383 : 8191, twmul = seq == 0 ? 1 : 2;
    uint2 a1[2][4], a2[2][4];
    {
      f32x4 acc[4][4]; zero_acc(acc);
      LdPlain la; la.init(tid, tab, 0, K); gemm_core(tid, acc, nk, la, lb, smem);
      f1_twiddle(tid, p, acc, 0, s2, smask, twmul, a1, a2);
    }
    if (seq == 0) {
      uint2 b1[2][4], b2[2][4];
      {
        f32x4 acc[4][4]; zero_acc(acc);
        LdPlain la; la.init(tid, tab, 128, K); gemm_core(tid, acc, nk, la, lb, smem);
        f1_twiddle(tid, p, acc, 1, s2, smask, twmul, b1, b2);
      }
      f1_write(tid, 1, off, b1, b2, zr, zi, smem);
    }
    f1_write(tid, 0, off, a1, a2, zr, zi, smem);
  }
}

struct TokF2 {
  const u16* zr; const u16* zi; unsigned off;
  DEVFN unsigned operator()(int k, const u16*& b) const {
    int ri = k >> 7, s2 = k & 127;
    b = ri ? zi : zr;
    return off + (unsigned)s2 * D;
  }
};
DEVFN void phase_fft2(const Params& p, u16* smem) {
  u16* zr = U(p, 3);
  const u16* gbp = U(p, 5);
  for (int tile = blockIdx.x; tile < 5120; tile += gridDim.x) {
    const int tid = otid(), lane = tid & 63, w = tid >> 6, wm = w >> 1, wn = w & 1, lr = lane & 15, quad = lane >> 4;
    int seq, k1, ct, n1;
    if (tile < 1024) { seq = 0; k1 = tile >> 3; ct = tile & 7; n1 = 128; }
    else { int t2 = tile - 1024; seq = 1 + (t2 >> 9); k1 = (t2 >> 3) & 63; ct = t2 & 7; n1 = 64; }
    const int sst = seq_start(seq);
    const unsigned off = (unsigned)(sst + k1 * 128) * D + ct * 128;
    LdTrans<TokF2> lb; lb.t_ = tid; lb.tok.zr = zr; lb.tok.zi = U(p, 4); lb.tok.off = off;
    LdPlain la; la.init(tid, TAB(p) + T_D2, 0, 256);
    f32x4 acc[4][4]; zero_acc(acc);
    gemm_core(tid, acc, 4, la, lb, smem);
    const float nrm = seq == 0 ? (1.f / 2048.f) : 6.9053396600248786e-4f;
    u16* so = smem;
#pragma unroll
    for (int c = 0; c < 8; ++c) {
      const int idx = tid + c * 256;
      const int row = idx >> 4, ch = idx & 15;
      *(uint4*)(so + row * 136 + ch * 8) = *(const uint4*)(gbp + ((unsigned)(sst + k1 + n1 * row) * D + ct * 128 + ch * 8));
    }
    __syncthreads();
#pragma unroll
    for (int i = 0; i < 4; ++i) {
      const int k2 = wm * 64 + i * 16 + lr;
#pragma unroll
      for (int j = 0; j < 4; ++j) {
        const int cl = wn * 64 + j * 16 + quad * 4;
        uint2 gv = *(const uint2*)(so + k2 * 136 + cl);
        uint2 o;
        o.x = pack2(acc[i][j][0] * nrm * lo2f(gv.x), acc[i][j][1] * nrm * hi2f(gv.x));
        o.y = pack2(acc[i][j][2] * nrm * lo2f(gv.y), acc[i][j][3] * nrm * hi2f(gv.y));
        *(uint2*)(so + k2 * 136 + cl) = o;
      }
    }
    __syncthreads();
#pragma unroll
    for (int c = 0; c < 8; ++c) {
      const int idx = tid + c * 256;
      const int row = idx >> 4, ch = idx & 15;
      *(uint4*)(zr + (off + (unsigned)row * D + ch * 8)) = *(const uint4*)(so + row * 136 + ch * 8);
    }
    __syncthreads();
  }
}

constexpr int SA_LD = 128;
template <int PASS>
DEVFN void phase_scan(const Params& p, int l, int dirsel, unsigned char* smem_raw) {
  float* sAf = (float*)smem_raw;
  u16* sBh = (u16*)(smem_raw + 32768);
  u16* sXc = (u16*)(smem_raw + 32768 + 16384);
  const int tid = otid(), lane = tid & 63, w = tid >> 6, lr = lane & 15, quad = lane >> 4;
  const int head = blockIdx.x & 7;
  const int dir = PASS == 1 ? ((blockIdx.x >> 3) & 1) : dirsel;
  const int tstart = PASS == 1 ? (blockIdx.x >> 4) : (blockIdx.x >> 3);
  const int tstep = PASS == 1 ? (gridDim.x >> 4) : (gridDim.x >> 3);
  const u16* xa = U(p, 1);
  u16* ga = U(p, 2);
  u16* hf = U(p, 5);
  float2* agg = (float2*)U(p, 4);
  float* carry = (float*)(agg + 1280L * 2 * 1024);
  bf16x8 bw[4][4];
  {
    const u16* wrg = WL(p, l) + W_RG;
#pragma unroll
    for (int jt = 0; jt < 4; ++jt) {
      int q = jt >> 1, col = w * 32 + (jt & 1) * 16 + lr;
      const u16* bp = wrg + (unsigned)((((dir * 2 + q) * 8 + head) * 128 + col) * 128 + quad * 8);
#pragma unroll
      for (int ks = 0; ks < 4; ++ks) bw[jt][ks] = *(const bf16x8*)(bp + ks * 32);
    }
  }
  float spl[2], brr[2], bii[2];
#pragma unroll
  for (int jc = 0; jc < 2; ++jc) {
    int cgl = head * 128 + w * 32 + jc * 16 + lr;
    float lm = p.lam[(l * 2 + dir) * D + cgl];
    spl[jc] = -8.f * 1.4426950408889634f * log1pf(expf(-lm));
    brr[jc] = -1.4426950408889634f * p.b_rg[((l * 2 + dir) * 2 + 0) * D + cgl];
    bii[jc] = -1.4426950408889634f * p.b_rg[((l * 2 + dir) * 2 + 1) * D + cgl];
  }
  const int c8 = tid & 15, tg = tid >> 4;
  float* sCw = (float*)(smem_raw + 65536);
  for (int i = tid; i < 640; i += 256) {
    int k = i >> 7, c = i & 127;
    sCw[i] = k < 4 ? p.conv_w[(l * 4 + k) * D + head * 128 + c] : p.conv_b[l * D + head * 128 + c];
  }
  __syncthreads();
  uint4 xr[7];
#define LOAD_XROWS(TT) do { const int _g0 = (TT) * 64; const int _sq = seq_of(_g0), _ss = seq_start(_sq), _se = _ss + seq_len(_sq); \
    _Pragma("unroll") for (int r = 0; r < 7; ++r) { int _g = _g0 + tg * 4 - 2 + r; xr[r] = make_uint4(0, 0, 0, 0); \
      if (_g >= _ss && _g < _se) xr[r] = *(const uint4*)(xa + ((unsigned)_g * D + head * 128 + c8 * 8)); } } while (0)
  if (tstart < 1280) LOAD_XROWS(tstart);
  for (int tt = tstart; tt < 1280; tt += tstep) {
    const int g0 = tt * 64;
    const int seq = seq_of(g0), sst = seq_start(seq), send = sst + seq_len(seq);
#pragma unroll
    for (int j = 0; j < 4; ++j) {
      float o[8];
      {
        float4 b0 = *(const float4*)(sCw + 512 + c8 * 8), b1 = *(const float4*)(sCw + 512 + c8 * 8 + 4);
        o[0] = b0.x; o[1] = b0.y; o[2] = b0.z; o[3] = b0.w; o[4] = b1.x; o[5] = b1.y; o[6] = b1.z; o[7] = b1.w;
      }
#pragma unroll
      for (int k = 0; k < 4; ++k) {
        uint4 v = xr[j + k];
        float4 w0 = *(const float4*)(sCw + k * 128 + c8 * 8), w1 = *(const float4*)(sCw + k * 128 + c8 * 8 + 4);
        o[0] += w0.x * lo2f(v.x); o[1] += w0.y * hi2f(v.x);
        o[2] += w0.z * lo2f(v.y); o[3] += w0.w * hi2f(v.y);
        o[4] += w1.x * lo2f(v.z); o[5] += w1.y * hi2f(v.z);
        o[6] += w1.z * lo2f(v.w); o[7] += w1.w * hi2f(v.w);
      }
      uint4 q0;
      q0.x = pack2(o[0], o[1]); q0.y = pack2(o[2], o[3]); q0.z = pack2(o[4], o[5]); q0.w = pack2(o[6], o[7]);
      const int tl = tg * 4 + j;
      *(uint4*)(sXc + tl * 128 + ((c8 ^ (tl & 7)) << 3)) = q0;
    }
    __syncthreads();
    if (tt + tstep < 1280) LOAD_XROWS(tt + tstep);
    const int gstart = dir == 0 ? sst : send - 1;
#pragma unroll 1
    for (int hv = 0; hv < 2; ++hv) {
      f32x4 acc[2][4];
#pragma unroll
      for (int it = 0; it < 2; ++it)
#pragma unroll
        for (int jt = 0; jt < 4; ++jt) acc[it][jt] = f32x4{0.f, 0.f, 0.f, 0.f};
#pragma unroll
      for (int ks = 0; ks < 4; ++ks) {
#pragma unroll
        for (int it = 0; it < 2; ++it) {
          bf16x8 af = *(const bf16x8*)(sXc + ((hv * 2 + it) * 16 + lr) * 128 + (((ks * 4 + quad) ^ (lr & 7)) << 3));
#pragma unroll
          for (int jt = 0; jt < 4; ++jt)
            acc[it][jt] = __builtin_amdgcn_mfma_f32_16x16x32_bf16(af, bw[jt][ks], acc[it][jt], 0, 0, 0);
        }
      }
#pragma unroll
      for (int it = 0; it < 2; ++it)
#pragma unroll
        for (int jc = 0; jc < 2; ++jc) {
#pragma unroll
          for (int r = 0; r < 4; ++r) {
            int tl = (hv * 2 + it) * 16 + quad * 4 + r, c = w * 32 + jc * 16 + lr;
            float er = 1.f + __builtin_amdgcn_exp2f(fminf(fmaf(acc[it][jc][r], -1.4426950408889634f, brr[jc]), 60.f));
            float ei = 1.f + __builtin_amdgcn_exp2f(fminf(fmaf(acc[it][2 + jc][r], -1.4426950408889634f, bii[jc]), 60.f));
            float q = __builtin_amdgcn_rcpf(er * ei);
            float rr = q * ei, ii = q * er;
            float a = __builtin_amdgcn_exp2f(rr * spl[jc]);
            float mult = __builtin_amdgcn_sqrtf((1.f - a) * (1.f + a));
            if (g0 + tl == gstart) mult = 1.f;
            float xv = bf2f(sXc[tl * 128 + (((c >> 3) ^ (tl & 7)) << 3) + (c & 7)]);
            sAf[tl * SA_LD + c] = a;
            sBh[tl * 128 + c] = f2bf(mult * ii * xv);
          }
        }
    }
    __syncthreads();
    if (tid < 128) {
      const int c = tid;
      const unsigned aidx = (unsigned)(tt * 2 + dir) * 1024 + head * 128 + c;
      const float* ap = sAf + c;
      u16* bp = sBh + c;
      if (PASS == 1) {
        float h = 0.f, P = 1.f;
        if (dir == 0) {
#pragma unroll 16
          for (int st = 0; st < 64; ++st) { float a = ap[st * SA_LD]; h = a * h + bf2f(bp[st * 128]); P *= a; }
        } else {
#pragma unroll 16
          for (int st = 63; st >= 0; --st) { float a = ap[st * SA_LD]; h = a * h + bf2f(bp[st * 128]); P *= a; }
        }
        agg[aidx] = make_float2(P, h);
      } else {
        float h = carry[aidx];
        if (dir == 0) {
#pragma unroll 16
          for (int st = 0; st < 64; ++st) { h = ap[st * SA_LD] * h + bf2f(bp[st * 128]); bp[st * 128] = f2bf(h); }
        } else {
#pragma unroll 16
          for (int st = 63; st >= 0; --st) { h = ap[st * SA_LD] * h + bf2f(bp[st * 128]); bp[st * 128] = f2bf(h); }
        }
      }
    }
    if (PASS == 3) {
      __syncthreads();
#pragma unroll
      for (int cch = 0; cch < 4; ++cch) {
        int chunk = tid + cch * 256;
        int t = chunk >> 4, cc = (chunk & 15) * 8;
        unsigned off = (unsigned)(g0 + t) * D + head * 128 + cc;
        uint4 hv = *(const uint4*)(sBh + t * 128 + cc);
        if (dir == 0) {
          *(uint4*)(hf + off) = hv;
        } else {
          uint4 fv = *(const uint4*)(hf + off);
          uint4 gv = *(const uint4*)(ga + off);
          uint4 o;
          o.x = pack2((lo2f(fv.x) + lo2f(hv.x)) * lo2f(gv.x), (hi2f(fv.x) + hi2f(hv.x)) * hi2f(gv.x));
          o.y = pack2((lo2f(fv.y) + lo2f(hv.y)) * lo2f(gv.y), (hi2f(fv.y) + hi2f(hv.y)) * hi2f(gv.y));
          o.z = pack2((lo2f(fv.z) + lo2f(hv.z)) * lo2f(gv.z), (hi2f(fv.z) + hi2f(hv.z)) * hi2f(gv.z));
          o.w = pack2((lo2f(fv.w) + lo2f(hv.w)) * lo2f(gv.w), (hi2f(fv.w) + hi2f(hv.w)) * hi2f(gv.w));
          *(uint4*)(ga + off) = o;
        }
      }
    }
    __syncthreads();
  }
#undef LOAD_XROWS
}

DEVFN void lb_st64(unsigned long long* q, unsigned long long v) { __hip_atomic_store(q, v, __ATOMIC_RELAXED, __HIP_MEMORY_SCOPE_AGENT); }
DEVFN unsigned long long lb_ld64(const unsigned long long* q) { return __hip_atomic_load(q, __ATOMIC_RELAXED, __HIP_MEMORY_SCOPE_AGENT); }
DEVFN void lb_st32(unsigned* q, unsigned v) { __hip_atomic_store(q, v, __ATOMIC_RELAXED, __HIP_MEMORY_SCOPE_AGENT); }
DEVFN unsigned lb_ld32(const unsigned* q) { return __hip_atomic_load(q, __ATOMIC_RELAXED, __HIP_MEMORY_SCOPE_AGENT); }
DEVFN unsigned long long lb_pack(float a, float b) { return (unsigned long long)__float_as_uint(a) | ((unsigned long long)__float_as_uint(b) << 32); }
DEVFN unsigned long long lb_gran(float P, float H, unsigned tag) {
  return ((unsigned long long)__float_as_uint(H) << 32) | (unsigned long long)((__float_as_uint(P) & 0xffffff00u) | tag);
}
DEVFN int lb_rank(int seq, int pos) { return seq == 0 ? (pos >> 1) * 10 + ((pos & 1) ? 9 : 0) : pos * 10 + seq; }
DEVFN void lb_decode(int r, int dir, int& seq, int& pos, int& tt) {
  int pair = r / 10, j = r - pair * 10;
  if (j == 0) { seq = 0; pos = 2 * pair; } else if (j == 9) { seq = 0; pos = 2 * pair + 1; } else { seq = j; pos = pair; }
  int len = seq == 0 ? 256 : 128;
  tt = (seq_start(seq) >> 6) + (dir ? len - 1 - pos : pos);
}
DEVFN void phase_scan_lb(const Params& p, int l, unsigned char* smem_raw) {
  float* sAf = (float*)smem_raw;
  u16* sBh = (u16*)(smem_raw + 32768);
  u16* sXc = (u16*)(smem_raw + 32768 + 16384);
  unsigned* sflag = (unsigned*)(smem_raw + 65536 + 2560);
  const int tid = otid(), lane = tid & 63, w = tid >> 6, lr = lane & 15, quad = lane >> 4;
  const int hd = blockIdx.x & 15, head = hd >> 1, dir = hd & 1;
  const int rstart = blockIdx.x >> 4, rstep = gridDim.x >> 4;
  const u16* xa = U(p, 1);
  u16* ga = U(p, 2);
  u16* hown = dir == 0 ? U(p, 5) : U(p, 4);
  const u16* hoth = dir == 0 ? U(p, 4) : U(p, 5);
  unsigned long long* slot = (unsigned long long*)(p.ws + OFF_LB_BYTES);
  unsigned* stat = (unsigned*)(p.ws + OFF_LB_BYTES + LB_SLOT_BYTES);
  unsigned* cnt = stat + 20480;
  const unsigned ep = 2u * (unsigned)l;
  const unsigned tagb = ((unsigned)l + 1u) * 4u;
  bf16x8 bw[4][4];
  {
    const u16* wrg = WL(p, l) + W_RG;
#pragma unroll
    for (int jt = 0; jt < 4; ++jt) {
      int q = jt >> 1, col = w * 32 + (jt & 1) * 16 + lr;
      const u16* bp = wrg + (unsigned)((((dir * 2 + q) * 8 + head) * 128 + col) * 128 + quad * 8);
#pragma unroll
      for (int ks = 0; ks < 4; ++ks) bw[jt][ks] = *(const bf16x8*)(bp + ks * 32);
    }
  }
  float spl[2], brr[2], bii[2];
#pragma unroll
  for (int jc = 0; jc < 2; ++jc) {
    int cgl = head * 128 + w * 32 + jc * 16 + lr;
    float lm = p.lam[(l * 2 + dir) * D + cgl];
    spl[jc] = -8.f * 1.4426950408889634f * log1pf(expf(-lm));
    brr[jc] = -1.4426950408889634f * p.b_rg[((l * 2 + dir) * 2 + 0) * D + cgl];
    bii[jc] = -1.4426950408889634f * p.b_rg[((l * 2 + dir) * 2 + 1) * D + cgl];
  }
  const int c8 = tid & 15, tg = tid >> 4;
  float* sCw = (float*)(smem_raw + 65536);
  for (int i = tid; i < 640; i += 256) {
    int k = i >> 7, c = i & 127;
    sCw[i] = k < 4 ? p.conv_w[(l * 4 + k) * D + head * 128 + c] : p.conv_b[l * D + head * 128 + c];
  }
  __syncthreads();
  uint4 xr[7];
#define LOAD_XROWS(TT) do { const int _g0 = (TT) * 64; const int _sq = seq_of(_g0), _ss = seq_start(_sq), _se = _ss + seq_len(_sq); \
    _Pragma("unroll") for (int r_ = 0; r_ < 7; ++r_) { int _g = _g0 + tg * 4 - 2 + r_; xr[r_] = make_uint4(0, 0, 0, 0); \
      if (_g >= _ss && _g < _se) xr[r_] = *(const uint4*)(xa + ((unsigned)_g * D + head * 128 + c8 * 8)); } } while (0)
  if (rstart < 1280) { int sq_, ps_, t0_; lb_decode(rstart, dir, sq_, ps_, t0_); LOAD_XROWS(t0_); }
  for (int r = rstart; r < 1280; r += rstep) {
    int seq, pos, tt;
    lb_decode(r, dir, seq, pos, tt);
    const int item = r * 16 + hd;
    const int g0 = tt * 64;
    const int sst = seq_start(seq), send = sst + seq_len(seq);
#pragma unroll
    for (int j = 0; j < 4; ++j) {
      float o[8];
      {
        float4 b0 = *(const float4*)(sCw + 512 + c8 * 8), b1 = *(const float4*)(sCw + 512 + c8 * 8 + 4);
        o[0] = b0.x; o[1] = b0.y; o[2] = b0.z; o[3] = b0.w; o[4] = b1.x; o[5] = b1.y; o[6] = b1.z; o[7] = b1.w;
      }
#pragma unroll
      for (int k = 0; k < 4; ++k) {
        uint4 v = xr[j + k];
        float4 w0 = *(const float4*)(sCw + k * 128 + c8 * 8), w1 = *(const float4*)(sCw + k * 128 + c8 * 8 + 4);
        o[0] += w0.x * lo2f(v.x); o[1] += w0.y * hi2f(v.x);
        o[2] += w0.z * lo2f(v.y); o[3] += w0.w * hi2f(v.y);
        o[4] += w1.x * lo2f(v.z); o[5] += w1.y * hi2f(v.z);
        o[6] += w1.z * lo2f(v.w); o[7] += w1.w * hi2f(v.w);
      }
      uint4 q0;
      q0.x = pack2(o[0], o[1]); q0.y = pack2(o[2], o[3]); q0.z = pack2(o[4], o[5]); q0.w = pack2(o[6], o[7]);
      const int tl = tg * 4 + j;
      *(uint4*)(sXc + tl * 128 + ((c8 ^ (tl & 7)) << 3)) = q0;
    }
    __syncthreads();
    if (r + rstep < 1280) { int sq_, ps_, t1_; lb_decode(r + rstep, dir, sq_, ps_, t1_); LOAD_XROWS(t1_); }
    const int gstart = dir == 0 ? sst : send - 1;
#pragma unroll 1
    for (int hv = 0; hv < 2; ++hv) {
      f32x4 acc[2][4];
#pragma unroll
      for (int it = 0; it < 2; ++it)
#pragma unroll
        for (int jt = 0; jt < 4; ++jt) acc[it][jt] = f32x4{0.f, 0.f, 0.f, 0.f};
#pragma unroll
      for (int ks = 0; ks < 4; ++ks) {
#pragma unroll
        for (int it = 0; it < 2; ++it) {
          bf16x8 af = *(const bf16x8*)(sXc + ((hv * 2 + it) * 16 + lr) * 128 + (((ks * 4 + quad) ^ (lr & 7)) << 3));
#pragma unroll
          for (int jt = 0; jt < 4; ++jt)
            acc[it][jt] = __builtin_amdgcn_mfma_f32_16x16x32_bf16(af, bw[jt][ks], acc[it][jt], 0, 0, 0);
        }
      }
#pragma unroll
      for (int it = 0; it < 2; ++it)
#pragma unroll
        for (int jc = 0; jc < 2; ++jc) {
#pragma unroll
          for (int r = 0; r < 4; ++r) {
            int tl = (hv * 2 + it) * 16 + quad * 4 + r, c = w * 32 + jc * 16 + lr;
            float er = 1.f + __builtin_amdgcn_exp2f(fminf(fmaf(acc[it][jc][r], -1.4426950408889634f, brr[jc]), 60.f));
            float ei = 1.f + __builtin_amdgcn_exp2f(fminf(fmaf(acc[it][2 + jc][r], -1.4426950408889634f, bii[jc]), 60.f));
            float q = __builtin_amdgcn_rcpf(er * ei);
            float rr = q * ei, ii = q * er;
            float a = __builtin_amdgcn_exp2f(rr * spl[jc]);
            float mult = __builtin_amdgcn_sqrtf((1.f - a) * (1.f + a));
            if (g0 + tl == gstart) mult = 1.f;
            float xv = bf2f(sXc[tl * 128 + (((c >> 3) ^ (tl & 7)) << 3) + (c & 7)]);
            sAf[tl * SA_LD + c] = a;
            sBh[tl * 128 + c] = f2bf(mult * ii * xv);
          }
        }
    }
    __syncthreads();
    const int sc_c = tid & 127, sc_part = tid >> 7;
    float2* sEx = (float2*)(smem_raw + 65536 + 2560 + 16);
    float* sCar = (float*)(sEx + 256);
    float partP = 1.f, partH = 0.f;
    {
      const float* ap = sAf + sc_c;
      const u16* bp = sBh + sc_c;
      if (dir == 0) {
        const int t0 = sc_part * 32;
#pragma unroll 16
        for (int st = 0; st < 32; ++st) { float a = ap[(t0 + st) * SA_LD]; partH = a * partH + bf2f(bp[(t0 + st) * 128]); partP *= a; }
      } else {
        const int t0 = 63 - sc_part * 32;
#pragma unroll 16
        for (int st = 0; st < 32; ++st) { float a = ap[(t0 - st) * SA_LD]; partH = a * partH + bf2f(bp[(t0 - st) * 128]); partP *= a; }
      }
      sEx[sc_part * 128 + sc_c] = make_float2(partP, partH);
    }
    __syncthreads();
    float carry = 0.f;
    if (tid < 128) {
      const float2 e1 = sEx[128 + tid];
      const float aggP = partP * e1.x, aggH = e1.x * partH + e1.y;
      lb_st64(slot + (unsigned)item * 128 + tid, lb_gran(pos == 0 ? 0.f : aggP, aggH, tagb + (pos == 0 ? 2u : 1u)));
      if (pos > 0) {
        float Pr = 1.f, Hr = 0.f;
        int pj = pos - 1;
        for (;;) {
          const int j = lb_rank(seq, pj) * 16 + hd;
          unsigned long long v;
          unsigned spins = 0;
          for (;;) {
            v = lb_ld64(slot + (unsigned)j * 128 + tid);
            unsigned tg_ = (unsigned)v & 0xffu;
            if ((tg_ >> 2) == (tagb >> 2) && (tg_ & 3u) != 0u) break;
            __builtin_amdgcn_s_sleep(1);
            if (++spins > (1u << 18)) break;
          }
          float Pj = __uint_as_float((unsigned)v & 0xffffff00u), Hj = __uint_as_float((unsigned)(v >> 32));
          Hr += Pr * Hj;
          Pr *= Pj;
          if (((unsigned)v & 3u) == 2u || pj == 0) break;
          --pj;
        }
        carry = Hr;
        lb_st64(slot + (unsigned)item * 128 + tid, lb_gran(0.f, aggP * carry + aggH, tagb + 2u));
      }
      sCar[tid] = partP * carry + partH;
    }
    __syncthreads();
    {
      const float* ap = sAf + sc_c;
      u16* bp = sBh + sc_c;
      float h = sc_part == 0 ? carry : sCar[sc_c];
      if (dir == 0) {
        const int t0 = sc_part * 32;
#pragma unroll 16
        for (int st = 0; st < 32; ++st) { h = ap[(t0 + st) * SA_LD] * h + bf2f(bp[(t0 + st) * 128]); bp[(t0 + st) * 128] = f2bf(h); }
      } else {
        const int t0 = 63 - sc_part * 32;
#pragma unroll 16
        for (int st = 0; st < 32; ++st) { h = ap[(t0 - st) * SA_LD] * h + bf2f(bp[(t0 - st) * 128]); bp[(t0 - st) * 128] = f2bf(h); }
      }
    }
    __syncthreads();
    const int len_ = seq == 0 ? 256 : 128;
    const int ppos = len_ - 1 - pos;
    if (pos < ppos) {
#pragma unroll
      for (int cch = 0; cch < 4; ++cch) {
        int chunk = tid + cch * 256;
        int t = chunk >> 4, cc = (chunk & 15) * 8;
        unsigned off = (unsigned)(g0 + t) * D + head * 128 + cc;
        uint4 hv = *(const uint4*)(sBh + t * 128 + cc);
        unsigned long long* q = (unsigned long long*)(hown + off);
        lb_st64(q, (unsigned long long)hv.x | ((unsigned long long)hv.y << 32));
        lb_st64(q + 1, (unsigned long long)hv.z | ((unsigned long long)hv.w << 32));
      }
      asm volatile("s_waitcnt vmcnt(0)" ::: "memory");
      __syncthreads();
      if (tid == 0) lb_st32(stat + item, (unsigned)l + 1u);
    } else {
      const int pit = lb_rank(seq, ppos) * 16 + (hd ^ 1);
      unsigned spins = 0;
      while (lb_ld32(stat + pit) != (unsigned)l + 1u) { __builtin_amdgcn_s_sleep(1); if (++spins > (1u << 18)) break; }
#pragma unroll
      for (int cch = 0; cch < 4; ++cch) {
        int chunk = tid + cch * 256;
        int t = chunk >> 4, cc = (chunk & 15) * 8;
        unsigned off = (unsigned)(g0 + t) * D + head * 128 + cc;
        uint4 hv = *(const uint4*)(sBh + t * 128 + cc);
        const unsigned long long* q = (const unsigned long long*)(hoth + off);
        unsigned long long f0 = lb_ld64(q), f1 = lb_ld64(q + 1);
        uint4 fv = make_uint4((unsigned)f0, (unsigned)(f0 >> 32), (unsigned)f1, (unsigned)(f1 >> 32));
        uint4 gv = *(const uint4*)(ga + off);
        uint4 o;
        o.x = pack2((lo2f(fv.x) + lo2f(hv.x)) * lo2f(gv.x), (hi2f(fv.x) + hi2f(hv.x)) * hi2f(gv.x));
        o.y = pack2((lo2f(fv.y) + lo2f(hv.y)) * lo2f(gv.y), (hi2f(fv.y) + hi2f(hv.y)) * hi2f(gv.y));
        o.z = pack2((lo2f(fv.z) + lo2f(hv.z)) * lo2f(gv.z), (hi2f(fv.z) + hi2f(hv.z)) * hi2f(gv.z));
        o.w = pack2((lo2f(fv.w) + lo2f(hv.w)) * lo2f(gv.w), (hi2f(fv.w) + hi2f(hv.w)) * hi2f(gv.w));
        *(uint4*)(ga + off) = o;
      }
    }
    __syncthreads();
  }
#undef LOAD_XROWS
}

DEVFN void phase_carry(const Params& p) {
  const float2* __restrict__ agg = (const float2*)U(p, 4);
  float* __restrict__ carry = (float*)(agg + 1280L * 2 * 1024);
  const int lane = threadIdx.x & 63, w = threadIdx.x >> 6;
  for (int u = blockIdx.x + gridDim.x * w; u < 288; u += gridDim.x * 4) {
    int id = u * 64 + lane;
    int seq = id >> 11, dir = (id >> 10) & 1, c = id & 1023;
    int nt = seq_len(seq) >> 6, tile0 = seq_start(seq) >> 6;
    float h = 0.f;
#pragma unroll 8
    for (int k = 0; k < nt; ++k) {
      int tt = tile0 + (dir ? nt - 1 - k : k);
      unsigned ix = (unsigned)(tt * 2 + dir) * 1024 + c;
      float2 v = agg[ix];
      carry[ix] = h;
      h = v.x * h + v.y;
    }
  }
}

DEVFN void phase_merge(const Params& p, int l, u16* smem) {
  const u16* wl = WL(p, l);
  u16* mo = U(p, 1);
  u16* tb = U(p, 5);
  u16* so = smem;
  for (int it = 0;; ++it) {
    int mt, nt;
    if (!tile_xcd(it, 1, 8, mt, nt)) break;
    const int g0 = mt * 256;
#pragma unroll 1
    for (int br = 0; br < 2; ++br) {
      {
        const int tid = otid(), lane = tid & 63, w = tid >> 6, wm = w >> 1, wn = w & 1, lr = lane & 15, quad = lane >> 4;
        f32x4 acc[8][4]; zero_acc8(acc);
        LdPlain lb; lb.init(tid, wl + (br == 0 ? W_A : W_B), nt * 128, D);
        if (br == 0) {
          LdPlain la; la.init(tid, U(p, 2), g0, D);
          gemm_core_b(tid, acc, 32, la, lb, smem);
        } else {
          const int seq = seq_of(g0);
          LdPerm la; la.base = U(p, 3); la.g0 = g0; la.sst = seq_start(seq); la.lg = seq == 0 ? 7 : 6;
          gemm_core_b(tid, acc, 32, la, lb, smem);
        }
#pragma unroll
        for (int i = 0; i < 8; ++i) {
          const int m = wm * 128 + i * 16 + lr;
#pragma unroll
          for (int j = 0; j < 4; ++j) {
            const int n = wn * 64 + j * 16 + quad * 4;
            uint2 o; o.x = pack2(acc[i][j][0], acc[i][j][1]); o.y = pack2(acc[i][j][2], acc[i][j][3]);
            *(uint2*)(so + m * 136 + n) = o;
          }
        }
        __syncthreads();
#pragma unroll
        for (int c = 0; c < 16; ++c) {
          const int idx = tid + c * 256;
          const int row = idx >> 4, ch = idx & 15;
          *(uint4*)(tb + ((unsigned)(g0 + row) * D + nt * 128 + ch * 8)) = *(const uint4*)(so + row * 136 + ch * 8);
        }
        __syncthreads();
      }
      {
        const int tid = otid(), lane = tid & 63, w = tid >> 6, wm = w >> 1, wn = w & 1, lr = lane & 15, quad = lane >> 4;
        f32x4 acc[8][4]; zero_acc8(acc);
        LdPlain la; la.init(tid, U(p, 0), g0, D);
        LdPlain lb; lb.init(tid, wl + W_CAT, 5120 + br * 1024 + nt * 128, D);
        gemm_core_b(tid, acc, 32, la, lb, smem);
#pragma unroll
        for (int c = 0; c < 16; ++c) {
          const int idx = tid + c * 256;
          const int row = idx >> 4, ch = idx & 15;
          *(uint4*)(so + row * 136 + ch * 8) = *(const uint4*)(tb + ((unsigned)(g0 + row) * D + nt * 128 + ch * 8));
        }
        __syncthreads();
#pragma unroll
        for (int i = 0; i < 8; ++i) {
          const int m = wm * 128 + i * 16 + lr;
#pragma unroll
          for (int j = 0; j < 4; ++j) {
            const int n = wn * 64 + j * 16 + quad * 4;
            uint2 tv = *(const uint2*)(so + m * 136 + n);
            acc[i][j][0] = sigm(acc[i][j][0]) * lo2f(tv.x);
            acc[i][j][1] = sigm(acc[i][j][1]) * hi2f(tv.x);
            acc[i][j][2] = sigm(acc[i][j][2]) * lo2f(tv.y);
            acc[i][j][3] = sigm(acc[i][j][3]) * hi2f(tv.y);
          }
        }
        if (br == 1) {
          __syncthreads();
#pragma unroll
          for (int c = 0; c < 16; ++c) {
            const int idx = tid + c * 256;
            const int row = idx >> 4, ch = idx & 15;
            *(uint4*)(so + row * 136 + ch * 8) = *(const uint4*)(mo + ((unsigned)(g0 + row) * D + nt * 128 + ch * 8));
          }
          __syncthreads();
#pragma unroll
          for (int i = 0; i < 8; ++i) {
            const int m = wm * 128 + i * 16 + lr;
#pragma unroll
            for (int j = 0; j < 4; ++j) {
              const int n = wn * 64 + j * 16 + quad * 4;
              uint2 pv = *(const uint2*)(so + m * 136 + n);
              acc[i][j][0] += lo2f(pv.x); acc[i][j][1] += hi2f(pv.x);
              acc[i][j][2] += lo2f(pv.y); acc[i][j][3] += hi2f(pv.y);
            }
          }
        }
        __syncthreads();
#pragma unroll
        for (int i = 0; i < 8; ++i) {
          const int m = wm * 128 + i * 16 + lr;
#pragma unroll
          for (int j = 0; j < 4; ++j) {
            const int n = wn * 64 + j * 16 + quad * 4;
            uint2 o; o.x = pack2(acc[i][j][0], acc[i][j][1]); o.y = pack2(acc[i][j][2], acc[i][j][3]);
            *(uint2*)(so + m * 136 + n) = o;
          }
        }
        __syncthreads();
#pragma unroll
        for (int c = 0; c < 16; ++c) {
          const int idx = tid + c * 256;
          const int row = idx >> 4, ch = idx & 15;
          *(uint4*)(mo + ((unsigned)(g0 + row) * D + nt * 128 + ch * 8)) = *(const uint4*)(so + row * 136 + ch * 8);
        }
        __syncthreads();
      }
    }
  }
}

DEVFN void phase_out(const Params& p, int l, u16* smem) {
  const u16* wo = WL(p, l) + W_O;
  for (int it = 0;; ++it) {
    int mt, nt;
    if (!tile_xcd(it, 1, 8, mt, nt)) break;
    const int tid = otid(), lane = tid & 63, w = tid >> 6, wm = w >> 1, wn = w & 1, lr = lane & 15, quad = lane >> 4;
    const int g0 = mt * 256;
    LdPlain la; la.init(tid, U(p, 1), g0, D);
    LdPlain lb; lb.init(tid, wo, nt * 128, D);
    f32x4 acc[8][4]; zero_acc8(acc);
    gemm_core_b(tid, acc, 32, la, lb, smem);
    const float* gate = MOD(p) + ((long)l * 9 + seq_of(g0)) * 3072 + 2048;
#pragma unroll
    for (int i = 0; i < 8; ++i) {
      unsigned g = g0 + wm * 128 + i * 16 + lr;
      const float* xb = (l == 0) ? (g0 < 16384 ? p.x_prompt : p.x_sample) : p.out;
      const float* xr = xb + (unsigned)((l == 0 && g0 >= 16384) ? g - 16384 : g) * D;
      float* orow = p.out + g * D;
#pragma unroll
      for (int j = 0; j < 4; ++j) {
        unsigned c = nt * 128 + wn * 64 + j * 16 + quad * 4;
        float4 xv = *(const float4*)(xr + c);
        float4 gt = *(const float4*)(gate + c);
        float4 o;
        o.x = xv.x + gt.x * acc[i][j][0]; o.y = xv.y + gt.y * acc[i][j][1];
        o.z = xv.z + gt.z * acc[i][j][2]; o.w = xv.w + gt.w * acc[i][j][3];
        *(float4*)(orow + c) = o;
      }
    }
  }
}

#define XB_TMO      128
#define XB_XCNT(j)  (256  + 64 * (j))
#define XB_XSUB(j)  (1280 + 64 * (j))
#define XB_XGEN(j)  (2304 + 64 * (j))
#define XB_TOP      3328
#define XB_TOPGEN   3392
#define XCD_BAR_WORDS 3456
#define XB_SPIN_CAP (1u << 18)
#define LAS __attribute__((address_space(3)))

__device__ __forceinline__ unsigned xb_ld(unsigned* p)              { return __hip_atomic_load(p, __ATOMIC_RELAXED, __HIP_MEMORY_SCOPE_AGENT); }
__device__ __forceinline__ unsigned xb_add(unsigned* p, unsigned v) { return __hip_atomic_fetch_add(p, v, __ATOMIC_RELAXED, __HIP_MEMORY_SCOPE_AGENT); }
__device__ __forceinline__ unsigned xb_xcc_id() { return (unsigned)__builtin_amdgcn_s_getreg((3 << 11) | 20) & 0xFu; }
#define XB_SPIN(cond, bar) do { unsigned _sp = 0; while (cond) { __builtin_amdgcn_s_sleep(1); \
    if ((++_sp & 255u) == 0u) { if (xb_ld(&(bar)[XB_TMO])) break; if (_sp > XB_SPIN_CAP) { atomicAdd(&(bar)[XB_TMO], 1u); break; } } } } while (0)

struct XcdBarrier {
    unsigned* bar; unsigned x;
    volatile LAS unsigned* st;
};

__device__ __forceinline__ XcdBarrier xcd_barrier_post(unsigned* bar, volatile LAS unsigned* st) {
    XcdBarrier b; b.bar = bar; b.x = xb_xcc_id(); b.st = st;
    if (threadIdx.x == 0) (void)xb_add(&bar[XB_XCNT(b.x)], 1u);
    return b;
}
__device__ __forceinline__ void xcd_barrier_complete(unsigned* bar, unsigned x, unsigned& nloc, unsigned& nx) {
    const unsigned G = gridDim.x * gridDim.y * gridDim.z;
    unsigned sum, cnt, mine, sp = 0u;
    for (;;) {
        sum = 0u; cnt = 0u; mine = 0u;
#pragma unroll
        for (unsigned j = 0; j < 16; ++j) { const unsigned c = xb_ld(&bar[XB_XCNT(j)]); sum += c; cnt += (c > 0u) ? 1u : 0u; mine = (j == x) ? c : mine; }
        if (sum == G) break;
        __builtin_amdgcn_s_sleep(1);
        if ((++sp & 255u) == 0u) { if (xb_ld(&bar[XB_TMO])) break; if (sp > XB_SPIN_CAP) { atomicAdd(&bar[XB_TMO], 1u); break; } }
    }
    nloc = mine > 0u ? mine : 1u; nx = cnt > 0u ? cnt : 1u;
}

__device__ __forceinline__ void xcd_barrier(const XcdBarrier& b) {
    asm volatile("s_waitcnt vmcnt(0)" ::: "memory");
    __syncthreads();
    if (threadIdx.x == 0) {
        unsigned* bar = b.bar;
        __builtin_amdgcn_s_waitcnt(0);
        unsigned nloc = b.st[0], nx = b.st[1];
        if (nloc == 0u) { xcd_barrier_complete(bar, b.x, nloc, nx); b.st[0] = nloc; b.st[1] = nx; }
        const unsigned old = xb_add(&bar[XB_XSUB(b.x)], 1u);
        const unsigned gen = old / nloc;
        if (old + 1u == (gen + 1u) * nloc) {
            __builtin_amdgcn_fence(__ATOMIC_RELEASE, "agent");
            asm volatile("s_waitcnt vmcnt(0)" ::: "memory");
            const unsigned og = xb_add(&bar[XB_TOP], 1u);
            const unsigned tg = og / nx;
            if (og + 1u == (tg + 1u) * nx) xb_add(&bar[XB_TOPGEN], 1u);
            else XB_SPIN(xb_ld(&bar[XB_TOPGEN]) == tg, bar);
            __builtin_amdgcn_fence(__ATOMIC_ACQUIRE, "agent");
            xb_add(&bar[XB_XGEN(b.x)], 1u);
            asm volatile("s_waitcnt vmcnt(0)" ::: "memory");
        } else {
            XB_SPIN(xb_ld(&bar[XB_XGEN(b.x)]) == gen, bar);
            __builtin_amdgcn_fence(__ATOMIC_ACQUIRE, "agent");
            asm volatile("s_waitcnt vmcnt(0)" ::: "memory");
        }
    }
    __syncthreads();
}


__global__ void __launch_bounds__(256, 2) hawk_fnet_megakernel(Params p) {
  extern __shared__ __attribute__((aligned(16))) unsigned char smem_raw[];
  cg::grid_group grid = cg::this_grid();
  u16* smem = (u16*)smem_raw;

  __shared__ unsigned xb_st[4];
  unsigned* bar = (unsigned*)(p.ws + OFF_BAR_BYTES);
  if (blockIdx.x == 0) {
    for (int i = threadIdx.x; i < XCD_BAR_WORDS; i += 256) __hip_atomic_store(&bar[i], 0u, __ATOMIC_RELAXED, __HIP_MEMORY_SCOPE_AGENT);
  }
  if (threadIdx.x < 4) xb_st[threadIdx.x] = 0u;
  {
    unsigned* lbs = (unsigned*)(p.ws + OFF_LB_BYTES + LB_SLOT_BYTES);
    for (int i = blockIdx.x * 256 + threadIdx.x; i < 20480 + 10240; i += gridDim.x * 256)
      __hip_atomic_store(&lbs[i], 0u, __ATOMIC_RELAXED, __HIP_MEMORY_SCOPE_AGENT);
    unsigned long long* lbq = (unsigned long long*)(p.ws + OFF_LB_BYTES);
    for (int i = blockIdx.x * 256 + threadIdx.x; i < (int)(LB_SLOT_BYTES / 8); i += gridDim.x * 256)
      __hip_atomic_store(&lbq[i], 0ull, __ATOMIC_RELAXED, __HIP_MEMORY_SCOPE_AGENT);
  }
  phase_prologue(p, smem_raw);
  grid.sync();
  XcdBarrier xb = xcd_barrier_post(bar, (volatile LAS unsigned*)xb_st);
  phase_fold(p, smem);
  phase_h(p, 0);
  xcd_barrier(xb);
  for (int l = 0; l < 2; ++l) {
    phase_gemm1(p, l, smem);
    xcd_barrier(xb);
    phase_fft1(p, smem);
    xcd_barrier(xb);
    phase_fft2(p, smem);
    xcd_barrier(xb);
    phase_scan_lb(p, l, smem_raw);
    xcd_barrier(xb);
    phase_merge(p, l, smem);
    xcd_barrier(xb);
    phase_out(p, l, smem);
    xcd_barrier(xb);
    if (l == 0) { phase_h(p, 1); xcd_barrier(xb); }
  }
  phase_final(p);
}

extern "C" void kernel_launch(void* const* d_in, const int* in_sizes, int n_in,
                              void* d_out, int out_size, void* d_ws, size_t ws_size,
                              hipStream_t stream) {
  (void)in_sizes; (void)n_in; (void)out_size;
  if (ws_size < (size_t)WS_NEED) {
    fprintf(stderr, "workspace too small: %zu < %ld\n", ws_size, (long)WS_NEED);
    return;
  }
  static int grid_blocks = 0;
  if (!grid_blocks) {
    hipFuncSetAttribute((const void*)hawk_fnet_megakernel, hipFuncAttributeMaxDynamicSharedMemorySize, SMEM_BYTES);
    int dev = 0, cus = 0, per_cu = 0;
    hipGetDevice(&dev);
    hipDeviceGetAttribute(&cus, hipDeviceAttributeMultiprocessorCount, dev);
    hipOccupancyMaxActiveBlocksPerMultiprocessor(&per_cu, hawk_fnet_megakernel, 256, SMEM_BYTES);
    if (per_cu > 2) per_cu = 2;
    if (per_cu < 1) per_cu = 1;
    grid_blocks = (cus * per_cu) & ~15;
  }
  Params p{};
  p.x_prompt = (const float*)d_in[0]; p.x_sample = (const float*)d_in[1];
  p.c_prompt = (const float*)d_in[2]; p.c_sample = (const float*)d_in[3];
  p.norm_g = (const float*)d_in[4]; p.w_ada = (const float*)d_in[5]; p.b_ada = (const float*)d_in[6];
  p.w_in = (const float*)d_in[7]; p.conv_w = (const float*)d_in[8]; p.conv_b = (const float*)d_in[9];
  p.w_rg = (const float*)d_in[10]; p.b_rg = (const float*)d_in[11]; p.lam = (const float*)d_in[12];
  p.w_a_out = (const float*)d_in[13]; p.w_b_out = (const float*)d_in[14]; p.w_o = (const float*)d_in[15];
  p.final_g = (const float*)d_in[16];
  p.out = (float*)d_out; p.ws = (unsigned char*)d_ws;
  void* args[] = {&p};
  hipError_t e = hipLaunchCooperativeKernel((void*)hawk_fnet_megakernel, dim3(grid_blocks), dim3(256), args, SMEM_BYTES, stream);
  if (e != hipSuccess) fprintf(stderr, "cooperative launch failed: %s (grid %d)\n", hipGetErrorString(e), grid_blocks);
}
```

```cpp
#include <hip/hip_runtime.h>
#include <hip/hip_cooperative_groups.h>
#include <cstdio>
namespace cg = cooperative_groups;

typedef unsigned short u16;
typedef __attribute__((ext_vector_type(8))) short bf16x8;
typedef __attribute__((ext_vector_type(4))) float f32x4;

#define DEVFN __device__ __forceinline__

constexpr int D = 1024;
constexpr int T_TOT = 81920;
constexpr long UNIT = (long)T_TOT * D;
constexpr int D_IN = 6144;

constexpr long OFF_W = 6 * UNIT;
constexpr long W_CAT = 0;
constexpr long W_A = 7168L * 1024;
constexpr long W_B = W_A + 1048576;
constexpr long W_O = W_B + 1048576;
constexpr long W_RG = W_O + 1048576;
constexpr long LW = W_RG + 524288;
constexpr long OFF_TAB = OFF_W + 2 * LW;
constexpr long T_D1A = 0;
constexpr long T_D1B = 65536;
constexpr long T_D2 = T_D1B + 16384;
constexpr long T_DC = T_D2 + 32768;
constexpr long TAB_ELEMS = T_DC + 131072;
constexpr long OFF_TW_BYTES = (OFF_TAB + TAB_ELEMS) * 2;
constexpr long OFF_MOD_BYTES = OFF_TW_BYTES + 131072;
constexpr long OFF_BAR_BYTES = OFF_MOD_BYTES + 221184;
constexpr long OFF_LB_BYTES = OFF_BAR_BYTES + 16384;
constexpr long LB_SLOT_BYTES = 20480L * 128 * 8;
constexpr long WS_NEED = OFF_LB_BYTES + LB_SLOT_BYTES + 20480 * 4 + 10240 * 4;
static_assert(WS_NEED <= (1L << 30), "workspace map exceeds the guaranteed 1 GiB");

constexpr int TILE = 128 * 64;
constexpr int SMEM_BYTES = 75776;

struct Params {
  const float* x_prompt; const float* x_sample; const float* c_prompt; const float* c_sample;
  const float* norm_g; const float* w_ada; const float* b_ada; const float* w_in;
  const float* conv_w; const float* conv_b; const float* w_rg; const float* b_rg; const float* lam;
  const float* w_a_out; const float* w_b_out; const float* w_o; const float* final_g;
  float* out; unsigned char* ws;
};

typedef __attribute__((ext_vector_type(2))) float f32x2_t;
typedef __attribute__((ext_vector_type(2))) __bf16 bf16x2_t;
DEVFN u16 f2bf(float f) {
  __bf16 h = (__bf16)f;
  return *(u16*)&h;
}
DEVFN float bf2f(u16 h) { return __uint_as_float(((unsigned)h) << 16); }
DEVFN unsigned pack2(float a, float b) {
  f32x2_t v = {a, b};
  bf16x2_t r = __builtin_convertvector(v, bf16x2_t);
  return *(unsigned*)&r;
}
DEVFN float lo2f(unsigned v) { return __uint_as_float(v << 16); }
DEVFN float hi2f(unsigned v) { return __uint_as_float(v & 0xffff0000u); }
DEVFN float sigm(float x) { return __builtin_amdgcn_rcpf(1.f + __expf(-x)); }
DEVFN float silu(float x) { return x * __builtin_amdgcn_rcpf(1.f + __expf(-x)); }
DEVFN float one_minus_exp(float x) {
  float pl = -x * (1.f + x * (0.5f + x * (1.f / 6.f + x * (1.f / 24.f + x * (1.f / 120.f + x * (1.f / 720.f))))));
  float dr = 1.f - __expf(x);
  return x > -0.3f ? pl : dr;
}

DEVFN int otid() { int t = threadIdx.x; asm volatile("" : "+v"(t)); return t; }
DEVFN int seq_of(int g) { int seg = g >> 13; return seg < 2 ? 0 : seg - 1; }
DEVFN int seq_start(int s) { return s == 0 ? 0 : 16384 + (s - 1) * 8192; }
DEVFN int seq_len(int s) { return s == 0 ? 16384 : 8192; }

DEVFN u16* U(const Params& p, int i) { return (u16*)(p.ws) + (long)i * UNIT; }
DEVFN u16* WL(const Params& p, int l) { return (u16*)(p.ws) + OFF_W + (long)l * LW; }
DEVFN u16* TAB(const Params& p) { return (u16*)(p.ws) + OFF_TAB; }
DEVFN float2* TW(const Params& p) { return (float2*)(p.ws + OFF_TW_BYTES); }
DEVFN float* MOD(const Params& p) { return (float*)(p.ws + OFF_MOD_BYTES); }
DEVFN const float* xrow(const Params& p, int g) {
  return g < 16384 ? p.x_prompt + (long)g * D : p.x_sample + (long)(g - 16384) * D;
}

struct LdPlain {
  static constexpr bool kDma = true; static constexpr bool kTr = false;
  const u16* base; unsigned off0; unsigned cst; int t_; unsigned row0_, stride_;
  DEVFN unsigned rowoff(int r) const { return (row0_ + r) * stride_; }
  DEVFN void init(int tid_, const u16* b, unsigned row0, unsigned stride) {
    unsigned tid = tid_; t_ = tid_; row0_ = row0; stride_ = stride;
    base = b;
    off0 = (row0 + (tid >> 3)) * stride + (((tid & 7) ^ ((tid >> 3) & 7)) << 3);
    cst = 32 * stride;
  }
  DEVFN void issue(u16* tile, int c, int kt) const {
    __builtin_amdgcn_global_load_lds((const unsigned*)(base + (off0 + c * cst + kt * 64)),
                                     (unsigned*)(tile + (t_ + c * 256) * 8), 16, 0, 0);
  }
  DEVFN uint4 load(int, int) const { return make_uint4(0, 0, 0, 0); }
  DEVFN void store(u16*, int, uint4) const {}
};
struct LdRows4 {
  static constexpr bool kDma = true; static constexpr bool kTr = false;
  const u16* base; unsigned off[4]; int t_;
  DEVFN void issue(u16* tile, int c, int kt) const {
    __builtin_amdgcn_global_load_lds((const unsigned*)(base + (off[c] + kt * 64)),
                                     (unsigned*)(tile + (t_ + c * 256) * 8), 16, 0, 0);
  }
  DEVFN uint4 load(int, int) const { return make_uint4(0, 0, 0, 0); }
  DEVFN void store(u16*, int, uint4) const {}
};
struct LdF32 {
  static constexpr bool kDma = false; static constexpr bool kTr = false;
  const float* base; unsigned off0; unsigned cst; int t_;
  DEVFN void init(int tid_, const float* b, unsigned row0, unsigned stride, unsigned col0) {
    unsigned tid = tid_; t_ = tid_;
    base = b;
    off0 = (row0 + (tid >> 3)) * stride + col0 + (tid & 7) * 8;
    cst = 32 * stride;
  }
  DEVFN void issue(u16*, int, int) const {}
  DEVFN uint4 load(int c, int kt) const {
    const float4* q = (const float4*)(base + (off0 + c * cst + kt * 64));
    float4 a = q[0], b = q[1];
    uint4 r; r.x = pack2(a.x, a.y); r.y = pack2(a.z, a.w); r.z = pack2(b.x, b.y); r.w = pack2(b.z, b.w);
    return r;
  }
  DEVFN void store(u16* tile, int c, uint4 v) const {
    int idx = t_ + c * 256;
    int row = idx >> 3, kc = idx & 7;
    *(uint4*)(tile + row * 64 + ((kc ^ (row & 7)) << 3)) = v;
  }
};
DEVFN int trf(int r) { return ((r & 3) << 2) | ((r >> 2) & 3); }
template <class TokFn>
struct LdTrans {
  static constexpr bool kDma = false; static constexpr bool kTr = false;
  TokFn tok; int t_;
  DEVFN void issue(u16*, int, int) const {}
  DEVFN uint4 load(int c, int kt) const {
    int idx = t_ + c * 256;
    int kk = idx & 63, cc = idx >> 6;
    const u16* b; unsigned o = tok(kt * 64 + kk, b);
    return *(const uint4*)(b + (o + cc * 8));
  }
  DEVFN void store(u16* tile, int c, uint4 v) const {
    int idx = t_ + c * 256;
    int kk = idx & 63, cc = idx >> 6;
    u16* q = tile + (cc * 8) * 64 + (kk & 7);
    int kc = kk >> 3;
    q[0 * 64 + ((kc ^ 0) << 3)] = (u16)(v.x & 0xffff); q[1 * 64 + ((kc ^ 1) << 3)] = (u16)(v.x >> 16);
    q[2 * 64 + ((kc ^ 2) << 3)] = (u16)(v.y & 0xffff); q[3 * 64 + ((kc ^ 3) << 3)] = (u16)(v.y >> 16);
    q[4 * 64 + ((kc ^ 4) << 3)] = (u16)(v.z & 0xffff); q[5 * 64 + ((kc ^ 5) << 3)] = (u16)(v.z >> 16);
    q[6 * 64 + ((kc ^ 6) << 3)] = (u16)(v.w & 0xffff); q[7 * 64 + ((kc ^ 7) << 3)] = (u16)(v.w >> 16);
  }
};

typedef __attribute__((ext_vector_type(4))) short s16x4;
DEVFN s16x4 lds_tr_read(const u16* q) {
  return __builtin_amdgcn_ds_read_tr16_b64_v4i16((s16x4 __attribute__((address_space(3)))*)(q));
}

DEVFN void zero_acc(f32x4 (&acc)[4][4]) {
#pragma unroll
  for (int i = 0; i < 4; ++i)
#pragma unroll
    for (int j = 0; j < 4; ++j) acc[i][j] = f32x4{0.f, 0.f, 0.f, 0.f};
}

template <class LA, class LB>
DEVFN void gemm_core(int tid, f32x4 (&acc)[4][4], int nk, const LA& la, const LB& lb, u16* smem) {
  const int lane = tid & 63, w = tid >> 6, wm = w >> 1, wn = w & 1;
  const int lr = lane & 15, quad = lane >> 4;
  uint4 ra[4], rb[4];
  if (LA::kDma) {
#pragma unroll
    for (int c = 0; c < 4; ++c) la.issue(smem, c, 0);
  } else {
#pragma unroll
    for (int c = 0; c < 4; ++c) ra[c] = la.load(c, 0);
  }
  if (LB::kDma) {
#pragma unroll
    for (int c = 0; c < 4; ++c) lb.issue(smem + TILE, c, 0);
  } else {
#pragma unroll
    for (int c = 0; c < 4; ++c) rb[c] = lb.load(c, 0);
  }
  if (!LA::kDma) {
#pragma unroll
    for (int c = 0; c < 4; ++c) la.store(smem, c, ra[c]);
  }
  if (!LB::kDma) {
#pragma unroll
    for (int c = 0; c < 4; ++c) lb.store(smem + TILE, c, rb[c]);
  }
  asm volatile("s_waitcnt vmcnt(0)" ::: "memory");
  __syncthreads();
  const int aoff = (wm * 64 + lr) * 64, boff = (wn * 64 + lr) * 64;
  const int sw0 = ((quad) ^ (lr & 7)) << 3, sw1 = ((4 + quad) ^ (lr & 7)) << 3;
  int troff[4][2];
  if (LB::kTr) {
    const int q = lr >> 2, pp = lr & 3;
#pragma unroll
    for (int j = 0; j < 4; ++j)
#pragma unroll
      for (int h = 0; h < 2; ++h) {
        int r = quad * 8 + h * 4 + q;
        int ch = (wn * 8 + j * 2 + (pp >> 1)) ^ trf(r);
        troff[j][h] = r * 128 + ch * 8 + (pp & 1) * 4;
      }
  }
  for (int kt = 0; kt < nk; ++kt) {
    const u16* sA = smem + (kt & 1) * 2 * TILE;
    const u16* sB = sA + TILE;
    u16* nA = smem + ((kt + 1) & 1) * 2 * TILE;
    const bool more = (kt + 1) < nk;
    if (more) {
      if (LA::kDma) {
#pragma unroll
        for (int c = 0; c < 4; ++c) la.issue(nA, c, kt + 1);
      } else {
#pragma unroll
        for (int c = 0; c < 4; ++c) ra[c] = la.load(c, kt + 1);
      }
      if (LB::kDma) {
#pragma unroll
        for (int c = 0; c < 4; ++c) lb.issue(nA + TILE, c, kt + 1);
      } else {
#pragma unroll
        for (int c = 0; c < 4; ++c) rb[c] = lb.load(c, kt + 1);
      }
    }
#pragma unroll
    for (int ks = 0; ks < 2; ++ks) {
      const int sw = ks == 0 ? sw0 : sw1;
      bf16x8 af[4], bfr[4];
#pragma unroll
      for (int i = 0; i < 4; ++i) af[i] = *(const bf16x8*)(sA + aoff + i * 1024 + sw);
      if (LB::kTr) {
#pragma unroll
        for (int j = 0; j < 4; ++j) {
          s16x4 lo = lds_tr_read(sB + troff[j][0] + ks * 4096);
          s16x4 hi = lds_tr_read(sB + troff[j][1] + ks * 4096);
          bfr[j] = __builtin_shufflevector(lo, hi, 0, 1, 2, 3, 4, 5, 6, 7);
        }
      } else {
#pragma unroll
        for (int j = 0; j < 4; ++j) bfr[j] = *(const bf16x8*)(sB + boff + j * 1024 + sw);
      }
      __builtin_amdgcn_s_setprio(1);
#pragma unroll
      for (int i = 0; i < 4; ++i)
#pragma unroll
        for (int j = 0; j < 4; ++j)
          acc[i][j] = __builtin_amdgcn_mfma_f32_16x16x32_bf16(bfr[j], af[i], acc[i][j], 0, 0, 0);
      __builtin_amdgcn_s_setprio(0);
    }
    if (more) {
      if (!LA::kDma) {
#pragma unroll
        for (int c = 0; c < 4; ++c) la.store(nA, c, ra[c]);
      }
      if (!LB::kDma) {
#pragma unroll
        for (int c = 0; c < 4; ++c) lb.store(nA + TILE, c, rb[c]);
      }
    }
    asm volatile("s_waitcnt vmcnt(0)" ::: "memory");
    __syncthreads();
  }
}

struct LdPerm {
  const u16* base; int g0, sst, lg;
  DEVFN unsigned rowoff(int r) const {
    int t = g0 - sst + r;
    int urow = ((t & ((1 << lg) - 1)) << 7) + (t >> lg);
    return (unsigned)(sst + urow) * D;
  }
};
#define GLDS16(gp, lp) __builtin_amdgcn_global_load_lds((const unsigned*)(gp), (unsigned*)(lp), 16, 0, 0)
DEVFN void zero_acc8(f32x4 (&acc)[8][4]) {
#pragma unroll
  for (int i = 0; i < 8; ++i)
#pragma unroll
    for (int j = 0; j < 4; ++j) acc[i][j] = f32x4{0.f, 0.f, 0.f, 0.f};
}
template <class LA, class LB>
DEVFN void gemm_core_b(int tid, f32x4 (&acc)[8][4], int nk, const LA& la, const LB& lb, u16* smem) {
  const int lane = tid & 63, w = tid >> 6, wm = w >> 1, wn = w & 1;
  const int lr = lane & 15, quad = lane >> 4;
  const int r0 = tid >> 2;
  const unsigned sw = (unsigned)(((tid & 3) ^ ((0 - (tid >> 4)) & 3)) << 3);
  const unsigned oa0 = la.rowoff(r0) + sw, oa1 = la.rowoff(r0 + 64) + sw, oa2 = la.rowoff(r0 + 128) + sw, oa3 = la.rowoff(r0 + 192) + sw;
  const unsigned ob0 = lb.rowoff(r0) + sw, ob1 = lb.rowoff(r0 + 64) + sw;
  const u16* ga = la.base; const u16* gb = lb.base;
  u16* l0 = smem + tid * 8;
#define ISSUE_STAGE(st, kt) do { u16* _s = l0 + (st) * 12288; unsigned _k = (unsigned)(kt) * 32u; \
    GLDS16(ga + (oa0 + _k), _s); GLDS16(ga + (oa1 + _k), _s + 2048); GLDS16(ga + (oa2 + _k), _s + 4096); GLDS16(ga + (oa3 + _k), _s + 6144); \
    GLDS16(gb + (ob0 + _k), _s + 8192); GLDS16(gb + (ob1 + _k), _s + 10240); } while (0)
  asm volatile("s_waitcnt vmcnt(0)" ::: "memory");
  ISSUE_STAGE(0, 0);
  ISSUE_STAGE(1, 1);
  const int fsw = (quad ^ ((0 - (lr >> 2)) & 3)) << 3;
  const int aoff = (wm * 128 + lr) * 32 + fsw, boff = 8192 + (wn * 64 + lr) * 32 + fsw;
  int cur = 0, nxt = 2;
  for (int kt = 0; kt < nk; ++kt) {
    if (kt + 1 < nk) asm volatile("s_waitcnt vmcnt(6)" ::: "memory");
    else asm volatile("s_waitcnt vmcnt(0)" ::: "memory");
    __builtin_amdgcn_s_barrier();
    asm volatile("" ::: "memory");
    if (kt + 2 < nk) ISSUE_STAGE(nxt, kt + 2);
    const u16* sb = smem + cur * 12288;
    bf16x8 af[8], bfr[4];
#pragma unroll
    for (int j = 0; j < 4; ++j) bfr[j] = *(const bf16x8*)(sb + boff + j * 512);
#pragma unroll
    for (int i = 0; i < 8; ++i) af[i] = *(const bf16x8*)(sb + aoff + i * 512);
    __builtin_amdgcn_s_setprio(1);
#pragma unroll
    for (int i = 0; i < 8; ++i)
#pragma unroll
      for (int j = 0; j < 4; ++j)
        acc[i][j] = __builtin_amdgcn_mfma_f32_16x16x32_bf16(bfr[j], af[i], acc[i][j], 0, 0, 0);
    __builtin_amdgcn_s_setprio(0);
    cur = cur == 2 ? 0 : cur + 1;
    nxt = nxt == 2 ? 0 : nxt + 1;
  }
  asm volatile("s_waitcnt lgkmcnt(0)" ::: "memory");
  __builtin_amdgcn_s_barrier();
  asm volatile("" ::: "memory");
#undef ISSUE_STAGE
}

DEVFN bool tile_xcd(int it, int ngrp, int ntn, int& mt, int& nt) {
  const int G = gridDim.x, b = blockIdx.x;
  if (G == 512) {
    if (it >= 5 * ngrp) return false;
    int xcd = b & 7, loc = b >> 3;
    mt = xcd * 40 + (it / ngrp) * 8 + (loc >> 3);
    nt = (it % ngrp) * 8 + (loc & 7);
    return true;
  }
  int tile = b + it * G;
  if (tile >= 320 * ntn) return false;
  mt = tile / ntn; nt = tile % ntn;
  return true;
}

DEVFN void transpose_tile(const float* src, long ld, u16* dst, long ldd, float* sT) {
  const int tid = otid();
#pragma unroll
  for (int pss = 0; pss < 4; ++pss) {
    int kk = (tid >> 4) + pss * 16, n4 = (tid & 15) * 4;
    float4 v = *(const float4*)(src + (long)kk * ld + n4);
    sT[kk * 65 + n4 + 0] = v.x; sT[kk * 65 + n4 + 1] = v.y; sT[kk * 65 + n4 + 2] = v.z; sT[kk * 65 + n4 + 3] = v.w;
  }
  __syncthreads();
  {
    int n = tid >> 2, k0 = (tid & 3) * 16;
    unsigned o[8];
#pragma unroll
    for (int e = 0; e < 8; ++e) o[e] = pack2(sT[(k0 + 2 * e) * 65 + n], sT[(k0 + 2 * e + 1) * 65 + n]);
    uint4* q = (uint4*)(dst + (long)n * ldd + k0);
    q[0] = make_uint4(o[0], o[1], o[2], o[3]);
    q[1] = make_uint4(o[4], o[5], o[6], o[7]);
  }
  __syncthreads();
}

DEVFN void phase_prologue(const Params& p, unsigned char* smem_raw) {
  const int tid = otid();
  constexpr int NJ_TR = 4352, NJ_MOD = 384, NJ_TAB = 256;
  for (int job = blockIdx.x; job < NJ_TR + NJ_MOD + NJ_TAB; job += gridDim.x) {
    if (job < NJ_TR) {
      float* sT = (float*)smem_raw;
      int l = job / 2176, r = job % 2176;
      u16* wl = WL(p, l);
      if (r < 1280) {
        int kt = r / 80, ntile = r % 80;
        int orow = ntile * 64;
        int scol;
        if (orow < 2048) scol = orow; else { orow += 2048; scol = orow - 1024; }
        transpose_tile(p.w_in + (long)l * D * D_IN + (long)(kt * 64) * D_IN + scol, D_IN,
                       wl + W_CAT + (long)orow * D + kt * 64, D, sT);
      } else if (r < 2048) {
        int r2 = r - 1280, which = r2 >> 8, t = r2 & 255, kt = t >> 4, ntile = t & 15;
        const float* src = (which == 0 ? p.w_a_out : which == 1 ? p.w_b_out : p.w_o) + (long)l * 1048576;
        long doff = which == 0 ? W_A : which == 1 ? W_B : W_O;
        transpose_tile(src + (long)(kt * 64) * D + ntile * 64, D, wl + doff + (long)(ntile * 64) * D + kt * 64, D, sT);
      } else {
        int r3 = r - 2048, mat = r3 >> 2, t = r3 & 3, kt = t >> 1, ntile = t & 1;
        const float* src = p.w_rg + ((long)l * 32 + mat) * 16384;
        transpose_tile(src + (long)(kt * 64) * 128 + ntile * 64, 128,
                       wl + W_RG + (long)mat * 16384 + (long)(ntile * 64) * 128 + kt * 64, 128, sT);
      }
    } else if (job < NJ_TR + NJ_MOD) {
      int jm = job - NJ_TR, l = jm / 192, cgp = jm % 192;
      float* sc = (float*)smem_raw;
      float* red = sc + 9 * 1024;
      for (int i = tid; i < 9 * 1024; i += 256) {
        int s_ = i >> 10, k = i & 1023;
        float cv = s_ == 0 ? p.c_prompt[k] : p.c_sample[(s_ - 1) * 1024 + k];
        sc[i] = silu(cv);
      }
      __syncthreads();
      int col = cgp * 16 + (tid & 15), kq = tid >> 4;
      float a0 = 0, a1 = 0, a2 = 0, a3 = 0, a4 = 0, a5 = 0, a6 = 0, a7 = 0, a8 = 0;
      const float* wp = p.w_ada + (long)l * D * 3072 + col;
#pragma unroll 8
      for (int k = kq * 64; k < kq * 64 + 64; ++k) {
        float wv = wp[(long)k * 3072];
        a0 += sc[0 * 1024 + k] * wv; a1 += sc[1 * 1024 + k] * wv; a2 += sc[2 * 1024 + k] * wv;
        a3 += sc[3 * 1024 + k] * wv; a4 += sc[4 * 1024 + k] * wv; a5 += sc[5 * 1024 + k] * wv;
        a6 += sc[6 * 1024 + k] * wv; a7 += sc[7 * 1024 + k] * wv; a8 += sc[8 * 1024 + k] * wv;
      }
      float* rq = red + kq * 144 + (tid & 15);
      rq[0 * 16] = a0; rq[1 * 16] = a1; rq[2 * 16] = a2; rq[3 * 16] = a3; rq[4 * 16] = a4;
      rq[5 * 16] = a5; rq[6 * 16] = a6; rq[7 * 16] = a7; rq[8 * 16] = a8;
      __syncthreads();
      if (tid < 144) {
        int s_ = tid >> 4, cc = tid & 15;
        float v = 0.f;
#pragma unroll
        for (int q = 0; q < 16; ++q) v += red[q * 144 + tid];
        int cf = cgp * 16 + cc;
        MOD(p)[((long)l * 9 + s_) * 3072 + cf] = v + p.b_ada[l * 3072 + cf];
      }
      __syncthreads();
    } else {
      int jt = job - NJ_TR - NJ_MOD;
      u16* tab = TAB(p);
#pragma unroll
      for (int e4 = 0; e4 < 4; ++e4) {
        int e = jt * 1024 + e4 * 256 + tid;
        if (e < 65536) {
          int m = e >> 8, k = e & 255;
          int k1 = (m >> 5) * 16 + (m & 15), ro = (m >> 4) & 1, ri = k >> 7, s1 = k & 127;
          float x = 2.f * (float)((k1 * s1) & 127) / 128.f;
          float cs = cospif(x), sn = sinpif(x);
          float v = (ro == ri) ? cs : (ro == 0 ? sn : -sn);
          tab[T_D1A + e] = f2bf(v);
        } else if (e < 65536 + 16384) {
          int e2 = e - 65536;
          int m = e2 >> 7, k = e2 & 127;
          int k1 = (m >> 5) * 16 + (m & 15), ro = (m >> 4) & 1, ri = k >> 6, s1 = k & 63;
          float x = 2.f * (float)((k1 * s1) & 63) / 64.f;
          float cs = cospif(x), sn = sinpif(x);
          float v = (ro == ri) ? cs : (ro == 0 ? sn : -sn);
          tab[T_D1B + e2] = f2bf(v);
        } else if (e < 65536 + 16384 + 32768) {
          int e2 = e - 65536 - 16384;
          int k2 = e2 >> 8, k = e2 & 255, ri = k >> 7, s2 = k & 127;
          float x = 2.f * (float)((k2 * s2) & 127) / 128.f;
          float v = ri == 0 ? cospif(x) : sinpif(x);
          tab[T_D2 + e2] = f2bf(v);
        } else if (e < 65536 + 16384 + 32768 + 131072) {
          int e2 = e - 65536 - 16384 - 32768;
          int row = e2 >> 8, c = e2 & 255, ri = row >> 8, m = row & 255;
          float x = 2.f * (float)((m * c) & 255) / 256.f;
          float v = ri == 0 ? cospif(x) : -sinpif(x);
          tab[T_DC + e2] = f2bf(v);
        } else {
          int e2 = e - (65536 + 16384 + 32768 + 131072);
          if (e2 < 16384) {
            float x = 2.f * (float)e2 / 16384.f;
            TW(p)[e2] = make_float2(cospif(x), sinpif(x));
          }
        }
      }
    }
  }
}

DEVFN void phase_fold(const Params& p, u16* smem) {
  for (int tile = blockIdx.x; tile < 256; tile += gridDim.x) {
    const int tid = otid(), lane = tid & 63, w = tid >> 6, wm = w >> 1, wn = w & 1, lr = lane & 15, quad = lane >> 4;
    int l = tile >> 7, g = (tile >> 5) & 3, mt = (tile >> 3) & 3, nt = tile & 7;
    LdPlain la; la.init(tid, TAB(p) + T_DC, mt * 128, 256);
    LdF32 lb; lb.init(tid, p.w_in + (long)l * D * D_IN, nt * 128, D_IN, 2048 + g * 256);
    f32x4 acc[4][4]; zero_acc(acc);
    gemm_core(tid, acc, 4, la, lb, smem);
    int ri = mt >> 1;
    u16* wc = WL(p, l) + W_CAT;
#pragma unroll
    for (int i = 0; i < 4; ++i) {
      int mrow = (mt & 1) * 128 + wm * 64 + i * 16 + lr;
      unsigned orow = 2048 + ri * 1024 + g * 256 + mrow;
#pragma unroll
      for (int j = 0; j < 4; ++j) {
        int n = nt * 128 + wn * 64 + j * 16 + quad * 4;
        uint2 o; o.x = pack2(acc[i][j][0], acc[i][j][1]); o.y = pack2(acc[i][j][2], acc[i][j][3]);
        *(uint2*)(wc + orow * D + n) = o;
      }
    }
  }
}

DEVFN void phase_h(const Params& p, int l) {
  const int lane = threadIdx.x & 63;
  const int wid = blockIdx.x * 4 + (threadIdx.x >> 6), nw = gridDim.x * 4;
  const float* ng = p.norm_g + l * D;
  const float* modl = MOD(p) + (long)l * 9 * 3072;
  u16* H = U(p, 0);
  float4 v[4], vn[4];
  auto ldrow = [&](int g, float4 (&dst)[4]) {
    const float* xb = (l == 0) ? (g < 16384 ? p.x_prompt : p.x_sample) : p.out;
    const unsigned xo = (unsigned)((l == 0 && g >= 16384) ? g - 16384 : g) * D;
#pragma unroll
    for (int i = 0; i < 4; ++i) dst[i] = *(const float4*)(xb + xo + i * 256 + lane * 4);
  };
  if (wid < T_TOT) ldrow(wid, v);
  for (int g = wid; g < T_TOT; g += nw) {
    if (g + nw < T_TOT) ldrow(g + nw, vn);
    const float* md = modl + seq_of(g) * 3072;
    float ss = 0.f;
#pragma unroll
    for (int i = 0; i < 4; ++i) ss += v[i].x * v[i].x + v[i].y * v[i].y + v[i].z * v[i].z + v[i].w * v[i].w;
#pragma unroll
    for (int o = 32; o >= 1; o >>= 1) ss += __shfl_xor(ss, o, 64);
    float rstd = rsqrtf(ss * (1.f / 1024.f) + 1e-6f);
#pragma unroll
    for (int i = 0; i < 4; ++i) {
      int c = i * 256 + lane * 4;
      float4 g4 = *(const float4*)(ng + c);
      float4 sh = *(const float4*)(md + c);
      float4 sc = *(const float4*)(md + 1024 + c);
      float h0 = v[i].x * rstd * g4.x * (1.f + sc.x) + sh.x;
      float h1 = v[i].y * rstd * g4.y * (1.f + sc.y) + sh.y;
      float h2 = v[i].z * rstd * g4.z * (1.f + sc.z) + sh.z;
      float h3 = v[i].w * rstd * g4.w * (1.f + sc.w) + sh.w;
      uint2 o; o.x = pack2(h0, h1); o.y = pack2(h2, h3);
      *(uint2*)(H + ((unsigned)g * D + c)) = o;
    }
#pragma unroll
    for (int i = 0; i < 4; ++i) v[i] = vn[i];
  }
}

DEVFN void phase_final(const Params& p) {
  const int lane = threadIdx.x & 63;
  const int wid = blockIdx.x * 4 + (threadIdx.x >> 6), nw = gridDim.x * 4;
  float4 v[4], vn[4];
  if (wid < T_TOT) {
#pragma unroll
    for (int i = 0; i < 4; ++i) v[i] = *(const float4*)(p.out + (unsigned)wid * D + i * 256 + lane * 4);
  }
  for (int g = wid; g < T_TOT; g += nw) {
    float* xr = p.out + (unsigned)g * D;
    if (g + nw < T_TOT) {
#pragma unroll
      for (int i = 0; i < 4; ++i) vn[i] = *(const float4*)(p.out + (unsigned)(g + nw) * D + i * 256 + lane * 4);
    }
    float ss = 0.f;
#pragma unroll
    for (int i = 0; i < 4; ++i) ss += v[i].x * v[i].x + v[i].y * v[i].y + v[i].z * v[i].z + v[i].w * v[i].w;
#pragma unroll
    for (int o = 32; o >= 1; o >>= 1) ss += __shfl_xor(ss, o, 64);
    float rstd = rsqrtf(ss * (1.f / 1024.f) + 1e-6f);
#pragma unroll
    for (int i = 0; i < 4; ++i) {
      int c = i * 256 + lane * 4;
      float4 g4 = *(const float4*)(p.final_g + c);
      float4 o;
      o.x = v[i].x * rstd * g4.x; o.y = v[i].y * rstd * g4.y; o.z = v[i].z * rstd * g4.z; o.w = v[i].w * rstd * g4.w;
      *(float4*)(xr + c) = o;
    }
#pragma unroll
    for (int i = 0; i < 4; ++i) v[i] = vn[i];
  }
}

DEVFN void phase_gemm1(const Params& p, int l, u16* smem) {
  const u16* H = U(p, 0);
  const u16* W = WL(p, l) + W_CAT;
  for (int it = 0;; ++it) {
    int mt, nt;
    if (!tile_xcd(it, 5, 40, mt, nt)) break;
    const int tid = otid(), lane = tid & 63, w = tid >> 6, wm = w >> 1, wn = w & 1, lr = lane & 15, quad = lane >> 4;
    LdPlain la; la.init(tid, H, mt * 256, D);
    LdPlain lb; lb.init(tid, W, nt * 128, D);
    f32x4 acc[8][4]; zero_acc8(acc);
    gemm_core_b(tid, acc, 32, la, lb, smem);
    int unit = nt >> 3, col0 = (nt & 7) * 128;
    u16* outp = U(p, 1 + unit);
    bool act = (unit == 1) || (unit == 4);
    {
      u16* so = smem;
#pragma unroll
      for (int i = 0; i < 8; ++i) {
        const int m = wm * 128 + i * 16 + lr;
#pragma unroll
        for (int j = 0; j < 4; ++j) {
          const int n = wn * 64 + j * 16 + quad * 4;
          float v0 = acc[i][j][0], v1 = acc[i][j][1], v2 = acc[i][j][2], v3 = acc[i][j][3];
          if (act) { v0 = silu(v0); v1 = silu(v1); v2 = silu(v2); v3 = silu(v3); }
          uint2 o; o.x = pack2(v0, v1); o.y = pack2(v2, v3);
          *(uint2*)(so + m * 136 + n) = o;
        }
      }
      __syncthreads();
#pragma unroll
      for (int c = 0; c < 16; ++c) {
        const int idx = tid + c * 256;
        const int row = idx >> 4, ch = idx & 15;
        uint4 v = *(const uint4*)(so + row * 136 + ch * 8);
        *(uint4*)(outp + ((unsigned)(mt * 256 + row) * D + col0 + ch * 8)) = v;
      }
      __syncthreads();
    }
  }
}

struct TokF1 {
  const u16* zr; const u16* zi; int n1; unsigned off;
  DEVFN unsigned operator()(int k, const u16*& b) const {
    int ri = k >= n1 ? 1 : 0;
    int s1 = k - ri * n1;
    b = ri ? zi : zr;
    return off + (unsigned)(s1 * 128) * D;
  }
};
DEVFN void f1_twiddle(int tid, const Params& p, const f32x4 (&acc)[4][4], int hf, int s2, int smask, int twmul,
                      uint2 (&o1)[2][4], uint2 (&o2)[2][4]) {
  const int lane = tid & 63, w = tid >> 6, wm = w >> 1, lr = lane & 15;
  const float2* tw = TW(p);
#pragma unroll
  for (int b = 0; b < 2; ++b) {
    int k1 = (hf * 4 + wm * 2 + b) * 16 + lr;
    float2 t = tw[((k1 * s2) & smask) * twmul];
#pragma unroll
    for (int j = 0; j < 4; ++j) {
      f32x4 orr = acc[2 * b][j], oii = acc[2 * b + 1][j];
      o1[b][j].x = pack2(orr[0] * t.x + oii[0] * t.y, orr[1] * t.x + oii[1] * t.y);
      o1[b][j].y = pack2(orr[2] * t.x + oii[2] * t.y, orr[3] * t.x + oii[3] * t.y);
      o2[b][j].x = pack2(oii[0] * t.x - orr[0] * t.y, oii[1] * t.x - orr[1] * t.y);
      o2[b][j].y = pack2(oii[2] * t.x - orr[2] * t.y, oii[3] * t.x - orr[3] * t.y);
    }
  }
}
DEVFN void f1_write(int tid, int hf, unsigned off, const uint2 (&o1)[2][4], const uint2 (&o2)[2][4], u16* zr, u16* zi, u16* so) {
  const int lane = tid & 63, w = tid >> 6, wm = w >> 1, wn = w & 1, lr = lane & 15, quad = lane >> 4;
#pragma unroll
  for (int b = 0; b < 2; ++b) {
    const int rl = (wm * 2 + b) * 16 + lr;
#pragma unroll
    for (int j = 0; j < 4; ++j) {
      const int n = wn * 64 + j * 16 + quad * 4;
      *(uint2*)(so + rl * 136 + n) = o1[b][j];
      *(uint2*)(so + (64 + rl) * 136 + n) = o2[b][j];
    }
  }
  __syncthreads();
#pragma unroll
  for (int c = 0; c < 8; ++c) {
    const int idx = tid + c * 256;
    const int pl = idx >> 10, row = (idx >> 4) & 63, ch = idx & 15;
    const unsigned k1 = hf * 64 + row;
    uint4 v = *(const uint4*)(so + (pl * 64 + row) * 136 + ch * 8);
    *(uint4*)((pl ? zi : zr) + (off + (k1 * 128) * D + ch * 8)) = v;
  }
  __syncthreads();
}
DEVFN void phase_fft1(const Params& p, u16* smem) {
  u16* zr = U(p, 3);
  u16* zi = U(p, 4);
  for (int tile = blockIdx.x; tile < 9216; tile += gridDim.x) {
    const int tid = otid();
    int seq, s2, ct, n1;
    if (tile < 1024) { seq = 0; s2 = tile >> 3; ct = tile & 7; n1 = 128; }
    else { int t2 = tile - 1024; seq = 1 + (t2 >> 10); s2 = (t2 >> 3) & 127; ct = t2 & 7; n1 = 64; }
    const unsigned off = (unsigned)(seq_start(seq) + s2) * D + ct * 128;
    LdTrans<TokF1> lb; lb.t_ = tid; lb.tok.zr = zr; lb.tok.zi = zi; lb.tok.n1 = n1; lb.tok.off = off;
    const int K = 2 * n1, nk = K >> 6;
    const u16* tab = TAB(p) + (seq == 0 ? T_D1A : T_D1B);
    const int smask = seq == 0 ? 16383 : 8191, twmul = seq == 0 ? 1 : 2;
    uint2 a1[2][4], a2[2][4];
    {
      f32x4 acc[4][4]; zero_acc(acc);
      LdPlain la; la.init(tid, tab, 0, K); gemm_core(tid, acc, nk, la, lb, smem);
      f1_twiddle(tid, p, acc, 0, s2, smask, twmul, a1, a2);
    }
    if (seq == 0) {
      uint2 b1[2][4], b2[2][4];
      {
        f32x4 acc[4][4]; zero_acc(acc);
        LdPlain la; la.init(tid, tab, 128, K); gemm_core(tid, acc, nk, la, lb, smem);
        f1_twiddle(tid, p, acc, 1, s2, smask, twmul, b1, b2);
      }
      f1_write(tid, 1, off, b1, b2, zr, zi, smem);
    }
    f1_write(tid, 0, off, a1, a2, zr, zi, smem);
  }
}

struct TokF2 {
  const u16* zr; const u16* zi; unsigned off;
  DEVFN unsigned operator()(int k, const u16*& b) const {
    int ri = k >> 7, s2 = k & 127;
    b = ri ? zi : zr;
    return off + (unsigned)s2 * D;
  }
};
DEVFN void phase_fft2(const Params& p, u16* smem) {
  u16* zr = U(p, 3);
  const u16* gbp = U(p, 5);
  for (int tile = blockIdx.x; tile < 5120; tile += gridDim.x) {
    const int tid = otid(), lane = tid & 63, w = tid >> 6, wm = w >> 1, wn = w & 1, lr = lane & 15, quad = lane >> 4;
    int seq, k1, ct, n1;
    if (tile < 1024) { seq = 0; k1 = tile >> 3; ct = tile & 7; n1 = 128; }
    else { int t2 = tile - 1024; seq = 1 + (t2 >> 9); k1 = (t2 >> 3) & 63; ct = t2 & 7; n1 = 64; }
    const int sst = seq_start(seq);
    const unsigned off = (unsigned)(sst + k1 * 128) * D + ct * 128;
    LdTrans<TokF2> lb; lb.t_ = tid; lb.tok.zr = zr; lb.tok.zi = U(p, 4); lb.tok.off = off;
    LdPlain la; la.init(tid, TAB(p) + T_D2, 0, 256);
    f32x4 acc[4][4]; zero_acc(acc);
    gemm_core(tid, acc, 4, la, lb, smem);
    const float nrm = seq == 0 ? (1.f / 2048.f) : 6.9053396600248786e-4f;
    u16* so = smem;
#pragma unroll
    for (int c = 0; c < 8; ++c) {
      const int idx = tid + c * 256;
      const int row = idx >> 4, ch = idx & 15;
      *(uint4*)(so + row * 136 + ch * 8) = *(const uint4*)(gbp + ((unsigned)(sst + k1 + n1 * row) * D + ct * 128 + ch * 8));
    }
    __syncthreads();
#pragma unroll
    for (int i = 0; i < 4; ++i) {
      const int k2 = wm * 64 + i * 16 + lr;
#pragma unroll
      for (int j = 0; j < 4; ++j) {
        const int cl = wn * 64 + j * 16 + quad * 4;
        uint2 gv = *(const uint2*)(so + k2 * 136 + cl);
        uint2 o;
        o.x = pack2(acc[i][j][0] * nrm * lo2f(gv.x), acc[i][j][1] * nrm * hi2f(gv.x));
        o.y = pack2(acc[i][j][2] * nrm * lo2f(gv.y), acc[i][j][3] * nrm * hi2f(gv.y));
        *(uint2*)(so + k2 * 136 + cl) = o;
      }
    }
    __syncthreads();
#pragma unroll
    for (int c = 0; c < 8; ++c) {
      const int idx = tid + c * 256;
      const int row = idx >> 4, ch = idx & 15;
      *(uint4*)(zr + (off + (unsigned)row * D + ch * 8)) = *(const uint4*)(so + row * 136 + ch * 8);
    }
    __syncthreads();
  }
}

constexpr int SA_LD = 128;
template <int PASS>
DEVFN void phase_scan(const Params& p, int l, int dirsel, unsigned char* smem_raw) {
  float* sAf = (float*)smem_raw;
  u16* sBh = (u16*)(smem_raw + 32768);
  u16* sXc = (u16*)(smem_raw + 32768 + 16384);
  const int tid = otid(), lane = tid & 63, w = tid >> 6, lr = lane & 15, quad = lane >> 4;
  const int head = blockIdx.x & 7;
  const int dir = PASS == 1 ? ((blockIdx.x >> 3) & 1) : dirsel;
  const int tstart = PASS == 1 ? (blockIdx.x >> 4) : (blockIdx.x >> 3);
  const int tstep = PASS == 1 ? (gridDim.x >> 4) : (gridDim.x >> 3);
  const u16* xa = U(p, 1);
  u16* ga = U(p, 2);
  u16* hf = U(p, 5);
  float2* agg = (float2*)U(p, 4);
  float* carry = (float*)(agg + 1280L * 2 * 1024);
  bf16x8 bw[4][4];
  {
    const u16* wrg = WL(p, l) + W_RG;
#pragma unroll
    for (int jt = 0; jt < 4; ++jt) {
      int q = jt >> 1, col = w * 32 + (jt & 1) * 16 + lr;
      const u16* bp = wrg + (unsigned)((((dir * 2 + q) * 8 + head) * 128 + col) * 128 + quad * 8);
#pragma unroll
      for (int ks = 0; ks < 4; ++ks) bw[jt][ks] = *(const bf16x8*)(bp + ks * 32);
    }
  }
  float spl[2], brr[2], bii[2];
#pragma unroll
  for (int jc = 0; jc < 2; ++jc) {
    int cgl = head * 128 + w * 32 + jc * 16 + lr;
    float lm = p.lam[(l * 2 + dir) * D + cgl];
    spl[jc] = -8.f * 1.4426950408889634f * log1pf(expf(-lm));
    brr[jc] = -1.4426950408889634f * p.b_rg[((l * 2 + dir) * 2 + 0) * D + cgl];
    bii[jc] = -1.4426950408889634f * p.b_rg[((l * 2 + dir) * 2 + 1) * D + cgl];
  }
  const int c8 = tid & 15, tg = tid >> 4;
  float* sCw = (float*)(smem_raw + 65536);
  for (int i = tid; i < 640; i += 256) {
    int k = i >> 7, c = i & 127;
    sCw[i] = k < 4 ? p.conv_w[(l * 4 + k) * D + head * 128 + c] : p.conv_b[l * D + head * 128 + c];
  }
  __syncthreads();
  uint4 xr[7];
#define LOAD_XROWS(TT) do { const int _g0 = (TT) * 64; const int _sq = seq_of(_g0), _ss = seq_start(_sq), _se = _ss + seq_len(_sq); \
    _Pragma("unroll") for (int r = 0; r < 7; ++r) { int _g = _g0 + tg * 4 - 2 + r; xr[r] = make_uint4(0, 0, 0, 0); \
      if (_g >= _ss && _g < _se) xr[r] = *(const uint4*)(xa + ((unsigned)_g * D + head * 128 + c8 * 8)); } } while (0)
  if (tstart < 1280) LOAD_XROWS(tstart);
  for (int tt = tstart; tt < 1280; tt += tstep) {
    const int g0 = tt * 64;
    const int seq = seq_of(g0), sst = seq_start(seq), send = sst + seq_len(seq);
#pragma unroll
    for (int j = 0; j < 4; ++j) {
      float o[8];
      {
        float4 b0 = *(const float4*)(sCw + 512 + c8 * 8), b1 = *(const float4*)(sCw + 512 + c8 * 8 + 4);
        o[0] = b0.x; o[1] = b0.y; o[2] = b0.z; o[3] = b0.w; o[4] = b1.x; o[5] = b1.y; o[6] = b1.z; o[7] = b1.w;
      }
#pragma unroll
      for (int k = 0; k < 4; ++k) {
        uint4 v = xr[j + k];
        float4 w0 = *(const float4*)(sCw + k * 128 + c8 * 8), w1 = *(const float4*)(sCw + k * 128 + c8 * 8 + 4);
        o[0] += w0.x * lo2f(v.x); o[1] += w0.y * hi2f(v.x);
        o[2] += w0.z * lo2f(v.y); o[3] += w0.w * hi2f(v.y);
        o[4] += w1.x * lo2f(v.z); o[5] += w1.y * hi2f(v.z);
        o[6] += w1.z * lo2f(v.w); o[7] += w1.w * hi2f(v.w);
      }
      uint4 q0;
      q0.x = pack2(o[0], o[1]); q0.y = pack2(o[2], o[3]); q0.z = pack2(o[4], o[5]); q0.w = pack2(o[6], o[7]);
      const int tl = tg * 4 + j;
      *(uint4*)(sXc + tl * 128 + ((c8 ^ (tl & 7)) << 3)) = q0;
    }
    __syncthreads();
    if (tt + tstep < 1280) LOAD_XROWS(tt + tstep);
    const int gstart = dir == 0 ? sst : send - 1;
#pragma unroll 1
    for (int hv = 0; hv < 2; ++hv) {
      f32x4 acc[2][4];
#pragma unroll
      for (int it = 0; it < 2; ++it)
#pragma unroll
        for (int jt = 0; jt < 4; ++jt) acc[it][jt] = f32x4{0.f, 0.f, 0.f, 0.f};
#pragma unroll
      for (int ks = 0; ks < 4; ++ks) {
#pragma unroll
        for (int it = 0; it < 2; ++it) {
          bf16x8 af = *(const bf16x8*)(sXc + ((hv * 2 + it) * 16 + lr) * 128 + (((ks * 4 + quad) ^ (lr & 7)) << 3));
#pragma unroll
          for (int jt = 0; jt < 4; ++jt)
            acc[it][jt] = __builtin_amdgcn_mfma_f32_16x16x32_bf16(af, bw[jt][ks], acc[it][jt], 0, 0, 0);
        }
      }
#pragma unroll
      for (int it = 0; it < 2; ++it)
#pragma unroll
        for (int jc = 0; jc < 2; ++jc) {
#pragma unroll
          for (int r = 0; r < 4; ++r) {
            int tl = (hv * 2 + it) * 16 + quad * 4 + r, c = w * 32 + jc * 16 + lr;
            float rr = __builtin_amdgcn_rcpf(1.f + __builtin_amdgcn_exp2f(fmaf(acc[it][jc][r], -1.4426950408889634f, brr[jc])));
            float ii = __builtin_amdgcn_rcpf(1.f + __builtin_amdgcn_exp2f(fmaf(acc[it][2 + jc][r], -1.4426950408889634f, bii[jc])));
            float a = __builtin_amdgcn_exp2f(rr * spl[jc]);
            float mult = __builtin_amdgcn_sqrtf((1.f - a) * (1.f + a));
            if (g0 + tl == gstart) mult = 1.f;
            float xv = bf2f(sXc[tl * 128 + (((c >> 3) ^ (tl & 7)) << 3) + (c & 7)]);
            sAf[tl * SA_LD + c] = a;
            sBh[tl * 128 + c] = f2bf(mult * ii * xv);
          }
        }
    }
    __syncthreads();
    if (tid < 128) {
      const int c = tid;
      const unsigned aidx = (unsigned)(tt * 2 + dir) * 1024 + head * 128 + c;
      const float* ap = sAf + c;
      u16* bp = sBh + c;
      if (PASS == 1) {
        float h = 0.f, P = 1.f;
        if (dir == 0) {
#pragma unroll 16
          for (int st = 0; st < 64; ++st) { float a = ap[st * SA_LD]; h = a * h + bf2f(bp[st * 128]); P *= a; }
        } else {
#pragma unroll 16
          for (int st = 63; st >= 0; --st) { float a = ap[st * SA_LD]; h = a * h + bf2f(bp[st * 128]); P *= a; }
        }
        agg[aidx] = make_float2(P, h);
      } else {
        float h = carry[aidx];
        if (dir == 0) {
#pragma unroll 16
          for (int st = 0; st < 64; ++st) { h = ap[st * SA_LD] * h + bf2f(bp[st * 128]); bp[st * 128] = f2bf(h); }
        } else {
#pragma unroll 16
          for (int st = 63; st >= 0; --st) { h = ap[st * SA_LD] * h + bf2f(bp[st * 128]); bp[st * 128] = f2bf(h); }
        }
      }
    }
    if (PASS == 3) {
      __syncthreads();
#pragma unroll
      for (int cch = 0; cch < 4; ++cch) {
        int chunk = tid + cch * 256;
        int t = chunk >> 4, cc = (chunk & 15) * 8;
        unsigned off = (unsigned)(g0 + t) * D + head * 128 + cc;
        uint4 hv = *(const uint4*)(sBh + t * 128 + cc);
        if (dir == 0) {
          *(uint4*)(hf + off) = hv;
        } else {
          uint4 fv = *(const uint4*)(hf + off);
          uint4 gv = *(const uint4*)(ga + off);
          uint4 o;
          o.x = pack2((lo2f(fv.x) + lo2f(hv.x)) * lo2f(gv.x), (hi2f(fv.x) + hi2f(hv.x)) * hi2f(gv.x));
          o.y = pack2((lo2f(fv.y) + lo2f(hv.y)) * lo2f(gv.y), (hi2f(fv.y) + hi2f(hv.y)) * hi2f(gv.y));
          o.z = pack2((lo2f(fv.z) + lo2f(hv.z)) * lo2f(gv.z), (hi2f(fv.z) + hi2f(hv.z)) * hi2f(gv.z));
          o.w = pack2((lo2f(fv.w) + lo2f(hv.w)) * lo2f(gv.w), (hi2f(fv.w) + hi2f(hv.w)) * hi2f(gv.w));
          *(uint4*)(ga + off) = o;
        }
      }
    }
    __syncthreads();
  }
#undef LOAD_XROWS
}

DEVFN void lb_st64(unsigned long long* q, unsigned long long v) { __hip_atomic_store(q, v, __ATOMIC_RELAXED, __HIP_MEMORY_SCOPE_AGENT); }
DEVFN unsigned long long lb_ld64(const unsigned long long* q) { return __hip_atomic_load(q, __ATOMIC_RELAXED, __HIP_MEMORY_SCOPE_AGENT); }
DEVFN void lb_st32(unsigned* q, unsigned v) { __hip_atomic_store(q, v, __ATOMIC_RELAXED, __HIP_MEMORY_SCOPE_AGENT); }
DEVFN unsigned lb_ld32(const unsigned* q) { return __hip_atomic_load(q, __ATOMIC_RELAXED, __HIP_MEMORY_SCOPE_AGENT); }
DEVFN unsigned long long lb_pack(float a, float b) { return (unsigned long long)__float_as_uint(a) | ((unsigned long long)__float_as_uint(b) << 32); }
DEVFN unsigned long long lb_gran(float P, float H, unsigned tag) {
  return ((unsigned long long)__float_as_uint(H) << 32) | (unsigned long long)((__float_as_uint(P) & 0xffffff00u) | tag);
}
DEVFN int lb_rank(int seq, int pos) { return seq == 0 ? (pos >> 1) * 10 + ((pos & 1) ? 9 : 0) : pos * 10 + seq; }
DEVFN void lb_decode(int r, int dir, int& seq, int& pos, int& tt) {
  int pair = r / 10, j = r - pair * 10;
  if (j == 0) { seq = 0; pos = 2 * pair; } else if (j == 9) { seq = 0; pos = 2 * pair + 1; } else { seq = j; pos = pair; }
  int len = seq == 0 ? 256 : 128;
  tt = (seq_start(seq) >> 6) + (dir ? len - 1 - pos : pos);
}
DEVFN void phase_scan_lb(const Params& p, int l, unsigned char* smem_raw) {
  float* sAt = (float*)smem_raw;
  u16* sBt = (u16*)(smem_raw + 34816);
  u16* sXc = (u16*)(smem_raw + 53248);
  u16* sBh = sXc;
  unsigned* sflag = (unsigned*)(smem_raw + 72192);
  const int tid = otid(), lane = tid & 63, w = tid >> 6, lr = lane & 15, quad = lane >> 4;
  const int hd = blockIdx.x & 15, head = hd >> 1, dir = hd & 1;
  const int rstart = blockIdx.x >> 4, rstep = gridDim.x >> 4;
  const u16* xa = U(p, 1);
  u16* ga = U(p, 2);
  u16* hown = dir == 0 ? U(p, 5) : U(p, 4);
  const u16* hoth = dir == 0 ? U(p, 4) : U(p, 5);
  unsigned long long* slot = (unsigned long long*)(p.ws + OFF_LB_BYTES);
  unsigned* stat = (unsigned*)(p.ws + OFF_LB_BYTES + LB_SLOT_BYTES);
  unsigned* cnt = stat + 20480;
  const unsigned ep = 2u * (unsigned)l;
  const unsigned tagb = ((unsigned)l + 1u) * 4u;
  bf16x8 bw[4][4];
  {
    const u16* wrg = WL(p, l) + W_RG;
#pragma unroll
    for (int jt = 0; jt < 4; ++jt) {
      int q = jt >> 1, col = w * 32 + (jt & 1) * 16 + lr;
      const u16* bp = wrg + (unsigned)((((dir * 2 + q) * 8 + head) * 128 + col) * 128 + quad * 8);
#pragma unroll
      for (int ks = 0; ks < 4; ++ks) bw[jt][ks] = *(const bf16x8*)(bp + ks * 32);
    }
  }
  float spl[2], brr[2], bii[2];
#pragma unroll
  for (int jc = 0; jc < 2; ++jc) {
    int cgl = head * 128 + w * 32 + jc * 16 + lr;
    float lm = p.lam[(l * 2 + dir) * D + cgl];
    spl[jc] = -8.f * 1.4426950408889634f * log1pf(expf(-lm));
    brr[jc] = -1.4426950408889634f * p.b_rg[((l * 2 + dir) * 2 + 0) * D + cgl];
    bii[jc] = -1.4426950408889634f * p.b_rg[((l * 2 + dir) * 2 + 1) * D + cgl];
  }
  const int c8 = tid & 15, tg = tid >> 4;
  float* sCw = (float*)(smem_raw + 69632);
  for (int i = tid; i < 640; i += 256) {
    int k = i >> 7, c = i & 127;
    sCw[i] = k < 4 ? p.conv_w[(l * 4 + k) * D + head * 128 + c] : p.conv_b[l * D + head * 128 + c];
  }
  __syncthreads();
  uint4 xr[7];
#define LOAD_XROWS(TT) do { const int _g0 = (TT) * 64; const int _sq = seq_of(_g0), _ss = seq_start(_sq), _se = _ss + seq_len(_sq); \
    _Pragma("unroll") for (int r_ = 0; r_ < 7; ++r_) { int _g = _g0 + tg * 4 - 2 + r_; xr[r_] = make_uint4(0, 0, 0, 0); \
      if (_g >= _ss && _g < _se) xr[r_] = *(const uint4*)(xa + ((unsigned)_g * D + head * 128 + c8 * 8)); } } while (0)
  if (rstart < 1280) { int sq_, ps_, t0_; lb_decode(rstart, dir, sq_, ps_, t0_); LOAD_XROWS(t0_); }
  for (int r = rstart; r < 1280; r += rstep) {
    int seq, pos, tt;
    lb_decode(r, dir, seq, pos, tt);
    const int item = r * 16 + hd;
    const int g0 = tt * 64;
    const int sst = seq_start(seq), send = sst + seq_len(seq);
#pragma unroll
    for (int j = 0; j < 4; ++j) {
      float o[8];
      {
        float4 b0 = *(const float4*)(sCw + 512 + c8 * 8), b1 = *(const float4*)(sCw + 512 + c8 * 8 + 4);
        o[0] = b0.x; o[1] = b0.y; o[2] = b0.z; o[3] = b0.w; o[4] = b1.x; o[5] = b1.y; o[6] = b1.z; o[7] = b1.w;
      }
#pragma unroll
      for (int k = 0; k < 4; ++k) {
        uint4 v = xr[j + k];
        float4 w0 = *(const float4*)(sCw + k * 128 + c8 * 8), w1 = *(const float4*)(sCw + k * 128 + c8 * 8 + 4);
        o[0] += w0.x * lo2f(v.x); o[1] += w0.y * hi2f(v.x);
        o[2] += w0.z * lo2f(v.y); o[3] += w0.w * hi2f(v.y);
        o[4] += w1.x * lo2f(v.z); o[5] += w1.y * hi2f(v.z);
        o[6] += w1.z * lo2f(v.w); o[7] += w1.w * hi2f(v.w);
      }
      uint4 q0;
      q0.x = pack2(o[0], o[1]); q0.y = pack2(o[2], o[3]); q0.z = pack2(o[4], o[5]); q0.w = pack2(o[6], o[7]);
      const int tl = tg * 4 + j;
      *(uint4*)(sXc + tl * 128 + ((c8 ^ (tl & 7)) << 3)) = q0;
    }
    __syncthreads();
    if (r + rstep < 1280) { int sq_, ps_, t1_; lb_decode(r + rstep, dir, sq_, ps_, t1_); LOAD_XROWS(t1_); }
    const int gstart = dir == 0 ? sst : send - 1;
#pragma unroll 1
    for (int hv = 0; hv < 2; ++hv) {
      f32x4 acc[2][4];
#pragma unroll
      for (int it = 0; it < 2; ++it)
#pragma unroll
        for (int jt = 0; jt < 4; ++jt) acc[it][jt] = f32x4{0.f, 0.f, 0.f, 0.f};
#pragma unroll
      for (int ks = 0; ks < 4; ++ks) {
#pragma unroll
        for (int it = 0; it < 2; ++it) {
          bf16x8 af = *(const bf16x8*)(sXc + ((hv * 2 + it) * 16 + lr) * 128 + (((ks * 4 + quad) ^ (lr & 7)) << 3));
#pragma unroll
          for (int jt = 0; jt < 4; ++jt)
            acc[it][jt] = __builtin_amdgcn_mfma_f32_16x16x32_bf16(af, bw[jt][ks], acc[it][jt], 0, 0, 0);
        }
      }
#pragma unroll
      for (int it = 0; it < 2; ++it)
#pragma unroll
        for (int jc = 0; jc < 2; ++jc) {
          float av[4], bv[4];
          const int c = w * 32 + jc * 16 + lr, t0 = (hv * 2 + it) * 16 + quad * 4;
#pragma unroll
          for (int r = 0; r < 4; ++r) {
            const int tl = t0 + r;
            float rr = __builtin_amdgcn_rcpf(1.f + __builtin_amdgcn_exp2f(fmaf(acc[it][jc][r], -1.4426950408889634f, brr[jc])));
            float ii = __builtin_amdgcn_rcpf(1.f + __builtin_amdgcn_exp2f(fmaf(acc[it][2 + jc][r], -1.4426950408889634f, bii[jc])));
            float a = __builtin_amdgcn_exp2f(rr * spl[jc]);
            float mult = __builtin_amdgcn_sqrtf((1.f - a) * (1.f + a));
            if (g0 + tl == gstart) mult = 1.f;
            float xv = bf2f(sXc[tl * 128 + (((c >> 3) ^ (tl & 7)) << 3) + (c & 7)]);
            av[r] = a;
            bv[r] = mult * ii * xv;
          }
          *(float4*)(sAt + c * 68 + t0) = make_float4(av[0], av[1], av[2], av[3]);
          uint2 bq; bq.x = pack2(bv[0], bv[1]); bq.y = pack2(bv[2], bv[3]);
          *(uint2*)(sBt + c * 72 + t0) = bq;
        }
    }
    __syncthreads();
    const int sc_c = tid & 127, sc_part = tid >> 7;
    float2* sEx = (float2*)(smem_raw + 72208);
    float* sCar = (float*)(sEx + 256);
    float partP = 1.f, partH = 0.f;
    {
      const float* ap = sAt + sc_c * 68;
      const u16* bp = sBt + sc_c * 72;
#pragma unroll
      for (int gq = 0; gq < 8; ++gq) {
        const int t = dir == 0 ? sc_part * 32 + gq * 4 : 60 - sc_part * 32 - gq * 4;
        const float4 a4 = *(const float4*)(ap + t);
        const uint2 b4 = *(const uint2*)(bp + t);
        if (dir == 0) {
          partH = a4.x * partH + lo2f(b4.x); partH = a4.y * partH + hi2f(b4.x);
          partH = a4.z * partH + lo2f(b4.y); partH = a4.w * partH + hi2f(b4.y);
        } else {
          partH = a4.w * partH + hi2f(b4.y); partH = a4.z * partH + lo2f(b4.y);
          partH = a4.y * partH + hi2f(b4.x); partH = a4.x * partH + lo2f(b4.x);
        }
        partP *= (a4.x * a4.y) * (a4.z * a4.w);
      }
      sEx[sc_part * 128 + sc_c] = make_float2(partP, partH);
    }
    __syncthreads();
    float carry = 0.f;
    if (tid < 128) {
      const float2 e1 = sEx[128 + tid];
      const float aggP = partP * e1.x, aggH = e1.x * partH + e1.y;
      lb_st64(slot + (unsigned)item * 128 + tid, lb_gran(pos == 0 ? 0.f : aggP, aggH, tagb + (pos == 0 ? 2u : 1u)));
      if (pos > 0) {
        float Pr = 1.f, Hr = 0.f;
        int pj = pos - 1;
        for (;;) {
          const int j = lb_rank(seq, pj) * 16 + hd;
          unsigned long long v;
          unsigned spins = 0;
          for (;;) {
            v = lb_ld64(slot + (unsigned)j * 128 + tid);
            unsigned tg_ = (unsigned)v & 0xffu;
            if ((tg_ >> 2) == (tagb >> 2) && (tg_ & 3u) != 0u) break;
            __builtin_amdgcn_s_sleep(1);
            if (++spins > (1u << 18)) break;
          }
          float Pj = __uint_as_float((unsigned)v & 0xffffff00u), Hj = __uint_as_float((unsigned)(v >> 32));
          Hr += Pr * Hj;
          Pr *= Pj;
          if (((unsigned)v & 3u) == 2u || pj == 0) break;
          --pj;
        }
        carry = Hr;
        lb_st64(slot + (unsigned)item * 128 + tid, lb_gran(0.f, aggP * carry + aggH, tagb + 2u));
      }
      sCar[tid] = partP * carry + partH;
    }
    __syncthreads();
    {
      const float* ap = sAt + sc_c * 68;
      const u16* bp = sBt + sc_c * 72;
      u16* hp = sBh + sc_c;
      float h = sc_part == 0 ? carry : sCar[sc_c];
#pragma unroll
      for (int gq = 0; gq < 8; ++gq) {
        const int t = dir == 0 ? sc_part * 32 + gq * 4 : 60 - sc_part * 32 - gq * 4;
        const float4 a4 = *(const float4*)(ap + t);
        const uint2 b4 = *(const uint2*)(bp + t);
        if (dir == 0) {
          h = a4.x * h + lo2f(b4.x); hp[(t + 0) * 128] = f2bf(h);
          h = a4.y * h + hi2f(b4.x); hp[(t + 1) * 128] = f2bf(h);
          h = a4.z * h + lo2f(b4.y); hp[(t + 2) * 128] = f2bf(h);
          h = a4.w * h + hi2f(b4.y); hp[(t + 3) * 128] = f2bf(h);
        } else {
          h = a4.w * h + hi2f(b4.y); hp[(t + 3) * 128] = f2bf(h);
          h = a4.z * h + lo2f(b4.y); hp[(t + 2) * 128] = f2bf(h);
          h = a4.y * h + hi2f(b4.x); hp[(t + 1) * 128] = f2bf(h);
          h = a4.x * h + lo2f(b4.x); hp[(t + 0) * 128] = f2bf(h);
        }
      }
    }
    __syncthreads();
    const int len_ = seq == 0 ? 256 : 128;
    const int ppos = len_ - 1 - pos;
    if (pos < ppos) {
#pragma unroll
      for (int cch = 0; cch < 4; ++cch) {
        int chunk = tid + cch * 256;
        int t = chunk >> 4, cc = (chunk & 15) * 8;
        unsigned off = (unsigned)(g0 + t) * D + head * 128 + cc;
        uint4 hv = *(const uint4*)(sBh + t * 128 + cc);
        unsigned long long* q = (unsigned long long*)(hown + off);
        lb_st64(q, (unsigned long long)hv.x | ((unsigned long long)hv.y << 32));
        lb_st64(q + 1, (unsigned long long)hv.z | ((unsigned long long)hv.w << 32));
      }
      asm volatile("s_waitcnt vmcnt(0)" ::: "memory");
      __syncthreads();
      if (tid == 0) lb_st32(stat + item, (unsigned)l + 1u);
    } else {
      const int pit = lb_rank(seq, ppos) * 16 + (hd ^ 1);
      unsigned spins = 0;
      while (lb_ld32(stat + pit) != (unsigned)l + 1u) { __builtin_amdgcn_s_sleep(1); if (++spins > (1u << 18)) break; }
#pragma unroll
      for (int cch = 0; cch < 4; ++cch) {
        int chunk = tid + cch * 256;
        int t = chunk >> 4, cc = (chunk & 15) * 8;
        unsigned off = (unsigned)(g0 + t) * D + head * 128 + cc;
        uint4 hv = *(const uint4*)(sBh + t * 128 + cc);
        const unsigned long long* q = (const unsigned long long*)(hoth + off);
        unsigned long long f0 = lb_ld64(q), f1 = lb_ld64(q + 1);
        uint4 fv = make_uint4((unsigned)f0, (unsigned)(f0 >> 32), (unsigned)f1, (unsigned)(f1 >> 32));
        uint4 gv = *(const uint4*)(ga + off);
        uint4 o;
        o.x = pack2((lo2f(fv.x) + lo2f(hv.x)) * lo2f(gv.x), (hi2f(fv.x) + hi2f(hv.x)) * hi2f(gv.x));
        o.y = pack2((lo2f(fv.y) + lo2f(hv.y)) * lo2f(gv.y), (hi2f(fv.y) + hi2f(hv.y)) * hi2f(gv.y));
        o.z = pack2((lo2f(fv.z) + lo2f(hv.z)) * lo2f(gv.z), (hi2f(fv.z) + hi2f(hv.z)) * hi2f(gv.z));
        o.w = pack2((lo2f(fv.w) + lo2f(hv.w)) * lo2f(gv.w), (hi2f(fv.w) + hi2f(hv.w)) * hi2f(gv.w));
        *(uint4*)(ga + off) = o;
      }
    }
    __syncthreads();
  }
#undef LOAD_XROWS
}

DEVFN void phase_carry(const Params& p) {
  const float2* __restrict__ agg = (const float2*)U(p, 4);
  float* __restrict__ carry = (float*)(agg + 1280L * 2 * 1024);
  const int lane = threadIdx.x & 63, w = threadIdx.x >> 6;
  for (int u = blockIdx.x + gridDim.x * w; u < 288; u += gridDim.x * 4) {
    int id = u * 64 + lane;
    int seq = id >> 11, dir = (id >> 10) & 1, c = id & 1023;
    int nt = seq_len(seq) >> 6, tile0 = seq_start(seq) >> 6;
    float h = 0.f;
#pragma unroll 8
    for (int k = 0; k < nt; ++k) {
      int tt = tile0 + (dir ? nt - 1 - k : k);
      unsigned ix = (unsigned)(tt * 2 + dir) * 1024 + c;
      float2 v = agg[ix];
      carry[ix] = h;
      h = v.x * h + v.y;
    }
  }
}

DEVFN void phase_merge(const Params& p, int l, u16* smem) {
  const u16* wl = WL(p, l);
  u16* mo = U(p, 1);
  u16* tb = U(p, 5);
  u16* so = smem;
  for (int it = 0;; ++it) {
    int mt, nt;
    if (!tile_xcd(it, 1, 8, mt, nt)) break;
    const int g0 = mt * 256;
#pragma unroll 1
    for (int br = 0; br < 2; ++br) {
      {
        const int tid = otid(), lane = tid & 63, w = tid >> 6, wm = w >> 1, wn = w & 1, lr = lane & 15, quad = lane >> 4;
        f32x4 acc[8][4]; zero_acc8(acc);
        LdPlain lb; lb.init(tid, wl + (br == 0 ? W_A : W_B), nt * 128, D);
        if (br == 0) {
          LdPlain la; la.init(tid, U(p, 2), g0, D);
          gemm_core_b(tid, acc, 32, la, lb, smem);
        } else {
          const int seq = seq_of(g0);
          LdPerm la; la.base = U(p, 3); la.g0 = g0; la.sst = seq_start(seq); la.lg = seq == 0 ? 7 : 6;
          gemm_core_b(tid, acc, 32, la, lb, smem);
        }
#pragma unroll
        for (int i = 0; i < 8; ++i) {
          const int m = wm * 128 + i * 16 + lr;
#pragma unroll
          for (int j = 0; j < 4; ++j) {
            const int n = wn * 64 + j * 16 + quad * 4;
            uint2 o; o.x = pack2(acc[i][j][0], acc[i][j][1]); o.y = pack2(acc[i][j][2], acc[i][j][3]);
            *(uint2*)(so + m * 136 + n) = o;
          }
        }
        __syncthreads();
#pragma unroll
        for (int c = 0; c < 16; ++c) {
          const int idx = tid + c * 256;
          const int row = idx >> 4, ch = idx & 15;
          *(uint4*)(tb + ((unsigned)(g0 + row) * D + nt * 128 + ch * 8)) = *(const uint4*)(so + row * 136 + ch * 8);
        }
        __syncthreads();
      }
      {
        const int tid = otid(), lane = tid & 63, w = tid >> 6, wm = w >> 1, wn = w & 1, lr = lane & 15, quad = lane >> 4;
        f32x4 acc[8][4]; zero_acc8(acc);
        LdPlain la; la.init(tid, U(p, 0), g0, D);
        LdPlain lb; lb.init(tid, wl + W_CAT, 5120 + br * 1024 + nt * 128, D);
        gemm_core_b(tid, acc, 32, la, lb, smem);
#pragma unroll
        for (int c = 0; c < 16; ++c) {
          const int idx = tid + c * 256;
          const int row = idx >> 4, ch = idx & 15;
          *(uint4*)(so + row * 136 + ch * 8) = *(const uint4*)(tb + ((unsigned)(g0 + row) * D + nt * 128 + ch * 8));
        }
        __syncthreads();
#pragma unroll
        for (int i = 0; i < 8; ++i) {
          const int m = wm * 128 + i * 16 + lr;
#pragma unroll
          for (int j = 0; j < 4; ++j) {
            const int n = wn * 64 + j * 16 + quad * 4;
            uint2 tv = *(const uint2*)(so + m * 136 + n);
            acc[i][j][0] = sigm(acc[i][j][0]) * lo2f(tv.x);
            acc[i][j][1] = sigm(acc[i][j][1]) * hi2f(tv.x);
            acc[i][j][2] = sigm(acc[i][j][2]) * lo2f(tv.y);
            acc[i][j][3] = sigm(acc[i][j][3]) * hi2f(tv.y);
          }
        }
        if (br == 1) {
          __syncthreads();
#pragma unroll
          for (int c = 0; c < 16; ++c) {
            const int idx = tid + c * 256;
            const int row = idx >> 4, ch = idx & 15;
            *(uint4*)(so + row * 136 + ch * 8) = *(const uint4*)(mo + ((unsigned)(g0 + row) * D + nt * 128 + ch * 8));
          }
          __syncthreads();
#pragma unroll
          for (int i = 0; i < 8; ++i) {
            const int m = wm * 128 + i * 16 + lr;
#pragma unroll
            for (int j = 0; j < 4; ++j) {
              const int n = wn * 64 + j * 16 + quad * 4;
              uint2 pv = *(const uint2*)(so + m * 136 + n);
              acc[i][j][0] += lo2f(pv.x); acc[i][j][1] += hi2f(pv.x);
              acc[i][j][2] += lo2f(pv.y); acc[i][j][3] += hi2f(pv.y);
            }
          }
        }
        __syncthreads();
#pragma unroll
        for (int i = 0; i < 8; ++i) {
          const int m = wm * 128 + i * 16 + lr;
#pragma unroll
          for (int j = 0; j < 4; ++j) {
            const int n = wn * 64 + j * 16 + quad * 4;
            uint2 o; o.x = pack2(acc[i][j][0], acc[i][j][1]); o.y = pack2(acc[i][j][2], acc[i][j][3]);
            *(uint2*)(so + m * 136 + n) = o;
          }
        }
        __syncthreads();
#pragma unroll
        for (int c = 0; c < 16; ++c) {
          const int idx = tid + c * 256;
          const int row = idx >> 4, ch = idx & 15;
          *(uint4*)(mo + ((unsigned)(g0 + row) * D + nt * 128 + ch * 8)) = *(const uint4*)(so + row * 136 + ch * 8);
        }
        __syncthreads();
      }
    }
  }
}

DEVFN void phase_out(const Params& p, int l, u16* smem) {
  const u16* wo = WL(p, l) + W_O;
  for (int it = 0;; ++it) {
    int mt, nt;
    if (!tile_xcd(it, 1, 8, mt, nt)) break;
    const int tid = otid(), lane = tid & 63, w = tid >> 6, wm = w >> 1, wn = w & 1, lr = lane & 15, quad = lane >> 4;
    const int g0 = mt * 256;
    LdPlain la; la.init(tid, U(p, 1), g0, D);
    LdPlain lb; lb.init(tid, wo, nt * 128, D);
    f32x4 acc[8][4]; zero_acc8(acc);
    gemm_core_b(tid, acc, 32, la, lb, smem);
    const float* gate = MOD(p) + ((long)l * 9 + seq_of(g0)) * 3072 + 2048;
#pragma unroll
    for (int i = 0; i < 8; ++i) {
      unsigned g = g0 + wm * 128 + i * 16 + lr;
      const float* xb = (l == 0) ? (g0 < 16384 ? p.x_prompt : p.x_sample) : p.out;
      const float* xr = xb + (unsigned)((l == 0 && g0 >= 16384) ? g - 16384 : g) * D;
      float* orow = p.out + g * D;
#pragma unroll
      for (int j = 0; j < 4; ++j) {
        unsigned c = nt * 128 + wn * 64 + j * 16 + quad * 4;
        float4 xv = *(const float4*)(xr + c);
        float4 gt = *(const float4*)(gate + c);
        float4 o;
        o.x = xv.x + gt.x * acc[i][j][0]; o.y = xv.y + gt.y * acc[i][j][1];
        o.z = xv.z + gt.z * acc[i][j][2]; o.w = xv.w + gt.w * acc[i][j][3];
        *(float4*)(orow + c) = o;
      }
    }
  }
}

#define XB_TMO      128
#define XB_XCNT(j)  (256  + 64 * (j))
#define XB_XSUB(j)  (1280 + 64 * (j))
#define XB_XGEN(j)  (2304 + 64 * (j))
#define XB_TOP      3328
#define XB_TOPGEN   3392
#define XCD_BAR_WORDS 3456
#define XB_SPIN_CAP (1u << 18)
#define LAS __attribute__((address_space(3)))

__device__ __forceinline__ unsigned xb_ld(unsigned* p)              { return __hip_atomic_load(p, __ATOMIC_RELAXED, __HIP_MEMORY_SCOPE_AGENT); }
__device__ __forceinline__ unsigned xb_add(unsigned* p, unsigned v) { return __hip_atomic_fetch_add(p, v, __ATOMIC_RELAXED, __HIP_MEMORY_SCOPE_AGENT); }
__device__ __forceinline__ unsigned xb_xcc_id() { return (unsigned)__builtin_amdgcn_s_getreg((3 << 11) | 20) & 0xFu; }
#define XB_SPIN(cond, bar) do { unsigned _sp = 0; while (cond) { __builtin_amdgcn_s_sleep(1); \
    if ((++_sp & 255u) == 0u) { if (xb_ld(&(bar)[XB_TMO])) break; if (_sp > XB_SPIN_CAP) { atomicAdd(&(bar)[XB_TMO], 1u); break; } } } } while (0)

struct XcdBarrier {
    unsigned* bar; unsigned x;
    volatile LAS unsigned* st;
};

__device__ __forceinline__ XcdBarrier xcd_barrier_post(unsigned* bar, volatile LAS unsigned* st) {
    XcdBarrier b; b.bar = bar; b.x = xb_xcc_id(); b.st = st;
    if (threadIdx.x == 0) (void)xb_add(&bar[XB_XCNT(b.x)], 1u);
    return b;
}
__device__ __forceinline__ void xcd_barrier_complete(unsigned* bar, unsigned x, unsigned& nloc, unsigned& nx) {
    const unsigned G = gridDim.x * gridDim.y * gridDim.z;
    unsigned sum, cnt, mine, sp = 0u;
    for (;;) {
        sum = 0u; cnt = 0u; mine = 0u;
#pragma unroll
        for (unsigned j = 0; j < 16; ++j) { const unsigned c = xb_ld(&bar[XB_XCNT(j)]); sum += c; cnt += (c > 0u) ? 1u : 0u; mine = (j == x) ? c : mine; }
        if (sum == G) break;
        __builtin_amdgcn_s_sleep(1);
        if ((++sp & 255u) == 0u) { if (xb_ld(&bar[XB_TMO])) break; if (sp > XB_SPIN_CAP) { atomicAdd(&bar[XB_TMO], 1u); break; } }
    }
    nloc = mine > 0u ? mine : 1u; nx = cnt > 0u ? cnt : 1u;
}

__device__ __forceinline__ void xcd_barrier(const XcdBarrier& b) {
    asm volatile("s_waitcnt vmcnt(0)" ::: "memory");
    __syncthreads();
    if (threadIdx.x == 0) {
        unsigned* bar = b.bar;
        __builtin_amdgcn_s_waitcnt(0);
        unsigned nloc = b.st[0], nx = b.st[1];
        if (nloc == 0u) { xcd_barrier_complete(bar, b.x, nloc, nx); b.st[0] = nloc; b.st[1] = nx; }
        const unsigned old = xb_add(&bar[XB_XSUB(b.x)], 1u);
        const unsigned gen = old / nloc;
        if (old + 1u == (gen + 1u) * nloc) {
            __builtin_amdgcn_fence(__ATOMIC_RELEASE, "agent");
            asm volatile("s_waitcnt vmcnt(0)" ::: "memory");
            const unsigned og = xb_add(&bar[XB_TOP], 1u);
            const unsigned tg = og / nx;
            if (og + 1u == (tg + 1u) * nx) xb_add(&bar[XB_TOPGEN], 1u);
            else XB_SPIN(xb_ld(&bar[XB_TOPGEN]) == tg, bar);
            __builtin_amdgcn_fence(__ATOMIC_ACQUIRE, "agent");
            xb_add(&bar[XB_XGEN(b.x)], 1u);
            asm volatile("s_waitcnt vmcnt(0)" ::: "memory");
        } else {
            XB_SPIN(xb_ld(&bar[XB_XGEN(b.x)]) == gen, bar);
            __builtin_amdgcn_fence(__ATOMIC_ACQUIRE, "agent");
            asm volatile("s_waitcnt vmcnt(0)" ::: "memory");
        }
    }
    __syncthreads();
}


__global__ void __launch_bounds__(256, 2) hawk_fnet_megakernel(Params p) {
  extern __shared__ __attribute__((aligned(16))) unsigned char smem_raw[];
  cg::grid_group grid = cg::this_grid();
  u16* smem = (u16*)smem_raw;

  __shared__ unsigned xb_st[4];
  unsigned* bar = (unsigned*)(p.ws + OFF_BAR_BYTES);
  if (blockIdx.x == 0) {
    for (int i = threadIdx.x; i < XCD_BAR_WORDS; i += 256) __hip_atomic_store(&bar[i], 0u, __ATOMIC_RELAXED, __HIP_MEMORY_SCOPE_AGENT);
  }
  if (threadIdx.x < 4) xb_st[threadIdx.x] = 0u;
  {
    unsigned* lbs = (unsigned*)(p.ws + OFF_LB_BYTES + LB_SLOT_BYTES);
    for (int i = blockIdx.x * 256 + threadIdx.x; i < 20480 + 10240; i += gridDim.x * 256)
      __hip_atomic_store(&lbs[i], 0u, __ATOMIC_RELAXED, __HIP_MEMORY_SCOPE_AGENT);
    unsigned long long* lbq = (unsigned long long*)(p.ws + OFF_LB_BYTES);
    for (int i = blockIdx.x * 256 + threadIdx.x; i < (int)(LB_SLOT_BYTES / 8); i += gridDim.x * 256)
      __hip_atomic_store(&lbq[i], 0ull, __ATOMIC_RELAXED, __HIP_MEMORY_SCOPE_AGENT);
  }
  phase_prologue(p, smem_raw);
  grid.sync();
  XcdBarrier xb = xcd_barrier_post(bar, (volatile LAS unsigned*)xb_st);
  phase_fold(p, smem);
  phase_h(p, 0);
  xcd_barrier(xb);
  for (int l = 0; l < 2; ++l) {
    phase_gemm1(p, l, smem);
    xcd_barrier(xb);
    phase_fft1(p, smem);
    xcd_barrier(xb);
    phase_fft2(p, smem);
    xcd_barrier(xb);
    phase_scan_lb(p, l, smem_raw);
    xcd_barrier(xb);
    phase_merge(p, l, smem);
    xcd_barrier(xb);
    phase_out(p, l, smem);
    xcd_barrier(xb);
    if (l == 0) { phase_h(p, 1); xcd_barrier(xb); }
  }
  phase_final(p);
}

extern "C" void kernel_launch(void* const* d_in, const int* in_sizes, int n_in,
                              void* d_out, int out_size, void* d_ws, size_t ws_size,
                              hipStream_t stream) {
  (void)in_sizes; (void)n_in; (void)out_size;
  if (ws_size < (size_t)WS_NEED) {
    fprintf(stderr, "workspace too small: %zu < %ld\n", ws_size, (long)WS_NEED);
    return;
  }
  static int grid_blocks = 0;
  if (!grid_blocks) {
    hipFuncSetAttribute((const void*)hawk_fnet_megakernel, hipFuncAttributeMaxDynamicSharedMemorySize, SMEM_BYTES);
    int dev = 0, cus = 0, per_cu = 0;
    hipGetDevice(&dev);
    hipDeviceGetAttribute(&cus, hipDeviceAttributeMultiprocessorCount, dev);
    hipOccupancyMaxActiveBlocksPerMultiprocessor(&per_cu, hawk_fnet_megakernel, 256, SMEM_BYTES);
    if (per_cu > 2) per_cu = 2;
    if (per_cu < 1) per_cu = 1;
    grid_blocks = (cus * per_cu) & ~15;
  }
  Params p{};
  p.x_prompt = (const float*)d_in[0]; p.x_sample = (const float*)d_in[1];
  p.c_prompt = (const float*)d_in[2]; p.c_sample = (const float*)d_in[3];
  p.norm_g = (const float*)d_in[4]; p.w_ada = (const float*)d_in[5]; p.b_ada = (const float*)d_in[6];
  p.w_in = (const float*)d_in[7]; p.conv_w = (const float*)d_in[8]; p.conv_b = (const float*)d_in[9];
  p.w_rg = (const float*)d_in[10]; p.b_rg = (const float*)d_in[11]; p.lam = (const float*)d_in[12];
  p.w_a_out = (const float*)d_in[13]; p.w_b_out = (const float*)d_in[14]; p.w_o = (const float*)d_in[15];
  p.final_g = (const float*)d_in[16];
  p.out = (float*)d_out; p.ws = (unsigned char*)d_ws;
  void* args[] = {&p};
  hipError_t e = hipLaunchCooperativeKernel((void*)hawk_fnet_megakernel, dim3(grid_blocks), dim3(256), args, SMEM_BYTES, stream);
  if (e != hipSuccess) fprintf(stderr, "cooperative launch failed: %s (grid %d)\n", hipGetErrorString(e), grid_blocks);
}
```

```cpp
#include <hip/hip_runtime.h>
#include <hip/hip_cooperative_groups.h>
#include <cstdio>
namespace cg = cooperative_groups;

typedef unsigned short u16;
typedef __attribute__((ext_vector_type(8))) short bf16x8;
typedef __attribute__((ext_vector_type(4))) float f32x4;

#define DEVFN __device__ __forceinline__

constexpr int D = 1024;
constexpr int T_TOT = 81920;
constexpr long UNIT = (long)T_TOT * D;
constexpr int D_IN = 6144;

constexpr long OFF_W = 6 * UNIT;
constexpr long W_CAT = 0;
constexpr long W_A = 7168L * 1024;
constexpr long W_B = W_A + 1048576;
constexpr long W_O = W_B + 1048576;
constexpr long W_RG = W_O + 1048576;
constexpr long LW = W_RG + 524288;
constexpr long OFF_TAB = OFF_W + 2 * LW;
constexpr long T_D1A = 0;
constexpr long T_D1B = 65536;
constexpr long T_D2 = T_D1B + 16384;
constexpr long T_DC = T_D2 + 32768;
constexpr long TAB_ELEMS = T_DC + 131072;
constexpr long OFF_TW_BYTES = (OFF_TAB + TAB_ELEMS) * 2;
constexpr long OFF_MOD_BYTES = OFF_TW_BYTES + 131072;
constexpr long OFF_BAR_BYTES = OFF_MOD_BYTES + 221184;
constexpr long OFF_LB_BYTES = OFF_BAR_BYTES + 16384;
constexpr long LB_SLOT_BYTES = 20480L * 128 * 8;
constexpr long WS_NEED = OFF_LB_BYTES + LB_SLOT_BYTES + 20480 * 4 + 10240 * 4;
static_assert(WS_NEED <= (1L << 30), "workspace map exceeds the guaranteed 1 GiB");

constexpr int TILE = 128 * 64;
constexpr int SMEM_BYTES = 75776;

struct Params {
  const float* x_prompt; const float* x_sample; const float* c_prompt; const float* c_sample;
  const float* norm_g; const float* w_ada; const float* b_ada; const float* w_in;
  const float* conv_w; const float* conv_b; const float* w_rg; const float* b_rg; const float* lam;
  const float* w_a_out; const float* w_b_out; const float* w_o; const float* final_g;
  float* out; unsigned char* ws;
};

typedef __attribute__((ext_vector_type(2))) float f32x2_t;
typedef __attribute__((ext_vector_type(2))) __bf16 bf16x2_t;
DEVFN u16 f2bf(float f) {
  __bf16 h = (__bf16)f;
  return *(u16*)&h;
}
DEVFN float bf2f(u16 h) { return __uint_as_float(((unsigned)h) << 16); }
DEVFN unsigned pack2(float a, float b) {
  f32x2_t v = {a, b};
  bf16x2_t r = __builtin_convertvector(v, bf16x2_t);
  return *(unsigned*)&r;
}
DEVFN float lo2f(unsigned v) { return __uint_as_float(v << 16); }
DEVFN float hi2f(unsigned v) { return __uint_as_float(v & 0xffff0000u); }
DEVFN float sigm(float x) { return __builtin_amdgcn_rcpf(1.f + __expf(-x)); }
DEVFN float silu(float x) { return x * __builtin_amdgcn_rcpf(1.f + __expf(-x)); }
DEVFN float one_minus_exp(float x) {
  float pl = -x * (1.f + x * (0.5f + x * (1.f / 6.f + x * (1.f / 24.f + x * (1.f / 120.f + x * (1.f / 720.f))))));
  float dr = 1.f - __expf(x);
  return x > -0.3f ? pl : dr;
}

DEVFN int otid() { int t = threadIdx.x; asm volatile("" : "+v"(t)); return t; }
DEVFN int seq_of(int g) { int seg = g >> 13; return seg < 2 ? 0 : seg - 1; }
DEVFN int seq_start(int s) { return s == 0 ? 0 : 16384 + (s - 1) * 8192; }
DEVFN int seq_len(int s) { return s == 0 ? 16384 : 8192; }

DEVFN u16* U(const Params& p, int i) { return (u16*)(p.ws) + (long)i * UNIT; }
DEVFN u16* WL(const Params& p, int l) { return (u16*)(p.ws) + OFF_W + (long)l * LW; }
DEVFN u16* TAB(const Params& p) { return (u16*)(p.ws) + OFF_TAB; }
DEVFN float2* TW(const Params& p) { return (float2*)(p.ws + OFF_TW_BYTES); }
DEVFN float* MOD(const Params& p) { return (float*)(p.ws + OFF_MOD_BYTES); }
DEVFN const float* xrow(const Params& p, int g) {
  return g < 16384 ? p.x_prompt + (long)g * D : p.x_sample + (long)(g - 16384) * D;
}

struct LdPlain {
  static constexpr bool kDma = true; static constexpr bool kTr = false;
  const u16* base; unsigned off0; unsigned cst; int t_; unsigned row0_, stride_;
  DEVFN unsigned rowoff(int r) const { return (row0_ + r) * stride_; }
  DEVFN void init(int tid_, const u16* b, unsigned row0, unsigned stride) {
    unsigned tid = tid_; t_ = tid_; row0_ = row0; stride_ = stride;
    base = b;
    off0 = (row0 + (tid >> 3)) * stride + (((tid & 7) ^ ((tid >> 3) & 7)) << 3);
    cst = 32 * stride;
  }
  DEVFN void issue(u16* tile, int c, int kt) const {
    __builtin_amdgcn_global_load_lds((const unsigned*)(base + (off0 + c * cst + kt * 64)),
                                     (unsigned*)(tile + (t_ + c * 256) * 8), 16, 0, 0);
  }
  DEVFN uint4 load(int, int) const { return make_uint4(0, 0, 0, 0); }
  DEVFN void store(u16*, int, uint4) const {}
};
struct LdRows4 {
  static constexpr bool kDma = true; static constexpr bool kTr = false;
  const u16* base; unsigned off[4]; int t_;
  DEVFN void issue(u16* tile, int c, int kt) const {
    __builtin_amdgcn_global_load_lds((const unsigned*)(base + (off[c] + kt * 64)),
                                     (unsigned*)(tile + (t_ + c * 256) * 8), 16, 0, 0);
  }
  DEVFN uint4 load(int, int) const { return make_uint4(0, 0, 0, 0); }
  DEVFN void store(u16*, int, uint4) const {}
};
struct LdF32 {
  static constexpr bool kDma = false; static constexpr bool kTr = false;
  const float* base; unsigned off0; unsigned cst; int t_;
  DEVFN void init(int tid_, const float* b, unsigned row0, unsigned stride, unsigned col0) {
    unsigned tid = tid_; t_ = tid_;
    base = b;
    off0 = (row0 + (tid >> 3)) * stride + col0 + (tid & 7) * 8;
    cst = 32 * stride;
  }
  DEVFN void issue(u16*, int, int) const {}
  DEVFN uint4 load(int c, int kt) const {
    const float4* q = (const float4*)(base + (off0 + c * cst + kt * 64));
    float4 a = q[0], b = q[1];
    uint4 r; r.x = pack2(a.x, a.y); r.y = pack2(a.z, a.w); r.z = pack2(b.x, b.y); r.w = pack2(b.z, b.w);
    return r;
  }
  DEVFN void store(u16* tile, int c, uint4 v) const {
    int idx = t_ + c * 256;
    int row = idx >> 3, kc = idx & 7;
    *(uint4*)(tile + row * 64 + ((kc ^ (row & 7)) << 3)) = v;
  }
};
DEVFN int trf(int r) { return ((r & 3) << 2) | ((r >> 2) & 3); }
template <class TokFn>
struct LdTrans {
  static constexpr bool kDma = false; static constexpr bool kTr = false;
  TokFn tok; int t_;
  DEVFN void issue(u16*, int, int) const {}
  DEVFN uint4 load(int c, int kt) const {
    int idx = t_ + c * 256;
    int kk = idx & 63, cc = idx >> 6;
    const u16* b; unsigned o = tok(kt * 64 + kk, b);
    return *(const uint4*)(b + (o + cc * 8));
  }
  DEVFN void store(u16* tile, int c, uint4 v) const {
    int idx = t_ + c * 256;
    int kk = idx & 63, cc = idx >> 6;
    u16* q = tile + (cc * 8) * 64 + (kk & 7);
    int kc = kk >> 3;
    q[0 * 64 + ((kc ^ 0) << 3)] = (u16)(v.x & 0xffff); q[1 * 64 + ((kc ^ 1) << 3)] = (u16)(v.x >> 16);
    q[2 * 64 + ((kc ^ 2) << 3)] = (u16)(v.y & 0xffff); q[3 * 64 + ((kc ^ 3) << 3)] = (u16)(v.y >> 16);
    q[4 * 64 + ((kc ^ 4) << 3)] = (u16)(v.z & 0xffff); q[5 * 64 + ((kc ^ 5) << 3)] = (u16)(v.z >> 16);
    q[6 * 64 + ((kc ^ 6) << 3)] = (u16)(v.w & 0xffff); q[7 * 64 + ((kc ^ 7) << 3)] = (u16)(v.w >> 16);
  }
};

typedef __attribute__((ext_vector_type(4))) short s16x4;
DEVFN s16x4 lds_tr_read(const u16* q) {
  return __builtin_amdgcn_ds_read_tr16_b64_v4i16((s16x4 __attribute__((address_space(3)))*)(q));
}

DEVFN void zero_acc(f32x4 (&acc)[4][4]) {
#pragma unroll
  for (int i = 0; i < 4; ++i)
#pragma unroll
    for (int j = 0; j < 4; ++j) acc[i][j] = f32x4{0.f, 0.f, 0.f, 0.f};
}

template <class LA, class LB>
DEVFN void gemm_core(int tid, f32x4 (&acc)[4][4], int nk, const LA& la, const LB& lb, u16* smem) {
  const int lane = tid & 63, w = tid >> 6, wm = w >> 1, wn = w & 1;
  const int lr = lane & 15, quad = lane >> 4;
  uint4 ra[4], rb[4];
  if (LA::kDma) {
#pragma unroll
    for (int c = 0; c < 4; ++c) la.issue(smem, c, 0);
  } else {
#pragma unroll
    for (int c = 0; c < 4; ++c) ra[c] = la.load(c, 0);
  }
  if (LB::kDma) {
#pragma unroll
    for (int c = 0; c < 4; ++c) lb.issue(smem + TILE, c, 0);
  } else {
#pragma unroll
    for (int c = 0; c < 4; ++c) rb[c] = lb.load(c, 0);
  }
  if (!LA::kDma) {
#pragma unroll
    for (int c = 0; c < 4; ++c) la.store(smem, c, ra[c]);
  }
  if (!LB::kDma) {
#pragma unroll
    for (int c = 0; c < 4; ++c) lb.store(smem + TILE, c, rb[c]);
  }
  asm volatile("s_waitcnt vmcnt(0)" ::: "memory");
  __syncthreads();
  const int aoff = (wm * 64 + lr) * 64, boff = (wn * 64 + lr) * 64;
  const int sw0 = ((quad) ^ (lr & 7)) << 3, sw1 = ((4 + quad) ^ (lr & 7)) << 3;
  int troff[4][2];
  if (LB::kTr) {
    const int q = lr >> 2, pp = lr & 3;
#pragma unroll
    for (int j = 0; j < 4; ++j)
#pragma unroll
      for (int h = 0; h < 2; ++h) {
        int r = quad * 8 + h * 4 + q;
        int ch = (wn * 8 + j * 2 + (pp >> 1)) ^ trf(r);
        troff[j][h] = r * 128 + ch * 8 + (pp & 1) * 4;
      }
  }
  for (int kt = 0; kt < nk; ++kt) {
    const u16* sA = smem + (kt & 1) * 2 * TILE;
    const u16* sB = sA + TILE;
    u16* nA = smem + ((kt + 1) & 1) * 2 * TILE;
    const bool more = (kt + 1) < nk;
    if (more) {
      if (LA::kDma) {
#pragma unroll
        for (int c = 0; c < 4; ++c) la.issue(nA, c, kt + 1);
      } else {
#pragma unroll
        for (int c = 0; c < 4; ++c) ra[c] = la.load(c, kt + 1);
      }
      if (LB::kDma) {
#pragma unroll
        for (int c = 0; c < 4; ++c) lb.issue(nA + TILE, c, kt + 1);
      } else {
#pragma unroll
        for (int c = 0; c < 4; ++c) rb[c] = lb.load(c, kt + 1);
      }
    }
#pragma unroll
    for (int ks = 0; ks < 2; ++ks) {
      const int sw = ks == 0 ? sw0 : sw1;
      bf16x8 af[4], bfr[4];
#pragma unroll
      for (int i = 0; i < 4; ++i) af[i] = *(const bf16x8*)(sA + aoff + i * 1024 + sw);
      if (LB::kTr) {
#pragma unroll
        for (int j = 0; j < 4; ++j) {
          s16x4 lo = lds_tr_read(sB + troff[j][0] + ks * 4096);
          s16x4 hi = lds_tr_read(sB + troff[j][1] + ks * 4096);
          bfr[j] = __builtin_shufflevector(lo, hi, 0, 1, 2, 3, 4, 5, 6, 7);
        }
      } else {
#pragma unroll
        for (int j = 0; j < 4; ++j) bfr[j] = *(const bf16x8*)(sB + boff + j * 1024 + sw);
      }
      __builtin_amdgcn_s_setprio(1);
#pragma unroll
      for (int i = 0; i < 4; ++i)
#pragma unroll
        for (int j = 0; j < 4; ++j)
          acc[i][j] = __builtin_amdgcn_mfma_f32_16x16x32_bf16(bfr[j], af[i], acc[i][j], 0, 0, 0);
      __builtin_amdgcn_s_setprio(0);
    }
    if (more) {
      if (!LA::kDma) {
#pragma unroll
        for (int c = 0; c < 4; ++c) la.store(nA, c, ra[c]);
      }
      if (!LB::kDma) {
#pragma unroll
        for (int c = 0; c < 4; ++c) lb.store(nA + TILE, c, rb[c]);
      }
    }
    asm volatile("s_waitcnt vmcnt(0)" ::: "memory");
    __syncthreads();
  }
}

struct LdPerm {
  const u16* base; int g0, sst, lg;
  DEVFN unsigned rowoff(int r) const {
    int t = g0 - sst + r;
    int urow = ((t & ((1 << lg) - 1)) << 7) + (t >> lg);
    return (unsigned)(sst + urow) * D;
  }
};
#define GLDS16(gp, lp) __builtin_amdgcn_global_load_lds((const unsigned*)(gp), (unsigned*)(lp), 16, 0, 0)
DEVFN void zero_acc8(f32x4 (&acc)[8][4]) {
#pragma unroll
  for (int i = 0; i < 8; ++i)
#pragma unroll
    for (int j = 0; j < 4; ++j) acc[i][j] = f32x4{0.f, 0.f, 0.f, 0.f};
}
template <class LA, class LB>
DEVFN void gemm_core_b(int tid, f32x4 (&acc)[8][4], int nk, const LA& la, const LB& lb, u16* smem) {
  const int lane = tid & 63, w = tid >> 6, wm = w >> 1, wn = w & 1;
  const int lr = lane & 15, quad = lane >> 4;
  const int r0 = tid >> 2;
  const unsigned sw = (unsigned)(((tid & 3) ^ ((0 - (tid >> 4)) & 3)) << 3);
  const unsigned oa0 = la.rowoff(r0) + sw, oa1 = la.rowoff(r0 + 64) + sw, oa2 = la.rowoff(r0 + 128) + sw, oa3 = la.rowoff(r0 + 192) + sw;
  const unsigned ob0 = lb.rowoff(r0) + sw, ob1 = lb.rowoff(r0 + 64) + sw;
  const u16* ga = la.base; const u16* gb = lb.base;
  u16* l0 = smem + tid * 8;
#define ISSUE_STAGE(st, kt) do { u16* _s = l0 + (st) * 12288; unsigned _k = (unsigned)(kt) * 32u; \
    GLDS16(ga + (oa0 + _k), _s); GLDS16(ga + (oa1 + _k), _s + 2048); GLDS16(ga + (oa2 + _k), _s + 4096); GLDS16(ga + (oa3 + _k), _s + 6144); \
    GLDS16(gb + (ob0 + _k), _s + 8192); GLDS16(gb + (ob1 + _k), _s + 10240); } while (0)
  asm volatile("s_waitcnt vmcnt(0)" ::: "memory");
  ISSUE_STAGE(0, 0);
  ISSUE_STAGE(1, 1);
  const int fsw = (quad ^ ((0 - (lr >> 2)) & 3)) << 3;
  const int aoff = (wm * 128 + lr) * 32 + fsw, boff = 8192 + (wn * 64 + lr) * 32 + fsw;
  int cur = 0, nxt = 2;
  for (int kt = 0; kt < nk; ++kt) {
    if (kt + 1 < nk) asm volatile("s_waitcnt vmcnt(6)" ::: "memory");
    else asm volatile("s_waitcnt vmcnt(0)" ::: "memory");
    __builtin_amdgcn_s_barrier();
    asm volatile("" ::: "memory");
    if (kt + 2 < nk) ISSUE_STAGE(nxt, kt + 2);
    const u16* sb = smem + cur * 12288;
    bf16x8 af[8], bfr[4];
#pragma unroll
    for (int j = 0; j < 4; ++j) bfr[j] = *(const bf16x8*)(sb + boff + j * 512);
#pragma unroll
    for (int i = 0; i < 8; ++i) af[i] = *(const bf16x8*)(sb + aoff + i * 512);
    __builtin_amdgcn_s_setprio(1);
#pragma unroll
    for (int i = 0; i < 8; ++i)
#pragma unroll
      for (int j = 0; j < 4; ++j)
        acc[i][j] = __builtin_amdgcn_mfma_f32_16x16x32_bf16(bfr[j], af[i], acc[i][j], 0, 0, 0);
    __builtin_amdgcn_s_setprio(0);
    cur = cur == 2 ? 0 : cur + 1;
    nxt = nxt == 2 ? 0 : nxt + 1;
  }
  asm volatile("s_waitcnt lgkmcnt(0)" ::: "memory");
  __builtin_amdgcn_s_barrier();
  asm volatile("" ::: "memory");
#undef ISSUE_STAGE
}

DEVFN bool tile_xcd(int it, int ngrp, int ntn, int& mt, int& nt) {
  const int G = gridDim.x, b = blockIdx.x;
  if (G == 512) {
    if (it >= 5 * ngrp) return false;
    int xcd = b & 7, loc = b >> 3;
    mt = xcd * 40 + (it / ngrp) * 8 + (loc >> 3);
    nt = (it % ngrp) * 8 + (loc & 7);
    return true;
  }
  int tile = b + it * G;
  if (tile >= 320 * ntn) return false;
  mt = tile / ntn; nt = tile % ntn;
  return true;
}

DEVFN void transpose_tile(const float* src, long ld, u16* dst, long ldd, float* sT) {
  const int tid = otid();
#pragma unroll
  for (int pss = 0; pss < 4; ++pss) {
    int kk = (tid >> 4) + pss * 16, n4 = (tid & 15) * 4;
    float4 v = *(const float4*)(src + (long)kk * ld + n4);
    sT[kk * 65 + n4 + 0] = v.x; sT[kk * 65 + n4 + 1] = v.y; sT[kk * 65 + n4 + 2] = v.z; sT[kk * 65 + n4 + 3] = v.w;
  }
  __syncthreads();
  {
    int n = tid >> 2, k0 = (tid & 3) * 16;
    unsigned o[8];
#pragma unroll
    for (int e = 0; e < 8; ++e) o[e] = pack2(sT[(k0 + 2 * e) * 65 + n], sT[(k0 + 2 * e + 1) * 65 + n]);
    uint4* q = (uint4*)(dst + (long)n * ldd + k0);
    q[0] = make_uint4(o[0], o[1], o[2], o[3]);
    q[1] = make_uint4(o[4], o[5], o[6], o[7]);
  }
  __syncthreads();
}

DEVFN void phase_prologue(const Params& p, unsigned char* smem_raw) {
  const int tid = otid();
  constexpr int NJ_TR = 4352, NJ_MOD = 384, NJ_TAB = 256;
  for (int job = blockIdx.x; job < NJ_TR + NJ_MOD + NJ_TAB; job += gridDim.x) {
    if (job < NJ_TR) {
      float* sT = (float*)smem_raw;
      int l = job / 2176, r = job % 2176;
      u16* wl = WL(p, l);
      if (r < 1280) {
        int kt = r / 80, ntile = r % 80;
        int orow = ntile * 64;
        int scol;
        if (orow < 2048) scol = orow; else { orow += 2048; scol = orow - 1024; }
        transpose_tile(p.w_in + (long)l * D * D_IN + (long)(kt * 64) * D_IN + scol, D_IN,
                       wl + W_CAT + (long)orow * D + kt * 64, D, sT);
      } else if (r < 2048) {
        int r2 = r - 1280, which = r2 >> 8, t = r2 & 255, kt = t >> 4, ntile = t & 15;
        const float* src = (which == 0 ? p.w_a_out : which == 1 ? p.w_b_out : p.w_o) + (long)l * 1048576;
        long doff = which == 0 ? W_A : which == 1 ? W_B : W_O;
        transpose_tile(src + (long)(kt * 64) * D + ntile * 64, D, wl + doff + (long)(ntile * 64) * D + kt * 64, D, sT);
      } else {
        int r3 = r - 2048, mat = r3 >> 2, t = r3 & 3, kt = t >> 1, ntile = t & 1;
        const float* src = p.w_rg + ((long)l * 32 + mat) * 16384;
        transpose_tile(src + (long)(kt * 64) * 128 + ntile * 64, 128,
                       wl + W_RG + (long)mat * 16384 + (long)(ntile * 64) * 128 + kt * 64, 128, sT);
      }
    } else if (job < NJ_TR + NJ_MOD) {
      int jm = job - NJ_TR, l = jm / 192, cgp = jm % 192;
      float* sc = (float*)smem_raw;
      float* red = sc + 9 * 1024;
      for (int i = tid; i < 9 * 1024; i += 256) {
        int s_ = i >> 10, k = i & 1023;
        float cv = s_ == 0 ? p.c_prompt[k] : p.c_sample[(s_ - 1) * 1024 + k];
        sc[i] = silu(cv);
      }
      __syncthreads();
      int col = cgp * 16 + (tid & 15), kq = tid >> 4;
      float a0 = 0, a1 = 0, a2 = 0, a3 = 0, a4 = 0, a5 = 0, a6 = 0, a7 = 0, a8 = 0;
      const float* wp = p.w_ada + (long)l * D * 3072 + col;
#pragma unroll 8
      for (int k = kq * 64; k < kq * 64 + 64; ++k) {
        float wv = wp[(long)k * 3072];
        a0 += sc[0 * 1024 + k] * wv; a1 += sc[1 * 1024 + k] * wv; a2 += sc[2 * 1024 + k] * wv;
        a3 += sc[3 * 1024 + k] * wv; a4 += sc[4 * 1024 + k] * wv; a5 += sc[5 * 1024 + k] * wv;
        a6 += sc[6 * 1024 + k] * wv; a7 += sc[7 * 1024 + k] * wv; a8 += sc[8 * 1024 + k] * wv;
      }
      float* rq = red + kq * 144 + (tid & 15);
      rq[0 * 16] = a0; rq[1 * 16] = a1; rq[2 * 16] = a2; rq[3 * 16] = a3; rq[4 * 16] = a4;
      rq[5 * 16] = a5; rq[6 * 16] = a6; rq[7 * 16] = a7; rq[8 * 16] = a8;
      __syncthreads();
      if (tid < 144) {
        int s_ = tid >> 4, cc = tid & 15;
        float v = 0.f;
#pragma unroll
        for (int q = 0; q < 16; ++q) v += red[q * 144 + tid];
        int cf = cgp * 16 + cc;
        MOD(p)[((long)l * 9 + s_) * 3072 + cf] = v + p.b_ada[l * 3072 + cf];
      }
      __syncthreads();
    } else {
      int jt = job - NJ_TR - NJ_MOD;
      u16* tab = TAB(p);
#pragma unroll
      for (int e4 = 0; e4 < 4; ++e4) {
        int e = jt * 1024 + e4 * 256 + tid;
        if (e < 65536) {
          int m = e >> 8, k = e & 255;
          int k1 = (m >> 5) * 16 + (m & 15), ro = (m >> 4) & 1, ri = k >> 7, s1 = k & 127;
          float x = 2.f * (float)((k1 * s1) & 127) / 128.f;
          float cs = cospif(x), sn = sinpif(x);
          float v = (ro == ri) ? cs : (ro == 0 ? sn : -sn);
          tab[T_D1A + e] = f2bf(v);
        } else if (e < 65536 + 16384) {
          int e2 = e - 65536;
          int m = e2 >> 7, k = e2 & 127;
          int k1 = (m >> 5) * 16 + (m & 15), ro = (m >> 4) & 1, ri = k >> 6, s1 = k & 63;
          float x = 2.f * (float)((k1 * s1) & 63) / 64.f;
          float cs = cospif(x), sn = sinpif(x);
          float v = (ro == ri) ? cs : (ro == 0 ? sn : -sn);
          tab[T_D1B + e2] = f2bf(v);
        } else if (e < 65536 + 16384 + 32768) {
          int e2 = e - 65536 - 16384;
          int k2 = e2 >> 8, k = e2 & 255, ri = k >> 7, s2 = k & 127;
          float x = 2.f * (float)((k2 * s2) & 127) / 128.f;
          float v = ri == 0 ? cospif(x) : sinpif(x);
          tab[T_D2 + e2] = f2bf(v);
        } else if (e < 65536 + 16384 + 32768 + 131072) {
          int e2 = e - 65536 - 16384 - 32768;
          int row = e2 >> 8, c = e2 & 255, ri = row >> 8, m = row & 255;
          float x = 2.f * (float)((m * c) & 255) / 256.f;
          float v = ri == 0 ? cospif(x) : -sinpif(x);
          tab[T_DC + e2] = f2bf(v);
        } else {
          int e2 = e - (65536 + 16384 + 32768 + 131072);
          if (e2 < 16384) {
            float x = 2.f * (float)e2 / 16384.f;
            TW(p)[e2] = make_float2(cospif(x), sinpif(x));
          }
        }
      }
    }
  }
}

DEVFN void phase_fold(const Params& p, u16* smem) {
  for (int tile = blockIdx.x; tile < 256; tile += gridDim.x) {
    const int tid = otid(), lane = tid & 63, w = tid >> 6, wm = w >> 1, wn = w & 1, lr = lane & 15, quad = lane >> 4;
    int l = tile >> 7, g = (tile >> 5) & 3, mt = (tile >> 3) & 3, nt = tile & 7;
    LdPlain la; la.init(tid, TAB(p) + T_DC, mt * 128, 256);
    LdF32 lb; lb.init(tid, p.w_in + (long)l * D * D_IN, nt * 128, D_IN, 2048 + g * 256);
    f32x4 acc[4][4]; zero_acc(acc);
    gemm_core(tid, acc, 4, la, lb, smem);
    int ri = mt >> 1;
    u16* wc = WL(p, l) + W_CAT;
#pragma unroll
    for (int i = 0; i < 4; ++i) {
      int mrow = (mt & 1) * 128 + wm * 64 + i * 16 + lr;
      unsigned orow = 2048 + ri * 1024 + g * 256 + mrow;
#pragma unroll
      for (int j = 0; j < 4; ++j) {
        int n = nt * 128 + wn * 64 + j * 16 + quad * 4;
        uint2 o; o.x = pack2(acc[i][j][0], acc[i][j][1]); o.y = pack2(acc[i][j][2], acc[i][j][3]);
        *(uint2*)(wc + orow * D + n) = o;
      }
    }
  }
}

DEVFN void phase_h(const Params& p, int l) {
  const int tid_ = otid();
  const int lane = tid_ & 63;
  const int wid = blockIdx.x * 4 + (tid_ >> 6), nw = gridDim.x * 4;
  const float* ng = p.norm_g + l * D;
  const float* modl = MOD(p) + (long)l * 9 * 3072;
  u16* H = U(p, 0);
  float4 v[4], vn[4], vm[4];
  auto ldrow = [&](int g, float4 (&dst)[4]) {
    const float* xb = (l == 0) ? (g < 16384 ? p.x_prompt : p.x_sample) : p.out;
    const unsigned xo = (unsigned)((l == 0 && g >= 16384) ? g - 16384 : g) * D;
#pragma unroll
    for (int i = 0; i < 4; ++i) dst[i] = *(const float4*)(xb + xo + i * 256 + lane * 4);
  };
  if (wid < T_TOT) ldrow(wid, v);
  if (wid + nw < T_TOT) ldrow(wid + nw, vn);
  for (int g = wid; g < T_TOT; g += nw) {
    if (g + 2 * nw < T_TOT) ldrow(g + 2 * nw, vm);
    const float* md = modl + seq_of(g) * 3072;
    float ss = 0.f;
#pragma unroll
    for (int i = 0; i < 4; ++i) ss += v[i].x * v[i].x + v[i].y * v[i].y + v[i].z * v[i].z + v[i].w * v[i].w;
#pragma unroll
    for (int o = 32; o >= 1; o >>= 1) ss += __shfl_xor(ss, o, 64);
    float rstd = rsqrtf(ss * (1.f / 1024.f) + 1e-6f);
#pragma unroll
    for (int i = 0; i < 4; ++i) {
      int c = i * 256 + lane * 4;
      float4 g4 = *(const float4*)(ng + c);
      float4 sh = *(const float4*)(md + c);
      float4 sc = *(const float4*)(md + 1024 + c);
      float h0 = v[i].x * rstd * g4.x * (1.f + sc.x) + sh.x;
      float h1 = v[i].y * rstd * g4.y * (1.f + sc.y) + sh.y;
      float h2 = v[i].z * rstd * g4.z * (1.f + sc.z) + sh.z;
      float h3 = v[i].w * rstd * g4.w * (1.f + sc.w) + sh.w;
      uint2 o; o.x = pack2(h0, h1); o.y = pack2(h2, h3);
      *(uint2*)(H + ((unsigned)g * D + c)) = o;
    }
#pragma unroll
    for (int i = 0; i < 4; ++i) { v[i] = vn[i]; vn[i] = vm[i]; }
  }
}

DEVFN void phase_final(const Params& p) {
  const int tid_ = otid();
  const int lane = tid_ & 63;
  const int wid = blockIdx.x * 4 + (tid_ >> 6), nw = gridDim.x * 4;
  float4 v[4], vn[4], vm[4];
  auto ldrow = [&](int g, float4 (&dst)[4]) {
    if (g < T_TOT) {
#pragma unroll
      for (int i = 0; i < 4; ++i) dst[i] = *(const float4*)(p.out + (unsigned)g * D + i * 256 + lane * 4);
    }
  };
  ldrow(wid, v); ldrow(wid + nw, vn);
  for (int g = wid; g < T_TOT; g += nw) {
    float* xr = p.out + (unsigned)g * D;
    ldrow(g + 2 * nw, vm);
    float ss = 0.f;
#pragma unroll
    for (int i = 0; i < 4; ++i) ss += v[i].x * v[i].x + v[i].y * v[i].y + v[i].z * v[i].z + v[i].w * v[i].w;
#pragma unroll
    for (int o = 32; o >= 1; o >>= 1) ss += __shfl_xor(ss, o, 64);
    float rstd = rsqrtf(ss * (1.f / 1024.f) + 1e-6f);
#pragma unroll
    for (int i = 0; i < 4; ++i) {
      int c = i * 256 + lane * 4;
      float4 g4 = *(const float4*)(p.final_g + c);
      float4 o;
      o.x = v[i].x * rstd * g4.x; o.y = v[i].y * rstd * g4.y; o.z = v[i].z * rstd * g4.z; o.w = v[i].w * rstd * g4.w;
      *(float4*)(xr + c) = o;
    }
#pragma unroll
    for (int i = 0; i < 4; ++i) { v[i] = vn[i]; vn[i] = vm[i]; }
  }
}

DEVFN void phase_gemm1(const Params& p, int l, u16* smem) {
  const u16* H = U(p, 0);
  const u16* W = WL(p, l) + W_CAT;
  for (int it = 0;; ++it) {
    int mt, nt;
    if (!tile_xcd(it, 5, 40, mt, nt)) break;
    const int tid = otid(), lane = tid & 63, w = tid >> 6, wm = w >> 1, wn = w & 1, lr = lane & 15, quad = lane >> 4;
    LdPlain la; la.init(tid, H, mt * 256, D);
    LdPlain lb; lb.init(tid, W, nt * 128, D);
    f32x4 acc[8][4]; zero_acc8(acc);
    gemm_core_b(tid, acc, 32, la, lb, smem);
    int unit = nt >> 3, col0 = (nt & 7) * 128;
    u16* outp = U(p, 1 + unit);
    bool act = (unit == 1) || (unit == 4);
    {
      u16* so = smem;
#pragma unroll
      for (int i = 0; i < 8; ++i) {
        const int m = wm * 128 + i * 16 + lr;
#pragma unroll
        for (int j = 0; j < 4; ++j) {
          const int n = wn * 64 + j * 16 + quad * 4;
          float v0 = acc[i][j][0], v1 = acc[i][j][1], v2 = acc[i][j][2], v3 = acc[i][j][3];
          if (act) { v0 = silu(v0); v1 = silu(v1); v2 = silu(v2); v3 = silu(v3); }
          uint2 o; o.x = pack2(v0, v1); o.y = pack2(v2, v3);
          *(uint2*)(so + m * 136 + n) = o;
        }
      }
      __syncthreads();
#pragma unroll
      for (int c = 0; c < 16; ++c) {
        const int idx = tid + c * 256;
        const int row = idx >> 4, ch = idx & 15;
        uint4 v = *(const uint4*)(so + row * 136 + ch * 8);
        *(uint4*)(outp + ((unsigned)(mt * 256 + row) * D + col0 + ch * 8)) = v;
      }
      __syncthreads();
    }
  }
}

struct TokF1 {
  const u16* zr; const u16* zi; int n1; unsigned off;
  DEVFN unsigned operator()(int k, const u16*& b) const {
    int ri = k >= n1 ? 1 : 0;
    int s1 = k - ri * n1;
    b = ri ? zi : zr;
    return off + (unsigned)(s1 * 128) * D;
  }
};
DEVFN void f1_twiddle(int tid, const Params& p, const f32x4 (&acc)[4][4], int hf, int s2, int smask, int twmul,
                      uint2 (&o1)[2][4], uint2 (&o2)[2][4]) {
  const int lane = tid & 63, w = tid >> 6, wm = w >> 1, lr = lane & 15;
  const float2* tw = TW(p);
#pragma unroll
  for (int b = 0; b < 2; ++b) {
    int k1 = (hf * 4 + wm * 2 + b) * 16 + lr;
    float2 t = tw[((k1 * s2) & smask) * twmul];
#pragma unroll
    for (int j = 0; j < 4; ++j) {
      f32x4 orr = acc[2 * b][j], oii = acc[2 * b + 1][j];
      o1[b][j].x = pack2(orr[0] * t.x + oii[0] * t.y, orr[1] * t.x + oii[1] * t.y);
      o1[b][j].y = pack2(orr[2] * t.x + oii[2] * t.y, orr[3] * t.x + oii[3] * t.y);
      o2[b][j].x = pack2(oii[0] * t.x - orr[0] * t.y, oii[1] * t.x - orr[1] * t.y);
      o2[b][j].y = pack2(oii[2] * t.x - orr[2] * t.y, oii[3] * t.x - orr[3] * t.y);
    }
  }
}
DEVFN void f1_write(int tid, int hf, unsigned off, const uint2 (&o1)[2][4], const uint2 (&o2)[2][4], u16* zr, u16* zi, u16* so) {
  const int lane = tid & 63, w = tid >> 6, wm = w >> 1, wn = w & 1, lr = lane & 15, quad = lane >> 4;
#pragma unroll
  for (int b = 0; b < 2; ++b) {
    const int rl = (wm * 2 + b) * 16 + lr;
#pragma unroll
    for (int j = 0; j < 4; ++j) {
      const int n = wn * 64 + j * 16 + quad * 4;
      *(uint2*)(so + rl * 136 + n) = o1[b][j];
      *(uint2*)(so + (64 + rl) * 136 + n) = o2[b][j];
    }
  }
  __syncthreads();
#pragma unroll
  for (int c = 0; c < 8; ++c) {
    const int idx = tid + c * 256;
    const int pl = idx >> 10, row = (idx >> 4) & 63, ch = idx & 15;
    const unsigned k1 = hf * 64 + row;
    uint4 v = *(const uint4*)(so + (pl * 64 + row) * 136 + ch * 8);
    *(uint4*)((pl ? zi : zr) + (off + (k1 * 128) * D + ch * 8)) = v;
  }
  __syncthreads();
}
DEVFN void phase_fft1(const Params& p, u16* smem) {
  u16* zr = U(p, 3);
  u16* zi = U(p, 4);
  for (int tile = blockIdx.x; tile < 9216; tile += gridDim.x) {
    const int tid = otid();
    int seq, s2, ct, n1;
    if (tile < 1024) { seq = 0; s2 = tile >> 3; ct = tile & 7; n1 = 128; }
    else { int t2 = tile - 1024; seq = 1 + (t2 >> 10); s2 = (t2 >> 3) & 127; ct = t2 & 7; n1 = 64; }
    const unsigned off = (unsigned)(seq_start(seq) + s2) * D + ct * 128;
    LdTrans<TokF1> lb; lb.t_ = tid; lb.tok.zr = zr; lb.tok.zi = zi; lb.tok.n1 = n1; lb.tok.off = off;
    const int K = 2 * n1, nk = K >> 6;
    const u16* tab = TAB(p) + (seq == 0 ? T_D1A : T_D1B);
    const int smask = seq == 0 ? 16383 : 8191, twmul = seq == 0 ? 1 : 2;
    uint2 a1[2][4], a2[2][4];
    {
      f32x4 acc[4][4]; zero_acc(acc);
      LdPlain la; la.init(tid, tab, 0, K); gemm_core(tid, acc, nk, la, lb, smem);
      f1_twiddle(tid, p, acc, 0, s2, smask, twmul, a1, a2);
    }
    if (seq == 0) {
      uint2 b1[2][4], b2[2][4];
      {
        f32x4 acc[4][4]; zero_acc(acc);
        LdPlain la; la.init(tid, tab, 128, K); gemm_core(tid, acc, nk, la, lb, smem);
        f1_twiddle(tid, p, acc, 1, s2, smask, twmul, b1, b2);
      }
      f1_write(tid, 1, off, b1, b2, zr, zi, smem);
    }
    f1_write(tid, 0, off, a1, a2, zr, zi, smem);
  }
}

struct TokF2 {
  const u16* zr; const u16* zi; unsigned off;
  DEVFN unsigned operator()(int k, const u16*& b) const {
    int ri = k >> 7, s2 = k & 127;
    b = ri ? zi : zr;
    return off + (unsigned)s2 * D;
  }
};
DEVFN void phase_fft2(const Params& p, u16* smem) {
  u16* zr = U(p, 3);
  const u16* gbp = U(p, 5);
  for (int tile = blockIdx.x; tile < 5120; tile += gridDim.x) {
    const int tid = otid(), lane = tid & 63, w = tid >> 6, wm = w >> 1, wn = w & 1, lr = lane & 15, quad = lane >> 4;
    int seq, k1, ct, n1;
    if (tile < 1024) { seq = 0; k1 = tile >> 3; ct = tile & 7; n1 = 128; }
    else { int t2 = tile - 1024; seq = 1 + (t2 >> 9); k1 = (t2 >> 3) & 63; ct = t2 & 7; n1 = 64; }
    const int sst = seq_start(seq);
    const unsigned off = (unsigned)(sst + k1 * 128) * D + ct * 128;
    LdTrans<TokF2> lb; lb.t_ = tid; lb.tok.zr = zr; lb.tok.zi = U(p, 4); lb.tok.off = off;
    LdPlain la; la.init(tid, TAB(p) + T_D2, 0, 256);
    f32x4 acc[4][4]; zero_acc(acc);
    gemm_core(tid, acc, 4, la, lb, smem);
    const float nrm = seq == 0 ? (1.f / 2048.f) : 6.9053396600248786e-4f;
    u16* so = smem;
#pragma unroll
    for (int c = 0; c < 8; ++c) {
      const int idx = tid + c * 256;
      const int row = idx >> 4, ch = idx & 15;
      *(uint4*)(so + row * 136 + ch * 8) = *(const uint4*)(gbp + ((unsigned)(sst + k1 + n1 * row) * D + ct * 128 + ch * 8));
    }
    __syncthreads();
#pragma unroll
    for (int i = 0; i < 4; ++i) {
      const int k2 = wm * 64 + i * 16 + lr;
#pragma unroll
      for (int j = 0; j < 4; ++j) {
        const int cl = wn * 64 + j * 16 + quad * 4;
        uint2 gv = *(const uint2*)(so + k2 * 136 + cl);
        uint2 o;
        o.x = pack2(acc[i][j][0] * nrm * lo2f(gv.x), acc[i][j][1] * nrm * hi2f(gv.x));
        o.y = pack2(acc[i][j][2] * nrm * lo2f(gv.y), acc[i][j][3] * nrm * hi2f(gv.y));
        *(uint2*)(so + k2 * 136 + cl) = o;
      }
    }
    __syncthreads();
#pragma unroll
    for (int c = 0; c < 8; ++c) {
      const int idx = tid + c * 256;
      const int row = idx >> 4, ch = idx & 15;
      *(uint4*)(zr + (off + (unsigned)row * D + ch * 8)) = *(const uint4*)(so + row * 136 + ch * 8);
    }
    __syncthreads();
  }
}

constexpr int SA_LD = 128;
template <int PASS>
DEVFN void phase_scan(const Params& p, int l, int dirsel, unsigned char* smem_raw) {
  float* sAf = (float*)smem_raw;
  u16* sBh = (u16*)(smem_raw + 32768);
  u16* sXc = (u16*)(smem_raw + 32768 + 16384);
  const int tid = otid(), lane = tid & 63, w = tid >> 6, lr = lane & 15, quad = lane >> 4;
  const int head = blockIdx.x & 7;
  const int dir = PASS == 1 ? ((blockIdx.x >> 3) & 1) : dirsel;
  const int tstart = PASS == 1 ? (blockIdx.x >> 4) : (blockIdx.x >> 3);
  const int tstep = PASS == 1 ? (gridDim.x >> 4) : (gridDim.x >> 3);
  const u16* xa = U(p, 1);
  u16* ga = U(p, 2);
  u16* hf = U(p, 5);
  float2* agg = (float2*)U(p, 4);
  float* carry = (float*)(agg + 1280L * 2 * 1024);
  bf16x8 bw[4][4];
  {
    const u16* wrg = WL(p, l) + W_RG;
#pragma unroll
    for (int jt = 0; jt < 4; ++jt) {
      int q = jt >> 1, col = w * 32 + (jt & 1) * 16 + lr;
      const u16* bp = wrg + (unsigned)((((dir * 2 + q) * 8 + head) * 128 + col) * 128 + quad * 8);
#pragma unroll
      for (int ks = 0; ks < 4; ++ks) bw[jt][ks] = *(const bf16x8*)(bp + ks * 32);
    }
  }
  float spl[2], brr[2], bii[2];
#pragma unroll
  for (int jc = 0; jc < 2; ++jc) {
    int cgl = head * 128 + w * 32 + jc * 16 + lr;
    float lm = p.lam[(l * 2 + dir) * D + cgl];
    spl[jc] = -8.f * 1.4426950408889634f * log1pf(expf(-lm));
    brr[jc] = -1.4426950408889634f * p.b_rg[((l * 2 + dir) * 2 + 0) * D + cgl];
    bii[jc] = -1.4426950408889634f * p.b_rg[((l * 2 + dir) * 2 + 1) * D + cgl];
  }
  const int c8 = tid & 15, tg = tid >> 4;
  float* sCw = (float*)(smem_raw + 65536);
  for (int i = tid; i < 640; i += 256) {
    int k = i >> 7, c = i & 127;
    sCw[i] = k < 4 ? p.conv_w[(l * 4 + k) * D + head * 128 + c] : p.conv_b[l * D + head * 128 + c];
  }
  __syncthreads();
  uint4 xr[7];
#define LOAD_XROWS(TT) do { const int _g0 = (TT) * 64; const int _sq = seq_of(_g0), _ss = seq_start(_sq), _se = _ss + seq_len(_sq); \
    _Pragma("unroll") for (int r = 0; r < 7; ++r) { int _g = _g0 + tg * 4 - 2 + r; xr[r] = make_uint4(0, 0, 0, 0); \
      if (_g >= _ss && _g < _se) xr[r] = *(const uint4*)(xa + ((unsigned)_g * D + head * 128 + c8 * 8)); } } while (0)
  if (tstart < 1280) LOAD_XROWS(tstart);
  for (int tt = tstart; tt < 1280; tt += tstep) {
    const int g0 = tt * 64;
    const int seq = seq_of(g0), sst = seq_start(seq), send = sst + seq_len(seq);
#pragma unroll
    for (int j = 0; j < 4; ++j) {
      float o[8];
      {
        float4 b0 = *(const float4*)(sCw + 512 + c8 * 8), b1 = *(const float4*)(sCw + 512 + c8 * 8 + 4);
        o[0] = b0.x; o[1] = b0.y; o[2] = b0.z; o[3] = b0.w; o[4] = b1.x; o[5] = b1.y; o[6] = b1.z; o[7] = b1.w;
      }
#pragma unroll
      for (int k = 0; k < 4; ++k) {
        uint4 v = xr[j + k];
        float4 w0 = *(const float4*)(sCw + k * 128 + c8 * 8), w1 = *(const float4*)(sCw + k * 128 + c8 * 8 + 4);
        o[0] += w0.x * lo2f(v.x); o[1] += w0.y * hi2f(v.x);
        o[2] += w0.z * lo2f(v.y); o[3] += w0.w * hi2f(v.y);
        o[4] += w1.x * lo2f(v.z); o[5] += w1.y * hi2f(v.z);
        o[6] += w1.z * lo2f(v.w); o[7] += w1.w * hi2f(v.w);
      }
      uint4 q0;
      q0.x = pack2(o[0], o[1]); q0.y = pack2(o[2], o[3]); q0.z = pack2(o[4], o[5]); q0.w = pack2(o[6], o[7]);
      const int tl = tg * 4 + j;
      *(uint4*)(sXc + tl * 128 + ((c8 ^ (tl & 7)) << 3)) = q0;
    }
    __syncthreads();
    if (tt + tstep < 1280) LOAD_XROWS(tt + tstep);
    const int gstart = dir == 0 ? sst : send - 1;
#pragma unroll 1
    for (int hv = 0; hv < 2; ++hv) {
      f32x4 acc[2][4];
#pragma unroll
      for (int it = 0; it < 2; ++it)
#pragma unroll
        for (int jt = 0; jt < 4; ++jt) acc[it][jt] = f32x4{0.f, 0.f, 0.f, 0.f};
#pragma unroll
      for (int ks = 0; ks < 4; ++ks) {
#pragma unroll
        for (int it = 0; it < 2; ++it) {
          bf16x8 af = *(const bf16x8*)(sXc + ((hv * 2 + it) * 16 + lr) * 128 + (((ks * 4 + quad) ^ (lr & 7)) << 3));
#pragma unroll
          for (int jt = 0; jt < 4; ++jt)
            acc[it][jt] = __builtin_amdgcn_mfma_f32_16x16x32_bf16(af, bw[jt][ks], acc[it][jt], 0, 0, 0);
        }
      }
#pragma unroll
      for (int it = 0; it < 2; ++it)
#pragma unroll
        for (int jc = 0; jc < 2; ++jc) {
#pragma unroll
          for (int r = 0; r < 4; ++r) {
            int tl = (hv * 2 + it) * 16 + quad * 4 + r, c = w * 32 + jc * 16 + lr;
            float rr = __builtin_amdgcn_rcpf(1.f + __builtin_amdgcn_exp2f(fmaf(acc[it][jc][r], -1.4426950408889634f, brr[jc])));
            float ii = __builtin_amdgcn_rcpf(1.f + __builtin_amdgcn_exp2f(fmaf(acc[it][2 + jc][r], -1.4426950408889634f, bii[jc])));
            float a = __builtin_amdgcn_exp2f(rr * spl[jc]);
            float mult = __builtin_amdgcn_sqrtf((1.f - a) * (1.f + a));
            if (g0 + tl == gstart) mult = 1.f;
            float xv = bf2f(sXc[tl * 128 + (((c >> 3) ^ (tl & 7)) << 3) + (c & 7)]);
            sAf[tl * SA_LD + c] = a;
            sBh[tl * 128 + c] = f2bf(mult * ii * xv);
          }
        }
    }
    __syncthreads();
    if (tid < 128) {
      const int c = tid;
      const unsigned aidx = (unsigned)(tt * 2 + dir) * 1024 + head * 128 + c;
      const float* ap = sAf + c;
      u16* bp = sBh + c;
      if (PASS == 1) {
        float h = 0.f, P = 1.f;
        if (dir == 0) {
#pragma unroll 16
          for (int st = 0; st < 64; ++st) { float a = ap[st * SA_LD]; h = a * h + bf2f(bp[st * 128]); P *= a; }
        } else {
#pragma unroll 16
          for (int st = 63; st >= 0; --st) { float a = ap[st * SA_LD]; h = a * h + bf2f(bp[st * 128]); P *= a; }
        }
        agg[aidx] = make_float2(P, h);
      } else {
        float h = carry[aidx];
        if (dir == 0) {
#pragma unroll 16
          for (int st = 0; st < 64; ++st) { h = ap[st * SA_LD] * h + bf2f(bp[st * 128]); bp[st * 128] = f2bf(h); }
        } else {
#pragma unroll 16
          for (int st = 63; st >= 0; --st) { h = ap[st * SA_LD] * h + bf2f(bp[st * 128]); bp[st * 128] = f2bf(h); }
        }
      }
    }
    if (PASS == 3) {
      __syncthreads();
#pragma unroll
      for (int cch = 0; cch < 4; ++cch) {
        int chunk = tid + cch * 256;
        int t = chunk >> 4, cc = (chunk & 15) * 8;
        unsigned off = (unsigned)(g0 + t) * D + head * 128 + cc;
        uint4 hv = *(const uint4*)(sBh + t * 128 + cc);
        if (dir == 0) {
          *(uint4*)(hf + off) = hv;
        } else {
          uint4 fv = *(const uint4*)(hf + off);
          uint4 gv = *(const uint4*)(ga + off);
          uint4 o;
          o.x = pack2((lo2f(fv.x) + lo2f(hv.x)) * lo2f(gv.x), (hi2f(fv.x) + hi2f(hv.x)) * hi2f(gv.x));
          o.y = pack2((lo2f(fv.y) + lo2f(hv.y)) * lo2f(gv.y), (hi2f(fv.y) + hi2f(hv.y)) * hi2f(gv.y));
          o.z = pack2((lo2f(fv.z) + lo2f(hv.z)) * lo2f(gv.z), (hi2f(fv.z) + hi2f(hv.z)) * hi2f(gv.z));
          o.w = pack2((lo2f(fv.w) + lo2f(hv.w)) * lo2f(gv.w), (hi2f(fv.w) + hi2f(hv.w)) * hi2f(gv.w));
          *(uint4*)(ga + off) = o;
        }
      }
    }
    __syncthreads();
  }
#undef LOAD_XROWS
}

DEVFN void lb_st64(unsigned long long* q, unsigned long long v) { __hip_atomic_store(q, v, __ATOMIC_RELAXED, __HIP_MEMORY_SCOPE_AGENT); }
DEVFN unsigned long long lb_ld64(const unsigned long long* q) { return __hip_atomic_load(q, __ATOMIC_RELAXED, __HIP_MEMORY_SCOPE_AGENT); }
DEVFN void lb_st32(unsigned* q, unsigned v) { __hip_atomic_store(q, v, __ATOMIC_RELAXED, __HIP_MEMORY_SCOPE_AGENT); }
DEVFN unsigned lb_ld32(const unsigned* q) { return __hip_atomic_load(q, __ATOMIC_RELAXED, __HIP_MEMORY_SCOPE_AGENT); }
DEVFN unsigned long long lb_pack(float a, float b) { return (unsigned long long)__float_as_uint(a) | ((unsigned long long)__float_as_uint(b) << 32); }
DEVFN unsigned long long lb_gran(float P, float H, unsigned tag) {
  return ((unsigned long long)__float_as_uint(H) << 32) | (unsigned long long)((__float_as_uint(P) & 0xffffff00u) | tag);
}
DEVFN int lb_rank(int seq, int pos) { return seq == 0 ? (pos >> 1) * 10 + ((pos & 1) ? 9 : 0) : pos * 10 + seq; }
DEVFN void lb_decode(int r, int dir, int& seq, int& pos, int& tt) {
  int pair = r / 10, j = r - pair * 10;
  if (j == 0) { seq = 0; pos = 2 * pair; } else if (j == 9) { seq = 0; pos = 2 * pair + 1; } else { seq = j; pos = pair; }
  int len = seq == 0 ? 256 : 128;
  tt = (seq_start(seq) >> 6) + (dir ? len - 1 - pos : pos);
}
DEVFN void phase_scan_lb(const Params& p, int l, unsigned char* smem_raw) {
  float* sAt = (float*)smem_raw;
  u16* sBt = (u16*)(smem_raw + 34816);
  u16* sXc = (u16*)(smem_raw + 53248);
  u16* sBh = sXc;
  unsigned* sflag = (unsigned*)(smem_raw + 72192);
  const int tid = otid(), lane = tid & 63, w = tid >> 6, lr = lane & 15, quad = lane >> 4;
  const int hd = blockIdx.x & 15, head = hd >> 1, dir = hd & 1;
  const int rstart = blockIdx.x >> 4, rstep = gridDim.x >> 4;
  const u16* xa = U(p, 1);
  u16* ga = U(p, 2);
  u16* hown = dir == 0 ? U(p, 5) : U(p, 4);
  const u16* hoth = dir == 0 ? U(p, 4) : U(p, 5);
  unsigned long long* slot = (unsigned long long*)(p.ws + OFF_LB_BYTES);
  unsigned* stat = (unsigned*)(p.ws + OFF_LB_BYTES + LB_SLOT_BYTES);
  unsigned* cnt = stat + 20480;
  const unsigned ep = 2u * (unsigned)l;
  const unsigned tagb = ((unsigned)l + 1u) * 4u;
  bf16x8 bw[4][4];
  {
    const u16* wrg = WL(p, l) + W_RG;
#pragma unroll
    for (int jt = 0; jt < 4; ++jt) {
      int q = jt >> 1, col = w * 32 + (jt & 1) * 16 + lr;
      const u16* bp = wrg + (unsigned)((((dir * 2 + q) * 8 + head) * 128 + col) * 128 + quad * 8);
#pragma unroll
      for (int ks = 0; ks < 4; ++ks) bw[jt][ks] = *(const bf16x8*)(bp + ks * 32);
    }
  }
  float spl[2], brr[2], bii[2];
#pragma unroll
  for (int jc = 0; jc < 2; ++jc) {
    int cgl = head * 128 + w * 32 + jc * 16 + lr;
    float lm = p.lam[(l * 2 + dir) * D + cgl];
    spl[jc] = -8.f * 1.4426950408889634f * log1pf(expf(-lm));
    brr[jc] = -1.4426950408889634f * p.b_rg[((l * 2 + dir) * 2 + 0) * D + cgl];
    bii[jc] = -1.4426950408889634f * p.b_rg[((l * 2 + dir) * 2 + 1) * D + cgl];
  }
  const int c8 = tid & 15, tg = tid >> 4;
  float* sCw = (float*)(smem_raw + 69632);
  for (int i = tid; i < 640; i += 256) {
    int k = i >> 7, c = i & 127;
    sCw[i] = k < 4 ? p.conv_w[(l * 4 + k) * D + head * 128 + c] : p.conv_b[l * D + head * 128 + c];
  }
  __syncthreads();
  uint4 xr[7];
#define LOAD_XROWS(TT) do { const int _g0 = (TT) * 64; const int _sq = seq_of(_g0), _ss = seq_start(_sq), _se = _ss + seq_len(_sq); \
    _Pragma("unroll") for (int r_ = 0; r_ < 7; ++r_) { int _g = _g0 + tg * 4 - 2 + r_; xr[r_] = make_uint4(0, 0, 0, 0); \
      if (_g >= _ss && _g < _se) xr[r_] = *(const uint4*)(xa + ((unsigned)_g * D + head * 128 + c8 * 8)); } } while (0)
  if (rstart < 1280) { int sq_, ps_, t0_; lb_decode(rstart, dir, sq_, ps_, t0_); LOAD_XROWS(t0_); }
  for (int r = rstart; r < 1280; r += rstep) {
    int seq, pos, tt;
    lb_decode(r, dir, seq, pos, tt);
    const int item = r * 16 + hd;
    const int g0 = tt * 64;
    const int sst = seq_start(seq), send = sst + seq_len(seq);
#pragma unroll
    for (int j = 0; j < 4; ++j) {
      float o[8];
      {
        float4 b0 = *(const float4*)(sCw + 512 + c8 * 8), b1 = *(const float4*)(sCw + 512 + c8 * 8 + 4);
        o[0] = b0.x; o[1] = b0.y; o[2] = b0.z; o[3] = b0.w; o[4] = b1.x; o[5] = b1.y; o[6] = b1.z; o[7] = b1.w;
      }
#pragma unroll
      for (int k = 0; k < 4; ++k) {
        uint4 v = xr[j + k];
        float4 w0 = *(const float4*)(sCw + k * 128 + c8 * 8), w1 = *(const float4*)(sCw + k * 128 + c8 * 8 + 4);
        o[0] += w0.x * lo2f(v.x); o[1] += w0.y * hi2f(v.x);
        o[2] += w0.z * lo2f(v.y); o[3] += w0.w * hi2f(v.y);
        o[4] += w1.x * lo2f(v.z); o[5] += w1.y * hi2f(v.z);
        o[6] += w1.z * lo2f(v.w); o[7] += w1.w * hi2f(v.w);
      }
      uint4 q0;
      q0.x = pack2(o[0], o[1]); q0.y = pack2(o[2], o[3]); q0.z = pack2(o[4], o[5]); q0.w = pack2(o[6], o[7]);
      const int tl = tg * 4 + j;
      *(uint4*)(sXc + tl * 128 + ((c8 ^ (tl & 7)) << 3)) = q0;
    }
    __syncthreads();
    if (r + rstep < 1280) { int sq_, ps_, t1_; lb_decode(r + rstep, dir, sq_, ps_, t1_); LOAD_XROWS(t1_); }
    const int gstart = dir == 0 ? sst : send - 1;
#pragma unroll 1
    for (int hv = 0; hv < 2; ++hv) {
      f32x4 acc[2][4];
#pragma unroll
      for (int it = 0; it < 2; ++it)
#pragma unroll
        for (int jt = 0; jt < 4; ++jt) acc[it][jt] = f32x4{0.f, 0.f, 0.f, 0.f};
#pragma unroll
      for (int ks = 0; ks < 4; ++ks) {
#pragma unroll
        for (int it = 0; it < 2; ++it) {
          bf16x8 af = *(const bf16x8*)(sXc + ((hv * 2 + it) * 16 + lr) * 128 + (((ks * 4 + quad) ^ (lr & 7)) << 3));
#pragma unroll
          for (int jt = 0; jt < 4; ++jt)
            acc[it][jt] = __builtin_amdgcn_mfma_f32_16x16x32_bf16(af, bw[jt][ks], acc[it][jt], 0, 0, 0);
        }
      }
#pragma unroll
      for (int it = 0; it < 2; ++it)
#pragma unroll
        for (int jc = 0; jc < 2; ++jc) {
          float av[4], bv[4];
          const int c = w * 32 + jc * 16 + lr, t0 = (hv * 2 + it) * 16 + quad * 4;
#pragma unroll
          for (int r = 0; r < 4; ++r) {
            const int tl = t0 + r;
            float rr = __builtin_amdgcn_rcpf(1.f + __builtin_amdgcn_exp2f(fmaf(acc[it][jc][r], -1.4426950408889634f, brr[jc])));
            float ii = __builtin_amdgcn_rcpf(1.f + __builtin_amdgcn_exp2f(fmaf(acc[it][2 + jc][r], -1.4426950408889634f, bii[jc])));
            float a = __builtin_amdgcn_exp2f(rr * spl[jc]);
            float mult = __builtin_amdgcn_sqrtf((1.f - a) * (1.f + a));
            if (g0 + tl == gstart) mult = 1.f;
            float xv = bf2f(sXc[tl * 128 + (((c >> 3) ^ (tl & 7)) << 3) + (c & 7)]);
            av[r] = a;
            bv[r] = mult * ii * xv;
          }
          *(float4*)(sAt + c * 68 + t0) = make_float4(av[0], av[1], av[2], av[3]);
          uint2 bq; bq.x = pack2(bv[0], bv[1]); bq.y = pack2(bv[2], bv[3]);
          *(uint2*)(sBt + c * 72 + t0) = bq;
        }
    }
    __syncthreads();
    const int sc_c = tid & 127, sc_part = tid >> 7;
    float2* sEx = (float2*)(smem_raw + 72208);
    float* sCar = (float*)(sEx + 256);
    float partP = 1.f, partH = 0.f;
    {
      const float* ap = sAt + sc_c * 68;
      const u16* bp = sBt + sc_c * 72;
#pragma unroll
      for (int gq = 0; gq < 8; ++gq) {
        const int t = dir == 0 ? sc_part * 32 + gq * 4 : 60 - sc_part * 32 - gq * 4;
        const float4 a4 = *(const float4*)(ap + t);
        const uint2 b4 = *(const uint2*)(bp + t);
        if (dir == 0) {
          partH = a4.x * partH + lo2f(b4.x); partH = a4.y * partH + hi2f(b4.x);
          partH = a4.z * partH + lo2f(b4.y); partH = a4.w * partH + hi2f(b4.y);
        } else {
          partH = a4.w * partH + hi2f(b4.y); partH = a4.z * partH + lo2f(b4.y);
          partH = a4.y * partH + hi2f(b4.x); partH = a4.x * partH + lo2f(b4.x);
        }
        partP *= (a4.x * a4.y) * (a4.z * a4.w);
      }
      sEx[sc_part * 128 + sc_c] = make_float2(partP, partH);
    }
    __syncthreads();
    float carry = 0.f;
    if (tid < 128) {
      const float2 e1 = sEx[128 + tid];
      const float aggP = partP * e1.x, aggH = e1.x * partH + e1.y;
      lb_st64(slot + (unsigned)item * 128 + tid, lb_gran(pos == 0 ? 0.f : aggP, aggH, tagb + (pos == 0 ? 2u : 1u)));
      if (pos > 0) {
        float Pr = 1.f, Hr = 0.f;
        int pj = pos - 1;
        for (;;) {
          const int j = lb_rank(seq, pj) * 16 + hd;
          unsigned long long v;
          unsigned spins = 0;
          for (;;) {
            v = lb_ld64(slot + (unsigned)j * 128 + tid);
            unsigned tg_ = (unsigned)v & 0xffu;
            if ((tg_ >> 2) == (tagb >> 2) && (tg_ & 3u) != 0u) break;
            __builtin_amdgcn_s_sleep(1);
            if (++spins > (1u << 18)) break;
          }
          float Pj = __uint_as_float((unsigned)v & 0xffffff00u), Hj = __uint_as_float((unsigned)(v >> 32));
          Hr += Pr * Hj;
          Pr *= Pj;
          if (((unsigned)v & 3u) == 2u || pj == 0) break;
          --pj;
        }
        carry = Hr;
        lb_st64(slot + (unsigned)item * 128 + tid, lb_gran(0.f, aggP * carry + aggH, tagb + 2u));
      }
      sCar[tid] = partP * carry + partH;
    }
    __syncthreads();
    {
      const float* ap = sAt + sc_c * 68;
      const u16* bp = sBt + sc_c * 72;
      u16* hp = sBh + sc_c;
      float h = sc_part == 0 ? carry : sCar[sc_c];
#pragma unroll
      for (int gq = 0; gq < 8; ++gq) {
        const int t = dir == 0 ? sc_part * 32 + gq * 4 : 60 - sc_part * 32 - gq * 4;
        const float4 a4 = *(const float4*)(ap + t);
        const uint2 b4 = *(const uint2*)(bp + t);
        if (dir == 0) {
          h = a4.x * h + lo2f(b4.x); hp[(t + 0) * 128] = f2bf(h);
          h = a4.y * h + hi2f(b4.x); hp[(t + 1) * 128] = f2bf(h);
          h = a4.z * h + lo2f(b4.y); hp[(t + 2) * 128] = f2bf(h);
          h = a4.w * h + hi2f(b4.y); hp[(t + 3) * 128] = f2bf(h);
        } else {
          h = a4.w * h + hi2f(b4.y); hp[(t + 3) * 128] = f2bf(h);
          h = a4.z * h + lo2f(b4.y); hp[(t + 2) * 128] = f2bf(h);
          h = a4.y * h + hi2f(b4.x); hp[(t + 1) * 128] = f2bf(h);
          h = a4.x * h + lo2f(b4.x); hp[(t + 0) * 128] = f2bf(h);
        }
      }
    }
    __syncthreads();
    const int len_ = seq == 0 ? 256 : 128;
    const int ppos = len_ - 1 - pos;
    if (pos < ppos) {
#pragma unroll
      for (int cch = 0; cch < 4; ++cch) {
        int chunk = tid + cch * 256;
        int t = chunk >> 4, cc = (chunk & 15) * 8;
        unsigned off = (unsigned)(g0 + t) * D + head * 128 + cc;
        uint4 hv = *(const uint4*)(sBh + t * 128 + cc);
        unsigned long long* q = (unsigned long long*)(hown + off);
        lb_st64(q, (unsigned long long)hv.x | ((unsigned long long)hv.y << 32));
        lb_st64(q + 1, (unsigned long long)hv.z | ((unsigned long long)hv.w << 32));
      }
      asm volatile("s_waitcnt vmcnt(0)" ::: "memory");
      __syncthreads();
      if (tid == 0) lb_st32(stat + item, (unsigned)l + 1u);
    } else {
      const int pit = lb_rank(seq, ppos) * 16 + (hd ^ 1);
      unsigned spins = 0;
      while (lb_ld32(stat + pit) != (unsigned)l + 1u) { __builtin_amdgcn_s_sleep(1); if (++spins > (1u << 18)) break; }
#pragma unroll
      for (int cch = 0; cch < 4; ++cch) {
        int chunk = tid + cch * 256;
        int t = chunk >> 4, cc = (chunk & 15) * 8;
        unsigned off = (unsigned)(g0 + t) * D + head * 128 + cc;
        uint4 hv = *(const uint4*)(sBh + t * 128 + cc);
        const unsigned long long* q = (const unsigned long long*)(hoth + off);
        unsigned long long f0 = lb_ld64(q), f1 = lb_ld64(q + 1);
        uint4 fv = make_uint4((unsigned)f0, (unsigned)(f0 >> 32), (unsigned)f1, (unsigned)(f1 >> 32));
        uint4 gv = *(const uint4*)(ga + off);
        uint4 o;
        o.x = pack2((lo2f(fv.x) + lo2f(hv.x)) * lo2f(gv.x), (hi2f(fv.x) + hi2f(hv.x)) * hi2f(gv.x));
        o.y = pack2((lo2f(fv.y) + lo2f(hv.y)) * lo2f(gv.y), (hi2f(fv.y) + hi2f(hv.y)) * hi2f(gv.y));
        o.z = pack2((lo2f(fv.z) + lo2f(hv.z)) * lo2f(gv.z), (hi2f(fv.z) + hi2f(hv.z)) * hi2f(gv.z));
        o.w = pack2((lo2f(fv.w) + lo2f(hv.w)) * lo2f(gv.w), (hi2f(fv.w) + hi2f(hv.w)) * hi2f(gv.w));
        *(uint4*)(ga + off) = o;
      }
    }
    __syncthreads();
  }
#undef LOAD_XROWS
}

DEVFN void phase_carry(const Params& p) {
  const float2* __restrict__ agg = (const float2*)U(p, 4);
  float* __restrict__ carry = (float*)(agg + 1280L * 2 * 1024);
  const int lane = threadIdx.x & 63, w = threadIdx.x >> 6;
  for (int u = blockIdx.x + gridDim.x * w; u < 288; u += gridDim.x * 4) {
    int id = u * 64 + lane;
    int seq = id >> 11, dir = (id >> 10) & 1, c = id & 1023;
    int nt = seq_len(seq) >> 6, tile0 = seq_start(seq) >> 6;
    float h = 0.f;
#pragma unroll 8
    for (int k = 0; k < nt; ++k) {
      int tt = tile0 + (dir ? nt - 1 - k : k);
      unsigned ix = (unsigned)(tt * 2 + dir) * 1024 + c;
      float2 v = agg[ix];
      carry[ix] = h;
      h = v.x * h + v.y;
    }
  }
}

DEVFN void phase_merge(const Params& p, int l, u16* smem) {
  const u16* wl = WL(p, l);
  u16* mo = U(p, 1);
  u16* tb = U(p, 5);
  u16* so = smem;
  for (int it = 0;; ++it) {
    int mt, nt;
    if (!tile_xcd(it, 1, 8, mt, nt)) break;
    const int g0 = mt * 256;
#pragma unroll 1
    for (int br = 0; br < 2; ++br) {
      {
        const int tid = otid(), lane = tid & 63, w = tid >> 6, wm = w >> 1, wn = w & 1, lr = lane & 15, quad = lane >> 4;
        f32x4 acc[8][4]; zero_acc8(acc);
        LdPlain lb; lb.init(tid, wl + (br == 0 ? W_A : W_B), nt * 128, D);
        if (br == 0) {
          LdPlain la; la.init(tid, U(p, 2), g0, D);
          gemm_core_b(tid, acc, 32, la, lb, smem);
        } else {
          const int seq = seq_of(g0);
          LdPerm la; la.base = U(p, 3); la.g0 = g0; la.sst = seq_start(seq); la.lg = seq == 0 ? 7 : 6;
          gemm_core_b(tid, acc, 32, la, lb, smem);
        }
#pragma unroll
        for (int i = 0; i < 8; ++i) {
          const int m = wm * 128 + i * 16 + lr;
#pragma unroll
          for (int j = 0; j < 4; ++j) {
            const int n = wn * 64 + j * 16 + quad * 4;
            uint2 o; o.x = pack2(acc[i][j][0], acc[i][j][1]); o.y = pack2(acc[i][j][2], acc[i][j][3]);
            *(uint2*)(so + m * 136 + n) = o;
          }
        }
        __syncthreads();
#pragma unroll
        for (int c = 0; c < 16; ++c) {
          const int idx = tid + c * 256;
          const int row = idx >> 4, ch = idx & 15;
          *(uint4*)(tb + ((unsigned)(g0 + row) * D + nt * 128 + ch * 8)) = *(const uint4*)(so + row * 136 + ch * 8);
        }
        __syncthreads();
      }
      {
        const int tid = otid(), lane = tid & 63, w = tid >> 6, wm = w >> 1, wn = w & 1, lr = lane & 15, quad = lane >> 4;
        f32x4 acc[8][4]; zero_acc8(acc);
        LdPlain la; la.init(tid, U(p, 0), g0, D);
        LdPlain lb; lb.init(tid, wl + W_CAT, 5120 + br * 1024 + nt * 128, D);
        gemm_core_b(tid, acc, 32, la, lb, smem);
#pragma unroll
        for (int c = 0; c < 16; ++c) {
          const int idx = tid + c * 256;
          const int row = idx >> 4, ch = idx & 15;
          *(uint4*)(so + row * 136 + ch * 8) = *(const uint4*)(tb + ((unsigned)(g0 + row) * D + nt * 128 + ch * 8));
        }
        __syncthreads();
#pragma unroll
        for (int i = 0; i < 8; ++i) {
          const int m = wm * 128 + i * 16 + lr;
#pragma unroll
          for (int j = 0; j < 4; ++j) {
            const int n = wn * 64 + j * 16 + quad * 4;
            uint2 tv = *(const uint2*)(so + m * 136 + n);
            acc[i][j][0] = sigm(acc[i][j][0]) * lo2f(tv.x);
            acc[i][j][1] = sigm(acc[i][j][1]) * hi2f(tv.x);
            acc[i][j][2] = sigm(acc[i][j][2]) * lo2f(tv.y);
            acc[i][j][3] = sigm(acc[i][j][3]) * hi2f(tv.y);
          }
        }
        if (br == 1) {
          __syncthreads();
#pragma unroll
          for (int c = 0; c < 16; ++c) {
            const int idx = tid + c * 256;
            const int row = idx >> 4, ch = idx & 15;
            *(uint4*)(so + row * 136 + ch * 8) = *(const uint4*)(mo + ((unsigned)(g0 + row) * D + nt * 128 + ch * 8));
          }
          __syncthreads();
#pragma unroll
          for (int i = 0; i < 8; ++i) {
            const int m = wm * 128 + i * 16 + lr;
#pragma unroll
            for (int j = 0; j < 4; ++j) {
              const int n = wn * 64 + j * 16 + quad * 4;
              uint2 pv = *(const uint2*)(so + m * 136 + n);
              acc[i][j][0] += lo2f(pv.x); acc[i][j][1] += hi2f(pv.x);
              acc[i][j][2] += lo2f(pv.y); acc[i][j][3] += hi2f(pv.y);
            }
          }
        }
        __syncthreads();
#pragma unroll
        for (int i = 0; i < 8; ++i) {
          const int m = wm * 128 + i * 16 + lr;
#pragma unroll
          for (int j = 0; j < 4; ++j) {
            const int n = wn * 64 + j * 16 + quad * 4;
            uint2 o; o.x = pack2(acc[i][j][0], acc[i][j][1]); o.y = pack2(acc[i][j][2], acc[i][j][3]);
            *(uint2*)(so + m * 136 + n) = o;
          }
        }
        __syncthreads();
#pragma unroll
        for (int c = 0; c < 16; ++c) {
          const int idx = tid + c * 256;
          const int row = idx >> 4, ch = idx & 15;
          *(uint4*)(mo + ((unsigned)(g0 + row) * D + nt * 128 + ch * 8)) = *(const uint4*)(so + row * 136 + ch * 8);
        }
        __syncthreads();
      }
    }
  }
}

DEVFN void phase_out(const Params& p, int l, u16* smem) {
  const u16* wo = WL(p, l) + W_O;
  for (int it = 0;; ++it) {
    int mt, nt;
    if (!tile_xcd(it, 1, 8, mt, nt)) break;
    const int tid = otid(), lane = tid & 63, w = tid >> 6, wm = w >> 1, wn = w & 1, lr = lane & 15, quad = lane >> 4;
    const int g0 = mt * 256;
    LdPlain la; la.init(tid, U(p, 1), g0, D);
    LdPlain lb; lb.init(tid, wo, nt * 128, D);
    f32x4 acc[8][4]; zero_acc8(acc);
    gemm_core_b(tid, acc, 32, la, lb, smem);
    const float* gate = MOD(p) + ((long)l * 9 + seq_of(g0)) * 3072 + 2048;
#pragma unroll
    for (int i = 0; i < 8; ++i) {
      unsigned g = g0 + wm * 128 + i * 16 + lr;
      const float* xb = (l == 0) ? (g0 < 16384 ? p.x_prompt : p.x_sample) : p.out;
      const float* xr = xb + (unsigned)((l == 0 && g0 >= 16384) ? g - 16384 : g) * D;
      float* orow = p.out + g * D;
#pragma unroll
      for (int j = 0; j < 4; ++j) {
        unsigned c = nt * 128 + wn * 64 + j * 16 + quad * 4;
        float4 xv = *(const float4*)(xr + c);
        float4 gt = *(const float4*)(gate + c);
        float4 o;
        o.x = xv.x + gt.x * acc[i][j][0]; o.y = xv.y + gt.y * acc[i][j][1];
        o.z = xv.z + gt.z * acc[i][j][2]; o.w = xv.w + gt.w * acc[i][j][3];
        *(float4*)(orow + c) = o;
      }
    }
  }
}

#define XB_TMO      128
#define XB_XCNT(j)  (256  + 64 * (j))
#define XB_XSUB(j)  (1280 + 64 * (j))
#define XB_XGEN(j)  (2304 + 64 * (j))
#define XB_TOP      3328
#define XB_TOPGEN   3392
#define XCD_BAR_WORDS 3456
#define XB_SPIN_CAP (1u << 18)
#define LAS __attribute__((address_space(3)))

__device__ __forceinline__ unsigned xb_ld(unsigned* p)              { return __hip_atomic_load(p, __ATOMIC_RELAXED, __HIP_MEMORY_SCOPE_AGENT); }
__device__ __forceinline__ unsigned xb_add(unsigned* p, unsigned v) { return __hip_atomic_fetch_add(p, v, __ATOMIC_RELAXED, __HIP_MEMORY_SCOPE_AGENT); }
__device__ __forceinline__ unsigned xb_xcc_id() { return (unsigned)__builtin_amdgcn_s_getreg((3 << 11) | 20) & 0xFu; }
#define XB_SPIN(cond, bar) do { unsigned _sp = 0; while (cond) { __builtin_amdgcn_s_sleep(1); \
    if ((++_sp & 255u) == 0u) { if (xb_ld(&(bar)[XB_TMO])) break; if (_sp > XB_SPIN_CAP) { atomicAdd(&(bar)[XB_TMO], 1u); break; } } } } while (0)

struct XcdBarrier {
    unsigned* bar; unsigned x;
    volatile LAS unsigned* st;
};

__device__ __forceinline__ XcdBarrier xcd_barrier_post(unsigned* bar, volatile LAS unsigned* st) {
    XcdBarrier b; b.bar = bar; b.x = xb_xcc_id(); b.st = st;
    if (threadIdx.x == 0) (void)xb_add(&bar[XB_XCNT(b.x)], 1u);
    return b;
}
__device__ __forceinline__ void xcd_barrier_complete(unsigned* bar, unsigned x, unsigned& nloc, unsigned& nx) {
    const unsigned G = gridDim.x * gridDim.y * gridDim.z;
    unsigned sum, cnt, mine, sp = 0u;
    for (;;) {
        sum = 0u; cnt = 0u; mine = 0u;
#pragma unroll
        for (unsigned j = 0; j < 16; ++j) { const unsigned c = xb_ld(&bar[XB_XCNT(j)]); sum += c; cnt += (c > 0u) ? 1u : 0u; mine = (j == x) ? c : mine; }
        if (sum == G) break;
        __builtin_amdgcn_s_sleep(1);
        if ((++sp & 255u) == 0u) { if (xb_ld(&bar[XB_TMO])) break; if (sp > XB_SPIN_CAP) { atomicAdd(&bar[XB_TMO], 1u); break; } }
    }
    nloc = mine > 0u ? mine : 1u; nx = cnt > 0u ? cnt : 1u;
}

__device__ __forceinline__ void xcd_barrier(const XcdBarrier& b) {
    asm volatile("s_waitcnt vmcnt(0)" ::: "memory");
    __syncthreads();
    if (threadIdx.x == 0) {
        unsigned* bar = b.bar;
        __builtin_amdgcn_s_waitcnt(0);
        unsigned nloc = b.st[0], nx = b.st[1];
        if (nloc == 0u) { xcd_barrier_complete(bar, b.x, nloc, nx); b.st[0] = nloc; b.st[1] = nx; }
        const unsigned old = xb_add(&bar[XB_XSUB(b.x)], 1u);
        const unsigned gen = old / nloc;
        if (old + 1u == (gen + 1u) * nloc) {
            __builtin_amdgcn_fence(__ATOMIC_RELEASE, "agent");
            asm volatile("s_waitcnt vmcnt(0)" ::: "memory");
            const unsigned og = xb_add(&bar[XB_TOP], 1u);
            const unsigned tg = og / nx;
            if (og + 1u == (tg + 1u) * nx) xb_add(&bar[XB_TOPGEN], 1u);
            else XB_SPIN(xb_ld(&bar[XB_TOPGEN]) == tg, bar);
            __builtin_amdgcn_fence(__ATOMIC_ACQUIRE, "agent");
            xb_add(&bar[XB_XGEN(b.x)], 1u);
            asm volatile("s_waitcnt vmcnt(0)" ::: "memory");
        } else {
            XB_SPIN(xb_ld(&bar[XB_XGEN(b.x)]) == gen, bar);
            __builtin_amdgcn_fence(__ATOMIC_ACQUIRE, "agent");
            asm volatile("s_waitcnt vmcnt(0)" ::: "memory");
        }
    }
    __syncthreads();
}


__global__ void __launch_bounds__(256, 2) hawk_fnet_megakernel(Params p) {
  extern __shared__ __attribute__((aligned(16))) unsigned char smem_raw[];
  cg::grid_group grid = cg::this_grid();
  u16* smem = (u16*)smem_raw;

  __shared__ unsigned xb_st[4];
  unsigned* bar = (unsigned*)(p.ws + OFF_BAR_BYTES);
  if (blockIdx.x == 0) {
    for (int i = threadIdx.x; i < XCD_BAR_WORDS; i += 256) __hip_atomic_store(&bar[i], 0u, __ATOMIC_RELAXED, __HIP_MEMORY_SCOPE_AGENT);
  }
  if (threadIdx.x < 4) xb_st[threadIdx.x] = 0u;
  {
    unsigned* lbs = (unsigned*)(p.ws + OFF_LB_BYTES + LB_SLOT_BYTES);
    for (int i = blockIdx.x * 256 + threadIdx.x; i < 20480 + 10240; i += gridDim.x * 256)
      __hip_atomic_store(&lbs[i], 0u, __ATOMIC_RELAXED, __HIP_MEMORY_SCOPE_AGENT);
    unsigned long long* lbq = (unsigned long long*)(p.ws + OFF_LB_BYTES);
    for (int i = blockIdx.x * 256 + threadIdx.x; i < (int)(LB_SLOT_BYTES / 8); i += gridDim.x * 256)
      __hip_atomic_store(&lbq[i], 0ull, __ATOMIC_RELAXED, __HIP_MEMORY_SCOPE_AGENT);
  }
  phase_prologue(p, smem_raw);
  grid.sync();
  XcdBarrier xb = xcd_barrier_post(bar, (volatile LAS unsigned*)xb_st);
  phase_fold(p, smem);
  phase_h(p, 0);
  xcd_barrier(xb);
  for (int l = 0; l < 2; ++l) {
    phase_gemm1(p, l, smem);
    xcd_barrier(xb);
    phase_fft1(p, smem);
    xcd_barrier(xb);
    phase_fft2(p, smem);
    xcd_barrier(xb);
    phase_scan_lb(p, l, smem_raw);
    xcd_barrier(xb);
    phase_merge(p, l, smem);
    xcd_barrier(xb);
    phase_out(p, l, smem);
    xcd_barrier(xb);
    if (l == 0) { phase_h(p, 1); xcd_barrier(xb); }
  }
  phase_final(p);
}

extern "C" void kernel_launch(void* const* d_in, const int* in_sizes, int n_in,
                              void* d_out, int out_size, void* d_ws, size_t ws_size,
                              hipStream_t stream) {
  (void)in_sizes; (void)n_in; (void)out_size;
  if (ws_size < (size_t)WS_NEED) {
    fprintf(stderr, "workspace too small: %zu < %ld\n", ws_size, (long)WS_NEED);
    return;
  }
  static int grid_blocks = 0;
  if (!grid_blocks) {
    hipFuncSetAttribute((const void*)hawk_fnet_megakernel, hipFuncAttributeMaxDynamicSharedMemorySize, SMEM_BYTES);
    int dev = 0, cus = 0, per_cu = 0;
    hipGetDevice(&dev);
    hipDeviceGetAttribute(&cus, hipDeviceAttributeMultiprocessorCount, dev);
    hipOccupancyMaxActiveBlocksPerMultiprocessor(&per_cu, hawk_fnet_megakernel, 256, SMEM_BYTES);
    if (per_cu > 2) per_cu = 2;
    if (per_cu < 1) per_cu = 1;
    grid_blocks = (cus * per_cu) & ~15;
  }
  Params p{};
  p.x_prompt = (const float*)d_in[0]; p.x_sample = (const float*)d_in[1];
  p.c_prompt = (const float*)d_in[2]; p.c_sample = (const float*)d_in[3];
  p.norm_g = (const float*)d_in[4]; p.w_ada = (const float*)d_in[5]; p.b_ada = (const float*)d_in[6];
  p.w_in = (const float*)d_in[7]; p.conv_w = (const float*)d_in[8]; p.conv_b = (const float*)d_in[9];
  p.w_rg = (const float*)d_in[10]; p.b_rg = (const float*)d_in[11]; p.lam = (const float*)d_in[12];
  p.w_a_out = (const float*)d_in[13]; p.w_b_out = (const float*)d_in[14]; p.w_o = (const float*)d_in[15];
  p.final_g = (const float*)d_in[16];
  p.out = (float*)d_out; p.ws = (unsigned char*)d_ws;
  void* args[] = {&p};
  hipError_t e = hipLaunchCooperativeKernel((void*)hawk_fnet_megakernel, dim3(grid_blocks), dim3(256), args, SMEM_BYTES, stream);
  if (e != hipSuccess) fprintf(stderr, "cooperative launch failed: %s (grid %d)\n", hipGetErrorString(e), grid_blocks);
}
```

```cpp
#include <hip/hip_runtime.h>
#include <hip/hip_cooperative_groups.h>
#include <cstdio>
namespace cg = cooperative_groups;

typedef unsigned short u16;
typedef __attribute__((ext_vector_type(8))) short bf16x8;
typedef __attribute__((ext_vector_type(4))) float f32x4;

#define DEVFN __device__ __forceinline__

constexpr int D = 1024;
constexpr int T_TOT = 81920;
constexpr long UNIT = (long)T_TOT * D;
constexpr int D_IN = 6144;

constexpr long OFF_W = 6 * UNIT;
constexpr long W_CAT = 0;
constexpr long W_A = 7168L * 1024;
constexpr long W_B = W_A + 1048576;
constexpr long W_O = W_B + 1048576;
constexpr long W_RG = W_O + 1048576;
constexpr long LW = W_RG + 524288;
constexpr long OFF_TAB = OFF_W + 2 * LW;
constexpr long T_D1A = 0;
constexpr long T_D1B = 65536;
constexpr long T_D2 = T_D1B + 16384;
constexpr long T_DC = T_D2 + 32768;
constexpr long TAB_ELEMS = T_DC + 131072;
constexpr long OFF_TW_BYTES = (OFF_TAB + TAB_ELEMS) * 2;
constexpr long OFF_MOD_BYTES = OFF_TW_BYTES + 131072;
constexpr long OFF_BAR_BYTES = OFF_MOD_BYTES + 221184;
constexpr long OFF_LB_BYTES = OFF_BAR_BYTES + 16384;
constexpr long LB_SLOT_BYTES = 20480L * 128 * 8;
constexpr long WS_NEED = OFF_LB_BYTES + LB_SLOT_BYTES + 20480 * 4 + 10240 * 4;
static_assert(WS_NEED <= (1L << 30), "workspace map exceeds the guaranteed 1 GiB");

constexpr int TILE = 128 * 64;
constexpr int SMEM_BYTES = 75776;

struct Params {
  const float* x_prompt; const float* x_sample; const float* c_prompt; const float* c_sample;
  const float* norm_g; const float* w_ada; const float* b_ada; const float* w_in;
  const float* conv_w; const float* conv_b; const float* w_rg; const float* b_rg; const float* lam;
  const float* w_a_out; const float* w_b_out; const float* w_o; const float* final_g;
  float* out; unsigned char* ws;
};

typedef __attribute__((ext_vector_type(2))) float f32x2_t;
typedef __attribute__((ext_vector_type(2))) __bf16 bf16x2_t;
DEVFN u16 f2bf(float f) {
  __bf16 h = (__bf16)f;
  return *(u16*)&h;
}
DEVFN float bf2f(u16 h) { return __uint_as_float(((unsigned)h) << 16); }
DEVFN unsigned pack2(float a, float b) {
  f32x2_t v = {a, b};
  bf16x2_t r = __builtin_convertvector(v, bf16x2_t);
  return *(unsigned*)&r;
}
DEVFN float lo2f(unsigned v) { return __uint_as_float(v << 16); }
DEVFN float hi2f(unsigned v) { return __uint_as_float(v & 0xffff0000u); }
DEVFN float sigm(float x) { return __builtin_amdgcn_rcpf(1.f + __expf(-x)); }
DEVFN float silu(float x) { return x * __builtin_amdgcn_rcpf(1.f + __expf(-x)); }
DEVFN float one_minus_exp(float x) {
  float pl = -x * (1.f + x * (0.5f + x * (1.f / 6.f + x * (1.f / 24.f + x * (1.f / 120.f + x * (1.f / 720.f))))));
  float dr = 1.f - __expf(x);
  return x > -0.3f ? pl : dr;
}

DEVFN int otid() { int t = threadIdx.x; asm volatile("" : "+v"(t)); return t; }
DEVFN int seq_of(int g) { int seg = g >> 13; return seg < 2 ? 0 : seg - 1; }
DEVFN int seq_start(int s) { return s == 0 ? 0 : 16384 + (s - 1) * 8192; }
DEVFN int seq_len(int s) { return s == 0 ? 16384 : 8192; }

DEVFN u16* U(const Params& p, int i) { return (u16*)(p.ws) + (long)i * UNIT; }
DEVFN u16* WL(const Params& p, int l) { return (u16*)(p.ws) + OFF_W + (long)l * LW; }
DEVFN u16* TAB(const Params& p) { return (u16*)(p.ws) + OFF_TAB; }
DEVFN float2* TW(const Params& p) { return (float2*)(p.ws + OFF_TW_BYTES); }
DEVFN float* MOD(const Params& p) { return (float*)(p.ws + OFF_MOD_BYTES); }
DEVFN const float* xrow(const Params& p, int g) {
  return g < 16384 ? p.x_prompt + (long)g * D : p.x_sample + (long)(g - 16384) * D;
}

struct LdPlain {
  static constexpr bool kDma = true; static constexpr bool kTr = false;
  const u16* base; unsigned off0; unsigned cst; int t_; unsigned row0_, stride_;
  DEVFN unsigned rowoff(int r) const { return (row0_ + r) * stride_; }
  DEVFN void init(int tid_, const u16* b, unsigned row0, unsigned stride) {
    unsigned tid = tid_; t_ = tid_; row0_ = row0; stride_ = stride;
    base = b;
    off0 = (row0 + (tid >> 3)) * stride + (((tid & 7) ^ ((tid >> 3) & 7)) << 3);
    cst = 32 * stride;
  }
  DEVFN void issue(u16* tile, int c, int kt) const {
    __builtin_amdgcn_global_load_lds((const unsigned*)(base + (off0 + c * cst + kt * 64)),
                                     (unsigned*)(tile + (t_ + c * 256) * 8), 16, 0, 0);
  }
  DEVFN uint4 load(int, int) const { return make_uint4(0, 0, 0, 0); }
  DEVFN void store(u16*, int, uint4) const {}
};
struct LdRows4 {
  static constexpr bool kDma = true; static constexpr bool kTr = false;
  const u16* base; unsigned off[4]; int t_;
  DEVFN void issue(u16* tile, int c, int kt) const {
    __builtin_amdgcn_global_load_lds((const unsigned*)(base + (off[c] + kt * 64)),
                                     (unsigned*)(tile + (t_ + c * 256) * 8), 16, 0, 0);
  }
  DEVFN uint4 load(int, int) const { return make_uint4(0, 0, 0, 0); }
  DEVFN void store(u16*, int, uint4) const {}
};
struct LdF32 {
  static constexpr bool kDma = false; static constexpr bool kTr = false;
  const float* base; unsigned off0; unsigned cst; int t_;
  DEVFN void init(int tid_, const float* b, unsigned row0, unsigned stride, unsigned col0) {
    unsigned tid = tid_; t_ = tid_;
    base = b;
    off0 = (row0 + (tid >> 3)) * stride + col0 + (tid & 7) * 8;
    cst = 32 * stride;
  }
  DEVFN void issue(u16*, int, int) const {}
  DEVFN uint4 load(int c, int kt) const {
    const float4* q = (const float4*)(base + (off0 + c * cst + kt * 64));
    float4 a = q[0], b = q[1];
    uint4 r; r.x = pack2(a.x, a.y); r.y = pack2(a.z, a.w); r.z = pack2(b.x, b.y); r.w = pack2(b.z, b.w);
    return r;
  }
  DEVFN void store(u16* tile, int c, uint4 v) const {
    int idx = t_ + c * 256;
    int row = idx >> 3, kc = idx & 7;
    *(uint4*)(tile + row * 64 + ((kc ^ (row & 7)) << 3)) = v;
  }
};
DEVFN int trf(int r) { return ((r & 3) << 2) | ((r >> 2) & 3); }
template <class TokFn>
struct LdTrans {
  static constexpr bool kDma = false; static constexpr bool kTr = false;
  TokFn tok; int t_;
  DEVFN void issue(u16*, int, int) const {}
  DEVFN uint4 load(int c, int kt) const {
    int idx = t_ + c * 256;
    int kk = idx & 63, cc = idx >> 6;
    const u16* b; unsigned o = tok(kt * 64 + kk, b);
    return *(const uint4*)(b + (o + cc * 8));
  }
  DEVFN void store(u16* tile, int c, uint4 v) const {
    int idx = t_ + c * 256;
    int kk = idx & 63, cc = idx >> 6;
    u16* q = tile + (cc * 8) * 64 + (kk & 7);
    int kc = kk >> 3;
    q[0 * 64 + ((kc ^ 0) << 3)] = (u16)(v.x & 0xffff); q[1 * 64 + ((kc ^ 1) << 3)] = (u16)(v.x >> 16);
    q[2 * 64 + ((kc ^ 2) << 3)] = (u16)(v.y & 0xffff); q[3 * 64 + ((kc ^ 3) << 3)] = (u16)(v.y >> 16);
    q[4 * 64 + ((kc ^ 4) << 3)] = (u16)(v.z & 0xffff); q[5 * 64 + ((kc ^ 5) << 3)] = (u16)(v.z >> 16);
    q[6 * 64 + ((kc ^ 6) << 3)] = (u16)(v.w & 0xffff); q[7 * 64 + ((kc ^ 7) << 3)] = (u16)(v.w >> 16);
  }
};

typedef __attribute__((ext_vector_type(4))) short s16x4;
DEVFN s16x4 lds_tr_read(const u16* q) {
  return __builtin_amdgcn_ds_read_tr16_b64_v4i16((s16x4 __attribute__((address_space(3)))*)(q));
}

DEVFN void zero_acc(f32x4 (&acc)[4][4]) {
#pragma unroll
  for (int i = 0; i < 4; ++i)
#pragma unroll
    for (int j = 0; j < 4; ++j) acc[i][j] = f32x4{0.f, 0.f, 0.f, 0.f};
}

template <class LA, class LB>
DEVFN void gemm_core(int tid, f32x4 (&acc)[4][4], int nk, const LA& la, const LB& lb, u16* smem) {
  const int lane = tid & 63, w = tid >> 6, wm = w >> 1, wn = w & 1;
  const int lr = lane & 15, quad = lane >> 4;
  uint4 ra[4], rb[4];
  if (LA::kDma) {
#pragma unroll
    for (int c = 0; c < 4; ++c) la.issue(smem, c, 0);
  } else {
#pragma unroll
    for (int c = 0; c < 4; ++c) ra[c] = la.load(c, 0);
  }
  if (LB::kDma) {
#pragma unroll
    for (int c = 0; c < 4; ++c) lb.issue(smem + TILE, c, 0);
  } else {
#pragma unroll
    for (int c = 0; c < 4; ++c) rb[c] = lb.load(c, 0);
  }
  if (!LA::kDma) {
#pragma unroll
    for (int c = 0; c < 4; ++c) la.store(smem, c, ra[c]);
  }
  if (!LB::kDma) {
#pragma unroll
    for (int c = 0; c < 4; ++c) lb.store(smem + TILE, c, rb[c]);
  }
  asm volatile("s_waitcnt vmcnt(0)" ::: "memory");
  __syncthreads();
  const int aoff = (wm * 64 + lr) * 64, boff = (wn * 64 + lr) * 64;
  const int sw0 = ((quad) ^ (lr & 7)) << 3, sw1 = ((4 + quad) ^ (lr & 7)) << 3;
  int troff[4][2];
  if (LB::kTr) {
    const int q = lr >> 2, pp = lr & 3;
#pragma unroll
    for (int j = 0; j < 4; ++j)
#pragma unroll
      for (int h = 0; h < 2; ++h) {
        int r = quad * 8 + h * 4 + q;
        int ch = (wn * 8 + j * 2 + (pp >> 1)) ^ trf(r);
        troff[j][h] = r * 128 + ch * 8 + (pp & 1) * 4;
      }
  }
  for (int kt = 0; kt < nk; ++kt) {
    const u16* sA = smem + (kt & 1) * 2 * TILE;
    const u16* sB = sA + TILE;
    u16* nA = smem + ((kt + 1) & 1) * 2 * TILE;
    const bool more = (kt + 1) < nk;
    if (more) {
      if (LA::kDma) {
#pragma unroll
        for (int c = 0; c < 4; ++c) la.issue(nA, c, kt + 1);
      } else {
#pragma unroll
        for (int c = 0; c < 4; ++c) ra[c] = la.load(c, kt + 1);
      }
      if (LB::kDma) {
#pragma unroll
        for (int c = 0; c < 4; ++c) lb.issue(nA + TILE, c, kt + 1);
      } else {
#pragma unroll
        for (int c = 0; c < 4; ++c) rb[c] = lb.load(c, kt + 1);
      }
    }
#pragma unroll
    for (int ks = 0; ks < 2; ++ks) {
      const int sw = ks == 0 ? sw0 : sw1;
      bf16x8 af[4], bfr[4];
#pragma unroll
      for (int i = 0; i < 4; ++i) af[i] = *(const bf16x8*)(sA + aoff + i * 1024 + sw);
      if (LB::kTr) {
#pragma unroll
        for (int j = 0; j < 4; ++j) {
          s16x4 lo = lds_tr_read(sB + troff[j][0] + ks * 4096);
          s16x4 hi = lds_tr_read(sB + troff[j][1] + ks * 4096);
          bfr[j] = __builtin_shufflevector(lo, hi, 0, 1, 2, 3, 4, 5, 6, 7);
        }
      } else {
#pragma unroll
        for (int j = 0; j < 4; ++j) bfr[j] = *(const bf16x8*)(sB + boff + j * 1024 + sw);
      }
      __builtin_amdgcn_s_setprio(1);
#pragma unroll
      for (int i = 0; i < 4; ++i)
#pragma unroll
        for (int j = 0; j < 4; ++j)
          acc[i][j] = __builtin_amdgcn_mfma_f32_16x16x32_bf16(bfr[j], af[i], acc[i][j], 0, 0, 0);
      __builtin_amdgcn_s_setprio(0);
    }
    if (more) {
      if (!LA::kDma) {
#pragma unroll
        for (int c = 0; c < 4; ++c) la.store(nA, c, ra[c]);
      }
      if (!LB::kDma) {
#pragma unroll
        for (int c = 0; c < 4; ++c) lb.store(nA + TILE, c, rb[c]);
      }
    }
    asm volatile("s_waitcnt vmcnt(0)" ::: "memory");
    __syncthreads();
  }
}

struct LdPerm {
  const u16* base; int g0, sst, lg;
  DEVFN unsigned rowoff(int r) const {
    int t = g0 - sst + r;
    int urow = ((t & ((1 << lg) - 1)) << 7) + (t >> lg);
    return (unsigned)(sst + urow) * D;
  }
};
#define GLDS16(gp, lp) __builtin_amdgcn_global_load_lds((const unsigned*)(gp), (unsigned*)(lp), 16, 0, 0)
DEVFN void zero_acc8(f32x4 (&acc)[8][4]) {
#pragma unroll
  for (int i = 0; i < 8; ++i)
#pragma unroll
    for (int j = 0; j < 4; ++j) acc[i][j] = f32x4{0.f, 0.f, 0.f, 0.f};
}
template <class LA, class LB>
DEVFN void gemm_core_b(int tid, f32x4 (&acc)[8][4], int nk, const LA& la, const LB& lb, u16* smem) {
  const int lane = tid & 63, w = tid >> 6, wm = w >> 1, wn = w & 1;
  const int lr = lane & 15, quad = lane >> 4;
  const int r0 = tid >> 2;
  const unsigned sw = (unsigned)(((tid & 3) ^ ((0 - (tid >> 4)) & 3)) << 3);
  const unsigned oa0 = la.rowoff(r0) + sw, oa1 = la.rowoff(r0 + 64) + sw, oa2 = la.rowoff(r0 + 128) + sw, oa3 = la.rowoff(r0 + 192) + sw;
  const unsigned ob0 = lb.rowoff(r0) + sw, ob1 = lb.rowoff(r0 + 64) + sw;
  const u16* ga = la.base; const u16* gb = lb.base;
  u16* l0 = smem + tid * 8;
#define ISSUE_STAGE(st, kt) do { u16* _s = l0 + (st) * 12288; unsigned _k = (unsigned)(kt) * 32u; \
    GLDS16(ga + (oa0 + _k), _s); GLDS16(ga + (oa1 + _k), _s + 2048); GLDS16(ga + (oa2 + _k), _s + 4096); GLDS16(ga + (oa3 + _k), _s + 6144); \
    GLDS16(gb + (ob0 + _k), _s + 8192); GLDS16(gb + (ob1 + _k), _s + 10240); } while (0)
  asm volatile("s_waitcnt vmcnt(0)" ::: "memory");
  ISSUE_STAGE(0, 0);
  ISSUE_STAGE(1, 1);
  const int fsw = (quad ^ ((0 - (lr >> 2)) & 3)) << 3;
  const int aoff = (wm * 128 + lr) * 32 + fsw, boff = 8192 + (wn * 64 + lr) * 32 + fsw;
  int cur = 0, nxt = 2;
  for (int kt = 0; kt < nk; ++kt) {
    if (kt + 1 < nk) asm volatile("s_waitcnt vmcnt(6)" ::: "memory");
    else asm volatile("s_waitcnt vmcnt(0)" ::: "memory");
    __builtin_amdgcn_s_barrier();
    asm volatile("" ::: "memory");
    if (kt + 2 < nk) ISSUE_STAGE(nxt, kt + 2);
    const u16* sb = smem + cur * 12288;
    bf16x8 af[8], bfr[4];
#pragma unroll
    for (int j = 0; j < 4; ++j) bfr[j] = *(const bf16x8*)(sb + boff + j * 512);
#pragma unroll
    for (int i = 0; i < 8; ++i) af[i] = *(const bf16x8*)(sb + aoff + i * 512);
    __builtin_amdgcn_s_setprio(1);
#pragma unroll
    for (int i = 0; i < 8; ++i)
#pragma unroll
      for (int j = 0; j < 4; ++j)
        acc[i][j] = __builtin_amdgcn_mfma_f32_16x16x32_bf16(bfr[j], af[i], acc[i][j], 0, 0, 0);
    __builtin_amdgcn_s_setprio(0);
    cur = cur == 2 ? 0 : cur + 1;
    nxt = nxt == 2 ? 0 : nxt + 1;
  }
  asm volatile("s_waitcnt lgkmcnt(0)" ::: "memory");
  __builtin_amdgcn_s_barrier();
  asm volatile("" ::: "memory");
#undef ISSUE_STAGE
}

DEVFN bool tile_xcd(int it, int ngrp, int ntn, int& mt, int& nt) {
  const int G = gridDim.x, b = blockIdx.x;
  if (G == 512) {
    if (it >= 5 * ngrp) return false;
    int xcd = b & 7, loc = b >> 3;
    mt = xcd * 40 + (it / ngrp) * 8 + (loc >> 3);
    nt = (it % ngrp) * 8 + (loc & 7);
    return true;
  }
  int tile = b + it * G;
  if (tile >= 320 * ntn) return false;
  mt = tile / ntn; nt = tile % ntn;
  return true;
}

DEVFN void transpose_tile(const float* src, long ld, u16* dst, long ldd, float* sT) {
  const int tid = otid();
#pragma unroll
  for (int pss = 0; pss < 4; ++pss) {
    int kk = (tid >> 4) + pss * 16, n4 = (tid & 15) * 4;
    float4 v = *(const float4*)(src + (long)kk * ld + n4);
    sT[kk * 65 + n4 + 0] = v.x; sT[kk * 65 + n4 + 1] = v.y; sT[kk * 65 + n4 + 2] = v.z; sT[kk * 65 + n4 + 3] = v.w;
  }
  __syncthreads();
  {
    int n = tid >> 2, k0 = (tid & 3) * 16;
    unsigned o[8];
#pragma unroll
    for (int e = 0; e < 8; ++e) o[e] = pack2(sT[(k0 + 2 * e) * 65 + n], sT[(k0 + 2 * e + 1) * 65 + n]);
    uint4* q = (uint4*)(dst + (long)n * ldd + k0);
    q[0] = make_uint4(o[0], o[1], o[2], o[3]);
    q[1] = make_uint4(o[4], o[5], o[6], o[7]);
  }
  __syncthreads();
}

DEVFN void phase_prologue(const Params& p, unsigned char* smem_raw) {
  const int tid = otid();
  constexpr int NJ_TR = 4352, NJ_MOD = 384, NJ_TAB = 256;
  for (int job = blockIdx.x; job < NJ_TR + NJ_MOD + NJ_TAB; job += gridDim.x) {
    if (job < NJ_TR) {
      float* sT = (float*)smem_raw;
      int l = job / 2176, r = job % 2176;
      u16* wl = WL(p, l);
      if (r < 1280) {
        int kt = r / 80, ntile = r % 80;
        int orow = ntile * 64;
        int scol;
        if (orow < 2048) scol = orow; else { orow += 2048; scol = orow - 1024; }
        transpose_tile(p.w_in + (long)l * D * D_IN + (long)(kt * 64) * D_IN + scol, D_IN,
                       wl + W_CAT + (long)orow * D + kt * 64, D, sT);
      } else if (r < 2048) {
        int r2 = r - 1280, which = r2 >> 8, t = r2 & 255, kt = t >> 4, ntile = t & 15;
        const float* src = (which == 0 ? p.w_a_out : which == 1 ? p.w_b_out : p.w_o) + (long)l * 1048576;
        long doff = which == 0 ? W_A : which == 1 ? W_B : W_O;
        transpose_tile(src + (long)(kt * 64) * D + ntile * 64, D, wl + doff + (long)(ntile * 64) * D + kt * 64, D, sT);
      } else {
        int r3 = r - 2048, mat = r3 >> 2, t = r3 & 3, kt = t >> 1, ntile = t & 1;
        const float* src = p.w_rg + ((long)l * 32 + mat) * 16384;
        transpose_tile(src + (long)(kt * 64) * 128 + ntile * 64, 128,
                       wl + W_RG + (long)mat * 16384 + (long)(ntile * 64) * 128 + kt * 64, 128, sT);
      }
    } else if (job < NJ_TR + NJ_MOD) {
      int jm = job - NJ_TR, l = jm / 192, cgp = jm % 192;
      float* sc = (float*)smem_raw;
      float* red = sc + 9 * 1024;
      for (int i = tid; i < 9 * 1024; i += 256) {
        int s_ = i >> 10, k = i & 1023;
        float cv = s_ == 0 ? p.c_prompt[k] : p.c_sample[(s_ - 1) * 1024 + k];
        sc[i] = silu(cv);
      }
      __syncthreads();
      int col = cgp * 16 + (tid & 15), kq = tid >> 4;
      float a0 = 0, a1 = 0, a2 = 0, a3 = 0, a4 = 0, a5 = 0, a6 = 0, a7 = 0, a8 = 0;
      const float* wp = p.w_ada + (long)l * D * 3072 + col;
#pragma unroll 8
      for (int k = kq * 64; k < kq * 64 + 64; ++k) {
        float wv = wp[(long)k * 3072];
        a0 += sc[0 * 1024 + k] * wv; a1 += sc[1 * 1024 + k] * wv; a2 += sc[2 * 1024 + k] * wv;
        a3 += sc[3 * 1024 + k] * wv; a4 += sc[4 * 1024 + k] * wv; a5 += sc[5 * 1024 + k] * wv;
        a6 += sc[6 * 1024 + k] * wv; a7 += sc[7 * 1024 + k] * wv; a8 += sc[8 * 1024 + k] * wv;
      }
      float* rq = red + kq * 144 + (tid & 15);
      rq[0 * 16] = a0; rq[1 * 16] = a1; rq[2 * 16] = a2; rq[3 * 16] = a3; rq[4 * 16] = a4;
      rq[5 * 16] = a5; rq[6 * 16] = a6; rq[7 * 16] = a7; rq[8 * 16] = a8;
      __syncthreads();
      if (tid < 144) {
        int s_ = tid >> 4, cc = tid & 15;
        float v = 0.f;
#pragma unroll
        for (int q = 0; q < 16; ++q) v += red[q * 144 + tid];
        int cf = cgp * 16 + cc;
        MOD(p)[((long)l * 9 + s_) * 3072 + cf] = v + p.b_ada[l * 3072 + cf];
      }
      __syncthreads();
    } else {
      int jt = job - NJ_TR - NJ_MOD;
      u16* tab = TAB(p);
#pragma unroll
      for (int e4 = 0; e4 < 4; ++e4) {
        int e = jt * 1024 + e4 * 256 + tid;
        if (e < 65536) {
          int m = e >> 8, k = e & 255;
          int k1 = (m >> 5) * 16 + (m & 15), ro = (m >> 4) & 1, ri = k >> 7, s1 = k & 127;
          float x = 2.f * (float)((k1 * s1) & 127) / 128.f;
          float cs = cospif(x), sn = sinpif(x);
          float v = (ro == ri) ? cs : (ro == 0 ? sn : -sn);
          tab[T_D1A + e] = f2bf(v);
        } else if (e < 65536 + 16384) {
          int e2 = e - 65536;
          int m = e2 >> 7, k = e2 & 127;
          int k1 = (m >> 5) * 16 + (m & 15), ro = (m >> 4) & 1, ri = k >> 6, s1 = k & 63;
          float x = 2.f * (float)((k1 * s1) & 63) / 64.f;
          float cs = cospif(x), sn = sinpif(x);
          float v = (ro == ri) ? cs : (ro == 0 ? sn : -sn);
          tab[T_D1B + e2] = f2bf(v);
        } else if (e < 65536 + 16384 + 32768) {
          int e2 = e - 65536 - 16384;
          int k2 = e2 >> 8, k = e2 & 255, ri = k >> 7, s2 = k & 127;
          float x = 2.f * (float)((k2 * s2) & 127) / 128.f;
          float v = ri == 0 ? cospif(x) : sinpif(x);
          tab[T_D2 + e2] = f2bf(v);
        } else if (e < 65536 + 16384 + 32768 + 131072) {
          int e2 = e - 65536 - 16384 - 32768;
          int row = e2 >> 8, c = e2 & 255, ri = row >> 8, m = row & 255;
          float x = 2.f * (float)((m * c) & 255) / 256.f;
          float v = ri == 0 ? cospif(x) : -sinpif(x);
          tab[T_DC + e2] = f2bf(v);
        } else {
          int e2 = e - (65536 + 16384 + 32768 + 131072);
          if (e2 < 16384) {
            float x = 2.f * (float)e2 / 16384.f;
            TW(p)[e2] = make_float2(cospif(x), sinpif(x));
          }
        }
      }
    }
  }
}

DEVFN void phase_fold(const Params& p, u16* smem) {
  for (int tile = blockIdx.x; tile < 256; tile += gridDim.x) {
    const int tid = otid(), lane = tid & 63, w = tid >> 6, wm = w >> 1, wn = w & 1, lr = lane & 15, quad = lane >> 4;
    int l = tile >> 7, g = (tile >> 5) & 3, mt = (tile >> 3) & 3, nt = tile & 7;
    LdPlain la; la.init(tid, TAB(p) + T_DC, mt * 128, 256);
    LdF32 lb; lb.init(tid, p.w_in + (long)l * D * D_IN, nt * 128, D_IN, 2048 + g * 256);
    f32x4 acc[4][4]; zero_acc(acc);
    gemm_core(tid, acc, 4, la, lb, smem);
    int ri = mt >> 1;
    u16* wc = WL(p, l) + W_CAT;
#pragma unroll
    for (int i = 0; i < 4; ++i) {
      int mrow = (mt & 1) * 128 + wm * 64 + i * 16 + lr;
      unsigned orow = 2048 + ri * 1024 + g * 256 + mrow;
#pragma unroll
      for (int j = 0; j < 4; ++j) {
        int n = nt * 128 + wn * 64 + j * 16 + quad * 4;
        uint2 o; o.x = pack2(acc[i][j][0], acc[i][j][1]); o.y = pack2(acc[i][j][2], acc[i][j][3]);
        *(uint2*)(wc + orow * D + n) = o;
      }
    }
  }
}

DEVFN void phase_h(const Params& p, int l) {
  const int tid_ = otid();
  const int lane = tid_ & 63;
  const int wid = blockIdx.x * 4 + (tid_ >> 6), nw = gridDim.x * 4;
  const float* ng = p.norm_g + l * D;
  const float* modl = MOD(p) + (long)l * 9 * 3072;
  u16* H = U(p, 0);
  float4 v[4], vn[4], vm[4];
  auto ldrow = [&](int g, float4 (&dst)[4]) {
    const float* xb = (l == 0) ? (g < 16384 ? p.x_prompt : p.x_sample) : p.out;
    const unsigned xo = (unsigned)((l == 0 && g >= 16384) ? g - 16384 : g) * D;
#pragma unroll
    for (int i = 0; i < 4; ++i) dst[i] = *(const float4*)(xb + xo + i * 256 + lane * 4);
  };
  if (wid < T_TOT) ldrow(wid, v);
  if (wid + nw < T_TOT) ldrow(wid + nw, vn);
  for (int g = wid; g < T_TOT; g += nw) {
    if (g + 2 * nw < T_TOT) ldrow(g + 2 * nw, vm);
    const float* md = modl + seq_of(g) * 3072;
    float ss = 0.f;
#pragma unroll
    for (int i = 0; i < 4; ++i) ss += v[i].x * v[i].x + v[i].y * v[i].y + v[i].z * v[i].z + v[i].w * v[i].w;
#pragma unroll
    for (int o = 32; o >= 1; o >>= 1) ss += __shfl_xor(ss, o, 64);
    float rstd = rsqrtf(ss * (1.f / 1024.f) + 1e-6f);
#pragma unroll
    for (int i = 0; i < 4; ++i) {
      int c = i * 256 + lane * 4;
      float4 g4 = *(const float4*)(ng + c);
      float4 sh = *(const float4*)(md + c);
      float4 sc = *(const float4*)(md + 1024 + c);
      float h0 = v[i].x * rstd * g4.x * (1.f + sc.x) + sh.x;
      float h1 = v[i].y * rstd * g4.y * (1.f + sc.y) + sh.y;
      float h2 = v[i].z * rstd * g4.z * (1.f + sc.z) + sh.z;
      float h3 = v[i].w * rstd * g4.w * (1.f + sc.w) + sh.w;
      uint2 o; o.x = pack2(h0, h1); o.y = pack2(h2, h3);
      *(uint2*)(H + ((unsigned)g * D + c)) = o;
    }
#pragma unroll
    for (int i = 0; i < 4; ++i) { v[i] = vn[i]; vn[i] = vm[i]; }
  }
}

DEVFN void phase_final(const Params& p) {
  const int tid_ = otid();
  const int lane = tid_ & 63;
  const int wid = blockIdx.x * 4 + (tid_ >> 6), nw = gridDim.x * 4;
  float4 v[4], vn[4], vm[4];
  auto ldrow = [&](int g, float4 (&dst)[4]) {
    if (g < T_TOT) {
#pragma unroll
      for (int i = 0; i < 4; ++i) dst[i] = *(const float4*)(p.out + (unsigned)g * D + i * 256 + lane * 4);
    }
  };
  ldrow(wid, v); ldrow(wid + nw, vn);
  for (int g = wid; g < T_TOT; g += nw) {
    float* xr = p.out + (unsigned)g * D;
    ldrow(g + 2 * nw, vm);
    float ss = 0.f;
#pragma unroll
    for (int i = 0; i < 4; ++i) ss += v[i].x * v[i].x + v[i].y * v[i].y + v[i].z * v[i].z + v[i].w * v[i].w;
#pragma unroll
    for (int o = 32; o >= 1; o >>= 1) ss += __shfl_xor(ss, o, 64);
    float rstd = rsqrtf(ss * (1.f / 1024.f) + 1e-6f);
#pragma unroll
    for (int i = 0; i < 4; ++i) {
      int c = i * 256 + lane * 4;
      float4 g4 = *(const float4*)(p.final_g + c);
      float4 o;
      o.x = v[i].x * rstd * g4.x; o.y = v[i].y * rstd * g4.y; o.z = v[i].z * rstd * g4.z; o.w = v[i].w * rstd * g4.w;
      *(float4*)(xr + c) = o;
    }
#pragma unroll
    for (int i = 0; i < 4; ++i) { v[i] = vn[i]; vn[i] = vm[i]; }
  }
}

DEVFN void phase_gemm1(const Params& p, int l, u16* smem) {
  const u16* H = U(p, 0);
  const u16* W = WL(p, l) + W_CAT;
  for (int it = 0;; ++it) {
    int mt, nt;
    if (!tile_xcd(it, 5, 40, mt, nt)) break;
    const int tid = otid(), lane = tid & 63, w = tid >> 6, wm = w >> 1, wn = w & 1, lr = lane & 15, quad = lane >> 4;
    LdPlain la; la.init(tid, H, mt * 256, D);
    LdPlain lb; lb.init(tid, W, nt * 128, D);
    f32x4 acc[8][4]; zero_acc8(acc);
    gemm_core_b(tid, acc, 32, la, lb, smem);
    int unit = nt >> 3, col0 = (nt & 7) * 128;
    u16* outp = U(p, 1 + unit);
    bool act = (unit == 1) || (unit == 4);
    {
      u16* so = smem;
#pragma unroll
      for (int i = 0; i < 8; ++i) {
        const int m = wm * 128 + i * 16 + lr;
#pragma unroll
        for (int j = 0; j < 4; ++j) {
          const int n = wn * 64 + j * 16 + quad * 4;
          float v0 = acc[i][j][0], v1 = acc[i][j][1], v2 = acc[i][j][2], v3 = acc[i][j][3];
          if (act) { v0 = silu(v0); v1 = silu(v1); v2 = silu(v2); v3 = silu(v3); }
          uint2 o; o.x = pack2(v0, v1); o.y = pack2(v2, v3);
          *(uint2*)(so + m * 136 + n) = o;
        }
      }
      __syncthreads();
#pragma unroll
      for (int c = 0; c < 16; ++c) {
        const int idx = tid + c * 256;
        const int row = idx >> 4, ch = idx & 15;
        uint4 v = *(const uint4*)(so + row * 136 + ch * 8);
        *(uint4*)(outp + ((unsigned)(mt * 256 + row) * D + col0 + ch * 8)) = v;
      }
      __syncthreads();
    }
  }
}

struct TokF1 {
  const u16* zr; const u16* zi; int n1; unsigned off;
  DEVFN unsigned operator()(int k, const u16*& b) const {
    int ri = k >= n1 ? 1 : 0;
    int s1 = k - ri * n1;
    b = ri ? zi : zr;
    return off + (unsigned)(s1 * 128) * D;
  }
};
DEVFN void f1_twiddle(int tid, const Params& p, const f32x4 (&acc)[4][4], int hf, int s2, int smask, int twmul,
                      uint2 (&o1)[2][4], uint2 (&o2)[2][4]) {
  const int lane = tid & 63, w = tid >> 6, wm = w >> 1, lr = lane & 15;
  const float2* tw = TW(p);
#pragma unroll
  for (int b = 0; b < 2; ++b) {
    int k1 = (hf * 4 + wm * 2 + b) * 16 + lr;
    float2 t = tw[((k1 * s2) & smask) * twmul];
#pragma unroll
    for (int j = 0; j < 4; ++j) {
      f32x4 orr = acc[2 * b][j], oii = acc[2 * b + 1][j];
      o1[b][j].x = pack2(orr[0] * t.x + oii[0] * t.y, orr[1] * t.x + oii[1] * t.y);
      o1[b][j].y = pack2(orr[2] * t.x + oii[2] * t.y, orr[3] * t.x + oii[3] * t.y);
      o2[b][j].x = pack2(oii[0] * t.x - orr[0] * t.y, oii[1] * t.x - orr[1] * t.y);
      o2[b][j].y = pack2(oii[2] * t.x - orr[2] * t.y, oii[3] * t.x - orr[3] * t.y);
    }
  }
}
DEVFN void f1_write(int tid, int hf, unsigned off, const uint2 (&o1)[2][4], const uint2 (&o2)[2][4], u16* zr, u16* zi, u16* so) {
  const int lane = tid & 63, w = tid >> 6, wm = w >> 1, wn = w & 1, lr = lane & 15, quad = lane >> 4;
#pragma unroll
  for (int b = 0; b < 2; ++b) {
    const int rl = (wm * 2 + b) * 16 + lr;
#pragma unroll
    for (int j = 0; j < 4; ++j) {
      const int n = wn * 64 + j * 16 + quad * 4;
      *(uint2*)(so + rl * 136 + n) = o1[b][j];
      *(uint2*)(so + (64 + rl) * 136 + n) = o2[b][j];
    }
  }
  __syncthreads();
#pragma unroll
  for (int c = 0; c < 8; ++c) {
    const int idx = tid + c * 256;
    const int pl = idx >> 10, row = (idx >> 4) & 63, ch = idx & 15;
    const unsigned k1 = hf * 64 + row;
    uint4 v = *(const uint4*)(so + (pl * 64 + row) * 136 + ch * 8);
    *(uint4*)((pl ? zi : zr) + (off + (k1 * 128) * D + ch * 8)) = v;
  }
  __syncthreads();
}
DEVFN void phase_fft1(const Params& p, u16* smem) {
  u16* zr = U(p, 3);
  u16* zi = U(p, 4);
  for (int tile = blockIdx.x; tile < 9216; tile += gridDim.x) {
    const int tid = otid();
    int seq, s2, ct, n1;
    if (tile < 1024) { seq = 0; s2 = tile >> 3; ct = tile & 7; n1 = 128; }
    else { int t2 = tile - 1024; seq = 1 + (t2 >> 10); s2 = (t2 >> 3) & 127; ct = t2 & 7; n1 = 64; }
    const unsigned off = (unsigned)(seq_start(seq) + s2) * D + ct * 128;
    LdTrans<TokF1> lb; lb.t_ = tid; lb.tok.zr = zr; lb.tok.zi = zi; lb.tok.n1 = n1; lb.tok.off = off;
    const int K = 2 * n1, nk = K >> 6;
    const u16* tab = TAB(p) + (seq == 0 ? T_D1A : T_D1B);
    const int smask = seq == 0 ? 16383 : 8191, twmul = seq == 0 ? 1 : 2;
    uint2 a1[2][4], a2[2][4];
    {
      f32x4 acc[4][4]; zero_acc(acc);
      LdPlain la; la.init(tid, tab, 0, K); gemm_core(tid, acc, nk, la, lb, smem);
      f1_twiddle(tid, p, acc, 0, s2, smask, twmul, a1, a2);
    }
    if (seq == 0) {
      uint2 b1[2][4], b2[2][4];
      {
        f32x4 acc[4][4]; zero_acc(acc);
        LdPlain la; la.init(tid, tab, 128, K); gemm_core(tid, acc, nk, la, lb, smem);
        f1_twiddle(tid, p, acc, 1, s2, smask, twmul, b1, b2);
      }
      f1_write(tid, 1, off, b1, b2, zr, zi, smem);
    }
    f1_write(tid, 0, off, a1, a2, zr, zi, smem);
  }
}

struct TokF2 {
  const u16* zr; const u16* zi; unsigned off;
  DEVFN unsigned operator()(int k, const u16*& b) const {
    int ri = k >> 7, s2 = k & 127;
    b = ri ? zi : zr;
    return off + (unsigned)s2 * D;
  }
};
DEVFN void phase_fft2(const Params& p, u16* smem) {
  u16* zr = U(p, 3);
  const u16* gbp = U(p, 5);
  for (int tile = blockIdx.x; tile < 5120; tile += gridDim.x) {
    const int tid = otid(), lane = tid & 63, w = tid >> 6, wm = w >> 1, wn = w & 1, lr = lane & 15, quad = lane >> 4;
    int seq, k1, ct, n1;
    if (tile < 1024) { seq = 0; k1 = tile >> 3; ct = tile & 7; n1 = 128; }
    else { int t2 = tile - 1024; seq = 1 + (t2 >> 9); k1 = (t2 >> 3) & 63; ct = t2 & 7; n1 = 64; }
    const int sst = seq_start(seq);
    const unsigned off = (unsigned)(sst + k1 * 128) * D + ct * 128;
    LdTrans<TokF2> lb; lb.t_ = tid; lb.tok.zr = zr; lb.tok.zi = U(p, 4); lb.tok.off = off;
    LdPlain la; la.init(tid, TAB(p) + T_D2, 0, 256);
#define GPRE_ADDR(c_) (gbp + ((unsigned)(sst + k1 + n1 * ((tid + (c_) * 256) >> 4)) * D + ct * 128 + ((tid + (c_) * 256) & 15) * 8))
    const uint4 gp0 = *(const uint4*)GPRE_ADDR(0), gp1 = *(const uint4*)GPRE_ADDR(1), gp2 = *(const uint4*)GPRE_ADDR(2), gp3 = *(const uint4*)GPRE_ADDR(3);
    const uint4 gp4 = *(const uint4*)GPRE_ADDR(4), gp5 = *(const uint4*)GPRE_ADDR(5), gp6 = *(const uint4*)GPRE_ADDR(6), gp7 = *(const uint4*)GPRE_ADDR(7);
#undef GPRE_ADDR
    f32x4 acc[4][4]; zero_acc(acc);
    gemm_core(tid, acc, 4, la, lb, smem);
    const float nrm = seq == 0 ? (1.f / 2048.f) : 6.9053396600248786e-4f;
    u16* so = smem;
#define GPRE_ST(c_, v_) *(uint4*)(so + ((tid + (c_) * 256) >> 4) * 136 + ((tid + (c_) * 256) & 15) * 8) = v_
    GPRE_ST(0, gp0); GPRE_ST(1, gp1); GPRE_ST(2, gp2); GPRE_ST(3, gp3);
    GPRE_ST(4, gp4); GPRE_ST(5, gp5); GPRE_ST(6, gp6); GPRE_ST(7, gp7);
#undef GPRE_ST
    __syncthreads();
#pragma unroll
    for (int i = 0; i < 4; ++i) {
      const int k2 = wm * 64 + i * 16 + lr;
#pragma unroll
      for (int j = 0; j < 4; ++j) {
        const int cl = wn * 64 + j * 16 + quad * 4;
        uint2 gv = *(const uint2*)(so + k2 * 136 + cl);
        uint2 o;
        o.x = pack2(acc[i][j][0] * nrm * lo2f(gv.x), acc[i][j][1] * nrm * hi2f(gv.x));
        o.y = pack2(acc[i][j][2] * nrm * lo2f(gv.y), acc[i][j][3] * nrm * hi2f(gv.y));
        *(uint2*)(so + k2 * 136 + cl) = o;
      }
    }
    __syncthreads();
#pragma unroll
    for (int c = 0; c < 8; ++c) {
      const int idx = tid + c * 256;
      const int row = idx >> 4, ch = idx & 15;
      *(uint4*)(zr + (off + (unsigned)row * D + ch * 8)) = *(const uint4*)(so + row * 136 + ch * 8);
    }
    __syncthreads();
  }
}

constexpr int SA_LD = 128;
template <int PASS>
DEVFN void phase_scan(const Params& p, int l, int dirsel, unsigned char* smem_raw) {
  float* sAf = (float*)smem_raw;
  u16* sBh = (u16*)(smem_raw + 32768);
  u16* sXc = (u16*)(smem_raw + 32768 + 16384);
  const int tid = otid(), lane = tid & 63, w = tid >> 6, lr = lane & 15, quad = lane >> 4;
  const int head = blockIdx.x & 7;
  const int dir = PASS == 1 ? ((blockIdx.x >> 3) & 1) : dirsel;
  const int tstart = PASS == 1 ? (blockIdx.x >> 4) : (blockIdx.x >> 3);
  const int tstep = PASS == 1 ? (gridDim.x >> 4) : (gridDim.x >> 3);
  const u16* xa = U(p, 1);
  u16* ga = U(p, 2);
  u16* hf = U(p, 5);
  float2* agg = (float2*)U(p, 4);
  float* carry = (float*)(agg + 1280L * 2 * 1024);
  bf16x8 bw[4][4];
  {
    const u16* wrg = WL(p, l) + W_RG;
#pragma unroll
    for (int jt = 0; jt < 4; ++jt) {
      int q = jt >> 1, col = w * 32 + (jt & 1) * 16 + lr;
      const u16* bp = wrg + (unsigned)((((dir * 2 + q) * 8 + head) * 128 + col) * 128 + quad * 8);
#pragma unroll
      for (int ks = 0; ks < 4; ++ks) bw[jt][ks] = *(const bf16x8*)(bp + ks * 32);
    }
  }
  float spl[2], brr[2], bii[2];
#pragma unroll
  for (int jc = 0; jc < 2; ++jc) {
    int cgl = head * 128 + w * 32 + jc * 16 + lr;
    float lm = p.lam[(l * 2 + dir) * D + cgl];
    spl[jc] = -8.f * 1.4426950408889634f * log1pf(expf(-lm));
    brr[jc] = -1.4426950408889634f * p.b_rg[((l * 2 + dir) * 2 + 0) * D + cgl];
    bii[jc] = -1.4426950408889634f * p.b_rg[((l * 2 + dir) * 2 + 1) * D + cgl];
  }
  const int c8 = tid & 15, tg = tid >> 4;
  float* sCw = (float*)(smem_raw + 65536);
  for (int i = tid; i < 640; i += 256) {
    int k = i >> 7, c = i & 127;
    sCw[i] = k < 4 ? p.conv_w[(l * 4 + k) * D + head * 128 + c] : p.conv_b[l * D + head * 128 + c];
  }
  __syncthreads();
  uint4 xr[7];
#define LOAD_XROWS(TT) do { const int _g0 = (TT) * 64; const int _sq = seq_of(_g0), _ss = seq_start(_sq), _se = _ss + seq_len(_sq); \
    _Pragma("unroll") for (int r = 0; r < 7; ++r) { int _g = _g0 + tg * 4 - 2 + r; xr[r] = make_uint4(0, 0, 0, 0); \
      if (_g >= _ss && _g < _se) xr[r] = *(const uint4*)(xa + ((unsigned)_g * D + head * 128 + c8 * 8)); } } while (0)
  if (tstart < 1280) LOAD_XROWS(tstart);
  for (int tt = tstart; tt < 1280; tt += tstep) {
    const int g0 = tt * 64;
    const int seq = seq_of(g0), sst = seq_start(seq), send = sst + seq_len(seq);
#pragma unroll
    for (int j = 0; j < 4; ++j) {
      float o[8];
      {
        float4 b0 = *(const float4*)(sCw + 512 + c8 * 8), b1 = *(const float4*)(sCw + 512 + c8 * 8 + 4);
        o[0] = b0.x; o[1] = b0.y; o[2] = b0.z; o[3] = b0.w; o[4] = b1.x; o[5] = b1.y; o[6] = b1.z; o[7] = b1.w;
      }
#pragma unroll
      for (int k = 0; k < 4; ++k) {
        uint4 v = xr[j + k];
        float4 w0 = *(const float4*)(sCw + k * 128 + c8 * 8), w1 = *(const float4*)(sCw + k * 128 + c8 * 8 + 4);
        o[0] += w0.x * lo2f(v.x); o[1] += w0.y * hi2f(v.x);
        o[2] += w0.z * lo2f(v.y); o[3] += w0.w * hi2f(v.y);
        o[4] += w1.x * lo2f(v.z); o[5] += w1.y * hi2f(v.z);
        o[6] += w1.z * lo2f(v.w); o[7] += w1.w * hi2f(v.w);
      }
      uint4 q0;
      q0.x = pack2(o[0], o[1]); q0.y = pack2(o[2], o[3]); q0.z = pack2(o[4], o[5]); q0.w = pack2(o[6], o[7]);
      const int tl = tg * 4 + j;
      *(uint4*)(sXc + tl * 128 + ((c8 ^ (tl & 7)) << 3)) = q0;
    }
    __syncthreads();
    if (tt + tstep < 1280) LOAD_XROWS(tt + tstep);
    const int gstart = dir == 0 ? sst : send - 1;
#pragma unroll 1
    for (int hv = 0; hv < 2; ++hv) {
      f32x4 acc[2][4];
#pragma unroll
      for (int it = 0; it < 2; ++it)
#pragma unroll
        for (int jt = 0; jt < 4; ++jt) acc[it][jt] = f32x4{0.f, 0.f, 0.f, 0.f};
#pragma unroll
      for (int ks = 0; ks < 4; ++ks) {
#pragma unroll
        for (int it = 0; it < 2; ++it) {
          bf16x8 af = *(const bf16x8*)(sXc + ((hv * 2 + it) * 16 + lr) * 128 + (((ks * 4 + quad) ^ (lr & 7)) << 3));
#pragma unroll
          for (int jt = 0; jt < 4; ++jt)
            acc[it][jt] = __builtin_amdgcn_mfma_f32_16x16x32_bf16(af, bw[jt][ks], acc[it][jt], 0, 0, 0);
        }
      }
#pragma unroll
      for (int it = 0; it < 2; ++it)
#pragma unroll
        for (int jc = 0; jc < 2; ++jc) {
#pragma unroll
          for (int r = 0; r < 4; ++r) {
            int tl = (hv * 2 + it) * 16 + quad * 4 + r, c = w * 32 + jc * 16 + lr;
            float rr = __builtin_amdgcn_rcpf(1.f + __builtin_amdgcn_exp2f(fmaf(acc[it][jc][r], -1.4426950408889634f, brr[jc])));
            float ii = __builtin_amdgcn_rcpf(1.f + __builtin_amdgcn_exp2f(fmaf(acc[it][2 + jc][r], -1.4426950408889634f, bii[jc])));
            float a = __builtin_amdgcn_exp2f(rr * spl[jc]);
            float mult = __builtin_amdgcn_sqrtf(fmaxf(fmaf(-a, a, 1.f), 0.f));
            if (g0 + tl == gstart) mult = 1.f;
            float xv = bf2f(sXc[tl * 128 + (((c >> 3) ^ (tl & 7)) << 3) + (c & 7)]);
            sAf[tl * SA_LD + c] = a;
            sBh[tl * 128 + c] = f2bf(mult * ii * xv);
          }
        }
    }
    __syncthreads();
    if (tid < 128) {
      const int c = tid;
      const unsigned aidx = (unsigned)(tt * 2 + dir) * 1024 + head * 128 + c;
      const float* ap = sAf + c;
      u16* bp = sBh + c;
      if (PASS == 1) {
        float h = 0.f, P = 1.f;
        if (dir == 0) {
#pragma unroll 16
          for (int st = 0; st < 64; ++st) { float a = ap[st * SA_LD]; h = a * h + bf2f(bp[st * 128]); P *= a; }
        } else {
#pragma unroll 16
          for (int st = 63; st >= 0; --st) { float a = ap[st * SA_LD]; h = a * h + bf2f(bp[st * 128]); P *= a; }
        }
        agg[aidx] = make_float2(P, h);
      } else {
        float h = carry[aidx];
        if (dir == 0) {
#pragma unroll 16
          for (int st = 0; st < 64; ++st) { h = ap[st * SA_LD] * h + bf2f(bp[st * 128]); bp[st * 128] = f2bf(h); }
        } else {
#pragma unroll 16
          for (int st = 63; st >= 0; --st) { h = ap[st * SA_LD] * h + bf2f(bp[st * 128]); bp[st * 128] = f2bf(h); }
        }
      }
    }
    if (PASS == 3) {
      __syncthreads();
#pragma unroll
      for (int cch = 0; cch < 4; ++cch) {
        int chunk = tid + cch * 256;
        int t = chunk >> 4, cc = (chunk & 15) * 8;
        unsigned off = (unsigned)(g0 + t) * D + head * 128 + cc;
        uint4 hv = *(const uint4*)(sBh + t * 128 + cc);
        if (dir == 0) {
          *(uint4*)(hf + off) = hv;
        } else {
          uint4 fv = *(const uint4*)(hf + off);
          uint4 gv = *(const uint4*)(ga + off);
          uint4 o;
          o.x = pack2((lo2f(fv.x) + lo2f(hv.x)) * lo2f(gv.x), (hi2f(fv.x) + hi2f(hv.x)) * hi2f(gv.x));
          o.y = pack2((lo2f(fv.y) + lo2f(hv.y)) * lo2f(gv.y), (hi2f(fv.y) + hi2f(hv.y)) * hi2f(gv.y));
          o.z = pack2((lo2f(fv.z) + lo2f(hv.z)) * lo2f(gv.z), (hi2f(fv.z) + hi2f(hv.z)) * hi2f(gv.z));
          o.w = pack2((lo2f(fv.w) + lo2f(hv.w)) * lo2f(gv.w), (hi2f(fv.w) + hi2f(hv.w)) * hi2f(gv.w));
          *(uint4*)(ga + off) = o;
        }
      }
    }
    __syncthreads();
  }
#undef LOAD_XROWS
}

DEVFN void lb_st64(unsigned long long* q, unsigned long long v) { __hip_atomic_store(q, v, __ATOMIC_RELAXED, __HIP_MEMORY_SCOPE_AGENT); }
DEVFN unsigned long long lb_ld64(const unsigned long long* q) { return __hip_atomic_load(q, __ATOMIC_RELAXED, __HIP_MEMORY_SCOPE_AGENT); }
DEVFN void lb_st32(unsigned* q, unsigned v) { __hip_atomic_store(q, v, __ATOMIC_RELAXED, __HIP_MEMORY_SCOPE_AGENT); }
DEVFN unsigned lb_ld32(const unsigned* q) { return __hip_atomic_load(q, __ATOMIC_RELAXED, __HIP_MEMORY_SCOPE_AGENT); }
DEVFN unsigned long long lb_pack(float a, float b) { return (unsigned long long)__float_as_uint(a) | ((unsigned long long)__float_as_uint(b) << 32); }
DEVFN unsigned long long lb_gran(float P, float H, unsigned tag) {
  return ((unsigned long long)__float_as_uint(H) << 32) | (unsigned long long)((__float_as_uint(P) & 0xffffff00u) | tag);
}
DEVFN int lb_rank(int seq, int pos) { return seq == 0 ? (pos >> 1) * 10 + ((pos & 1) ? 9 : 0) : pos * 10 + seq; }
DEVFN void lb_decode(int r, int dir, int& seq, int& pos, int& tt) {
  int pair = r / 10, j = r - pair * 10;
  if (j == 0) { seq = 0; pos = 2 * pair; } else if (j == 9) { seq = 0; pos = 2 * pair + 1; } else { seq = j; pos = pair; }
  int len = seq == 0 ? 256 : 128;
  tt = (seq_start(seq) >> 6) + (dir ? len - 1 - pos : pos);
}
DEVFN void phase_scan_lb(const Params& p, int l, unsigned char* smem_raw) {
  float* sAt = (float*)smem_raw;
  u16* sBt = (u16*)(smem_raw + 34816);
  u16* sXc = (u16*)(smem_raw + 53248);
  u16* sBh = sXc;
  unsigned* sflag = (unsigned*)(smem_raw + 72192);
  const int tid = otid(), lane = tid & 63, w = tid >> 6, lr = lane & 15, quad = lane >> 4;
  const int hd = blockIdx.x & 15, head = hd >> 1, dir = hd & 1;
  const int rstart = blockIdx.x >> 4, rstep = gridDim.x >> 4;
  const u16* xa = U(p, 1);
  u16* ga = U(p, 2);
  u16* hown = dir == 0 ? U(p, 5) : U(p, 4);
  const u16* hoth = dir == 0 ? U(p, 4) : U(p, 5);
  unsigned long long* slot = (unsigned long long*)(p.ws + OFF_LB_BYTES);
  unsigned* stat = (unsigned*)(p.ws + OFF_LB_BYTES + LB_SLOT_BYTES);
  unsigned* cnt = stat + 20480;
  const unsigned ep = 2u * (unsigned)l;
  const unsigned tagb = ((unsigned)l + 1u) * 4u;
  bf16x8 bw[4][4];
  {
    const u16* wrg = WL(p, l) + W_RG;
#pragma unroll
    for (int jt = 0; jt < 4; ++jt) {
      int q = jt >> 1, col = w * 32 + (jt & 1) * 16 + lr;
      const u16* bp = wrg + (unsigned)((((dir * 2 + q) * 8 + head) * 128 + col) * 128 + quad * 8);
#pragma unroll
      for (int ks = 0; ks < 4; ++ks) bw[jt][ks] = *(const bf16x8*)(bp + ks * 32);
    }
  }
  float spl[2], brr[2], bii[2];
#pragma unroll
  for (int jc = 0; jc < 2; ++jc) {
    int cgl = head * 128 + w * 32 + jc * 16 + lr;
    float lm = p.lam[(l * 2 + dir) * D + cgl];
    spl[jc] = -8.f * 1.4426950408889634f * log1pf(expf(-lm));
    brr[jc] = -1.4426950408889634f * p.b_rg[((l * 2 + dir) * 2 + 0) * D + cgl];
    bii[jc] = -1.4426950408889634f * p.b_rg[((l * 2 + dir) * 2 + 1) * D + cgl];
  }
  const int c8 = tid & 15, tg = tid >> 4;
  float* sCw = (float*)(smem_raw + 69632);
  for (int i = tid; i < 640; i += 256) {
    int k = i >> 7, c = i & 127;
    sCw[i] = k < 4 ? p.conv_w[(l * 4 + k) * D + head * 128 + c] : p.conv_b[l * D + head * 128 + c];
  }
  __syncthreads();
  uint4 xr[7];
#define LOAD_XROWS(TT) do { const int _g0 = (TT) * 64; const int _sq = seq_of(_g0), _ss = seq_start(_sq), _se = _ss + seq_len(_sq); \
    _Pragma("unroll") for (int r_ = 0; r_ < 7; ++r_) { int _g = _g0 + tg * 4 - 2 + r_; xr[r_] = make_uint4(0, 0, 0, 0); \
      if (_g >= _ss && _g < _se) xr[r_] = *(const uint4*)(xa + ((unsigned)_g * D + head * 128 + c8 * 8)); } } while (0)
  if (rstart < 1280) { int sq_, ps_, t0_; lb_decode(rstart, dir, sq_, ps_, t0_); LOAD_XROWS(t0_); }
  for (int r = rstart; r < 1280; r += rstep) {
    int seq, pos, tt;
    lb_decode(r, dir, seq, pos, tt);
    const int item = r * 16 + hd;
    const int g0 = tt * 64;
    const int sst = seq_start(seq), send = sst + seq_len(seq);
#pragma unroll
    for (int j = 0; j < 4; ++j) {
      float o[8];
      {
        float4 b0 = *(const float4*)(sCw + 512 + c8 * 8), b1 = *(const float4*)(sCw + 512 + c8 * 8 + 4);
        o[0] = b0.x; o[1] = b0.y; o[2] = b0.z; o[3] = b0.w; o[4] = b1.x; o[5] = b1.y; o[6] = b1.z; o[7] = b1.w;
      }
#pragma unroll
      for (int k = 0; k < 4; ++k) {
        uint4 v = xr[j + k];
        float4 w0 = *(const float4*)(sCw + k * 128 + c8 * 8), w1 = *(const float4*)(sCw + k * 128 + c8 * 8 + 4);
        o[0] += w0.x * lo2f(v.x); o[1] += w0.y * hi2f(v.x);
        o[2] += w0.z * lo2f(v.y); o[3] += w0.w * hi2f(v.y);
        o[4] += w1.x * lo2f(v.z); o[5] += w1.y * hi2f(v.z);
        o[6] += w1.z * lo2f(v.w); o[7] += w1.w * hi2f(v.w);
      }
      uint4 q0;
      q0.x = pack2(o[0], o[1]); q0.y = pack2(o[2], o[3]); q0.z = pack2(o[4], o[5]); q0.w = pack2(o[6], o[7]);
      const int tl = tg * 4 + j;
      *(uint4*)(sXc + tl * 128 + ((c8 ^ (tl & 7)) << 3)) = q0;
    }
    __syncthreads();
    if (r + rstep < 1280) { int sq_, ps_, t1_; lb_decode(r + rstep, dir, sq_, ps_, t1_); LOAD_XROWS(t1_); }
    const int gstart = dir == 0 ? sst : send - 1;
#pragma unroll 1
    for (int hv = 0; hv < 2; ++hv) {
      f32x4 acc[2][4];
#pragma unroll
      for (int it = 0; it < 2; ++it)
#pragma unroll
        for (int jt = 0; jt < 4; ++jt) acc[it][jt] = f32x4{0.f, 0.f, 0.f, 0.f};
#pragma unroll
      for (int ks = 0; ks < 4; ++ks) {
#pragma unroll
        for (int it = 0; it < 2; ++it) {
          bf16x8 af = *(const bf16x8*)(sXc + ((hv * 2 + it) * 16 + lr) * 128 + (((ks * 4 + quad) ^ (lr & 7)) << 3));
#pragma unroll
          for (int jt = 0; jt < 4; ++jt)
            acc[it][jt] = __builtin_amdgcn_mfma_f32_16x16x32_bf16(af, bw[jt][ks], acc[it][jt], 0, 0, 0);
        }
      }
#pragma unroll
      for (int it = 0; it < 2; ++it)
#pragma unroll
        for (int jc = 0; jc < 2; ++jc) {
          float av[4], bv[4];
          const int c = w * 32 + jc * 16 + lr, t0 = (hv * 2 + it) * 16 + quad * 4;
#pragma unroll
          for (int r = 0; r < 4; ++r) {
            const int tl = t0 + r;
            float rr = __builtin_amdgcn_rcpf(1.f + __builtin_amdgcn_exp2f(fmaf(acc[it][jc][r], -1.4426950408889634f, brr[jc])));
            float ii = __builtin_amdgcn_rcpf(1.f + __builtin_amdgcn_exp2f(fmaf(acc[it][2 + jc][r], -1.4426950408889634f, bii[jc])));
            float a = __builtin_amdgcn_exp2f(rr * spl[jc]);
            float mult = __builtin_amdgcn_sqrtf(fmaxf(fmaf(-a, a, 1.f), 0.f));
            if (g0 + tl == gstart) mult = 1.f;
            float xv = bf2f(sXc[tl * 128 + (((c >> 3) ^ (tl & 7)) << 3) + (c & 7)]);
            av[r] = a;
            bv[r] = mult * ii * xv;
          }
          *(float4*)(sAt + c * 68 + t0) = make_float4(av[0], av[1], av[2], av[3]);
          uint2 bq; bq.x = pack2(bv[0], bv[1]); bq.y = pack2(bv[2], bv[3]);
          *(uint2*)(sBt + c * 72 + t0) = bq;
        }
    }
    __syncthreads();
    const int sc_c = tid & 127, sc_part = tid >> 7;
    float2* sEx = (float2*)(smem_raw + 72208);
    float* sCar = (float*)(sEx + 256);
    float partP = 1.f, partH = 0.f;
    {
      const float* ap = sAt + sc_c * 68;
      const u16* bp = sBt + sc_c * 72;
#pragma unroll
      for (int gq = 0; gq < 8; ++gq) {
        const int t = dir == 0 ? sc_part * 32 + gq * 4 : 60 - sc_part * 32 - gq * 4;
        const float4 a4 = *(const float4*)(ap + t);
        const uint2 b4 = *(const uint2*)(bp + t);
        if (dir == 0) {
          partH = a4.x * partH + lo2f(b4.x); partH = a4.y * partH + hi2f(b4.x);
          partH = a4.z * partH + lo2f(b4.y); partH = a4.w * partH + hi2f(b4.y);
        } else {
          partH = a4.w * partH + hi2f(b4.y); partH = a4.z * partH + lo2f(b4.y);
          partH = a4.y * partH + hi2f(b4.x); partH = a4.x * partH + lo2f(b4.x);
        }
        partP *= (a4.x * a4.y) * (a4.z * a4.w);
      }
      sEx[sc_part * 128 + sc_c] = make_float2(partP, partH);
    }
    __syncthreads();
    float carry = 0.f;
    if (tid < 128) {
      const float2 e1 = sEx[128 + tid];
      const float aggP = partP * e1.x, aggH = e1.x * partH + e1.y;
      lb_st64(slot + (unsigned)item * 128 + tid, lb_gran(pos == 0 ? 0.f : aggP, aggH, tagb + (pos == 0 ? 2u : 1u)));
      if (pos > 0) {
        float Pr = 1.f, Hr = 0.f;
        int pj = pos - 1;
        for (;;) {
          const int j = lb_rank(seq, pj) * 16 + hd;
          unsigned long long v;
          unsigned spins = 0;
          for (;;) {
            v = lb_ld64(slot + (unsigned)j * 128 + tid);
            unsigned tg_ = (unsigned)v & 0xffu;
            if ((tg_ >> 2) == (tagb >> 2) && (tg_ & 3u) != 0u) break;
            __builtin_amdgcn_s_sleep(1);
            if (++spins > (1u << 18)) break;
          }
          float Pj = __uint_as_float((unsigned)v & 0xffffff00u), Hj = __uint_as_float((unsigned)(v >> 32));
          Hr += Pr * Hj;
          Pr *= Pj;
          if (((unsigned)v & 3u) == 2u || pj == 0) break;
          --pj;
        }
        carry = Hr;
        lb_st64(slot + (unsigned)item * 128 + tid, lb_gran(0.f, aggP * carry + aggH, tagb + 2u));
      }
      sCar[tid] = partP * carry + partH;
    }
    __syncthreads();
    {
      const float* ap = sAt + sc_c * 68;
      const u16* bp = sBt + sc_c * 72;
      u16* hp = sBh + sc_c;
      float h = sc_part == 0 ? carry : sCar[sc_c];
#pragma unroll
      for (int gq = 0; gq < 8; ++gq) {
        const int t = dir == 0 ? sc_part * 32 + gq * 4 : 60 - sc_part * 32 - gq * 4;
        const float4 a4 = *(const float4*)(ap + t);
        const uint2 b4 = *(const uint2*)(bp + t);
        if (dir == 0) {
          h = a4.x * h + lo2f(b4.x); hp[(t + 0) * 128] = f2bf(h);
          h = a4.y * h + hi2f(b4.x); hp[(t + 1) * 128] = f2bf(h);
          h = a4.z * h + lo2f(b4.y); hp[(t + 2) * 128] = f2bf(h);
          h = a4.w * h + hi2f(b4.y); hp[(t + 3) * 128] = f2bf(h);
        } else {
          h = a4.w * h + hi2f(b4.y); hp[(t + 3) * 128] = f2bf(h);
          h = a4.z * h + lo2f(b4.y); hp[(t + 2) * 128] = f2bf(h);
          h = a4.y * h + hi2f(b4.x); hp[(t + 1) * 128] = f2bf(h);
          h = a4.x * h + lo2f(b4.x); hp[(t + 0) * 128] = f2bf(h);
        }
      }
    }
    __syncthreads();
    const int len_ = seq == 0 ? 256 : 128;
    const int ppos = len_ - 1 - pos;
    if (pos < ppos) {
#pragma unroll
      for (int cch = 0; cch < 4; ++cch) {
        int chunk = tid + cch * 256;
        int t = chunk >> 4, cc = (chunk & 15) * 8;
        unsigned off = (unsigned)(g0 + t) * D + head * 128 + cc;
        uint4 hv = *(const uint4*)(sBh + t * 128 + cc);
        unsigned long long* q = (unsigned long long*)(hown + off);
        lb_st64(q, (unsigned long long)hv.x | ((unsigned long long)hv.y << 32));
        lb_st64(q + 1, (unsigned long long)hv.z | ((unsigned long long)hv.w << 32));
      }
      asm volatile("s_waitcnt vmcnt(0)" ::: "memory");
      __syncthreads();
      if (tid == 0) lb_st32(stat + item, (unsigned)l + 1u);
    } else {
      const int pit = lb_rank(seq, ppos) * 16 + (hd ^ 1);
      unsigned spins = 0;
      while (lb_ld32(stat + pit) != (unsigned)l + 1u) { __builtin_amdgcn_s_sleep(1); if (++spins > (1u << 18)) break; }
#pragma unroll
      for (int cch = 0; cch < 4; ++cch) {
        int chunk = tid + cch * 256;
        int t = chunk >> 4, cc = (chunk & 15) * 8;
        unsigned off = (unsigned)(g0 + t) * D + head * 128 + cc;
        uint4 hv = *(const uint4*)(sBh + t * 128 + cc);
        const unsigned long long* q = (const unsigned long long*)(hoth + off);
        unsigned long long f0 = lb_ld64(q), f1 = lb_ld64(q + 1);
        uint4 fv = make_uint4((unsigned)f0, (unsigned)(f0 >> 32), (unsigned)f1, (unsigned)(f1 >> 32));
        uint4 gv = *(const uint4*)(ga + off);
        uint4 o;
        o.x = pack2((lo2f(fv.x) + lo2f(hv.x)) * lo2f(gv.x), (hi2f(fv.x) + hi2f(hv.x)) * hi2f(gv.x));
        o.y = pack2((lo2f(fv.y) + lo2f(hv.y)) * lo2f(gv.y), (hi2f(fv.y) + hi2f(hv.y)) * hi2f(gv.y));
        o.z = pack2((lo2f(fv.z) + lo2f(hv.z)) * lo2f(gv.z), (hi2f(fv.z) + hi2f(hv.z)) * hi2f(gv.z));
        o.w = pack2((lo2f(fv.w) + lo2f(hv.w)) * lo2f(gv.w), (hi2f(fv.w) + hi2f(hv.w)) * hi2f(gv.w));
        *(uint4*)(ga + off) = o;
      }
    }
    __syncthreads();
  }
#undef LOAD_XROWS
}

DEVFN void phase_carry(const Params& p) {
  const float2* __restrict__ agg = (const float2*)U(p, 4);
  float* __restrict__ carry = (float*)(agg + 1280L * 2 * 1024);
  const int lane = threadIdx.x & 63, w = threadIdx.x >> 6;
  for (int u = blockIdx.x + gridDim.x * w; u < 288; u += gridDim.x * 4) {
    int id = u * 64 + lane;
    int seq = id >> 11, dir = (id >> 10) & 1, c = id & 1023;
    int nt = seq_len(seq) >> 6, tile0 = seq_start(seq) >> 6;
    float h = 0.f;
#pragma unroll 8
    for (int k = 0; k < nt; ++k) {
      int tt = tile0 + (dir ? nt - 1 - k : k);
      unsigned ix = (unsigned)(tt * 2 + dir) * 1024 + c;
      float2 v = agg[ix];
      carry[ix] = h;
      h = v.x * h + v.y;
    }
  }
}

DEVFN void phase_merge(const Params& p, int l, u16* smem) {
  const u16* wl = WL(p, l);
  u16* mo = U(p, 1);
  u16* tb = U(p, 5);
  u16* so = smem;
  for (int it = 0;; ++it) {
    int mt, nt;
    if (!tile_xcd(it, 1, 8, mt, nt)) break;
    const int g0 = mt * 256;
#pragma unroll 1
    for (int br = 0; br < 2; ++br) {
      {
        const int tid = otid(), lane = tid & 63, w = tid >> 6, wm = w >> 1, wn = w & 1, lr = lane & 15, quad = lane >> 4;
        f32x4 acc[8][4]; zero_acc8(acc);
        LdPlain lb; lb.init(tid, wl + (br == 0 ? W_A : W_B), nt * 128, D);
        if (br == 0) {
          LdPlain la; la.init(tid, U(p, 2), g0, D);
          gemm_core_b(tid, acc, 32, la, lb, smem);
        } else {
          const int seq = seq_of(g0);
          LdPerm la; la.base = U(p, 3); la.g0 = g0; la.sst = seq_start(seq); la.lg = seq == 0 ? 7 : 6;
          gemm_core_b(tid, acc, 32, la, lb, smem);
        }
#pragma unroll
        for (int i = 0; i < 8; ++i) {
          const int m = wm * 128 + i * 16 + lr;
#pragma unroll
          for (int j = 0; j < 4; ++j) {
            const int n = wn * 64 + j * 16 + quad * 4;
            uint2 o; o.x = pack2(acc[i][j][0], acc[i][j][1]); o.y = pack2(acc[i][j][2], acc[i][j][3]);
            *(uint2*)(so + m * 136 + n) = o;
          }
        }
        __syncthreads();
#pragma unroll
        for (int c = 0; c < 16; ++c) {
          const int idx = tid + c * 256;
          const int row = idx >> 4, ch = idx & 15;
          *(uint4*)(tb + ((unsigned)(g0 + row) * D + nt * 128 + ch * 8)) = *(const uint4*)(so + row * 136 + ch * 8);
        }
        __syncthreads();
      }
      {
        const int tid = otid(), lane = tid & 63, w = tid >> 6, wm = w >> 1, wn = w & 1, lr = lane & 15, quad = lane >> 4;
        f32x4 acc[8][4]; zero_acc8(acc);
        LdPlain la; la.init(tid, U(p, 0), g0, D);
        LdPlain lb; lb.init(tid, wl + W_CAT, 5120 + br * 1024 + nt * 128, D);
        gemm_core_b(tid, acc, 32, la, lb, smem);
#pragma unroll
        for (int c = 0; c < 16; ++c) {
          const int idx = tid + c * 256;
          const int row = idx >> 4, ch = idx & 15;
          *(uint4*)(so + row * 136 + ch * 8) = *(const uint4*)(tb + ((unsigned)(g0 + row) * D + nt * 128 + ch * 8));
        }
        __syncthreads();
#pragma unroll
        for (int i = 0; i < 8; ++i) {
          const int m = wm * 128 + i * 16 + lr;
#pragma unroll
          for (int j = 0; j < 4; ++j) {
            const int n = wn * 64 + j * 16 + quad * 4;
            uint2 tv = *(const uint2*)(so + m * 136 + n);
            acc[i][j][0] = sigm(acc[i][j][0]) * lo2f(tv.x);
            acc[i][j][1] = sigm(acc[i][j][1]) * hi2f(tv.x);
            acc[i][j][2] = sigm(acc[i][j][2]) * lo2f(tv.y);
            acc[i][j][3] = sigm(acc[i][j][3]) * hi2f(tv.y);
          }
        }
        if (br == 1) {
          __syncthreads();
#pragma unroll
          for (int c = 0; c < 16; ++c) {
            const int idx = tid + c * 256;
            const int row = idx >> 4, ch = idx & 15;
            *(uint4*)(so + row * 136 + ch * 8) = *(const uint4*)(mo + ((unsigned)(g0 + row) * D + nt * 128 + ch * 8));
          }
          __syncthreads();
#pragma unroll
          for (int i = 0; i < 8; ++i) {
            const int m = wm * 128 + i * 16 + lr;
#pragma unroll
            for (int j = 0; j < 4; ++j) {
              const int n = wn * 64 + j * 16 + quad * 4;
              uint2 pv = *(const uint2*)(so + m * 136 + n);
              acc[i][j][0] += lo2f(pv.x); acc[i][j][1] += hi2f(pv.x);
              acc[i][j][2] += lo2f(pv.y); acc[i][j][3] += hi2f(pv.y);
            }
          }
        }
        __syncthreads();
#pragma unroll
        for (int i = 0; i < 8; ++i) {
          const int m = wm * 128 + i * 16 + lr;
#pragma unroll
          for (int j = 0; j < 4; ++j) {
            const int n = wn * 64 + j * 16 + quad * 4;
            uint2 o; o.x = pack2(acc[i][j][0], acc[i][j][1]); o.y = pack2(acc[i][j][2], acc[i][j][3]);
            *(uint2*)(so + m * 136 + n) = o;
          }
        }
        __syncthreads();
#pragma unroll
        for (int c = 0; c < 16; ++c) {
          const int idx = tid + c * 256;
          const int row = idx >> 4, ch = idx & 15;
          *(uint4*)(mo + ((unsigned)(g0 + row) * D + nt * 128 + ch * 8)) = *(const uint4*)(so + row * 136 + ch * 8);
        }
        __syncthreads();
      }
    }
  }
}

DEVFN void phase_out(const Params& p, int l, u16* smem) {
  const u16* wo = WL(p, l) + W_O;
  for (int it = 0;; ++it) {
    int mt, nt;
    if (!tile_xcd(it, 1, 8, mt, nt)) break;
    const int tid = otid(), lane = tid & 63, w = tid >> 6, wm = w >> 1, wn = w & 1, lr = lane & 15, quad = lane >> 4;
    const int g0 = mt * 256;
    LdPlain la; la.init(tid, U(p, 1), g0, D);
    LdPlain lb; lb.init(tid, wo, nt * 128, D);
    f32x4 acc[8][4]; zero_acc8(acc);
    gemm_core_b(tid, acc, 32, la, lb, smem);
    const float* gate = MOD(p) + ((long)l * 9 + seq_of(g0)) * 3072 + 2048;
#pragma unroll
    for (int i = 0; i < 8; ++i) {
      unsigned g = g0 + wm * 128 + i * 16 + lr;
      const float* xb = (l == 0) ? (g0 < 16384 ? p.x_prompt : p.x_sample) : p.out;
      const float* xr = xb + (unsigned)((l == 0 && g0 >= 16384) ? g - 16384 : g) * D;
      float* orow = p.out + g * D;
#pragma unroll
      for (int j = 0; j < 4; ++j) {
        unsigned c = nt * 128 + wn * 64 + j * 16 + quad * 4;
        float4 xv = *(const float4*)(xr + c);
        float4 gt = *(const float4*)(gate + c);
        float4 o;
        o.x = xv.x + gt.x * acc[i][j][0]; o.y = xv.y + gt.y * acc[i][j][1];
        o.z = xv.z + gt.z * acc[i][j][2]; o.w = xv.w + gt.w * acc[i][j][3];
        *(float4*)(orow + c) = o;
      }
    }
  }
}

#define XB_TMO      128
#define XB_XCNT(j)  (256  + 64 * (j))
#define XB_XSUB(j)  (1280 + 64 * (j))
#define XB_XGEN(j)  (2304 + 64 * (j))
#define XB_TOP      3328
#define XB_TOPGEN   3392
#define XCD_BAR_WORDS 3456
#define XB_SPIN_CAP (1u << 18)
#define LAS __attribute__((address_space(3)))

__device__ __forceinline__ unsigned xb_ld(unsigned* p)              { return __hip_atomic_load(p, __ATOMIC_RELAXED, __HIP_MEMORY_SCOPE_AGENT); }
__device__ __forceinline__ unsigned xb_add(unsigned* p, unsigned v) { return __hip_atomic_fetch_add(p, v, __ATOMIC_RELAXED, __HIP_MEMORY_SCOPE_AGENT); }
__device__ __forceinline__ unsigned xb_xcc_id() { return (unsigned)__builtin_amdgcn_s_getreg((3 << 11) | 20) & 0xFu; }
#define XB_SPIN(cond, bar) do { unsigned _sp = 0; while (cond) { __builtin_amdgcn_s_sleep(1); \
    if ((++_sp & 255u) == 0u) { if (xb_ld(&(bar)[XB_TMO])) break; if (_sp > XB_SPIN_CAP) { atomicAdd(&(bar)[XB_TMO], 1u); break; } } } } while (0)

struct XcdBarrier {
    unsigned* bar; unsigned x;
    volatile LAS unsigned* st;
};

__device__ __forceinline__ XcdBarrier xcd_barrier_post(unsigned* bar, volatile LAS unsigned* st) {
    XcdBarrier b; b.bar = bar; b.x = xb_xcc_id(); b.st = st;
    if (threadIdx.x == 0) (void)xb_add(&bar[XB_XCNT(b.x)], 1u);
    return b;
}
__device__ __forceinline__ void xcd_barrier_complete(unsigned* bar, unsigned x, unsigned& nloc, unsigned& nx) {
    const unsigned G = gridDim.x * gridDim.y * gridDim.z;
    unsigned sum, cnt, mine, sp = 0u;
    for (;;) {
        sum = 0u; cnt = 0u; mine = 0u;
#pragma unroll
        for (unsigned j = 0; j < 16; ++j) { const unsigned c = xb_ld(&bar[XB_XCNT(j)]); sum += c; cnt += (c > 0u) ? 1u : 0u; mine = (j == x) ? c : mine; }
        if (sum == G) break;
        __builtin_amdgcn_s_sleep(1);
        if ((++sp & 255u) == 0u) { if (xb_ld(&bar[XB_TMO])) break; if (sp > XB_SPIN_CAP) { atomicAdd(&bar[XB_TMO], 1u); break; } }
    }
    nloc = mine > 0u ? mine : 1u; nx = cnt > 0u ? cnt : 1u;
}

__device__ __forceinline__ void xcd_barrier(const XcdBarrier& b) {
    asm volatile("s_waitcnt vmcnt(0)" ::: "memory");
    __syncthreads();
    if (threadIdx.x == 0) {
        unsigned* bar = b.bar;
        __builtin_amdgcn_s_waitcnt(0);
        unsigned nloc = b.st[0], nx = b.st[1];
        if (nloc == 0u) { xcd_barrier_complete(bar, b.x, nloc, nx); b.st[0] = nloc; b.st[1] = nx; }
        const unsigned old = xb_add(&bar[XB_XSUB(b.x)], 1u);
        const unsigned gen = old / nloc;
        if (old + 1u == (gen + 1u) * nloc) {
            __builtin_amdgcn_fence(__ATOMIC_RELEASE, "agent");
            asm volatile("s_waitcnt vmcnt(0)" ::: "memory");
            const unsigned og = xb_add(&bar[XB_TOP], 1u);
            const unsigned tg = og / nx;
            if (og + 1u == (tg + 1u) * nx) xb_add(&bar[XB_TOPGEN], 1u);
            else XB_SPIN(xb_ld(&bar[XB_TOPGEN]) == tg, bar);
            __builtin_amdgcn_fence(__ATOMIC_ACQUIRE, "agent");
            xb_add(&bar[XB_XGEN(b.x)], 1u);
            asm volatile("s_waitcnt vmcnt(0)" ::: "memory");
        } else {
            XB_SPIN(xb_ld(&bar[XB_XGEN(b.x)]) == gen, bar);
            __builtin_amdgcn_fence(__ATOMIC_ACQUIRE, "agent");
            asm volatile("s_waitcnt vmcnt(0)" ::: "memory");
        }
    }
    __syncthreads();
}


__global__ void __launch_bounds__(256, 2) hawk_fnet_megakernel(Params p) {
  extern __shared__ __attribute__((aligned(16))) unsigned char smem_raw[];
  cg::grid_group grid = cg::this_grid();
  u16* smem = (u16*)smem_raw;

  __shared__ unsigned xb_st[4];
  unsigned* bar = (unsigned*)(p.ws + OFF_BAR_BYTES);
  if (blockIdx.x == 0) {
    for (int i = threadIdx.x; i < XCD_BAR_WORDS; i += 256) __hip_atomic_store(&bar[i], 0u, __ATOMIC_RELAXED, __HIP_MEMORY_SCOPE_AGENT);
  }
  if (threadIdx.x < 4) xb_st[threadIdx.x] = 0u;
  {
    unsigned* lbs = (unsigned*)(p.ws + OFF_LB_BYTES + LB_SLOT_BYTES);
    for (int i = blockIdx.x * 256 + threadIdx.x; i < 20480 + 10240; i += gridDim.x * 256)
      __hip_atomic_store(&lbs[i], 0u, __ATOMIC_RELAXED, __HIP_MEMORY_SCOPE_AGENT);
    unsigned long long* lbq = (unsigned long long*)(p.ws + OFF_LB_BYTES);
    for (int i = blockIdx.x * 256 + threadIdx.x; i < (int)(LB_SLOT_BYTES / 8); i += gridDim.x * 256)
      __hip_atomic_store(&lbq[i], 0ull, __ATOMIC_RELAXED, __HIP_MEMORY_SCOPE_AGENT);
  }
  phase_prologue(p, smem_raw);
  grid.sync();
  XcdBarrier xb = xcd_barrier_post(bar, (volatile LAS unsigned*)xb_st);
  phase_fold(p, smem);
  phase_h(p, 0);
  xcd_barrier(xb);
  for (int l = 0; l < 2; ++l) {
    phase_gemm1(p, l, smem);
    xcd_barrier(xb);
    phase_fft1(p, smem);
    xcd_barrier(xb);
    phase_fft2(p, smem);
    xcd_barrier(xb);
    phase_scan_lb(p, l, smem_raw);
    xcd_barrier(xb);
    phase_merge(p, l, smem);
    xcd_barrier(xb);
    phase_out(p, l, smem);
    xcd_barrier(xb);
    if (l == 0) { phase_h(p, 1); xcd_barrier(xb); }
  }
  phase_final(p);
}

extern "C" void kernel_launch(void* const* d_in, const int* in_sizes, int n_in,
                              void* d_out, int out_size, void* d_ws, size_t ws_size,
                              hipStream_t stream) {
  (void)in_sizes; (void)n_in; (void)out_size;
  if (ws_size < (size_t)WS_NEED) {
    fprintf(stderr, "workspace too small: %zu < %ld\n", ws_size, (long)WS_NEED);
    return;
  }
  static int grid_blocks = 0;
  if (!grid_blocks) {
    hipFuncSetAttribute((const void*)hawk_fnet_megakernel, hipFuncAttributeMaxDynamicSharedMemorySize, SMEM_BYTES);
    int dev = 0, cus = 0, per_cu = 0;
    hipGetDevice(&dev);
    hipDeviceGetAttribute(&cus, hipDeviceAttributeMultiprocessorCount, dev);
    hipOccupancyMaxActiveBlocksPerMultiprocessor(&per_cu, hawk_fnet_megakernel, 256, SMEM_BYTES);
    if (per_cu > 2) per_cu = 2;
    if (per_cu < 1) per_cu = 1;
    grid_blocks = (cus * per_cu) & ~15;
  }
  Params p{};
  p.x_prompt = (const float*)d_in[0]; p.x_sample = (const float*)d_in[1];
  p.c_prompt = (const float*)d_in[2]; p.c_sample = (const float*)d_in[3];
  p.norm_g = (const float*)d_in[4]; p.w_ada = (const float*)d_in[5]; p.b_ada = (const float*)d_in[6];
  p.w_in = (const float*)d_in[7]; p.conv_w = (const float*)d_in[8]; p.conv_b = (const float*)d_in[9];
  p.w_rg = (const float*)d_in[10]; p.b_rg = (const float*)d_in[11]; p.lam = (const float*)d_in[12];
  p.w_a_out = (const float*)d_in[13]; p.w_b_out = (const float*)d_in[14]; p.w_o = (const float*)d_in[15];
  p.final_g = (const float*)d_in[16];
  p.out = (float*)d_out; p.ws = (unsigned char*)d_ws;
  void* args[] = {&p};
  hipError_t e = hipLaunchCooperativeKernel((void*)hawk_fnet_megakernel, dim3(grid_blocks), dim3(256), args, SMEM_BYTES, stream);
  if (e != hipSuccess) fprintf(stderr, "cooperative launch failed: %s (grid %d)\n", hipGetErrorString(e), grid_blocks);
}
```

```cpp
#include <hip/hip_runtime.h>
#include <hip/hip_cooperative_groups.h>
#include <cstdio>
namespace cg = cooperative_groups;

typedef unsigned short u16;
typedef __attribute__((ext_vector_type(8))) short bf16x8;
typedef __attribute__((ext_vector_type(4))) float f32x4;

#define DEVFN __device__ __forceinline__

constexpr int D = 1024;
constexpr int T_TOT = 81920;
constexpr long UNIT = (long)T_TOT * D;
constexpr int D_IN = 6144;

constexpr long OFF_W = 6 * UNIT;
constexpr long W_CAT = 0;
constexpr long W_A = 7168L * 1024;
constexpr long W_B = W_A + 1048576;
constexpr long W_O = W_B + 1048576;
constexpr long W_RG = W_O + 1048576;
constexpr long LW = W_RG + 524288;
constexpr long OFF_TAB = OFF_W + 2 * LW;
constexpr long T_D1A = 0;
constexpr long T_D1B = 65536;
constexpr long T_D2 = T_D1B + 16384;
constexpr long T_DC = T_D2 + 32768;
constexpr long TAB_ELEMS = T_DC + 131072;
constexpr long OFF_TW_BYTES = (OFF_TAB + TAB_ELEMS) * 2;
constexpr long OFF_MOD_BYTES = OFF_TW_BYTES + 131072;
constexpr long OFF_BAR_BYTES = OFF_MOD_BYTES + 221184;
constexpr long OFF_LB_BYTES = OFF_BAR_BYTES + 16384;
constexpr long LB_SLOT_BYTES = 20480L * 128 * 8;
constexpr long WS_NEED = OFF_LB_BYTES + LB_SLOT_BYTES + 20480 * 4 + 10240 * 4;
static_assert(WS_NEED <= (1L << 30), "workspace map exceeds the guaranteed 1 GiB");

constexpr int TILE = 128 * 64;
constexpr int SMEM_BYTES = 75776;

struct Params {
  const float* x_prompt; const float* x_sample; const float* c_prompt; const float* c_sample;
  const float* norm_g; const float* w_ada; const float* b_ada; const float* w_in;
  const float* conv_w; const float* conv_b; const float* w_rg; const float* b_rg; const float* lam;
  const float* w_a_out; const float* w_b_out; const float* w_o; const float* final_g;
  float* out; unsigned char* ws;
};

typedef __attribute__((ext_vector_type(2))) float f32x2_t;
typedef __attribute__((ext_vector_type(2))) __bf16 bf16x2_t;
DEVFN u16 f2bf(float f) {
  __bf16 h = (__bf16)f;
  return *(u16*)&h;
}
DEVFN float bf2f(u16 h) { return __uint_as_float(((unsigned)h) << 16); }
DEVFN unsigned pack2(float a, float b) {
  f32x2_t v = {a, b};
  bf16x2_t r = __builtin_convertvector(v, bf16x2_t);
  return *(unsigned*)&r;
}
DEVFN float lo2f(unsigned v) { return __uint_as_float(v << 16); }
DEVFN float hi2f(unsigned v) { return __uint_as_float(v & 0xffff0000u); }
DEVFN float sigm(float x) { return __builtin_amdgcn_rcpf(1.f + __expf(-x)); }
DEVFN float silu(float x) { return x * __builtin_amdgcn_rcpf(1.f + __expf(-x)); }
DEVFN float one_minus_exp(float x) {
  float pl = -x * (1.f + x * (0.5f + x * (1.f / 6.f + x * (1.f / 24.f + x * (1.f / 120.f + x * (1.f / 720.f))))));
  float dr = 1.f - __expf(x);
  return x > -0.3f ? pl : dr;
}

DEVFN int otid() { int t = threadIdx.x; asm volatile("" : "+v"(t)); return t; }
DEVFN int seq_of(int g) { int seg = g >> 13; return seg < 2 ? 0 : seg - 1; }
DEVFN int seq_start(int s) { return s == 0 ? 0 : 16384 + (s - 1) * 8192; }
DEVFN int seq_len(int s) { return s == 0 ? 16384 : 8192; }

DEVFN u16* U(const Params& p, int i) { return (u16*)(p.ws) + (long)i * UNIT; }
DEVFN u16* WL(const Params& p, int l) { return (u16*)(p.ws) + OFF_W + (long)l * LW; }
DEVFN u16* TAB(const Params& p) { return (u16*)(p.ws) + OFF_TAB; }
DEVFN float2* TW(const Params& p) { return (float2*)(p.ws + OFF_TW_BYTES); }
DEVFN float* MOD(const Params& p) { return (float*)(p.ws + OFF_MOD_BYTES); }
DEVFN const float* xrow(const Params& p, int g) {
  return g < 16384 ? p.x_prompt + (long)g * D : p.x_sample + (long)(g - 16384) * D;
}

struct LdPlain {
  static constexpr bool kDma = true; static constexpr bool kTr = false; static constexpr bool kSw2 = false;
  const u16* base; unsigned off0; unsigned cst; int t_; unsigned row0_, stride_;
  DEVFN unsigned rowoff(int r) const { return (row0_ + r) * stride_; }
  DEVFN void init(int tid_, const u16* b, unsigned row0, unsigned stride) {
    unsigned tid = tid_; t_ = tid_; row0_ = row0; stride_ = stride;
    base = b;
    off0 = (row0 + (tid >> 3)) * stride + (((tid & 7) ^ ((tid >> 3) & 7)) << 3);
    cst = 32 * stride;
  }
  DEVFN void issue(u16* tile, int c, int kt) const {
    __builtin_amdgcn_global_load_lds((const unsigned*)(base + (off0 + c * cst + kt * 64)),
                                     (unsigned*)(tile + (t_ + c * 256) * 8), 16, 0, 0);
  }
  DEVFN uint4 load(int, int) const { return make_uint4(0, 0, 0, 0); }
  DEVFN void store(u16*, int, uint4) const {}
};
struct LdRows4 {
  static constexpr bool kDma = true; static constexpr bool kTr = false; static constexpr bool kSw2 = false;
  const u16* base; unsigned off[4]; int t_;
  DEVFN void issue(u16* tile, int c, int kt) const {
    __builtin_amdgcn_global_load_lds((const unsigned*)(base + (off[c] + kt * 64)),
                                     (unsigned*)(tile + (t_ + c * 256) * 8), 16, 0, 0);
  }
  DEVFN uint4 load(int, int) const { return make_uint4(0, 0, 0, 0); }
  DEVFN void store(u16*, int, uint4) const {}
};
struct LdF32 {
  static constexpr bool kDma = false; static constexpr bool kTr = false; static constexpr bool kSw2 = false;
  const float* base; unsigned off0; unsigned cst; int t_;
  DEVFN void init(int tid_, const float* b, unsigned row0, unsigned stride, unsigned col0) {
    unsigned tid = tid_; t_ = tid_;
    base = b;
    off0 = (row0 + (tid >> 3)) * stride + col0 + (tid & 7) * 8;
    cst = 32 * stride;
  }
  DEVFN void issue(u16*, int, int) const {}
  DEVFN uint4 load(int c, int kt) const {
    const float4* q = (const float4*)(base + (off0 + c * cst + kt * 64));
    float4 a = q[0], b = q[1];
    uint4 r; r.x = pack2(a.x, a.y); r.y = pack2(a.z, a.w); r.z = pack2(b.x, b.y); r.w = pack2(b.z, b.w);
    return r;
  }
  DEVFN void store(u16* tile, int c, uint4 v) const {
    int idx = t_ + c * 256;
    int row = idx >> 3, kc = idx & 7;
    *(uint4*)(tile + row * 64 + ((kc ^ (row & 7)) << 3)) = v;
  }
};
DEVFN int trf(int r) { return ((r & 3) << 2) | ((r >> 2) & 3); }
template <class TokFn>
struct LdTrans {
  static constexpr bool kDma = false; static constexpr bool kTr = false; static constexpr bool kSw2 = true;
  TokFn tok; int t_;
  DEVFN void issue(u16*, int, int) const {}
  DEVFN uint4 load(int c, int kt) const {
    const u16* b; unsigned o = tok(kt * 64 + (t_ >> 4), b);
    return *(const uint4*)(b + (o + c * TokFn::kStep16 + (t_ & 15) * 8));
  }
  DEVFN void store(u16* tile, int c, uint4 v) const {
    const int kk = (t_ >> 4) + c * 16, cc = t_ & 15;
    u16* q = tile + (cc * 8) * 64 + (kk & 7);
    const int kc = (kk >> 3) ^ ((cc >> 1) & 7);
    q[0 * 64 + ((kc ^ 0) << 3)] = (u16)(v.x & 0xffff); q[1 * 64 + ((kc ^ 1) << 3)] = (u16)(v.x >> 16);
    q[2 * 64 + ((kc ^ 2) << 3)] = (u16)(v.y & 0xffff); q[3 * 64 + ((kc ^ 3) << 3)] = (u16)(v.y >> 16);
    q[4 * 64 + ((kc ^ 4) << 3)] = (u16)(v.z & 0xffff); q[5 * 64 + ((kc ^ 5) << 3)] = (u16)(v.z >> 16);
    q[6 * 64 + ((kc ^ 6) << 3)] = (u16)(v.w & 0xffff); q[7 * 64 + ((kc ^ 7) << 3)] = (u16)(v.w >> 16);
  }
};
typedef __attribute__((ext_vector_type(4))) short s16x4;
DEVFN s16x4 lds_tr_read(const u16* q) {
  return __builtin_amdgcn_ds_read_tr16_b64_v4i16((s16x4 __attribute__((address_space(3)))*)(q));
}

DEVFN void zero_acc(f32x4 (&acc)[4][4]) {
#pragma unroll
  for (int i = 0; i < 4; ++i)
#pragma unroll
    for (int j = 0; j < 4; ++j) acc[i][j] = f32x4{0.f, 0.f, 0.f, 0.f};
}

template <class LA, class LB>
DEVFN void gemm_core(int tid, f32x4 (&acc)[4][4], int nk, const LA& la, const LB& lb, u16* smem) {
  const int lane = tid & 63, w = tid >> 6, wm = w >> 1, wn = w & 1;
  const int lr = lane & 15, quad = lane >> 4;
  uint4 ra[4], rb[4];
  if (LA::kDma) {
#pragma unroll
    for (int c = 0; c < 4; ++c) la.issue(smem, c, 0);
  } else {
#pragma unroll
    for (int c = 0; c < 4; ++c) ra[c] = la.load(c, 0);
  }
  if (LB::kDma) {
#pragma unroll
    for (int c = 0; c < 4; ++c) lb.issue(smem + TILE, c, 0);
  } else {
#pragma unroll
    for (int c = 0; c < 4; ++c) rb[c] = lb.load(c, 0);
  }
  if (!LA::kDma) {
#pragma unroll
    for (int c = 0; c < 4; ++c) la.store(smem, c, ra[c]);
  }
  if (!LB::kDma) {
#pragma unroll
    for (int c = 0; c < 4; ++c) lb.store(smem + TILE, c, rb[c]);
  }
  asm volatile("s_waitcnt vmcnt(0)" ::: "memory");
  __syncthreads();
  const int aoff = (wm * 64 + lr) * 64, boff = (wn * 64 + lr) * 64;
  const int sw0 = ((quad) ^ (lr & 7)) << 3, sw1 = ((4 + quad) ^ (lr & 7)) << 3;
  int troff[4][2];
  if (LB::kTr) {
    const int q = lr >> 2, pp = lr & 3;
#pragma unroll
    for (int j = 0; j < 4; ++j)
#pragma unroll
      for (int h = 0; h < 2; ++h) {
        int r = quad * 8 + h * 4 + q;
        int ch = (wn * 8 + j * 2 + (pp >> 1)) ^ trf(r);
        troff[j][h] = r * 128 + ch * 8 + (pp & 1) * 4;
      }
  }
  for (int kt = 0; kt < nk; ++kt) {
    const u16* sA = smem + (kt & 1) * 2 * TILE;
    const u16* sB = sA + TILE;
    u16* nA = smem + ((kt + 1) & 1) * 2 * TILE;
    const bool more = (kt + 1) < nk;
    if (more) {
      if (LA::kDma) {
#pragma unroll
        for (int c = 0; c < 4; ++c) la.issue(nA, c, kt + 1);
      } else {
#pragma unroll
        for (int c = 0; c < 4; ++c) ra[c] = la.load(c, kt + 1);
      }
      if (LB::kDma) {
#pragma unroll
        for (int c = 0; c < 4; ++c) lb.issue(nA + TILE, c, kt + 1);
      } else {
#pragma unroll
        for (int c = 0; c < 4; ++c) rb[c] = lb.load(c, kt + 1);
      }
    }
#pragma unroll
    for (int ks = 0; ks < 2; ++ks) {
      const int sw = ks == 0 ? sw0 : sw1;
      bf16x8 af[4], bfr[4];
#pragma unroll
      for (int i = 0; i < 4; ++i) af[i] = *(const bf16x8*)(sA + aoff + i * 1024 + sw);
      if (LB::kTr) {
#pragma unroll
        for (int j = 0; j < 4; ++j) {
          s16x4 lo = lds_tr_read(sB + troff[j][0] + ks * 4096);
          s16x4 hi = lds_tr_read(sB + troff[j][1] + ks * 4096);
          bfr[j] = __builtin_shufflevector(lo, hi, 0, 1, 2, 3, 4, 5, 6, 7);
        }
      } else {
#pragma unroll
        for (int j = 0; j < 4; ++j) {
          const int swb = LB::kSw2 ? (sw ^ (((wn * 4 + j) & 7) << 3)) : sw;
          bfr[j] = *(const bf16x8*)(sB + boff + j * 1024 + swb);
        }
      }
      __builtin_amdgcn_s_setprio(1);
#pragma unroll
      for (int i = 0; i < 4; ++i)
#pragma unroll
        for (int j = 0; j < 4; ++j)
          acc[i][j] = __builtin_amdgcn_mfma_f32_16x16x32_bf16(bfr[j], af[i], acc[i][j], 0, 0, 0);
      __builtin_amdgcn_s_setprio(0);
    }
    if (more) {
      if (!LA::kDma) {
#pragma unroll
        for (int c = 0; c < 4; ++c) la.store(nA, c, ra[c]);
      }
      if (!LB::kDma) {
#pragma unroll
        for (int c = 0; c < 4; ++c) lb.store(nA + TILE, c, rb[c]);
      }
    }
    asm volatile("s_waitcnt vmcnt(0)" ::: "memory");
    __syncthreads();
  }
}

struct LdPerm {
  const u16* base; int g0, sst, lg;
  DEVFN unsigned rowoff(int r) const {
    int t = g0 - sst + r;
    int urow = ((t & ((1 << lg) - 1)) << 7) + (t >> lg);
    return (unsigned)(sst + urow) * D;
  }
};
#define GLDS16(gp, lp) __builtin_amdgcn_global_load_lds((const unsigned*)(gp), (unsigned*)(lp), 16, 0, 0)
DEVFN void zero_acc8(f32x4 (&acc)[8][4]) {
#pragma unroll
  for (int i = 0; i < 8; ++i)
#pragma unroll
    for (int j = 0; j < 4; ++j) acc[i][j] = f32x4{0.f, 0.f, 0.f, 0.f};
}
template <class LA, class LB>
DEVFN void gemm_core_b(int tid, f32x4 (&acc)[8][4], int nk, const LA& la, const LB& lb, u16* smem) {
  const int lane = tid & 63, w = tid >> 6, wm = w >> 1, wn = w & 1;
  const int lr = lane & 15, quad = lane >> 4;
  const int r0 = tid >> 2;
  const unsigned sw = (unsigned)(((tid & 3) ^ ((0 - (tid >> 4)) & 3)) << 3);
  const unsigned oa0 = la.rowoff(r0) + sw, oa1 = la.rowoff(r0 + 64) + sw, oa2 = la.rowoff(r0 + 128) + sw, oa3 = la.rowoff(r0 + 192) + sw;
  const unsigned ob0 = lb.rowoff(r0) + sw, ob1 = lb.rowoff(r0 + 64) + sw;
  const u16* ga = la.base; const u16* gb = lb.base;
  u16* l0 = smem + tid * 8;
#define ISSUE_STAGE(st, kt) do { u16* _s = l0 + (st) * 12288; unsigned _k = (unsigned)(kt) * 32u; \
    GLDS16(ga + (oa0 + _k), _s); GLDS16(ga + (oa1 + _k), _s + 2048); GLDS16(ga + (oa2 + _k), _s + 4096); GLDS16(ga + (oa3 + _k), _s + 6144); \
    GLDS16(gb + (ob0 + _k), _s + 8192); GLDS16(gb + (ob1 + _k), _s + 10240); } while (0)
  asm volatile("s_waitcnt vmcnt(0)" ::: "memory");
  ISSUE_STAGE(0, 0);
  ISSUE_STAGE(1, 1);
  const int fsw = (quad ^ ((0 - (lr >> 2)) & 3)) << 3;
  const int aoff = (wm * 128 + lr) * 32 + fsw, boff = 8192 + (wn * 64 + lr) * 32 + fsw;
  int cur = 0, nxt = 2;
  for (int kt = 0; kt < nk; ++kt) {
    if (kt + 1 < nk) asm volatile("s_waitcnt vmcnt(6)" ::: "memory");
    else asm volatile("s_waitcnt vmcnt(0)" ::: "memory");
    __builtin_amdgcn_s_barrier();
    asm volatile("" ::: "memory");
    if (kt + 2 < nk) ISSUE_STAGE(nxt, kt + 2);
    const u16* sb = smem + cur * 12288;
    bf16x8 af[8], bfr[4];
#pragma unroll
    for (int j = 0; j < 4; ++j) bfr[j] = *(const bf16x8*)(sb + boff + j * 512);
#pragma unroll
    for (int i = 0; i < 8; ++i) af[i] = *(const bf16x8*)(sb + aoff + i * 512);
    __builtin_amdgcn_s_setprio(1);
#pragma unroll
    for (int i = 0; i < 8; ++i)
#pragma unroll
      for (int j = 0; j < 4; ++j)
        acc[i][j] = __builtin_amdgcn_mfma_f32_16x16x32_bf16(bfr[j], af[i], acc[i][j], 0, 0, 0);
    __builtin_amdgcn_s_setprio(0);
    cur = cur == 2 ? 0 : cur + 1;
    nxt = nxt == 2 ? 0 : nxt + 1;
  }
  asm volatile("s_waitcnt lgkmcnt(0)" ::: "memory");
  __builtin_amdgcn_s_barrier();
  asm volatile("" ::: "memory");
#undef ISSUE_STAGE
}

DEVFN bool tile_xcd(int it, int ngrp, int ntn, int& mt, int& nt) {
  const int G = gridDim.x, b = blockIdx.x;
  if (G == 512) {
    if (it >= 5 * ngrp) return false;
    int xcd = b & 7, loc = b >> 3;
    mt = xcd * 40 + (it / ngrp) * 8 + (loc >> 3);
    nt = (it % ngrp) * 8 + (loc & 7);
    return true;
  }
  int tile = b + it * G;
  if (tile >= 320 * ntn) return false;
  mt = tile / ntn; nt = tile % ntn;
  return true;
}

DEVFN void transpose_tile(const float* src, long ld, u16* dst, long ldd, float* sT) {
  const int tid = otid();
#pragma unroll
  for (int pss = 0; pss < 4; ++pss) {
    int kk = (tid >> 4) + pss * 16, n4 = (tid & 15) * 4;
    float4 v = *(const float4*)(src + (long)kk * ld + n4);
    sT[kk * 65 + n4 + 0] = v.x; sT[kk * 65 + n4 + 1] = v.y; sT[kk * 65 + n4 + 2] = v.z; sT[kk * 65 + n4 + 3] = v.w;
  }
  __syncthreads();
  {
    int n = tid >> 2, k0 = (tid & 3) * 16;
    unsigned o[8];
#pragma unroll
    for (int e = 0; e < 8; ++e) o[e] = pack2(sT[(k0 + 2 * e) * 65 + n], sT[(k0 + 2 * e + 1) * 65 + n]);
    uint4* q = (uint4*)(dst + (long)n * ldd + k0);
    q[0] = make_uint4(o[0], o[1], o[2], o[3]);
    q[1] = make_uint4(o[4], o[5], o[6], o[7]);
  }
  __syncthreads();
}

DEVFN void phase_prologue(const Params& p, unsigned char* smem_raw) {
  const int tid = otid();
  constexpr int NJ_TR = 4352, NJ_MOD = 384, NJ_TAB = 256;
  for (int job = blockIdx.x; job < NJ_TR + NJ_MOD + NJ_TAB; job += gridDim.x) {
    if (job < NJ_TR) {
      float* sT = (float*)smem_raw;
      int l = job / 2176, r = job % 2176;
      u16* wl = WL(p, l);
      if (r < 1280) {
        int kt = r / 80, ntile = r % 80;
        int orow = ntile * 64;
        int scol;
        if (orow < 2048) scol = orow; else { orow += 2048; scol = orow - 1024; }
        transpose_tile(p.w_in + (long)l * D * D_IN + (long)(kt * 64) * D_IN + scol, D_IN,
                       wl + W_CAT + (long)orow * D + kt * 64, D, sT);
      } else if (r < 2048) {
        int r2 = r - 1280, which = r2 >> 8, t = r2 & 255, kt = t >> 4, ntile = t & 15;
        const float* src = (which == 0 ? p.w_a_out : which == 1 ? p.w_b_out : p.w_o) + (long)l * 1048576;
        long doff = which == 0 ? W_A : which == 1 ? W_B : W_O;
        transpose_tile(src + (long)(kt * 64) * D + ntile * 64, D, wl + doff + (long)(ntile * 64) * D + kt * 64, D, sT);
      } else {
        int r3 = r - 2048, mat = r3 >> 2, t = r3 & 3, kt = t >> 1, ntile = t & 1;
        const float* src = p.w_rg + ((long)l * 32 + mat) * 16384;
        transpose_tile(src + (long)(kt * 64) * 128 + ntile * 64, 128,
                       wl + W_RG + (long)mat * 16384 + (long)(ntile * 64) * 128 + kt * 64, 128, sT);
      }
    } else if (job < NJ_TR + NJ_MOD) {
      int jm = job - NJ_TR, l = jm / 192, cgp = jm % 192;
      float* sc = (float*)smem_raw;
      float* red = sc + 9 * 1024;
      for (int i = tid; i < 9 * 1024; i += 256) {
        int s_ = i >> 10, k = i & 1023;
        float cv = s_ == 0 ? p.c_prompt[k] : p.c_sample[(s_ - 1) * 1024 + k];
        sc[i] = silu(cv);
      }
      __syncthreads();
      int col = cgp * 16 + (tid & 15), kq = tid >> 4;
      float a0 = 0, a1 = 0, a2 = 0, a3 = 0, a4 = 0, a5 = 0, a6 = 0, a7 = 0, a8 = 0;
      const float* wp = p.w_ada + (long)l * D * 3072 + col;
#pragma unroll 8
      for (int k = kq * 64; k < kq * 64 + 64; ++k) {
        float wv = wp[(long)k * 3072];
        a0 += sc[0 * 1024 + k] * wv; a1 += sc[1 * 1024 + k] * wv; a2 += sc[2 * 1024 + k] * wv;
        a3 += sc[3 * 1024 + k] * wv; a4 += sc[4 * 1024 + k] * wv; a5 += sc[5 * 1024 + k] * wv;
        a6 += sc[6 * 1024 + k] * wv; a7 += sc[7 * 1024 + k] * wv; a8 += sc[8 * 1024 + k] * wv;
      }
      float* rq = red + kq * 144 + (tid & 15);
      rq[0 * 16] = a0; rq[1 * 16] = a1; rq[2 * 16] = a2; rq[3 * 16] = a3; rq[4 * 16] = a4;
      rq[5 * 16] = a5; rq[6 * 16] = a6; rq[7 * 16] = a7; rq[8 * 16] = a8;
      __syncthreads();
      if (tid < 144) {
        int s_ = tid >> 4, cc = tid & 15;
        float v = 0.f;
#pragma unroll
        for (int q = 0; q < 16; ++q) v += red[q * 144 + tid];
        int cf = cgp * 16 + cc;
        MOD(p)[((long)l * 9 + s_) * 3072 + cf] = v + p.b_ada[l * 3072 + cf];
      }
      __syncthreads();
    } else {
      int jt = job - NJ_TR - NJ_MOD;
      u16* tab = TAB(p);
#pragma unroll
      for (int e4 = 0; e4 < 4; ++e4) {
        int e = jt * 1024 + e4 * 256 + tid;
        if (e < 65536) {
          int m = e >> 8, k = e & 255;
          int k1 = (m >> 5) * 16 + (m & 15), ro = (m >> 4) & 1, ri = k >> 7, s1 = k & 127;
          float x = 2.f * (float)((k1 * s1) & 127) / 128.f;
          float cs = cospif(x), sn = sinpif(x);
          float v = (ro == ri) ? cs : (ro == 0 ? sn : -sn);
          tab[T_D1A + e] = f2bf(v);
        } else if (e < 65536 + 16384) {
          int e2 = e - 65536;
          int m = e2 >> 7, k = e2 & 127;
          int k1 = (m >> 5) * 16 + (m & 15), ro = (m >> 4) & 1, ri = k >> 6, s1 = k & 63;
          float x = 2.f * (float)((k1 * s1) & 63) / 64.f;
          float cs = cospif(x), sn = sinpif(x);
          float v = (ro == ri) ? cs : (ro == 0 ? sn : -sn);
          tab[T_D1B + e2] = f2bf(v);
        } else if (e < 65536 + 16384 + 32768) {
          int e2 = e - 65536 - 16384;
          int k2 = e2 >> 8, k = e2 & 255, ri = k >> 7, s2 = k & 127;
          float x = 2.f * (float)((k2 * s2) & 127) / 128.f;
          float v = ri == 0 ? cospif(x) : sinpif(x);
          tab[T_D2 + e2] = f2bf(v);
        } else if (e < 65536 + 16384 + 32768 + 131072) {
          int e2 = e - 65536 - 16384 - 32768;
          int row = e2 >> 8, c = e2 & 255, ri = row >> 8, m = row & 255;
          float x = 2.f * (float)((m * c) & 255) / 256.f;
          float v = ri == 0 ? cospif(x) : -sinpif(x);
          tab[T_DC + e2] = f2bf(v);
        } else {
          int e2 = e - (65536 + 16384 + 32768 + 131072);
          if (e2 < 16384) {
            float x = 2.f * (float)e2 / 16384.f;
            TW(p)[e2] = make_float2(cospif(x), sinpif(x));
          }
        }
      }
    }
  }
}

DEVFN void phase_fold(const Params& p, u16* smem) {
  for (int tile = blockIdx.x; tile < 256; tile += gridDim.x) {
    const int tid = otid(), lane = tid & 63, w = tid >> 6, wm = w >> 1, wn = w & 1, lr = lane & 15, quad = lane >> 4;
    int l = tile >> 7, g = (tile >> 5) & 3, mt = (tile >> 3) & 3, nt = tile & 7;
    LdPlain la; la.init(tid, TAB(p) + T_DC, mt * 128, 256);
    LdF32 lb; lb.init(tid, p.w_in + (long)l * D * D_IN, nt * 128, D_IN, 2048 + g * 256);
    f32x4 acc[4][4]; zero_acc(acc);
    gemm_core(tid, acc, 4, la, lb, smem);
    int ri = mt >> 1;
    u16* wc = WL(p, l) + W_CAT;
#pragma unroll
    for (int i = 0; i < 4; ++i) {
      int mrow = (mt & 1) * 128 + wm * 64 + i * 16 + lr;
      unsigned orow = 2048 + ri * 1024 + g * 256 + mrow;
#pragma unroll
      for (int j = 0; j < 4; ++j) {
        int n = nt * 128 + wn * 64 + j * 16 + quad * 4;
        uint2 o; o.x = pack2(acc[i][j][0], acc[i][j][1]); o.y = pack2(acc[i][j][2], acc[i][j][3]);
        *(uint2*)(wc + orow * D + n) = o;
      }
    }
  }
}

DEVFN void phase_h(const Params& p, int l) {
  const int tid_ = otid();
  const int lane = tid_ & 63;
  const int wid = blockIdx.x * 4 + (tid_ >> 6), nw = gridDim.x * 4;
  const float* ng = p.norm_g + l * D;
  const float* modl = MOD(p) + (long)l * 9 * 3072;
  u16* H = U(p, 0);
  float4 v[4], vn[4], vm[4];
  auto ldrow = [&](int g, float4 (&dst)[4]) {
    const float* xb = (l == 0) ? (g < 16384 ? p.x_prompt : p.x_sample) : p.out;
    const unsigned xo = (unsigned)((l == 0 && g >= 16384) ? g - 16384 : g) * D;
#pragma unroll
    for (int i = 0; i < 4; ++i) dst[i] = *(const float4*)(xb + xo + i * 256 + lane * 4);
  };
  if (wid < T_TOT) ldrow(wid, v);
  if (wid + nw < T_TOT) ldrow(wid + nw, vn);
  for (int g = wid; g < T_TOT; g += nw) {
    if (g + 2 * nw < T_TOT) ldrow(g + 2 * nw, vm);
    const float* md = modl + seq_of(g) * 3072;
    float ss = 0.f;
#pragma unroll
    for (int i = 0; i < 4; ++i) ss += v[i].x * v[i].x + v[i].y * v[i].y + v[i].z * v[i].z + v[i].w * v[i].w;
#pragma unroll
    for (int o = 32; o >= 1; o >>= 1) ss += __shfl_xor(ss, o, 64);
    float rstd = rsqrtf(ss * (1.f / 1024.f) + 1e-6f);
#pragma unroll
    for (int i = 0; i < 4; ++i) {
      int c = i * 256 + lane * 4;
      float4 g4 = *(const float4*)(ng + c);
      float4 sh = *(const float4*)(md + c);
      float4 sc = *(const float4*)(md + 1024 + c);
      float h0 = v[i].x * rstd * g4.x * (1.f + sc.x) + sh.x;
      float h1 = v[i].y * rstd * g4.y * (1.f + sc.y) + sh.y;
      float h2 = v[i].z * rstd * g4.z * (1.f + sc.z) + sh.z;
      float h3 = v[i].w * rstd * g4.w * (1.f + sc.w) + sh.w;
      uint2 o; o.x = pack2(h0, h1); o.y = pack2(h2, h3);
      *(uint2*)(H + ((unsigned)g * D + c)) = o;
    }
#pragma unroll
    for (int i = 0; i < 4; ++i) { v[i] = vn[i]; vn[i] = vm[i]; }
  }
}

DEVFN void phase_final(const Params& p) {
  const int tid_ = otid();
  const int lane = tid_ & 63;
  const int wid = blockIdx.x * 4 + (tid_ >> 6), nw = gridDim.x * 4;
  float4 v[4], vn[4], vm[4];
  auto ldrow = [&](int g, float4 (&dst)[4]) {
    if (g < T_TOT) {
#pragma unroll
      for (int i = 0; i < 4; ++i) dst[i] = *(const float4*)(p.out + (unsigned)g * D + i * 256 + lane * 4);
    }
  };
  ldrow(wid, v); ldrow(wid + nw, vn);
  for (int g = wid; g < T_TOT; g += nw) {
    float* xr = p.out + (unsigned)g * D;
    ldrow(g + 2 * nw, vm);
    float ss = 0.f;
#pragma unroll
    for (int i = 0; i < 4; ++i) ss += v[i].x * v[i].x + v[i].y * v[i].y + v[i].z * v[i].z + v[i].w * v[i].w;
#pragma unroll
    for (int o = 32; o >= 1; o >>= 1) ss += __shfl_xor(ss, o, 64);
    float rstd = rsqrtf(ss * (1.f / 1024.f) + 1e-6f);
#pragma unroll
    for (int i = 0; i < 4; ++i) {
      int c = i * 256 + lane * 4;
      float4 g4 = *(const float4*)(p.final_g + c);
      float4 o;
      o.x = v[i].x * rstd * g4.x; o.y = v[i].y * rstd * g4.y; o.z = v[i].z * rstd * g4.z; o.w = v[i].w * rstd * g4.w;
      *(float4*)(xr + c) = o;
    }
#pragma unroll
    for (int i = 0; i < 4; ++i) { v[i] = vn[i]; vn[i] = vm[i]; }
  }
}

DEVFN void phase_gemm1(const Params& p, int l, u16* smem) {
  const u16* H = U(p, 0);
  const u16* W = WL(p, l) + W_CAT;
  for (int it = 0;; ++it) {
    int mt, nt;
    if (!tile_xcd(it, 5, 40, mt, nt)) break;
    const int tid = otid(), lane = tid & 63, w = tid >> 6, wm = w >> 1, wn = w & 1, lr = lane & 15, quad = lane >> 4;
    LdPlain la; la.init(tid, H, mt * 256, D);
    LdPlain lb; lb.init(tid, W, nt * 128, D);
    f32x4 acc[8][4]; zero_acc8(acc);
    gemm_core_b(tid, acc, 32, la, lb, smem);
    int unit = nt >> 3, col0 = (nt & 7) * 128;
    u16* outp = U(p, 1 + unit);
    bool act = (unit == 1) || (unit == 4);
    {
      u16* so = smem;
#pragma unroll
      for (int i = 0; i < 8; ++i) {
        const int m = wm * 128 + i * 16 + lr;
#pragma unroll
        for (int j = 0; j < 4; ++j) {
          const int n = wn * 64 + j * 16 + quad * 4;
          float v0 = acc[i][j][0], v1 = acc[i][j][1], v2 = acc[i][j][2], v3 = acc[i][j][3];
          if (act) { v0 = silu(v0); v1 = silu(v1); v2 = silu(v2); v3 = silu(v3); }
          uint2 o; o.x = pack2(v0, v1); o.y = pack2(v2, v3);
          *(uint2*)(so + m * 136 + n) = o;
        }
      }
      __syncthreads();
#pragma unroll
      for (int c = 0; c < 16; ++c) {
        const int idx = tid + c * 256;
        const int row = idx >> 4, ch = idx & 15;
        uint4 v = *(const uint4*)(so + row * 136 + ch * 8);
        *(uint4*)(outp + ((unsigned)(mt * 256 + row) * D + col0 + ch * 8)) = v;
      }
      __syncthreads();
    }
  }
}

struct TokF1 {
  static constexpr unsigned kStep16 = 16u * 128u * D;
  const u16* zr; const u16* zi; int n1; unsigned off;
  DEVFN unsigned operator()(int k, const u16*& b) const {
    int ri = k >= n1 ? 1 : 0;
    int s1 = k - ri * n1;
    b = ri ? zi : zr;
    return off + (unsigned)(s1 * 128) * D;
  }
};
DEVFN void f1_twiddle(int tid, const Params& p, const f32x4 (&acc)[4][4], int hf, int s2, int smask, int twmul,
                      uint2 (&o1)[2][4], uint2 (&o2)[2][4]) {
  const int lane = tid & 63, w = tid >> 6, wm = w >> 1, lr = lane & 15;
  const float2* tw = TW(p);
#pragma unroll
  for (int b = 0; b < 2; ++b) {
    int k1 = (hf * 4 + wm * 2 + b) * 16 + lr;
    float2 t = tw[((k1 * s2) & smask) * twmul];
#pragma unroll
    for (int j = 0; j < 4; ++j) {
      f32x4 orr = acc[2 * b][j], oii = acc[2 * b + 1][j];
      o1[b][j].x = pack2(orr[0] * t.x + oii[0] * t.y, orr[1] * t.x + oii[1] * t.y);
      o1[b][j].y = pack2(orr[2] * t.x + oii[2] * t.y, orr[3] * t.x + oii[3] * t.y);
      o2[b][j].x = pack2(oii[0] * t.x - orr[0] * t.y, oii[1] * t.x - orr[1] * t.y);
      o2[b][j].y = pack2(oii[2] * t.x - orr[2] * t.y, oii[3] * t.x - orr[3] * t.y);
    }
  }
}
DEVFN void f1_write(int tid, int hf, unsigned off, const uint2 (&o1)[2][4], const uint2 (&o2)[2][4], u16* zr, u16* zi, u16* so) {
  const int lane = tid & 63, w = tid >> 6, wm = w >> 1, wn = w & 1, lr = lane & 15, quad = lane >> 4;
#pragma unroll
  for (int b = 0; b < 2; ++b) {
    const int rl = (wm * 2 + b) * 16 + lr;
#pragma unroll
    for (int j = 0; j < 4; ++j) {
      const int n = wn * 64 + j * 16 + quad * 4;
      *(uint2*)(so + rl * 136 + n) = o1[b][j];
      *(uint2*)(so + (64 + rl) * 136 + n) = o2[b][j];
    }
  }
  __syncthreads();
#pragma unroll
  for (int c = 0; c < 8; ++c) {
    const int idx = tid + c * 256;
    const int pl = idx >> 10, row = (idx >> 4) & 63, ch = idx & 15;
    const unsigned k1 = hf * 64 + row;
    uint4 v = *(const uint4*)(so + (pl * 64 + row) * 136 + ch * 8);
    *(uint4*)((pl ? zi : zr) + (off + (k1 * 128) * D + ch * 8)) = v;
  }
  __syncthreads();
}
DEVFN void phase_fft1(const Params& p, u16* smem) {
  u16* zr = U(p, 3);
  u16* zi = U(p, 4);
  for (int tile = blockIdx.x; tile < 9216; tile += gridDim.x) {
    const int tid = otid();
    int seq, s2, ct, n1;
    if (tile < 1024) { seq = 0; s2 = tile >> 3; ct = tile & 7; n1 = 128; }
    else { int t2 = tile - 1024; seq = 1 + (t2 >> 10); s2 = (t2 >> 3) & 127; ct = t2 & 7; n1 = 64; }
    const unsigned off = (unsigned)(seq_start(seq) + s2) * D + ct * 128;
    LdTrans<TokF1> lb; lb.t_ = tid; lb.tok.zr = zr; lb.tok.zi = zi; lb.tok.n1 = n1; lb.tok.off = off;
    const int K = 2 * n1, nk = K >> 6;
    const u16* tab = TAB(p) + (seq == 0 ? T_D1A : T_D1B);
    const int smask = seq == 0 ? 16383 : 8191, twmul = seq == 0 ? 1 : 2;
    uint2 a1[2][4], a2[2][4];
    {
      f32x4 acc[4][4]; zero_acc(acc);
      LdPlain la; la.init(tid, tab, 0, K); gemm_core(tid, acc, nk, la, lb, smem);
      f1_twiddle(tid, p, acc, 0, s2, smask, twmul, a1, a2);
    }
    if (seq == 0) {
      uint2 b1[2][4], b2[2][4];
      {
        f32x4 acc[4][4]; zero_acc(acc);
        LdPlain la; la.init(tid, tab, 128, K); gemm_core(tid, acc, nk, la, lb, smem);
        f1_twiddle(tid, p, acc, 1, s2, smask, twmul, b1, b2);
      }
      f1_write(tid, 1, off, b1, b2, zr, zi, smem);
    }
    f1_write(tid, 0, off, a1, a2, zr, zi, smem);
  }
}

struct TokF2 {
  static constexpr unsigned kStep16 = 16u * D;
  const u16* zr; const u16* zi; unsigned off;
  DEVFN unsigned operator()(int k, const u16*& b) const {
    int ri = k >> 7, s2 = k & 127;
    b = ri ? zi : zr;
    return off + (unsigned)s2 * D;
  }
};
DEVFN void phase_fft2(const Params& p, u16* smem) {
  u16* zr = U(p, 3);
  const u16* gbp = U(p, 5);
  for (int tile = blockIdx.x; tile < 5120; tile += gridDim.x) {
    const int tid = otid(), lane = tid & 63, w = tid >> 6, wm = w >> 1, wn = w & 1, lr = lane & 15, quad = lane >> 4;
    int seq, k1, ct, n1;
    if (tile < 1024) { seq = 0; k1 = tile >> 3; ct = tile & 7; n1 = 128; }
    else { int t2 = tile - 1024; seq = 1 + (t2 >> 9); k1 = (t2 >> 3) & 63; ct = t2 & 7; n1 = 64; }
    const int sst = seq_start(seq);
    const unsigned off = (unsigned)(sst + k1 * 128) * D + ct * 128;
    LdTrans<TokF2> lb; lb.t_ = tid; lb.tok.zr = zr; lb.tok.zi = U(p, 4); lb.tok.off = off;
    LdPlain la; la.init(tid, TAB(p) + T_D2, 0, 256);
#define GPRE_ADDR(c_) (gbp + ((unsigned)(sst + k1 + n1 * ((tid + (c_) * 256) >> 4)) * D + ct * 128 + ((tid + (c_) * 256) & 15) * 8))
    const uint4 gp0 = *(const uint4*)GPRE_ADDR(0), gp1 = *(const uint4*)GPRE_ADDR(1), gp2 = *(const uint4*)GPRE_ADDR(2), gp3 = *(const uint4*)GPRE_ADDR(3);
    const uint4 gp4 = *(const uint4*)GPRE_ADDR(4), gp5 = *(const uint4*)GPRE_ADDR(5), gp6 = *(const uint4*)GPRE_ADDR(6), gp7 = *(const uint4*)GPRE_ADDR(7);
#undef GPRE_ADDR
    f32x4 acc[4][4]; zero_acc(acc);
    gemm_core(tid, acc, 4, la, lb, smem);
    const float nrm = seq == 0 ? (1.f / 2048.f) : 6.9053396600248786e-4f;
    u16* so = smem;
#define GPRE_ST(c_, v_) *(uint4*)(so + ((tid + (c_) * 256) >> 4) * 136 + ((tid + (c_) * 256) & 15) * 8) = v_
    GPRE_ST(0, gp0); GPRE_ST(1, gp1); GPRE_ST(2, gp2); GPRE_ST(3, gp3);
    GPRE_ST(4, gp4); GPRE_ST(5, gp5); GPRE_ST(6, gp6); GPRE_ST(7, gp7);
#undef GPRE_ST
    __syncthreads();
#pragma unroll
    for (int i = 0; i < 4; ++i) {
      const int k2 = wm * 64 + i * 16 + lr;
#pragma unroll
      for (int j = 0; j < 4; ++j) {
        const int cl = wn * 64 + j * 16 + quad * 4;
        uint2 gv = *(const uint2*)(so + k2 * 136 + cl);
        uint2 o;
        o.x = pack2(acc[i][j][0] * nrm * lo2f(gv.x), acc[i][j][1] * nrm * hi2f(gv.x));
        o.y = pack2(acc[i][j][2] * nrm * lo2f(gv.y), acc[i][j][3] * nrm * hi2f(gv.y));
        *(uint2*)(so + k2 * 136 + cl) = o;
      }
    }
    __syncthreads();
#pragma unroll
    for (int c = 0; c < 8; ++c) {
      const int idx = tid + c * 256;
      const int row = idx >> 4, ch = idx & 15;
      *(uint4*)(zr + (off + (unsigned)row * D + ch * 8)) = *(const uint4*)(so + row * 136 + ch * 8);
    }
    __syncthreads();
  }
}

constexpr int SA_LD = 128;
template <int PASS>
DEVFN void phase_scan(const Params& p, int l, int dirsel, unsigned char* smem_raw) {
  float* sAf = (float*)smem_raw;
  u16* sBh = (u16*)(smem_raw + 32768);
  u16* sXc = (u16*)(smem_raw + 32768 + 16384);
  const int tid = otid(), lane = tid & 63, w = tid >> 6, lr = lane & 15, quad = lane >> 4;
  const int head = blockIdx.x & 7;
  const int dir = PASS == 1 ? ((blockIdx.x >> 3) & 1) : dirsel;
  const int tstart = PASS == 1 ? (blockIdx.x >> 4) : (blockIdx.x >> 3);
  const int tstep = PASS == 1 ? (gridDim.x >> 4) : (gridDim.x >> 3);
  const u16* xa = U(p, 1);
  u16* ga = U(p, 2);
  u16* hf = U(p, 5);
  float2* agg = (float2*)U(p, 4);
  float* carry = (float*)(agg + 1280L * 2 * 1024);
  bf16x8 bw[4][4];
  {
    const u16* wrg = WL(p, l) + W_RG;
#pragma unroll
    for (int jt = 0; jt < 4; ++jt) {
      int q = jt >> 1, col = w * 32 + (jt & 1) * 16 + lr;
      const u16* bp = wrg + (unsigned)((((dir * 2 + q) * 8 + head) * 128 + col) * 128 + quad * 8);
#pragma unroll
      for (int ks = 0; ks < 4; ++ks) bw[jt][ks] = *(const bf16x8*)(bp + ks * 32);
    }
  }
  float spl[2], brr[2], bii[2];
#pragma unroll
  for (int jc = 0; jc < 2; ++jc) {
    int cgl = head * 128 + w * 32 + jc * 16 + lr;
    float lm = p.lam[(l * 2 + dir) * D + cgl];
    spl[jc] = -8.f * 1.4426950408889634f * log1pf(expf(-lm));
    brr[jc] = -1.4426950408889634f * p.b_rg[((l * 2 + dir) * 2 + 0) * D + cgl];
    bii[jc] = -1.4426950408889634f * p.b_rg[((l * 2 + dir) * 2 + 1) * D + cgl];
  }
  const int c8 = tid & 15, tg = tid >> 4;
  float* sCw = (float*)(smem_raw + 65536);
  for (int i = tid; i < 640; i += 256) {
    int k = i >> 7, c = i & 127;
    sCw[i] = k < 4 ? p.conv_w[(l * 4 + k) * D + head * 128 + c] : p.conv_b[l * D + head * 128 + c];
  }
  __syncthreads();
  uint4 xr[7];
#define LOAD_XROWS(TT) do { const int _g0 = (TT) * 64; const int _sq = seq_of(_g0), _ss = seq_start(_sq), _se = _ss + seq_len(_sq); \
    _Pragma("unroll") for (int r = 0; r < 7; ++r) { int _g = _g0 + tg * 4 - 2 + r; xr[r] = make_uint4(0, 0, 0, 0); \
      if (_g >= _ss && _g < _se) xr[r] = *(const uint4*)(xa + ((unsigned)_g * D + head * 128 + c8 * 8)); } } while (0)
  if (tstart < 1280) LOAD_XROWS(tstart);
  for (int tt = tstart; tt < 1280; tt += tstep) {
    const int g0 = tt * 64;
    const int seq = seq_of(g0), sst = seq_start(seq), send = sst + seq_len(seq);
#pragma unroll
    for (int j = 0; j < 4; ++j) {
      float o[8];
      {
        float4 b0 = *(const float4*)(sCw + 512 + c8 * 8), b1 = *(const float4*)(sCw + 512 + c8 * 8 + 4);
        o[0] = b0.x; o[1] = b0.y; o[2] = b0.z; o[3] = b0.w; o[4] = b1.x; o[5] = b1.y; o[6] = b1.z; o[7] = b1.w;
      }
#pragma unroll
      for (int k = 0; k < 4; ++k) {
        uint4 v = xr[j + k];
        float4 w0 = *(const float4*)(sCw + k * 128 + c8 * 8), w1 = *(const float4*)(sCw + k * 128 + c8 * 8 + 4);
        o[0] += w0.x * lo2f(v.x); o[1] += w0.y * hi2f(v.x);
        o[2] += w0.z * lo2f(v.y); o[3] += w0.w * hi2f(v.y);
        o[4] += w1.x * lo2f(v.z); o[5] += w1.y * hi2f(v.z);
        o[6] += w1.z * lo2f(v.w); o[7] += w1.w * hi2f(v.w);
      }
      uint4 q0;
      q0.x = pack2(o[0], o[1]); q0.y = pack2(o[2], o[3]); q0.z = pack2(o[4], o[5]); q0.w = pack2(o[6], o[7]);
      const int tl = tg * 4 + j;
      *(uint4*)(sXc + tl * 128 + ((c8 ^ (tl & 7)) << 3)) = q0;
    }
    __syncthreads();
    if (tt + tstep < 1280) LOAD_XROWS(tt + tstep);
    const int gstart = dir == 0 ? sst : send - 1;
#pragma unroll 1
    for (int hv = 0; hv < 2; ++hv) {
      f32x4 acc[2][4];
#pragma unroll
      for (int it = 0; it < 2; ++it)
#pragma unroll
        for (int jt = 0; jt < 4; ++jt) acc[it][jt] = f32x4{0.f, 0.f, 0.f, 0.f};
#pragma unroll
      for (int ks = 0; ks < 4; ++ks) {
#pragma unroll
        for (int it = 0; it < 2; ++it) {
          bf16x8 af = *(const bf16x8*)(sXc + ((hv * 2 + it) * 16 + lr) * 128 + (((ks * 4 + quad) ^ (lr & 7)) << 3));
#pragma unroll
          for (int jt = 0; jt < 4; ++jt)
            acc[it][jt] = __builtin_amdgcn_mfma_f32_16x16x32_bf16(af, bw[jt][ks], acc[it][jt], 0, 0, 0);
        }
      }
#pragma unroll
      for (int it = 0; it < 2; ++it)
#pragma unroll
        for (int jc = 0; jc < 2; ++jc) {
#pragma unroll
          for (int r = 0; r < 4; ++r) {
            int tl = (hv * 2 + it) * 16 + quad * 4 + r, c = w * 32 + jc * 16 + lr;
            float rr = __builtin_amdgcn_rcpf(1.f + __builtin_amdgcn_exp2f(fmaf(acc[it][jc][r], -1.4426950408889634f, brr[jc])));
            float ii = __builtin_amdgcn_rcpf(1.f + __builtin_amdgcn_exp2f(fmaf(acc[it][2 + jc][r], -1.4426950408889634f, bii[jc])));
            float a = __builtin_amdgcn_exp2f(rr * spl[jc]);
            float mult = __builtin_amdgcn_sqrtf(fmaxf(fmaf(-a, a, 1.f), 0.f));
            if (g0 + tl == gstart) mult = 1.f;
            float xv = bf2f(sXc[tl * 128 + (((c >> 3) ^ (tl & 7)) << 3) + (c & 7)]);
            sAf[tl * SA_LD + c] = a;
            sBh[tl * 128 + c] = f2bf(mult * ii * xv);
          }
        }
    }
    __syncthreads();
    if (tid < 128) {
      const int c = tid;
      const unsigned aidx = (unsigned)(tt * 2 + dir) * 1024 + head * 128 + c;
      const float* ap = sAf + c;
      u16* bp = sBh + c;
      if (PASS == 1) {
        float h = 0.f, P = 1.f;
        if (dir == 0) {
#pragma unroll 16
          for (int st = 0; st < 64; ++st) { float a = ap[st * SA_LD]; h = a * h + bf2f(bp[st * 128]); P *= a; }
        } else {
#pragma unroll 16
          for (int st = 63; st >= 0; --st) { float a = ap[st * SA_LD]; h = a * h + bf2f(bp[st * 128]); P *= a; }
        }
        agg[aidx] = make_float2(P, h);
      } else {
        float h = carry[aidx];
        if (dir == 0) {
#pragma unroll 16
          for (int st = 0; st < 64; ++st) { h = ap[st * SA_LD] * h + bf2f(bp[st * 128]); bp[st * 128] = f2bf(h); }
        } else {
#pragma unroll 16
          for (int st = 63; st >= 0; --st) { h = ap[st * SA_LD] * h + bf2f(bp[st * 128]); bp[st * 128] = f2bf(h); }
        }
      }
    }
    if (PASS == 3) {
      __syncthreads();
#pragma unroll
      for (int cch = 0; cch < 4; ++cch) {
        int chunk = tid + cch * 256;
        int t = chunk >> 4, cc = (chunk & 15) * 8;
        unsigned off = (unsigned)(g0 + t) * D + head * 128 + cc;
        uint4 hv = *(const uint4*)(sBh + t * 128 + cc);
        if (dir == 0) {
          *(uint4*)(hf + off) = hv;
        } else {
          uint4 fv = *(const uint4*)(hf + off);
          uint4 gv = *(const uint4*)(ga + off);
          uint4 o;
          o.x = pack2((lo2f(fv.x) + lo2f(hv.x)) * lo2f(gv.x), (hi2f(fv.x) + hi2f(hv.x)) * hi2f(gv.x));
          o.y = pack2((lo2f(fv.y) + lo2f(hv.y)) * lo2f(gv.y), (hi2f(fv.y) + hi2f(hv.y)) * hi2f(gv.y));
          o.z = pack2((lo2f(fv.z) + lo2f(hv.z)) * lo2f(gv.z), (hi2f(fv.z) + hi2f(hv.z)) * hi2f(gv.z));
          o.w = pack2((lo2f(fv.w) + lo2f(hv.w)) * lo2f(gv.w), (hi2f(fv.w) + hi2f(hv.w)) * hi2f(gv.w));
          *(uint4*)(ga + off) = o;
        }
      }
    }
    __syncthreads();
  }
#undef LOAD_XROWS
}

DEVFN void lb_st64(unsigned long long* q, unsigned long long v) { __hip_atomic_store(q, v, __ATOMIC_RELAXED, __HIP_MEMORY_SCOPE_AGENT); }
DEVFN unsigned long long lb_ld64(const unsigned long long* q) { return __hip_atomic_load(q, __ATOMIC_RELAXED, __HIP_MEMORY_SCOPE_AGENT); }
DEVFN void lb_st32(unsigned* q, unsigned v) { __hip_atomic_store(q, v, __ATOMIC_RELAXED, __HIP_MEMORY_SCOPE_AGENT); }
DEVFN unsigned lb_ld32(const unsigned* q) { return __hip_atomic_load(q, __ATOMIC_RELAXED, __HIP_MEMORY_SCOPE_AGENT); }
DEVFN unsigned long long lb_pack(float a, float b) { return (unsigned long long)__float_as_uint(a) | ((unsigned long long)__float_as_uint(b) << 32); }
DEVFN unsigned long long lb_gran(float P, float H, unsigned tag) {
  return ((unsigned long long)__float_as_uint(H) << 32) | (unsigned long long)((__float_as_uint(P) & 0xffffff00u) | tag);
}
DEVFN int lb_rank(int seq, int pos) { return seq == 0 ? (pos >> 1) * 10 + ((pos & 1) ? 9 : 0) : pos * 10 + seq; }
DEVFN void lb_decode(int r, int dir, int& seq, int& pos, int& tt) {
  int pair = r / 10, j = r - pair * 10;
  if (j == 0) { seq = 0; pos = 2 * pair; } else if (j == 9) { seq = 0; pos = 2 * pair + 1; } else { seq = j; pos = pair; }
  int len = seq == 0 ? 256 : 128;
  tt = (seq_start(seq) >> 6) + (dir ? len - 1 - pos : pos);
}
DEVFN void phase_scan_lb(const Params& p, int l, unsigned char* smem_raw) {
  float* sAt = (float*)smem_raw;
  u16* sBt = (u16*)(smem_raw + 34816);
  u16* sXc = (u16*)(smem_raw + 53248);
  u16* sBh = sXc;
  unsigned* sflag = (unsigned*)(smem_raw + 72192);
  const int tid = otid(), lane = tid & 63, w = tid >> 6, lr = lane & 15, quad = lane >> 4;
  const int hd = blockIdx.x & 15, head = hd >> 1, dir = hd & 1;
  const int rstart = blockIdx.x >> 4, rstep = gridDim.x >> 4;
  const u16* xa = U(p, 1);
  u16* ga = U(p, 2);
  u16* hown = dir == 0 ? U(p, 5) : U(p, 4);
  const u16* hoth = dir == 0 ? U(p, 4) : U(p, 5);
  unsigned long long* slot = (unsigned long long*)(p.ws + OFF_LB_BYTES);
  unsigned* stat = (unsigned*)(p.ws + OFF_LB_BYTES + LB_SLOT_BYTES);
  unsigned* cnt = stat + 20480;
  const unsigned ep = 2u * (unsigned)l;
  const unsigned tagb = ((unsigned)l + 1u) * 4u;
  bf16x8 bw[4][4];
  {
    const u16* wrg = WL(p, l) + W_RG;
#pragma unroll
    for (int jt = 0; jt < 4; ++jt) {
      int q = jt >> 1, col = w * 32 + (jt & 1) * 16 + lr;
      const u16* bp = wrg + (unsigned)((((dir * 2 + q) * 8 + head) * 128 + col) * 128 + quad * 8);
#pragma unroll
      for (int ks = 0; ks < 4; ++ks) bw[jt][ks] = *(const bf16x8*)(bp + ks * 32);
    }
  }
  float spl[2], brr[2], bii[2];
#pragma unroll
  for (int jc = 0; jc < 2; ++jc) {
    int cgl = head * 128 + w * 32 + jc * 16 + lr;
    float lm = p.lam[(l * 2 + dir) * D + cgl];
    spl[jc] = -8.f * 1.4426950408889634f * log1pf(expf(-lm));
    brr[jc] = -1.4426950408889634f * p.b_rg[((l * 2 + dir) * 2 + 0) * D + cgl];
    bii[jc] = -1.4426950408889634f * p.b_rg[((l * 2 + dir) * 2 + 1) * D + cgl];
  }
  const int c8 = tid & 15, tg = tid >> 4;
  float* sCw = (float*)(smem_raw + 69632);
  for (int i = tid; i < 640; i += 256) {
    int k = i >> 7, c = i & 127;
    sCw[i] = k < 4 ? p.conv_w[(l * 4 + k) * D + head * 128 + c] : p.conv_b[l * D + head * 128 + c];
  }
  __syncthreads();
  uint4 xr[7];
#define LOAD_XROWS(TT) do { const int _g0 = (TT) * 64; const int _sq = seq_of(_g0), _ss = seq_start(_sq), _se = _ss + seq_len(_sq); \
    _Pragma("unroll") for (int r_ = 0; r_ < 7; ++r_) { int _g = _g0 + tg * 4 - 2 + r_; xr[r_] = make_uint4(0, 0, 0, 0); \
      if (_g >= _ss && _g < _se) xr[r_] = *(const uint4*)(xa + ((unsigned)_g * D + head * 128 + c8 * 8)); } } while (0)
  if (rstart < 1280) { int sq_, ps_, t0_; lb_decode(rstart, dir, sq_, ps_, t0_); LOAD_XROWS(t0_); }
  for (int r = rstart; r < 1280; r += rstep) {
    int seq, pos, tt;
    lb_decode(r, dir, seq, pos, tt);
    const int item = r * 16 + hd;
    const int g0 = tt * 64;
    const int sst = seq_start(seq), send = sst + seq_len(seq);
#pragma unroll
    for (int j = 0; j < 4; ++j) {
      float o[8];
      {
        float4 b0 = *(const float4*)(sCw + 512 + c8 * 8), b1 = *(const float4*)(sCw + 512 + c8 * 8 + 4);
        o[0] = b0.x; o[1] = b0.y; o[2] = b0.z; o[3] = b0.w; o[4] = b1.x; o[5] = b1.y; o[6] = b1.z; o[7] = b1.w;
      }
#pragma unroll
      for (int k = 0; k < 4; ++k) {
        uint4 v = xr[j + k];
        float4 w0 = *(const float4*)(sCw + k * 128 + c8 * 8), w1 = *(const float4*)(sCw + k * 128 + c8 * 8 + 4);
        o[0] += w0.x * lo2f(v.x); o[1] += w0.y * hi2f(v.x);
        o[2] += w0.z * lo2f(v.y); o[3] += w0.w * hi2f(v.y);
        o[4] += w1.x * lo2f(v.z); o[5] += w1.y * hi2f(v.z);
        o[6] += w1.z * lo2f(v.w); o[7] += w1.w * hi2f(v.w);
      }
      uint4 q0;
      q0.x = pack2(o[0], o[1]); q0.y = pack2(o[2], o[3]); q0.z = pack2(o[4], o[5]); q0.w = pack2(o[6], o[7]);
      const int tl = tg * 4 + j;
      *(uint4*)(sXc + tl * 128 + ((c8 ^ (tl & 7)) << 3)) = q0;
    }
    __syncthreads();
    if (r + rstep < 1280) { int sq_, ps_, t1_; lb_decode(r + rstep, dir, sq_, ps_, t1_); LOAD_XROWS(t1_); }
    const int gstart = dir == 0 ? sst : send - 1;
#pragma unroll 1
    for (int hv = 0; hv < 2; ++hv) {
      f32x4 acc[2][4];
#pragma unroll
      for (int it = 0; it < 2; ++it)
#pragma unroll
        for (int jt = 0; jt < 4; ++jt) acc[it][jt] = f32x4{0.f, 0.f, 0.f, 0.f};
#pragma unroll
      for (int ks = 0; ks < 4; ++ks) {
#pragma unroll
        for (int it = 0; it < 2; ++it) {
          bf16x8 af = *(const bf16x8*)(sXc + ((hv * 2 + it) * 16 + lr) * 128 + (((ks * 4 + quad) ^ (lr & 7)) << 3));
#pragma unroll
          for (int jt = 0; jt < 4; ++jt)
            acc[it][jt] = __builtin_amdgcn_mfma_f32_16x16x32_bf16(af, bw[jt][ks], acc[it][jt], 0, 0, 0);
        }
      }
#pragma unroll
      for (int it = 0; it < 2; ++it)
#pragma unroll
        for (int jc = 0; jc < 2; ++jc) {
          float av[4], bv[4];
          const int c = w * 32 + jc * 16 + lr, t0 = (hv * 2 + it) * 16 + quad * 4;
#pragma unroll
          for (int r = 0; r < 4; ++r) {
            const int tl = t0 + r;
            float rr = __builtin_amdgcn_rcpf(1.f + __builtin_amdgcn_exp2f(fmaf(acc[it][jc][r], -1.4426950408889634f, brr[jc])));
            float ii = __builtin_amdgcn_rcpf(1.f + __builtin_amdgcn_exp2f(fmaf(acc[it][2 + jc][r], -1.4426950408889634f, bii[jc])));
            float a = __builtin_amdgcn_exp2f(rr * spl[jc]);
            float mult = __builtin_amdgcn_sqrtf(fmaxf(fmaf(-a, a, 1.f), 0.f));
            if (g0 + tl == gstart) mult = 1.f;
            float xv = bf2f(sXc[tl * 128 + (((c >> 3) ^ (tl & 7)) << 3) + (c & 7)]);
            av[r] = a;
            bv[r] = mult * ii * xv;
          }
          *(float4*)(sAt + c * 68 + t0) = make_float4(av[0], av[1], av[2], av[3]);
          uint2 bq; bq.x = pack2(bv[0], bv[1]); bq.y = pack2(bv[2], bv[3]);
          *(uint2*)(sBt + c * 72 + t0) = bq;
        }
    }
    __syncthreads();
    const int sc_c = tid & 127, sc_part = tid >> 7;
    float2* sEx = (float2*)(smem_raw + 72208);
    float* sCar = (float*)(sEx + 256);
    float partP = 1.f, partH = 0.f;
    {
      const float* ap = sAt + sc_c * 68;
      const u16* bp = sBt + sc_c * 72;
#pragma unroll
      for (int gq = 0; gq < 8; ++gq) {
        const int t = dir == 0 ? sc_part * 32 + gq * 4 : 60 - sc_part * 32 - gq * 4;
        const float4 a4 = *(const float4*)(ap + t);
        const uint2 b4 = *(const uint2*)(bp + t);
        if (dir == 0) {
          partH = a4.x * partH + lo2f(b4.x); partH = a4.y * partH + hi2f(b4.x);
          partH = a4.z * partH + lo2f(b4.y); partH = a4.w * partH + hi2f(b4.y);
        } else {
          partH = a4.w * partH + hi2f(b4.y); partH = a4.z * partH + lo2f(b4.y);
          partH = a4.y * partH + hi2f(b4.x); partH = a4.x * partH + lo2f(b4.x);
        }
        partP *= (a4.x * a4.y) * (a4.z * a4.w);
      }
      sEx[sc_part * 128 + sc_c] = make_float2(partP, partH);
    }
    __syncthreads();
    float carry = 0.f;
    if (tid < 128) {
      const float2 e1 = sEx[128 + tid];
      const float aggP = partP * e1.x, aggH = e1.x * partH + e1.y;
      lb_st64(slot + (unsigned)item * 128 + tid, lb_gran(pos == 0 ? 0.f : aggP, aggH, tagb + (pos == 0 ? 2u : 1u)));
      if (pos > 0) {
        float Pr = 1.f, Hr = 0.f;
        int pj = pos - 1;
        for (;;) {
          const int j = lb_rank(seq, pj) * 16 + hd;
          unsigned long long v;
          unsigned spins = 0;
          for (;;) {
            v = lb_ld64(slot + (unsigned)j * 128 + tid);
            unsigned tg_ = (unsigned)v & 0xffu;
            if ((tg_ >> 2) == (tagb >> 2) && (tg_ & 3u) != 0u) break;
            __builtin_amdgcn_s_sleep(1);
            if (++spins > (1u << 18)) break;
          }
          float Pj = __uint_as_float((unsigned)v & 0xffffff00u), Hj = __uint_as_float((unsigned)(v >> 32));
          Hr += Pr * Hj;
          Pr *= Pj;
          if (((unsigned)v & 3u) == 2u || pj == 0) break;
          --pj;
        }
        carry = Hr;
        lb_st64(slot + (unsigned)item * 128 + tid, lb_gran(0.f, aggP * carry + aggH, tagb + 2u));
      }
      sCar[tid] = partP * carry + partH;
    }
    __syncthreads();
    {
      const float* ap = sAt + sc_c * 68;
      const u16* bp = sBt + sc_c * 72;
      u16* hp = sBh + sc_c;
      float h = sc_part == 0 ? carry : sCar[sc_c];
#pragma unroll
      for (int gq = 0; gq < 8; ++gq) {
        const int t = dir == 0 ? sc_part * 32 + gq * 4 : 60 - sc_part * 32 - gq * 4;
        const float4 a4 = *(const float4*)(ap + t);
        const uint2 b4 = *(const uint2*)(bp + t);
        if (dir == 0) {
          h = a4.x * h + lo2f(b4.x); hp[(t + 0) * 128] = f2bf(h);
          h = a4.y * h + hi2f(b4.x); hp[(t + 1) * 128] = f2bf(h);
          h = a4.z * h + lo2f(b4.y); hp[(t + 2) * 128] = f2bf(h);
          h = a4.w * h + hi2f(b4.y); hp[(t + 3) * 128] = f2bf(h);
        } else {
          h = a4.w * h + hi2f(b4.y); hp[(t + 3) * 128] = f2bf(h);
          h = a4.z * h + lo2f(b4.y); hp[(t + 2) * 128] = f2bf(h);
          h = a4.y * h + hi2f(b4.x); hp[(t + 1) * 128] = f2bf(h);
          h = a4.x * h + lo2f(b4.x); hp[(t + 0) * 128] = f2bf(h);
        }
      }
    }
    __syncthreads();
    const int len_ = seq == 0 ? 256 : 128;
    const int ppos = len_ - 1 - pos;
    if (pos < ppos) {
#pragma unroll
      for (int cch = 0; cch < 4; ++cch) {
        int chunk = tid + cch * 256;
        int t = chunk >> 4, cc = (chunk & 15) * 8;
        unsigned off = (unsigned)(g0 + t) * D + head * 128 + cc;
        uint4 hv = *(const uint4*)(sBh + t * 128 + cc);
        unsigned long long* q = (unsigned long long*)(hown + off);
        lb_st64(q, (unsigned long long)hv.x | ((unsigned long long)hv.y << 32));
        lb_st64(q + 1, (unsigned long long)hv.z | ((unsigned long long)hv.w << 32));
      }
      asm volatile("s_waitcnt vmcnt(0)" ::: "memory");
      __syncthreads();
      if (tid == 0) lb_st32(stat + item, (unsigned)l + 1u);
    } else {
      const int pit = lb_rank(seq, ppos) * 16 + (hd ^ 1);
      unsigned spins = 0;
      while (lb_ld32(stat + pit) != (unsigned)l + 1u) { __builtin_amdgcn_s_sleep(1); if (++spins > (1u << 18)) break; }
#pragma unroll
      for (int cch = 0; cch < 4; ++cch) {
        int chunk = tid + cch * 256;
        int t = chunk >> 4, cc = (chunk & 15) * 8;
        unsigned off = (unsigned)(g0 + t) * D + head * 128 + cc;
        uint4 hv = *(const uint4*)(sBh + t * 128 + cc);
        const unsigned long long* q = (const unsigned long long*)(hoth + off);
        unsigned long long f0 = lb_ld64(q), f1 = lb_ld64(q + 1);
        uint4 fv = make_uint4((unsigned)f0, (unsigned)(f0 >> 32), (unsigned)f1, (unsigned)(f1 >> 32));
        uint4 gv = *(const uint4*)(ga + off);
        uint4 o;
        o.x = pack2((lo2f(fv.x) + lo2f(hv.x)) * lo2f(gv.x), (hi2f(fv.x) + hi2f(hv.x)) * hi2f(gv.x));
        o.y = pack2((lo2f(fv.y) + lo2f(hv.y)) * lo2f(gv.y), (hi2f(fv.y) + hi2f(hv.y)) * hi2f(gv.y));
        o.z = pack2((lo2f(fv.z) + lo2f(hv.z)) * lo2f(gv.z), (hi2f(fv.z) + hi2f(hv.z)) * hi2f(gv.z));
        o.w = pack2((lo2f(fv.w) + lo2f(hv.w)) * lo2f(gv.w), (hi2f(fv.w) + hi2f(hv.w)) * hi2f(gv.w));
        *(uint4*)(ga + off) = o;
      }
    }
    __syncthreads();
  }
#undef LOAD_XROWS
}

DEVFN void phase_carry(const Params& p) {
  const float2* __restrict__ agg = (const float2*)U(p, 4);
  float* __restrict__ carry = (float*)(agg + 1280L * 2 * 1024);
  const int lane = threadIdx.x & 63, w = threadIdx.x >> 6;
  for (int u = blockIdx.x + gridDim.x * w; u < 288; u += gridDim.x * 4) {
    int id = u * 64 + lane;
    int seq = id >> 11, dir = (id >> 10) & 1, c = id & 1023;
    int nt = seq_len(seq) >> 6, tile0 = seq_start(seq) >> 6;
    float h = 0.f;
#pragma unroll 8
    for (int k = 0; k < nt; ++k) {
      int tt = tile0 + (dir ? nt - 1 - k : k);
      unsigned ix = (unsigned)(tt * 2 + dir) * 1024 + c;
      float2 v = agg[ix];
      carry[ix] = h;
      h = v.x * h + v.y;
    }
  }
}

DEVFN void phase_merge(const Params& p, int l, u16* smem) {
  const u16* wl = WL(p, l);
  u16* mo = U(p, 1);
  u16* tb = U(p, 5);
  u16* so = smem;
  for (int it = 0;; ++it) {
    int mt, nt;
    if (!tile_xcd(it, 1, 8, mt, nt)) break;
    const int g0 = mt * 256;
#pragma unroll 1
    for (int br = 0; br < 2; ++br) {
      {
        const int tid = otid(), lane = tid & 63, w = tid >> 6, wm = w >> 1, wn = w & 1, lr = lane & 15, quad = lane >> 4;
        f32x4 acc[8][4]; zero_acc8(acc);
        LdPlain lb; lb.init(tid, wl + (br == 0 ? W_A : W_B), nt * 128, D);
        if (br == 0) {
          LdPlain la; la.init(tid, U(p, 2), g0, D);
          gemm_core_b(tid, acc, 32, la, lb, smem);
        } else {
          const int seq = seq_of(g0);
          LdPerm la; la.base = U(p, 3); la.g0 = g0; la.sst = seq_start(seq); la.lg = seq == 0 ? 7 : 6;
          gemm_core_b(tid, acc, 32, la, lb, smem);
        }
#pragma unroll
        for (int i = 0; i < 8; ++i) {
          const int m = wm * 128 + i * 16 + lr;
#pragma unroll
          for (int j = 0; j < 4; ++j) {
            const int n = wn * 64 + j * 16 + quad * 4;
            uint2 o; o.x = pack2(acc[i][j][0], acc[i][j][1]); o.y = pack2(acc[i][j][2], acc[i][j][3]);
            *(uint2*)(so + m * 136 + n) = o;
          }
        }
        __syncthreads();
#pragma unroll
        for (int c = 0; c < 16; ++c) {
          const int idx = tid + c * 256;
          const int row = idx >> 4, ch = idx & 15;
          *(uint4*)(tb + ((unsigned)(g0 + row) * D + nt * 128 + ch * 8)) = *(const uint4*)(so + row * 136 + ch * 8);
        }
        __syncthreads();
      }
      {
        const int tid = otid(), lane = tid & 63, w = tid >> 6, wm = w >> 1, wn = w & 1, lr = lane & 15, quad = lane >> 4;
        f32x4 acc[8][4]; zero_acc8(acc);
        LdPlain la; la.init(tid, U(p, 0), g0, D);
        LdPlain lb; lb.init(tid, wl + W_CAT, 5120 + br * 1024 + nt * 128, D);
        gemm_core_b(tid, acc, 32, la, lb, smem);
#pragma unroll
        for (int c = 0; c < 16; ++c) {
          const int idx = tid + c * 256;
          const int row = idx >> 4, ch = idx & 15;
          *(uint4*)(so + row * 136 + ch * 8) = *(const uint4*)(tb + ((unsigned)(g0 + row) * D + nt * 128 + ch * 8));
        }
        __syncthreads();
#pragma unroll
        for (int i = 0; i < 8; ++i) {
          const int m = wm * 128 + i * 16 + lr;
#pragma unroll
          for (int j = 0; j < 4; ++j) {
            const int n = wn * 64 + j * 16 + quad * 4;
            uint2 tv = *(const uint2*)(so + m * 136 + n);
            acc[i][j][0] = sigm(acc[i][j][0]) * lo2f(tv.x);
            acc[i][j][1] = sigm(acc[i][j][1]) * hi2f(tv.x);
            acc[i][j][2] = sigm(acc[i][j][2]) * lo2f(tv.y);
            acc[i][j][3] = sigm(acc[i][j][3]) * hi2f(tv.y);
          }
        }
        if (br == 1) {
          __syncthreads();
#pragma unroll
          for (int c = 0; c < 16; ++c) {
            const int idx = tid + c * 256;
            const int row = idx >> 4, ch = idx & 15;
            *(uint4*)(so + row * 136 + ch * 8) = *(const uint4*)(mo + ((unsigned)(g0 + row) * D + nt * 128 + ch * 8));
          }
          __syncthreads();
#pragma unroll
          for (int i = 0; i < 8; ++i) {
            const int m = wm * 128 + i * 16 + lr;
#pragma unroll
            for (int j = 0; j < 4; ++j) {
              const int n = wn * 64 + j * 16 + quad * 4;
              uint2 pv = *(const uint2*)(so + m * 136 + n);
              acc[i][j][0] += lo2f(pv.x); acc[i][j][1] += hi2f(pv.x);
              acc[i][j][2] += lo2f(pv.y); acc[i][j][3] += hi2f(pv.y);
            }
          }
        }
        __syncthreads();
#pragma unroll
        for (int i = 0; i < 8; ++i) {
          const int m = wm * 128 + i * 16 + lr;
#pragma unroll
          for (int j = 0; j < 4; ++j) {
            const int n = wn * 64 + j * 16 + quad * 4;
            uint2 o; o.x = pack2(acc[i][j][0], acc[i][j][1]); o.y = pack2(acc[i][j][2], acc[i][j][3]);
            *(uint2*)(so + m * 136 + n) = o;
          }
        }
        __syncthreads();
#pragma unroll
        for (int c = 0; c < 16; ++c) {
          const int idx = tid + c * 256;
          const int row = idx >> 4, ch = idx & 15;
          *(uint4*)(mo + ((unsigned)(g0 + row) * D + nt * 128 + ch * 8)) = *(const uint4*)(so + row * 136 + ch * 8);
        }
        __syncthreads();
      }
    }
  }
}

DEVFN void phase_out(const Params& p, int l, u16* smem) {
  const u16* wo = WL(p, l) + W_O;
  for (int it = 0;; ++it) {
    int mt, nt;
    if (!tile_xcd(it, 1, 8, mt, nt)) break;
    const int tid = otid(), lane = tid & 63, w = tid >> 6, wm = w >> 1, wn = w & 1, lr = lane & 15, quad = lane >> 4;
    const int g0 = mt * 256;
    LdPlain la; la.init(tid, U(p, 1), g0, D);
    LdPlain lb; lb.init(tid, wo, nt * 128, D);
    f32x4 acc[8][4]; zero_acc8(acc);
    gemm_core_b(tid, acc, 32, la, lb, smem);
    const float* gate = MOD(p) + ((long)l * 9 + seq_of(g0)) * 3072 + 2048;
#pragma unroll
    for (int i = 0; i < 8; ++i) {
      unsigned g = g0 + wm * 128 + i * 16 + lr;
      const float* xb = (l == 0) ? (g0 < 16384 ? p.x_prompt : p.x_sample) : p.out;
      const float* xr = xb + (unsigned)((l == 0 && g0 >= 16384) ? g - 16384 : g) * D;
      float* orow = p.out + g * D;
#pragma unroll
      for (int j = 0; j < 4; ++j) {
        unsigned c = nt * 128 + wn * 64 + j * 16 + quad * 4;
        float4 xv = *(const float4*)(xr + c);
        float4 gt = *(const float4*)(gate + c);
        float4 o;
        o.x = xv.x + gt.x * acc[i][j][0]; o.y = xv.y + gt.y * acc[i][j][1];
        o.z = xv.z + gt.z * acc[i][j][2]; o.w = xv.w + gt.w * acc[i][j][3];
        *(float4*)(orow + c) = o;
      }
    }
  }
}

#define XB_TMO      128
#define XB_XCNT(j)  (256  + 64 * (j))
#define XB_XSUB(j)  (1280 + 64 * (j))
#define XB_XGEN(j)  (2304 + 64 * (j))
#define XB_TOP      3328
#define XB_TOPGEN   3392
#define XCD_BAR_WORDS 3456
#define XB_SPIN_CAP (1u << 18)
#define LAS __attribute__((address_space(3)))

__device__ __forceinline__ unsigned xb_ld(unsigned* p)              { return __hip_atomic_load(p, __ATOMIC_RELAXED, __HIP_MEMORY_SCOPE_AGENT); }
__device__ __forceinline__ unsigned xb_add(unsigned* p, unsigned v) { return __hip_atomic_fetch_add(p, v, __ATOMIC_RELAXED, __HIP_MEMORY_SCOPE_AGENT); }
__device__ __forceinline__ unsigned xb_xcc_id() { return (unsigned)__builtin_amdgcn_s_getreg((3 << 11) | 20) & 0xFu; }
#define XB_SPIN(cond, bar) do { unsigned _sp = 0; while (cond) { __builtin_amdgcn_s_sleep(1); \
    if ((++_sp & 255u) == 0u) { if (xb_ld(&(bar)[XB_TMO])) break; if (_sp > XB_SPIN_CAP) { atomicAdd(&(bar)[XB_TMO], 1u); break; } } } } while (0)

struct XcdBarrier {
    unsigned* bar; unsigned x;
    volatile LAS unsigned* st;
};

__device__ __forceinline__ XcdBarrier xcd_barrier_post(unsigned* bar, volatile LAS unsigned* st) {
    XcdBarrier b; b.bar = bar; b.x = xb_xcc_id(); b.st = st;
    if (threadIdx.x == 0) (void)xb_add(&bar[XB_XCNT(b.x)], 1u);
    return b;
}
__device__ __forceinline__ void xcd_barrier_complete(unsigned* bar, unsigned x, unsigned& nloc, unsigned& nx) {
    const unsigned G = gridDim.x * gridDim.y * gridDim.z;
    unsigned sum, cnt, mine, sp = 0u;
    for (;;) {
        sum = 0u; cnt = 0u; mine = 0u;
#pragma unroll
        for (unsigned j = 0; j < 16; ++j) { const unsigned c = xb_ld(&bar[XB_XCNT(j)]); sum += c; cnt += (c > 0u) ? 1u : 0u; mine = (j == x) ? c : mine; }
        if (sum == G) break;
        __builtin_amdgcn_s_sleep(1);
        if ((++sp & 255u) == 0u) { if (xb_ld(&bar[XB_TMO])) break; if (sp > XB_SPIN_CAP) { atomicAdd(&bar[XB_TMO], 1u); break; } }
    }
    nloc = mine > 0u ? mine : 1u; nx = cnt > 0u ? cnt : 1u;
}

__device__ __forceinline__ void xcd_barrier(const XcdBarrier& b) {
    asm volatile("s_waitcnt vmcnt(0)" ::: "memory");
    __syncthreads();
    if (threadIdx.x == 0) {
        unsigned* bar = b.bar;
        __builtin_amdgcn_s_waitcnt(0);
        unsigned nloc = b.st[0], nx = b.st[1];
        if (nloc == 0u) { xcd_barrier_complete(bar, b.x, nloc, nx); b.st[0] = nloc; b.st[1] = nx; }
        const unsigned old = xb_add(&bar[XB_XSUB(b.x)], 1u);
        const unsigned gen = old / nloc;
        if (old + 1u == (gen + 1u) * nloc) {
            __builtin_amdgcn_fence(__ATOMIC_RELEASE, "agent");
            asm volatile("s_waitcnt vmcnt(0)" ::: "memory");
            const unsigned og = xb_add(&bar[XB_TOP], 1u);
            const unsigned tg = og / nx;
            if (og + 1u == (tg + 1u) * nx) xb_add(&bar[XB_TOPGEN], 1u);
            else XB_SPIN(xb_ld(&bar[XB_TOPGEN]) == tg, bar);
            __builtin_amdgcn_fence(__ATOMIC_ACQUIRE, "agent");
            xb_add(&bar[XB_XGEN(b.x)], 1u);
            asm volatile("s_waitcnt vmcnt(0)" ::: "memory");
        } else {
            XB_SPIN(xb_ld(&bar[XB_XGEN(b.x)]) == gen, bar);
            __builtin_amdgcn_fence(__ATOMIC_ACQUIRE, "agent");
            asm volatile("s_waitcnt vmcnt(0)" ::: "memory");
        }
    }
    __syncthreads();
}


__global__ void __launch_bounds__(256, 2) hawk_fnet_megakernel(Params p) {
  extern __shared__ __attribute__((aligned(16))) unsigned char smem_raw[];
  cg::grid_group grid = cg::this_grid();
  u16* smem = (u16*)smem_raw;

  __shared__ unsigned xb_st[4];
  unsigned* bar = (unsigned*)(p.ws + OFF_BAR_BYTES);
  if (blockIdx.x == 0) {
    for (int i = threadIdx.x; i < XCD_BAR_WORDS; i += 256) __hip_atomic_store(&bar[i], 0u, __ATOMIC_RELAXED, __HIP_MEMORY_SCOPE_AGENT);
  }
  if (threadIdx.x < 4) xb_st[threadIdx.x] = 0u;
  {
    unsigned* lbs = (unsigned*)(p.ws + OFF_LB_BYTES + LB_SLOT_BYTES);
    for (int i = blockIdx.x * 256 + threadIdx.x; i < 20480 + 10240; i += gridDim.x * 256)
      __hip_atomic_store(&lbs[i], 0u, __ATOMIC_RELAXED, __HIP_MEMORY_SCOPE_AGENT);
    unsigned long long* lbq = (unsigned long long*)(p.ws + OFF_LB_BYTES);
    for (int i = blockIdx.x * 256 + threadIdx.x; i < (int)(LB_SLOT_BYTES / 8); i += gridDim.x * 256)
      __hip_atomic_store(&lbq[i], 0ull, __ATOMIC_RELAXED, __HIP_MEMORY_SCOPE_AGENT);
  }
  phase_prologue(p, smem_raw);
  grid.sync();
  XcdBarrier xb = xcd_barrier_post(bar, (volatile LAS unsigned*)xb_st);
  phase_fold(p, smem);
  phase_h(p, 0);
  xcd_barrier(xb);
  for (int l = 0; l < 2; ++l) {
    phase_gemm1(p, l, smem);
    xcd_barrier(xb);
    phase_fft1(p, smem);
    xcd_barrier(xb);
    phase_fft2(p, smem);
    xcd_barrier(xb);
    phase_scan_lb(p, l, smem_raw);
    xcd_barrier(xb);
    phase_merge(p, l, smem);
    xcd_barrier(xb);
    phase_out(p, l, smem);
    xcd_barrier(xb);
    if (l == 0) { phase_h(p, 1); xcd_barrier(xb); }
  }
  phase_final(p);
}

extern "C" void kernel_launch(void* const* d_in, const int* in_sizes, int n_in,
                              void* d_out, int out_size, void* d_ws, size_t ws_size,
                              hipStream_t stream) {
  (void)in_sizes; (void)n_in; (void)out_size;
  if (ws_size < (size_t)WS_NEED) {
    fprintf(stderr, "workspace too small: %zu < %ld\n", ws_size, (long)WS_NEED);
    return;
  }
  static int grid_blocks = 0;
  if (!grid_blocks) {
    hipFuncSetAttribute((const void*)hawk_fnet_megakernel, hipFuncAttributeMaxDynamicSharedMemorySize, SMEM_BYTES);
    int dev = 0, cus = 0, per_cu = 0;
    hipGetDevice(&dev);
    hipDeviceGetAttribute(&cus, hipDeviceAttributeMultiprocessorCount, dev);
    hipOccupancyMaxActiveBlocksPerMultiprocessor(&per_cu, hawk_fnet_megakernel, 256, SMEM_BYTES);
    if (per_cu > 2) per_cu = 2;
    if (per_cu < 1) per_cu = 1;
    grid_blocks = (cus * per_cu) & ~15;
  }
  Params p{};
  p.x_prompt = (const float*)d_in[0]; p.x_sample = (const float*)d_in[1];
  p.c_prompt = (const float*)d_in[2]; p.c_sample = (const float*)d_in[3];
  p.norm_g = (const float*)d_in[4]; p.w_ada = (const float*)d_in[5]; p.b_ada = (const float*)d_in[6];
  p.w_in = (const float*)d_in[7]; p.conv_w = (const float*)d_in[8]; p.conv_b = (const float*)d_in[9];
  p.w_rg = (const float*)d_in[10]; p.b_rg = (const float*)d_in[11]; p.lam = (const float*)d_in[12];
  p.w_a_out = (const float*)d_in[13]; p.w_b_out = (const float*)d_in[14]; p.w_o = (const float*)d_in[15];
  p.final_g = (const float*)d_in[16];
  p.out = (float*)d_out; p.ws = (unsigned char*)d_ws;
  void* args[] = {&p};
  hipError_t e = hipLaunchCooperativeKernel((void*)hawk_fnet_megakernel, dim3(grid_blocks), dim3(256), args, SMEM_BYTES, stream);
  if (e != hipSuccess) fprintf(stderr, "cooperative launch failed: %s (grid %d)\n", hipGetErrorString(e), grid_blocks);
}
```
